# Optimizing an MI355X kernel written in HIP

```python
import math
import jax, jax.numpy as jnp
from jax import lax
import numpy as np


D_MODEL = 1024
BATCH = 8
SEQ = 4096
DEPTH = 4

N_HEADS_DIFF = 8
HEAD_DIM_DIFF = 64
V_DIM_DIFF = 2 * HEAD_DIM_DIFF
Q_BLOCK = 128
N_HEADS_GLA = 4
KEY_DIM_GLA = D_MODEL // 2 // N_HEADS_GLA
VAL_DIM_GLA = D_MODEL // N_HEADS_GLA
GLA_RANK = 16
GLA_TAU = 16.0
GLA_CHUNK = 64
N_GROUPS = 4
EXPERTS_PER_GROUP = 8
N_EXPERTS = N_GROUPS * EXPERTS_PER_GROUP
TOP_K_IN_GROUP = 2
D_EXPERT = D_MODEL // 2
MOE_BLOCK = 128
LN_EPS = 1e-5
DEEPNORM_ALPHA = (2.0 * DEPTH) ** 0.25
DEEPNORM_BETA = (8.0 * DEPTH) ** -0.25
W_QA = N_HEADS_DIFF * 2 * HEAD_DIM_DIFF
W_KA = N_HEADS_DIFF * 2 * HEAD_DIM_DIFF
W_VA = N_HEADS_DIFF * V_DIM_DIFF
W_QB = N_HEADS_GLA * KEY_DIM_GLA
W_KB = N_HEADS_GLA * KEY_DIM_GLA
W_VB = N_HEADS_GLA * VAL_DIM_GLA
W_GB = N_HEADS_GLA * VAL_DIM_GLA
W_AB = GLA_RANK
W_GATES = 2 * D_MODEL
IN_WIDTHS = (W_QA, W_KA, W_VA, W_QB, W_KB, W_VB, W_GB, W_AB, W_GATES)
D_IN = W_QA + W_KA + W_VA + W_QB + W_KB + W_VB + W_GB + W_AB + W_GATES

kernel_name = 'hybrid_diffattn_gla_hmoe_deepnorm'


def _split_points():
    pts, acc = [], 0
    for w in IN_WIDTHS[:-1]:
        acc += w
        pts.append(acc)
    return pts


def _standardize_f32(x):
    xf = x.astype(jnp.float32)
    mu = jnp.mean(xf, axis=-1, keepdims=True)
    var = jnp.mean(jnp.square(xf - mu), axis=-1, keepdims=True)
    return (xf - mu) * lax.rsqrt(var + LN_EPS)


def _layer_norm(x, g, b):
    return (_standardize_f32(x) * g + b).astype(x.dtype)


def _rms_norm(x, g):
    xf = x.astype(jnp.float32)
    return xf * lax.rsqrt(jnp.mean(jnp.square(xf), axis=-1, keepdims=True) + LN_EPS) * g


def _modulate(x, shift, scale):
    return (_standardize_f32(x) * (1.0 + scale[:, None, :]) + shift[:, None, :]).astype(x.dtype)


def _alibi_slopes(n_heads):
    return jnp.asarray(2.0 ** (-8.0 * np.arange(1, n_heads + 1) / n_heads), dtype=jnp.float32)


def diff_attention(q, k, v, lam):
    slopes = _alibi_slopes(q.shape[1])
    scale = HEAD_DIM_DIFF ** -0.5
    n_blocks = q.shape[3] // Q_BLOCK
    outs = []
    for i in range(n_blocks):
        q0 = i * Q_BLOCK
        kv = q0 + Q_BLOCK
        s = jnp.einsum('bhcqd,bhckd->bhcqk', q[:, :, :, q0:kv], k[:, :, :, :kv]).astype(jnp.float32) * scale
        dist = (jnp.arange(q0, kv)[:, None] - jnp.arange(kv)[None, :]).astype(jnp.float32)
        bias = jnp.where(dist >= 0, -slopes[:, None, None] * dist, -jnp.inf)
        p = jax.nn.softmax(s + bias[None, :, None], axis=-1)
        a = (p[:, :, 0] - lam * p[:, :, 1]).astype(v.dtype)
        outs.append(jnp.einsum('bhqk,bhkd->bhqd', a, v[:, :, :kv]))
    return jnp.concatenate(outs, axis=2)


def gla_chunked(q, k, v, log_a):
    b_, h_, s_, dk = q.shape
    dv = v.shape[-1]
    n_chunks = s_ // GLA_CHUNK

    def to_chunks(t):
        return jnp.moveaxis(t.astype(jnp.float32).reshape(b_, h_, n_chunks, GLA_CHUNK, t.shape[-1]), 2, 0)

    causal = jnp.tril(jnp.ones((GLA_CHUNK, GLA_CHUNK), dtype=bool))

    def step(state, inp):
        qc, kc, vc, ac = inp
        cum = jnp.cumsum(ac, axis=2)
        o_inter = jnp.einsum('bhtk,bhkv->bhtv', qc * jnp.exp(cum), state)
        diff = cum[:, :, :, None, :] - cum[:, :, None, :, :]
        decay = jnp.exp(jnp.where(causal[:, :, None], diff, -jnp.inf))
        att = jnp.einsum('bhtk,bhsk,bhtsk->bhts', qc, kc, decay)
        o_intra = jnp.einsum('bhts,bhsv->bhtv', att, vc)
        last = cum[:, :, -1:, :]
        new_state = jnp.exp(last)[:, :, 0, :, None] * state + jnp.einsum('bhsk,bhsv->bhkv', kc * jnp.exp(last - cum), vc)
        return new_state, o_inter + o_intra

    state0 = jnp.zeros((b_, h_, dk, dv), jnp.float32)
    _, o = lax.scan(step, state0, (to_chunks(q), to_chunks(k), to_chunks(v), to_chunks(log_a)))
    return jnp.moveaxis(o, 0, 2).reshape(b_, h_, s_, dv)


def token_mixer(u, layer_idx, w_in, b_gates, w_alpha, b_alpha, lq1, lk1, lq2, lk2,
                diff_g, gla_g, w_ba, w_bb, w_out):
    b_, s_, _ = u.shape
    proj = u @ w_in
    qa, ka, va, qb, kb, vb, gb, ab, gates = jnp.split(proj, _split_points(), axis=-1)

    qa = qa.reshape(b_, s_, N_HEADS_DIFF, 2, HEAD_DIM_DIFF).transpose(0, 2, 3, 1, 4)
    ka = ka.reshape(b_, s_, N_HEADS_DIFF, 2, HEAD_DIM_DIFF).transpose(0, 2, 3, 1, 4)
    va = va.reshape(b_, s_, N_HEADS_DIFF, V_DIM_DIFF).transpose(0, 2, 1, 3)
    lam_init = 0.8 - 0.6 * math.exp(-0.3 * layer_idx)
    lam = (jnp.exp(jnp.sum(lq1.astype(jnp.float32) * lk1)) - jnp.exp(jnp.sum(lq2.astype(jnp.float32) * lk2)) + lam_init)
    oa = diff_attention(qa, ka, va, lam)
    oa = (_rms_norm(oa, diff_g) * (1.0 - lam_init)).astype(u.dtype)
    oa = oa.transpose(0, 2, 1, 3).reshape(b_, s_, W_VA)

    log_a = jax.nn.log_sigmoid((ab @ w_alpha + b_alpha).astype(jnp.float32)) / GLA_TAU
    heads_k = lambda t: t.reshape(b_, s_, N_HEADS_GLA, -1).transpose(0, 2, 1, 3)
    ob = gla_chunked(heads_k(qb * (KEY_DIM_GLA ** -0.5)), heads_k(kb), heads_k(vb), heads_k(log_a))
    ob = _rms_norm(ob, gla_g).transpose(0, 2, 1, 3).reshape(b_, s_, W_VB)
    ob = (ob * jax.nn.silu(gb.astype(jnp.float32))).astype(u.dtype)

    gate_a, gate_b = jnp.split(jax.nn.sigmoid(gates + b_gates), 2, axis=-1)
    mixed = gate_a * (oa @ w_ba) + gate_b * (ob @ w_bb)
    return mixed @ w_out


def hier_moe(u, w_rg, b_rg, w_re, b_re, wg, wu, wd):
    b_, s_, d_ = u.shape
    n_tok = b_ * s_
    uf = u.reshape(n_tok, d_)
    g_logits = (uf @ w_rg + b_rg).astype(jnp.float32)
    g_prob = jax.nn.softmax(g_logits, axis=-1)
    g_idx = jnp.argmax(g_logits, axis=-1).astype(jnp.int32)
    g_w = jnp.take_along_axis(g_prob, g_idx[:, None], axis=1)[:, 0]
    e_logits = (uf @ w_re + b_re).astype(jnp.float32).reshape(n_tok, N_GROUPS, EXPERTS_PER_GROUP)
    e_in = jnp.take_along_axis(e_logits, g_idx[:, None, None], axis=1)[:, 0]
    top_v, top_i = lax.top_k(e_in, TOP_K_IN_GROUP)
    weights = jax.nn.softmax(top_v, axis=-1) * g_w[:, None]

    expert_id = (g_idx[:, None] * EXPERTS_PER_GROUP + top_i).reshape(-1).astype(jnp.int32)
    token_id = jnp.repeat(jnp.arange(n_tok, dtype=jnp.int32), TOP_K_IN_GROUP)
    weight = weights.reshape(-1)
    n_assign = n_tok * TOP_K_IN_GROUP

    order = jnp.argsort(expert_id)
    se, st, sw = expert_id[order], token_id[order], weight[order]
    counts = jnp.bincount(expert_id, length=N_EXPERTS).astype(jnp.int32)
    starts = jnp.cumsum(counts) - counts
    padded = ((counts + MOE_BLOCK - 1) // MOE_BLOCK) * MOE_BLOCK
    pends = jnp.cumsum(padded)
    pstarts = pends - padded
    dest = pstarts[se] + (jnp.arange(n_assign, dtype=jnp.int32) - starts[se])
    n_rows = ((n_assign + MOE_BLOCK - 1) // MOE_BLOCK) * MOE_BLOCK + N_EXPERTS * MOE_BLOCK
    n_blocks = n_rows // MOE_BLOCK
    buf_tok = jnp.full((n_rows,), n_tok, jnp.int32).at[dest].set(st)
    buf_w = jnp.zeros((n_rows,), jnp.float32).at[dest].set(sw)
    blk_start = jnp.arange(n_blocks, dtype=jnp.int32) * MOE_BLOCK
    blk_e = jnp.minimum(jnp.searchsorted(pends, blk_start, side='right'), N_EXPERTS - 1).astype(jnp.int32)

    u_pad = jnp.concatenate([uf, jnp.zeros((1, d_), uf.dtype)], axis=0)
    xb = u_pad[buf_tok].reshape(n_blocks, MOE_BLOCK, d_)

    def expert_block(args):
        xblk, e = args
        h = jax.nn.silu(xblk @ wg[e]) * (xblk @ wu[e])
        return h @ wd[e]

    yb = lax.map(expert_block, (xb, blk_e)).reshape(n_rows, d_)
    y = jax.ops.segment_sum(yb.astype(jnp.float32) * buf_w[:, None], buf_tok, num_segments=n_tok + 1)[:n_tok]
    return y.astype(u.dtype).reshape(b_, s_, d_)


def setup_inputs(seed: int = 0) -> dict:
    key = jax.random.key(seed)
    ks = jax.random.split(key, 32)
    f32 = jnp.float32

    def nrm(k, shape, scale):
        return jax.random.normal(k, shape, f32) * scale

    d = D_MODEL
    col_scale = jnp.concatenate([
        jnp.ones((W_QA + W_KA,), f32), jnp.full((W_VA,), DEEPNORM_BETA, f32),
        jnp.ones((W_QB + W_KB,), f32), jnp.full((W_VB,), DEEPNORM_BETA, f32),
        jnp.ones((W_GB + W_AB + W_GATES,), f32)])
    return {
        'x': nrm(ks[0], (BATCH, SEQ, d), 1.0),
        'c': nrm(ks[1], (BATCH, d), 1.0),
        'w_ada': nrm(ks[2], (DEPTH, d, 6 * d), d ** -0.5),
        'b_ada': nrm(ks[3], (DEPTH, 6 * d), 0.02),
        'w_in': nrm(ks[4], (DEPTH, d, D_IN), d ** -0.5) * col_scale,
        'b_gates': nrm(ks[5], (DEPTH, W_GATES), 0.02),
        'w_alpha': nrm(ks[6], (DEPTH, GLA_RANK, W_QB), GLA_RANK ** -0.5),
        'b_alpha': nrm(ks[7], (DEPTH, W_QB), 0.02),
        'lambda_q1': nrm(ks[8], (DEPTH, HEAD_DIM_DIFF), 0.1),
        'lambda_k1': nrm(ks[9], (DEPTH, HEAD_DIM_DIFF), 0.1),
        'lambda_q2': nrm(ks[10], (DEPTH, HEAD_DIM_DIFF), 0.1),
        'lambda_k2': nrm(ks[11], (DEPTH, HEAD_DIM_DIFF), 0.1),
        'diff_norm_g': 1.0 + nrm(ks[12], (DEPTH, V_DIM_DIFF), 0.02),
        'gla_norm_g': 1.0 + nrm(ks[13], (DEPTH, VAL_DIM_GLA), 0.02),
        'w_branch_a': nrm(ks[14], (DEPTH, W_VA, d), W_VA ** -0.5),
        'w_branch_b': nrm(ks[15], (DEPTH, W_VB, d), W_VB ** -0.5),
        'w_out': nrm(ks[16], (DEPTH, d, d), d ** -0.5 * DEEPNORM_BETA),
        'ln1_g': 1.0 + nrm(ks[17], (DEPTH, d), 0.02),
        'ln1_b': nrm(ks[18], (DEPTH, d), 0.02),
        'w_router_g': nrm(ks[19], (DEPTH, d, N_GROUPS), d ** -0.5),
        'b_router_g': nrm(ks[20], (DEPTH, N_GROUPS), 0.01),
        'w_router_e': nrm(ks[21], (DEPTH, d, N_EXPERTS), d ** -0.5),
        'b_router_e': nrm(ks[22], (DEPTH, N_EXPERTS), 0.01),
        'w_gate_e': nrm(ks[23], (DEPTH, N_EXPERTS, d, D_EXPERT), d ** -0.5),
        'w_up_e': nrm(ks[24], (DEPTH, N_EXPERTS, d, D_EXPERT), d ** -0.5 * DEEPNORM_BETA),
        'w_down_e': nrm(ks[25], (DEPTH, N_EXPERTS, D_EXPERT, d), D_EXPERT ** -0.5 * DEEPNORM_BETA),
        'ln2_g': 1.0 + nrm(ks[26], (DEPTH, d), 0.02),
        'ln2_b': nrm(ks[27], (DEPTH, d), 0.02),
    }


def reference(x, c, w_ada, b_ada, w_in, b_gates, w_alpha, b_alpha, lambda_q1, lambda_k1,
              lambda_q2, lambda_k2, diff_norm_g, gla_norm_g, w_branch_a, w_branch_b, w_out,
              ln1_g, ln1_b, w_router_g, b_router_g, w_router_e, b_router_e, w_gate_e, w_up_e,
              w_down_e, ln2_g, ln2_b):
    cond = jax.nn.silu(c)
    for l in range(DEPTH):
        ada = cond @ w_ada[l] + b_ada[l]
        sh1, sc1, g1, sh2, sc2, g2 = jnp.split(ada, 6, axis=-1)
        u = _modulate(x, sh1, sc1)
        y = token_mixer(u, l, w_in[l], b_gates[l], w_alpha[l], b_alpha[l],
                        lambda_q1[l], lambda_k1[l], lambda_q2[l], lambda_k2[l],
                        diff_norm_g[l], gla_norm_g[l], w_branch_a[l], w_branch_b[l], w_out[l])
        x = _layer_norm(DEEPNORM_ALPHA * x + g1[:, None, :] * y, ln1_g[l], ln1_b[l])
        u = _modulate(x, sh2, sc2)
        y = hier_moe(u, w_router_g[l], b_router_g[l], w_router_e[l], b_router_e[l],
                     w_gate_e[l], w_up_e[l], w_down_e[l])
        x = _layer_norm(DEEPNORM_ALPHA * x + g2[:, None, :] * y, ln2_g[l], ln2_b[l])
    return x
```

```cpp
#include <hip/hip_runtime.h>
#include <hip/hip_bf16.h>
#include <cstdio>
#include <cstdint>
#include <cmath>
namespace pg8 {
#define PG8_LAS __attribute__((address_space(3)))
typedef unsigned short bf16_t;
typedef short bf16x8 __attribute__((ext_vector_type(8)));
typedef float f32x4 __attribute__((ext_vector_type(4)));
typedef float f32x2 __attribute__((ext_vector_type(2)));
typedef unsigned u32x4 __attribute__((ext_vector_type(4)));
typedef unsigned u32x2 __attribute__((ext_vector_type(2)));
constexpr int BM = 256, BK = 64, HALF = 128, HTB = HALF * BK * 2  , STAGE_BYTES = 8 * HTB, NXCD = 8, WGM = 8;

__host__ __device__ __forceinline__ int lds_byte(int r, int c) { const int st = (r >> 4) * 2 + (c >> 5), rr = r & 15, cc = c & 31, ob = rr * 64 + cc * 2; return st * 1024 + (ob ^ (((ob >> 9) & 1) << 5)); }
__host__ __device__ __forceinline__ void stage_rc(int b, int& R, int& C) { const int st = b / 1024, sb = b % 1024, swz = sb ^ (((sb >> 9) & 1) << 5); R = (st >> 1) * 16 + swz / 64; C = (st & 1) * 32 + (swz % 64) / 2; }
__host__ __device__ __forceinline__ int perm32(int rho) { const int n = rho >> 4, i = rho & 15; return 8 * (i >> 2) + 4 * n + (i & 3); }

struct Unit { int pm, pn, pb; };
struct Gemm { const bf16_t* A; const bf16_t* Bt; int M, N, K; };

struct StaticOrder {
    int nM, nN, nwg, G, c;
    __host__ __device__ void init(int M, int N, int G_, int c_) { nM = M / BM; nN = N / BM; nwg = nM * nN; G = G_; c = c_; }
    __host__ __device__ bool next(int i, Unit& u) const {
        const long L = (long)i * G + c; if (L >= nwg) return false;
        int wgid = (int)L; { const int q = nwg / NXCD, r = nwg % NXCD, xcd = wgid % NXCD, off = wgid / NXCD; wgid = (xcd < r ? xcd * (q + 1) : r * (q + 1) + (xcd - r) * q) + off; }
        const int nig = WGM * nN, gid = wgid / nig, fm = gid * WGM, gsz = (nM - fm) < WGM ? (nM - fm) : WGM;
        u.pm = fm + ((wgid % nig) % gsz); u.pn = (wgid % nig) / gsz; u.pb = u.pn; return true;
    }
};

__device__ __forceinline__ unsigned cvt_pk_bf16(float lo, float hi) { unsigned r; asm volatile("v_cvt_pk_bf16_f32 %0, %1, %2" : "=v"(r) : "v"(lo), "v"(hi)); return r; }
__device__ __forceinline__ float bf_lo(unsigned w) { return __uint_as_float(w << 16); }
__device__ __forceinline__ float bf_hi(unsigned w) { return __uint_as_float(w & 0xffff0000u); }
__device__ __forceinline__ float sigmoidf_(float x) { return __builtin_amdgcn_rcpf(1.0f + __expf(-x)); }

template <class Epi, class Sched, bool ALIGN_EPI, bool GATHER>
__device__ __forceinline__ void gemm_phase(PG8_LAS unsigned char* lds, const Gemm g, const Sched& S, const Epi& E, const PG8_LAS int* idxtab) {
    int tid_ = threadIdx.x; asm volatile("" : "+v"(tid_));
    const int tid = tid_, wid = __builtin_amdgcn_readfirstlane(tid >> 6), lane = tid & 63, wr = wid >> 2, wc = wid & 3, fr = lane & 15, fq = lane >> 4;
    const int K = g.K, nt = K / BK;
    unsigned voffA[2], voffB[2];
#pragma unroll
    for (int i = 0; i < 2; ++i) { int R, C; stage_rc(tid * 16 + i * 8192, R, C); const int Rb = Epi::PERM ? ((R & ~31) + perm32(R & 31)) : R;
        voffA[i] = (unsigned)(R * K + C) * 2u; voffB[i] = (unsigned)(Rb * K + C) * 2u; }
    const size_t kstep = (size_t)(BK * 2);
    const size_t hstep = (size_t)HALF * K * 2;
    const size_t tstep = 2 * hstep;
    const unsigned ldsw = (unsigned)wid * 1024u;
    const int aoff = lds_byte(wr * 64 + fr, fq * 8), boff = lds_byte(wc * 32 + fr, fq * 8);
    unsigned offAc[2][2];
    int nui = 0;
#define PG8_SA(b, h) (((b) * 2 + (h)) * HTB)
#define PG8_SB(b, h) ((4 + (b) * 2 + (h)) * HTB)
#define PG8_STAGE(bufoff, gbase, voff) do { _Pragma("unroll") for (int _i = 0; _i < 2; ++_i) \
        __builtin_amdgcn_global_load_lds((const unsigned*)((const char*)(gbase) + (voff)[_i]), (PG8_LAS unsigned*)(lds + (bufoff) + ldsw + _i * 8192), 16, 0, 0); } while (0)
#define PG8_GOFF(uix, h, i, tt) ({ int _R, _C; stage_rc((tt) * 16 + (i) * 8192, _R, _C); (unsigned)idxtab[(uix) * 256 + (h) * HALF + _R] * (unsigned)(K * 2) + (unsigned)_C * 2u; })
#define PG8_STAGE_A(bufoff, kb, h, nx) do { if constexpr (GATHER) { unsigned _o[2] = {offAc[h][0], offAc[h][1]}; \
        if (nx) { int _t = tid; asm volatile("" : "+v"(_t)); _o[0] = PG8_GOFF(nui, h, 0, _t); _o[1] = PG8_GOFF(nui, h, 1, _t); } \
        _Pragma("unroll") for (int _i = 0; _i < 2; ++_i) \
        __builtin_amdgcn_global_load_lds((const unsigned*)((const char*)g.A + (size_t)(kb) + _o[_i]), (PG8_LAS unsigned*)(lds + (bufoff) + ldsw + _i * 8192), 16, 0, 0); } \
        else { const char* _b = ((nx) ? nA : cA) + (size_t)(kb) + (size_t)(h) * hstep; PG8_STAGE(bufoff, _b, voffA); } } while (0)
#define PG8_GIDX(dst, uix) do { if constexpr (GATHER) { int _t = tid; asm volatile("" : "+v"(_t)); _Pragma("unroll") for (int _h = 0; _h < 2; ++_h) _Pragma("unroll") for (int _i = 0; _i < 2; ++_i) \
        dst[_h][_i] = PG8_GOFF(uix, _h, _i, _t); } } while (0)
#define PG8_LDA(dst, b, h) do { _Pragma("unroll") for (int m = 0; m < 4; ++m) _Pragma("unroll") for (int k = 0; k < 2; ++k) dst[m][k] = *(const PG8_LAS bf16x8*)(lds + PG8_SA(b, h) + aoff + m * 2048 + k * 1024); } while (0)
#define PG8_LDB(dst, b, h) do { _Pragma("unroll") for (int n = 0; n < 2; ++n) _Pragma("unroll") for (int k = 0; k < 2; ++k) dst[n][k] = *(const PG8_LAS bf16x8*)(lds + PG8_SB(b, h) + boff + n * 2048 + k * 1024); } while (0)
#define PG8_MMA(ai, bj, At, Bt) do { __builtin_amdgcn_s_setprio(1); _Pragma("unroll") for (int m = 0; m < 4; ++m) _Pragma("unroll") for (int n = 0; n < 2; ++n) _Pragma("unroll") for (int k = 0; k < 2; ++k) \
        acc[ai][bj][m][n] = __builtin_amdgcn_mfma_f32_16x16x32_bf16(Bt[n][k], At[m][k], acc[ai][bj][m][n], 0, 0, 0); __builtin_amdgcn_s_setprio(0); } while (0)
#define PG8_WAIT_V(n) asm volatile("s_waitcnt vmcnt(" #n ")" ::: "memory")
#define PG8_WAIT_L(n) asm volatile("s_waitcnt lgkmcnt(" #n ")" ::: "memory")
#define PG8_BAR __builtin_amdgcn_s_barrier()
#define PG8_SCHED __builtin_amdgcn_sched_barrier(0)
    Unit cur, nxt; int ui = 0;
    if (!S.next(0, cur)) return;
    f32x4 acc[2][2][4][2];
#pragma unroll
    for (int a = 0; a < 2; ++a)
#pragma unroll
        for (int b = 0; b < 2; ++b)
#pragma unroll
            for (int m = 0; m < 4; ++m)
#pragma unroll
                for (int n = 0; n < 2; ++n) acc[a][b][m][n] = (f32x4){0.f, 0.f, 0.f, 0.f};
    bf16x8 At[4][2], B0[2][2], B1[2][2];
    const char* cA = (const char*)g.A + (size_t)cur.pm * tstep; const char* cB = (const char*)g.Bt + (size_t)cur.pb * tstep;
    const char* nA = cA;
    PG8_GIDX(offAc, 0);
    PG8_STAGE(PG8_SB(0, 0), cB, voffB); PG8_STAGE(PG8_SB(0, 1), cB + hstep, voffB); PG8_STAGE_A(PG8_SA(0, 0), 0, 0, false); PG8_STAGE_A(PG8_SA(0, 1), 0, 1, false);
    if (wr == 1) PG8_BAR;
    PG8_WAIT_V(2); PG8_BAR;
    PG8_STAGE(PG8_SB(1, 0), cB + kstep, voffB); PG8_STAGE_A(PG8_SA(1, 0), kstep, 0, false); PG8_STAGE(PG8_SB(1, 1), cB + hstep + kstep, voffB);
    PG8_WAIT_V(6); PG8_BAR;
    for (;;) {
        const bool has_next = S.next(ui + 1, nxt);
        nA = has_next ? (const char*)g.A + (size_t)nxt.pm * tstep : cA; const char* nB = has_next ? (const char*)g.Bt + (size_t)nxt.pb * tstep : cB;
        nui = has_next ? ui + 1 : ui;
        for (int t = 0; t < nt; t += 2) {
            const bool last = (t == nt - 2);
            const size_t kb1 = (size_t)(t + 1) * kstep;
            const size_t kb2 = last ? (size_t)0 : (size_t)(t + 2) * kstep, kb3 = kb2 + kstep;
            const char* b2 = last ? nB : cB + (size_t)(t + 2) * kstep; const char* b3 = b2 + kstep;
            PG8_LDB(B0, 0, 0); PG8_LDB(B1, 0, 1); PG8_SCHED; PG8_LDA(At, 0, 0); PG8_STAGE_A(PG8_SA(1, 1), kb1, 1, false);
            PG8_WAIT_V(8); PG8_WAIT_L(0); PG8_BAR; PG8_MMA(0, 0, At, B0); PG8_MMA(0, 1, At, B1); PG8_BAR; PG8_SCHED;
            PG8_LDA(At, 0, 1); PG8_STAGE(PG8_SB(0, 0), b2, voffB); PG8_STAGE(PG8_SB(0, 1), b2 + hstep, voffB); PG8_STAGE_A(PG8_SA(0, 0), kb2, 0, last);
            PG8_WAIT_V(8); PG8_WAIT_L(0); PG8_BAR; PG8_MMA(1, 0, At, B0); PG8_MMA(1, 1, At, B1); PG8_BAR; PG8_SCHED;
            PG8_LDB(B0, 1, 0); PG8_LDB(B1, 1, 1); PG8_SCHED; PG8_LDA(At, 1, 0); PG8_STAGE_A(PG8_SA(0, 1), kb2, 1, last);
            PG8_WAIT_V(8); PG8_WAIT_L(0); PG8_BAR; PG8_MMA(0, 0, At, B0); PG8_MMA(0, 1, At, B1); PG8_BAR; PG8_SCHED;
            PG8_LDA(At, 1, 1); PG8_STAGE(PG8_SB(1, 0), b3, voffB); PG8_STAGE(PG8_SB(1, 1), b3 + hstep, voffB); PG8_STAGE_A(PG8_SA(1, 0), kb3, 0, last);
            PG8_WAIT_V(8); PG8_WAIT_L(0); PG8_BAR; PG8_MMA(1, 0, At, B0); PG8_MMA(1, 1, At, B1); PG8_BAR; PG8_SCHED;
        }
        if constexpr (ALIGN_EPI) { if (wr == 0) PG8_BAR; }
        E(acc, cur, wr, wc, fr, fq);
        if (!has_next) break;
#pragma unroll
        for (int a = 0; a < 2; ++a)
#pragma unroll
            for (int b = 0; b < 2; ++b)
#pragma unroll
                for (int m = 0; m < 4; ++m)
#pragma unroll
                    for (int n = 0; n < 2; ++n) acc[a][b][m][n] = (f32x4){0.f, 0.f, 0.f, 0.f};
        cur = nxt; cA = nA; cB = nB; ++ui;
        PG8_GIDX(offAc, ui);
        if constexpr (ALIGN_EPI) { if (wr == 1) PG8_BAR; }
    }
    PG8_WAIT_V(0);
    if constexpr (!ALIGN_EPI) { if (wr == 0) PG8_BAR; }
    PG8_BAR;
#undef PG8_SA
#undef PG8_SB
#undef PG8_STAGE
#undef PG8_STAGE_A
#undef PG8_GIDX
#undef PG8_GOFF
#undef PG8_LDA
#undef PG8_LDB
#undef PG8_MMA
#undef PG8_WAIT_V
#undef PG8_WAIT_L
#undef PG8_BAR
#undef PG8_SCHED
}
}
namespace pg8 {
constexpr float ATT_C2 = 0.125f * 1.4426950408889634f;
constexpr float GLA_QS = 0.08838834764831845f;
struct EpiProj {
    static constexpr bool PERM = true;
    bf16_t *Qb, *Kb, *Vb, *GQ, *GK, *GV, *SG, *GT; const float* bgates;
    __device__ __forceinline__ void operator()(const f32x4 (&acc)[2][2][4][2], const Unit& u, int wr, int wc, int fr, int fq) const {
        asm volatile("" : "+v"(fr), "+v"(fq));
        const int pn = u.pn; bf16_t* base; int ldc = 1024, ct; int act = 0; float sc = 1.f;
        if (pn < 4) { base = Qb; ct = pn; sc = ATT_C2; }
        else if (pn < 8) { base = Kb; ct = pn - 4; }
        else if (pn < 12) { base = Vb; ct = pn - 8; }
        else if (pn < 14) { base = GQ; ldc = 512; ct = pn - 12; sc = GLA_QS; }
        else if (pn < 16) { base = GK; ldc = 512; ct = pn - 14; }
        else if (pn < 20) { base = GV; ct = pn - 16; }
        else if (pn < 24) { base = SG; ct = pn - 20; act = 1; }
        else { base = GT; ldc = 2048; ct = pn - 24; act = 2; }
        const int row0 = u.pm * BM + wr * 64 + fr, col0 = ct * BM + wc * 32 + 8 * fq;
        f32x4 bv[2][2];
#pragma unroll
        for (int bj = 0; bj < 2; ++bj)
#pragma unroll
            for (int n = 0; n < 2; ++n) bv[bj][n] = (act == 2) ? *(const f32x4*)(bgates + col0 + bj * HALF + 4 * n) : (f32x4){0.f, 0.f, 0.f, 0.f};
#pragma unroll
        for (int ai = 0; ai < 2; ++ai)
#pragma unroll
            for (int m = 0; m < 4; ++m) { bf16_t* rowp = base + (size_t)(row0 + ai * HALF + m * 16) * ldc + col0;
#pragma unroll
                for (int bj = 0; bj < 2; ++bj) { f32x4 v0 = acc[ai][bj][m][0] * sc + bv[bj][0], v1 = acc[ai][bj][m][1] * sc + bv[bj][1];
                    if (act != 0) {
#pragma unroll
                        for (int e = 0; e < 4; ++e) { const float s0 = sigmoidf_(v0[e]), s1 = sigmoidf_(v1[e]); v0[e] = (act == 1) ? v0[e] * s0 : s0; v1[e] = (act == 1) ? v1[e] * s1 : s1; } }
                    u32x4 w; w.x = cvt_pk_bf16(v0[0], v0[1]); w.y = cvt_pk_bf16(v0[2], v0[3]); w.z = cvt_pk_bf16(v1[0], v1[1]); w.w = cvt_pk_bf16(v1[2], v1[3]);
                    *(u32x4*)(rowp + bj * HALF) = w; } }
    }
};
template <int MODE> struct EpiGate {
    static constexpr bool PERM = true;
    bf16_t* O; int ldo; const bf16_t* T; const bf16_t* gate; int ldg, gcol0;
    __device__ __forceinline__ void operator()(const f32x4 (&acc)[2][2][4][2], const Unit& u, int wr, int wc, int fr, int fq) const {
        asm volatile("" : "+v"(fr), "+v"(fq));
        const int row0 = u.pm * BM + wr * 64 + fr, col0 = u.pn * BM + wc * 32 + 8 * fq;
#pragma unroll
        for (int ai = 0; ai < 2; ++ai)
#pragma unroll
            for (int m = 0; m < 4; ++m) { const size_t row = (size_t)(row0 + ai * HALF + m * 16);
#pragma unroll
                for (int bj = 0; bj < 2; ++bj) { f32x4 v0 = acc[ai][bj][m][0], v1 = acc[ai][bj][m][1]; const int col = col0 + bj * HALF;
                    if (MODE != 2) { const u32x4 gw = *(const u32x4*)(gate + row * ldg + gcol0 + col);
                        v0 = v0 * (f32x4){bf_lo(gw.x), bf_hi(gw.x), bf_lo(gw.y), bf_hi(gw.y)}; v1 = v1 * (f32x4){bf_lo(gw.z), bf_hi(gw.z), bf_lo(gw.w), bf_hi(gw.w)}; }
                    if (MODE == 1) { const u32x4 tw = *(const u32x4*)(T + row * ldo + col);
                        v0 = v0 + (f32x4){bf_lo(tw.x), bf_hi(tw.x), bf_lo(tw.y), bf_hi(tw.y)}; v1 = v1 + (f32x4){bf_lo(tw.z), bf_hi(tw.z), bf_lo(tw.w), bf_hi(tw.w)}; }
                    u32x4 w; w.x = cvt_pk_bf16(v0[0], v0[1]); w.y = cvt_pk_bf16(v0[2], v0[3]); w.z = cvt_pk_bf16(v1[0], v1[1]); w.w = cvt_pk_bf16(v1[2], v1[3]);
                    *(u32x4*)(O + row * ldo + col) = w; }
                asm volatile("" ::: "memory"); }
    }
};
struct EpiResid {
    static constexpr bool PERM = false;
    float* X; const float* gvec; int gstride; float alpha;
    __device__ __forceinline__ void operator()(const f32x4 (&acc)[2][2][4][2], const Unit& u, int wr, int wc, int fr, int fq) const {
        asm volatile("" : "+v"(fr), "+v"(fq));
        const int row0 = u.pm * BM + wr * 64 + fr, col0 = u.pn * BM + wc * 32 + 4 * fq; const float* gv = gvec + (size_t)(u.pm >> 4) * gstride;
        f32x4 g4[2][2];
#pragma unroll
        for (int bj = 0; bj < 2; ++bj)
#pragma unroll
            for (int n = 0; n < 2; ++n) g4[bj][n] = *(const f32x4*)(gv + col0 + bj * HALF + n * 16);
#pragma unroll
        for (int ai = 0; ai < 2; ++ai)
#pragma unroll
            for (int m = 0; m < 4; ++m) { float* rowp = X + (size_t)(row0 + ai * HALF + m * 16) * 1024 + col0;
#pragma unroll
                for (int bj = 0; bj < 2; ++bj)
#pragma unroll
                    for (int n = 0; n < 2; ++n) { float* p = rowp + bj * HALF + n * 16; const f32x4 xv = *(const f32x4*)p; *(f32x4*)p = xv * alpha + g4[bj][n] * acc[ai][bj][m][n]; }
                asm volatile("" ::: "memory"); }
    }
};
struct EpiSwiGLU {
    static constexpr bool PERM = true;
    bf16_t* H;
    __device__ __forceinline__ void operator()(const f32x4 (&acc)[2][2][4][2], const Unit& u, int wr, int wc, int fr, int fq) const {
        asm volatile("" : "+v"(fr), "+v"(fq));
        const int row0 = u.pm * BM + wr * 64 + fr, col0 = u.pn * HALF + wc * 32 + 8 * fq;
#pragma unroll
        for (int ai = 0; ai < 2; ++ai)
#pragma unroll
            for (int m = 0; m < 4; ++m) { f32x4 h0, h1;
#pragma unroll
                for (int e = 0; e < 4; ++e) { const float g0 = acc[ai][0][m][0][e], g1 = acc[ai][0][m][1][e]; h0[e] = g0 * sigmoidf_(g0) * acc[ai][1][m][0][e]; h1[e] = g1 * sigmoidf_(g1) * acc[ai][1][m][1][e]; }
                u32x4 w; w.x = cvt_pk_bf16(h0[0], h0[1]); w.y = cvt_pk_bf16(h0[2], h0[3]); w.z = cvt_pk_bf16(h1[0], h1[1]); w.w = cvt_pk_bf16(h1[2], h1[3]);
                *(u32x4*)(H + (size_t)(row0 + ai * HALF + m * 16) * 512 + col0) = w; }
    }
};
}
#include <hip/hip_bf16.h>
#include <cmath>
namespace attn_body {
using bf16=__hip_bfloat16;
using bf16x8=__attribute__((ext_vector_type(8)))short;
using s16x4=__attribute__((ext_vector_type(4)))short;
using f32x16=__attribute__((ext_vector_type(16)))float;
using u32x4=__attribute__((ext_vector_type(4)))unsigned;
constexpr int BATCH=8,NHEAD=16,SEQ=4096,D=64,DM=NHEAD*D,OPITCH=2048;
constexpr int NW=8,QBLK=32,QB=QBLK*NW,KVBLK=64,NQB=SEQ/QB;
constexpr int ATTN_PITCH=DM, ATTN_UNIT_ROWS=QB;
__device__ __forceinline__ int crow(int r,int hi){return (r&3)+8*(r>>2)+4*hi;}
#define SBAR() __builtin_amdgcn_sched_barrier(0)
__device__ __forceinline__ void cmask(f32x16&p0,f32x16&p1,int jb,int qrel,int hi){
  const float NEG=-INFINITY; int kb=64*jb+4*hi;
  #pragma unroll
  for(int r=0;r<16;++r){int kv=kb+(r&3)+8*(r>>2); if(kv>qrel)p0[r]=NEG; if(kv+32>qrel)p1[r]=NEG;}
}

constexpr int NSLOT=3, SLOTB=8192;
constexpr int LDS_K=0, LDS_V=NSLOT*SLOTB, LDS_WS=2*NSLOT*SLOTB, LDS_OST=LDS_WS+NW*64*4, LDS_BYTES=LDS_OST+NW*4096;
constexpr float C2=0.125f*1.4426950408889634f;
__device__ __forceinline__ void glds16s(const void*sbase,unsigned voff,unsigned lds_dst){unsigned keep;
  asm volatile("s_mov_b32 %0, m0\n\ts_mov_b32 m0, %2\n\ts_nop 0\n\tglobal_load_lds_dwordx4 %1, %3\n\ts_mov_b32 m0, %0":"=&s"(keep):"v"(voff),"s"(lds_dst),"s"(sbase):"memory");}
__device__ __forceinline__ void glds16(const void*gsrc,unsigned lds_dst){unsigned keep;
  asm volatile("s_mov_b32 %0, m0\n\ts_mov_b32 m0, %2\n\ts_nop 0\n\tglobal_load_lds_dwordx4 %1, off\n\ts_mov_b32 m0, %0":"=&s"(keep):"v"(gsrc),"s"(lds_dst):"memory");}
__device__ __forceinline__ float max3f(float a,float b,float c){float r;asm("v_max3_f32 %0, %1, %2, %3":"=v"(r):"v"(a),"v"(b),"v"(c));return r;}
__device__ __forceinline__ float max2f(float a,float b){float r;asm("v_max_f32_e32 %0, %1, %2":"=v"(r):"v"(a),"v"(b));return r;}
__device__ __forceinline__ float fadd_s(float a,float b){float r;asm("v_add_f32_e32 %0, %1, %2":"=v"(r):"v"(a),"v"(b));return r;}
__device__ __forceinline__ float fsub_s(float a,float b){float r;asm("v_sub_f32_e32 %0, %1, %2":"=v"(r):"v"(a),"v"(b));return r;}
typedef float f32x2_t __attribute__((ext_vector_type(2))); typedef __bf16 bf16x2_t __attribute__((ext_vector_type(2)));
__device__ __forceinline__ unsigned cvtpk_s(float lo,float hi){f32x2_t v={lo,hi};bf16x2_t b=__builtin_convertvector(v,bf16x2_t);return __builtin_bit_cast(unsigned,b);}
#define WAIT_BAR(N) asm volatile("s_waitcnt vmcnt(" #N ") lgkmcnt(0)\n\ts_barrier":::"memory")

__device__ __forceinline__ void qkt(f32x16&p0,f32x16&p1,const char*Kslot,const bf16x8*qr,const f32x16&c0,const f32x16&c1,int r32,int hi){
  const char*kb=Kslot+hi*1024+r32*16;
  #pragma unroll
  for(int d0=0;d0<4;++d0){
    const bf16x8 b0=*reinterpret_cast<const bf16x8*>(kb+d0*2048);
    const bf16x8 b1=*reinterpret_cast<const bf16x8*>(kb+d0*2048+512);
    if(d0==0){p0=__builtin_amdgcn_mfma_f32_32x32x16_bf16(b0,qr[0],c0,0,0,0);p1=__builtin_amdgcn_mfma_f32_32x32x16_bf16(b1,qr[0],c1,0,0,0);}
    else{p0=__builtin_amdgcn_mfma_f32_32x32x16_bf16(b0,qr[d0],p0,0,0,0);p1=__builtin_amdgcn_mfma_f32_32x32x16_bf16(b1,qr[d0],p1,0,0,0);}}
}
typedef __attribute__((address_space(3))) const char* lds_cptr;
typedef short v4i16_t __attribute__((ext_vector_type(4)));
__device__ __forceinline__ void kload8(bf16x8*kf,lds_cptr kp){
  kf[0]=*(const __attribute__((address_space(3))) bf16x8*)(kp);      kf[1]=*(const __attribute__((address_space(3))) bf16x8*)(kp+512);
  kf[2]=*(const __attribute__((address_space(3))) bf16x8*)(kp+2048); kf[3]=*(const __attribute__((address_space(3))) bf16x8*)(kp+2560);
  kf[4]=*(const __attribute__((address_space(3))) bf16x8*)(kp+4096); kf[5]=*(const __attribute__((address_space(3))) bf16x8*)(kp+4608);
  kf[6]=*(const __attribute__((address_space(3))) bf16x8*)(kp+6144); kf[7]=*(const __attribute__((address_space(3))) bf16x8*)(kp+6656);
}
__device__ __forceinline__ void kload2(bf16x8*kf,lds_cptr kp,int j){ kf[2*j]=*(const __attribute__((address_space(3))) bf16x8*)(kp+j*2048); kf[2*j+1]=*(const __attribute__((address_space(3))) bf16x8*)(kp+j*2048+512); }
__device__ __forceinline__ s16x4 vtr(lds_cptr p){ return __builtin_bit_cast(s16x4,__builtin_amdgcn_ds_read_tr16_b64_v4i16((__attribute__((address_space(3))) v4i16_t*)p)); }
__device__ __forceinline__ float rowmax(const f32x16&p0,const f32x16&p1){
  float a=max3f(p0[0],p0[1],p1[0]),b=max3f(p0[2],p0[3],p1[1]);a=max3f(a,p1[2],p1[3]);
  #pragma unroll
  for(int r=4;r<16;r+=4){a=max3f(a,p0[r],p0[r+1]);b=max3f(b,p0[r+2],p0[r+3]);a=max3f(a,p1[r],p1[r+1]);b=max3f(b,p1[r+2],p1[r+3]);}
  const float m=max2f(a,b);
  auto rr=__builtin_amdgcn_permlane32_swap(__float_as_uint(m),__float_as_uint(m),false,false);
  return max2f(__uint_as_float(rr[0]),__uint_as_float(rr[1]));
}
__device__ __forceinline__ void pv(f32x16*o,int vb,bf16x8 pa0,bf16x8 pa1,bf16x8 pa2,bf16x8 pa3){
  #pragma unroll
  for(int d0=0;d0<2;++d0){s16x4 lo[4],hi[4];
    #pragma unroll
    for(int ks=0;ks<4;++ks){
      asm volatile("ds_read_b64_tr_b16 %0,%1 offset:%c2":"=&v"(lo[ks]):"v"(vb),"i"(d0*4096+ks*1024):"memory");
      asm volatile("ds_read_b64_tr_b16 %0,%1 offset:%c2":"=&v"(hi[ks]):"v"(vb),"i"(d0*4096+ks*1024+512):"memory");}
    asm volatile("s_waitcnt lgkmcnt(0)":::"memory");SBAR();
    #define PK(k) (bf16x8){lo[k][0],lo[k][1],lo[k][2],lo[k][3],hi[k][0],hi[k][1],hi[k][2],hi[k][3]}
    o[d0]=__builtin_amdgcn_mfma_f32_32x32x16_bf16(pa0,PK(0),o[d0],0,0,0);
    o[d0]=__builtin_amdgcn_mfma_f32_32x32x16_bf16(pa1,PK(1),o[d0],0,0,0);
    o[d0]=__builtin_amdgcn_mfma_f32_32x32x16_bf16(pa2,PK(2),o[d0],0,0,0);
    o[d0]=__builtin_amdgcn_mfma_f32_32x32x16_bf16(pa3,PK(3),o[d0],0,0,0);
    #undef PK
  }
}

#ifndef ATTN_STORE16
#define ATTN_STORE16(p,v) (*(u32x4*)(p)=(v))
#endif
template<int THRL> __device__ __forceinline__ void attn_unit(int b,int hq,int hv,int ocol,int qb,float sl2,const bf16*Q,const bf16*__restrict__ K,const bf16*__restrict__ V,bf16*O,char*shm){
  int tid_=threadIdx.x; asm volatile("":"+v"(tid_));
  const int tid=tid_,lane=tid&63,r32=lane&31,hi=lane>>5; const int wid=__builtin_amdgcn_readfirstlane(tid>>6);
  const long rowbase=(long)b*SEQ; const int q0=qb*QB;
  const bf16*Qw=Q+(rowbase+q0+wid*QBLK)*DM+hq*D;
  const bf16*Kh=K+rowbase*DM+hq*D,*Vh=V+rowbase*DM+hv*D;
  const unsigned lds0=(unsigned)(uintptr_t)shm;
  float*wsf=(float*)(shm+LDS_WS)+wid*64;
  const unsigned kvoff=(unsigned)(lane*DM+wid*8)*2u;
  const unsigned vvoff=(unsigned)((16*(wid&3)+(lane>>2))*DM+(wid>>2)*32+(lane&3)*8)*2u;
  const unsigned kdst=lds0+LDS_K+wid*1024, vdst=lds0+LDS_V+wid*1024;
  #define DMA_K(t,slot) glds16s(Kh+(long)(t)*KVBLK*DM,kvoff,(unsigned)__builtin_amdgcn_readfirstlane(kdst+(slot)))
  #define DMA_V(t,slot) glds16s(Vh+(long)(t)*KVBLK*DM,vvoff,(unsigned)__builtin_amdgcn_readfirstlane(vdst+(slot)))
  const int vb0=(int)(lds0+LDS_V)+((lane>>4)&1)*32+(lane&3)*8+(4*hi+((lane&15)>>2))*64;
  const char*Kbase=shm+LDS_K; bf16x8 kf[8];
  const lds_cptr shm3=(lds_cptr)shm; const lds_cptr kp0=shm3+LDS_K+hi*1024+r32*16; const lds_cptr vp0=shm3+LDS_V+((lane>>4)&1)*32+(lane&3)*8+(4*hi+((lane&15)>>2))*64;
  const int NT=(q0+QB)/KVBLK;
  DMA_K(0,0);DMA_V(0,0);DMA_K(1,SLOTB);
  bf16x8 qr[4];
  #pragma unroll
  for(int d0=0;d0<4;++d0)qr[d0]=*reinterpret_cast<const bf16x8*>(&Qw[(long)r32*DM+d0*16+hi*8]);
  float mhat=0.f,l_reg=0.f;f32x16 o[2];o[0]=f32x16{};o[1]=f32x16{};
  #define CINIT0(C0_,t_) do{ const float bt_=sl2*(float)(64*(t_)-q0+4*hi)-mhat; _Pragma("unroll") for(int r=0;r<16;++r){C0_[r]=__builtin_fmaf(sl2,(float)((r&3)+8*(r>>2)),bt_);} }while(0)
  #define CINIT1(C1_,t_) do{ const float bt_=sl2*(float)(64*(t_)-q0+4*hi)-mhat; _Pragma("unroll") for(int r=0;r<16;++r){C1_[r]=__builtin_fmaf(sl2,(float)((r&3)+8*(r>>2)+32),bt_);} }while(0)
  #define CINIT(C0_,C1_,t_) do{ CINIT0(C0_,t_); CINIT1(C1_,t_); }while(0)
  const int qrel=wid*QBLK+r32;
  #define CMASK(P0,P1,t) do{int jb_=(t)-(NT-4); if(jb_>=0)cmask(P0,P1,jb_,qrel,hi);}while(0)
  bool resc=false;
  #define START(P0,P1) do{ const float rm=rowmax(P0,P1); resc=false; \
    { const float dl=rm; mhat=fadd_s(mhat,dl); \
      _Pragma("unroll") for(int r=0;r<16;++r){P0[r]=fsub_s(P0[r],dl);P1[r]=fsub_s(P1[r],dl);} } \
    _Pragma("unroll") for(int r=0;r<16;++r)P0[r]=__builtin_amdgcn_exp2f(P0[r]); }while(0)
  #define RESC() do{ if(resc){ asm volatile("s_waitcnt lgkmcnt(0)":::"memory"); \
      _Pragma("unroll") for(int d_=0;d_<2;++d_) _Pragma("unroll") for(int r=0;r<16;++r)o[d_][r]*=wsf[crow(r,hi)]; } }while(0)
  f32x16 pA0,pA1,pB0,pB1;
  int sl_prev=0,sl_cur=0,sl_next=SLOTB;
  #define ROT() do{sl_prev=sl_cur;sl_cur=sl_next;sl_next=(sl_next==(NSLOT-1)*SLOTB)?0:sl_next+SLOTB;}while(0)
  DMA_K(2,2*SLOTB);
  WAIT_BAR(3);
  { f32x16 c0_,c1_; CINIT(c0_,c1_,0); qkt(pA0,pA1,Kbase,qr,c0_,c1_,r32,hi); } asm volatile("s_nop 15\n\ts_nop 7":"+v"(pA0),"+v"(pA1));CMASK(pA0,pA1,0);
  START(pA0,pA1);
  _Pragma("unroll") for(int r=0;r<16;++r)pA1[r]=__builtin_amdgcn_exp2f(pA1[r]);
  WAIT_BAR(0);
  DMA_K(3,0);DMA_V(1,SLOTB);
  ROT();
  kload8(kf,kp0+sl_cur);
  WAIT_BAR(2);
  s16x4 vlo[8],vhi[8]; u32x4 pw0,pw1,pw2,pw3;
  #define PKW(P,B) cvtpk_s(P[B],P[B+1])
  #define PAF(k) __builtin_bit_cast(bf16x8,pw##k)
  #define VFR(i) (bf16x8){vlo[i][0],vlo[i][1],vlo[i][2],vlo[i][3],vhi[i][0],vhi[i][1],vhi[i][2],vhi[i][3]}
  #define PIN(x) asm volatile("":"+v"(x))
  #define MX3(a,b,c) __builtin_fmaxf(__builtin_fmaxf((a),(b)),(c))
  #define GAPA(MF,A0,A1,A2,A3,W0,W1,PW) do{ MF; sacc+=A0; sacc+=A1; sacc+=A2; sacc+=A3; PIN(sacc); W0; W1; PIN(PW); SBAR(); }while(0)
  #define EX(v) __builtin_amdgcn_exp2f(v)
  #define GAPB(MF,X,B) do{ MF; X[B]=EX(X[B]); X[B+1]=EX(X[B+1]); X[B+2]=EX(X[B+2]); X[B+3]=EX(X[B+3]); PIN(X); SBAR(); }while(0)
  #define VRD(i) do{ vlo[i]=vtr(vp_+(((i)>>2)*4096+((i)&3)*1024)); vhi[i]=vtr(vp_+(((i)>>2)*4096+((i)&3)*1024+512)); }while(0)
  #define KRD(G,j) do{ if(G){ kload2(kf,kp0+sl_next,j); SBAR(); } }while(0)
  #define STEP(C0,C1,P0,P1,t,GK,GV,GL) do{ CINIT0(C0,t); SBAR(); \
    const lds_cptr vp_=vp0+sl_prev; \
    VRD(0); SBAR(); float sacc=(P0[0]+P0[1]); \
    GAPA(C0=__builtin_amdgcn_mfma_f32_32x32x16_bf16(kf[0],qr[0],C0,0,0,0), P0[2],P0[3],P0[4],P0[5],     pw0[0]=PKW(P0,0), pw0[1]=PKW(P0,2), pw0); \
    CINIT1(C1,t); VRD(4); SBAR(); GAPA(C1=__builtin_amdgcn_mfma_f32_32x32x16_bf16(kf[1],qr[0],C1,0,0,0), P0[6],P0[7],P0[8],P0[9],     pw0[2]=PKW(P0,4), pw0[3]=PKW(P0,6), pw0); \
    VRD(1); SBAR(); GAPA(C0=__builtin_amdgcn_mfma_f32_32x32x16_bf16(kf[2],qr[1],C0,0,0,0),   P0[10],P0[11],P0[12],P0[13], pw1[0]=PKW(P0,8), pw1[1]=PKW(P0,10), pw1); \
    VRD(5); SBAR(); GAPA(C1=__builtin_amdgcn_mfma_f32_32x32x16_bf16(kf[3],qr[1],C1,0,0,0),   P0[14],P0[15],P1[0],P1[1],   pw1[2]=PKW(P0,12),pw1[3]=PKW(P0,14), pw1); \
    VRD(2); SBAR(); GAPA(C0=__builtin_amdgcn_mfma_f32_32x32x16_bf16(kf[4],qr[2],C0,0,0,0),   P1[2],P1[3],P1[4],P1[5],     pw2[0]=PKW(P1,0), pw2[1]=PKW(P1,2), pw2); \
    VRD(6); SBAR(); GAPA(C1=__builtin_amdgcn_mfma_f32_32x32x16_bf16(kf[5],qr[2],C1,0,0,0),   P1[6],P1[7],P1[8],P1[9],     pw2[2]=PKW(P1,4), pw2[3]=PKW(P1,6), pw2); \
    VRD(3); SBAR(); GAPA(C0=__builtin_amdgcn_mfma_f32_32x32x16_bf16(kf[6],qr[3],C0,0,0,0),   P1[10],P1[11],P1[12],P1[13], pw3[0]=PKW(P1,8), pw3[1]=PKW(P1,10), pw3); \
    VRD(7); SBAR(); GAPA(C1=__builtin_amdgcn_mfma_f32_32x32x16_bf16(kf[7],qr[3],C1,0,0,0),   P1[14],P1[15],0.f,0.f,       pw3[2]=PKW(P1,12),pw3[3]=PKW(P1,14), pw3); \
    l_reg+=sacc; \
    if(GK){DMA_K((t)+3,sl_cur);} if(GV){DMA_V((t)+1,sl_next);} \
    CMASK(C0,C1,t); \
    { float a=MX3(C0[0],C0[1],C1[0]),b=MX3(C0[2],C0[3],C1[1]); a=MX3(a,C1[2],C1[3]); \
      _Pragma("unroll") for(int r=4;r<16;r+=4){a=MX3(a,C0[r],C0[r+1]);b=MX3(b,C0[r+2],C0[r+3]);a=MX3(a,C1[r],C1[r+1]);b=MX3(b,C1[r+2],C1[r+3]);} \
      float rm=__builtin_fmaxf(a,b); { auto rr=__builtin_amdgcn_permlane32_swap(__float_as_uint(rm),__float_as_uint(rm),false,false); rm=__builtin_fmaxf(__uint_as_float(rr[0]),__uint_as_float(rr[1])); } \
      resc=false; \
      if(__builtin_expect(__any(rm>(float)THRL),0)){ const float dl=__builtin_fmaxf(rm,0.f); mhat+=dl; \
        _Pragma("unroll") for(int r=0;r<16;++r){C0[r]-=dl;C1[r]-=dl;} \
        const float f=__builtin_amdgcn_exp2f(-dl); l_reg*=f; if(hi==0)wsf[r32]=f; resc=true; } } \
    SBAR(); \
    GAPB(o[0]=__builtin_amdgcn_mfma_f32_32x32x16_bf16(PAF(0),VFR(0),o[0],0,0,0), C0,0); \
    GAPB(o[1]=__builtin_amdgcn_mfma_f32_32x32x16_bf16(PAF(0),VFR(4),o[1],0,0,0), C0,4); \
    KRD(GL,0); GAPB(o[0]=__builtin_amdgcn_mfma_f32_32x32x16_bf16(PAF(1),VFR(1),o[0],0,0,0), C0,8); \
    KRD(GL,1); GAPB(o[1]=__builtin_amdgcn_mfma_f32_32x32x16_bf16(PAF(1),VFR(5),o[1],0,0,0), C0,12); \
    KRD(GL,2); GAPB(o[0]=__builtin_amdgcn_mfma_f32_32x32x16_bf16(PAF(2),VFR(2),o[0],0,0,0), C1,0); \
    KRD(GL,3); GAPB(o[1]=__builtin_amdgcn_mfma_f32_32x32x16_bf16(PAF(2),VFR(6),o[1],0,0,0), C1,4); \
    GAPB(o[0]=__builtin_amdgcn_mfma_f32_32x32x16_bf16(PAF(3),VFR(3),o[0],0,0,0), C1,8); \
    GAPB(o[1]=__builtin_amdgcn_mfma_f32_32x32x16_bf16(PAF(3),VFR(7),o[1],0,0,0), C1,12); \
    }while(0)
  int t=1;
  #undef CMASK
  #define CMASK(P0,P1,t) do{}while(0)
  for(;t+5<NT;t+=2){
    STEP(pB0,pB1,pA0,pA1,t,true,true,true);     WAIT_BAR(2); RESC(); ROT();
    STEP(pA0,pA1,pB0,pB1,t+1,true,true,true);   WAIT_BAR(2); RESC(); ROT();
  }
  #undef CMASK
  #define CMASK(P0,P1,t) do{int jb_=(t)-(NT-4); if(jb_>=0)cmask(P0,P1,jb_,qrel,hi);}while(0)
  #define ENDW(tt) do{ if((tt)+3<NT){WAIT_BAR(2);} else if((tt)+2<NT){WAIT_BAR(1);} else {WAIT_BAR(0);} }while(0)
  for(;t+1<NT;t+=2){
    STEP(pB0,pB1,pA0,pA1,t,(t+3<NT),(t+1<NT),(t+1<NT));       ENDW(t);   RESC(); ROT();
    STEP(pA0,pA1,pB0,pB1,t+1,(t+4<NT),(t+2<NT),(t+2<NT));     ENDW(t+1); RESC(); ROT();
  }
  STEP(pB0,pB1,pA0,pA1,NT-1,false,false,false); RESC();
  { float sacc=pB0[0]+pB0[1]; _Pragma("unroll") for(int r=2;r<16;++r)sacc+=pB0[r]; _Pragma("unroll") for(int r=0;r<16;++r)sacc+=pB1[r]; l_reg+=sacc;
    pw0=(u32x4){PKW(pB0,0),PKW(pB0,2),PKW(pB0,4),PKW(pB0,6)};pw1=(u32x4){PKW(pB0,8),PKW(pB0,10),PKW(pB0,12),PKW(pB0,14)};pw2=(u32x4){PKW(pB1,0),PKW(pB1,2),PKW(pB1,4),PKW(pB1,6)};pw3=(u32x4){PKW(pB1,8),PKW(pB1,10),PKW(pB1,12),PKW(pB1,14)};
    SBAR(); pv(o,vb0+sl_cur,PAF(0),PAF(1),PAF(2),PAF(3)); }
  #undef PKW
  #undef PAF
  #undef VFR
  #undef PIN
  #undef MX3
  #undef GAPA
  #undef GAPB
  #undef EX
  #undef VRD
  #undef KRD
  #undef STEP
  #undef ENDW
  {auto rr=__builtin_amdgcn_permlane32_swap(__float_as_uint(l_reg),__float_as_uint(l_reg),false,false);l_reg=__uint_as_float(rr[0])+__uint_as_float(rr[1]);}
  if(hi==0)wsf[32+r32]=l_reg;asm volatile("s_waitcnt lgkmcnt(0)":::"memory");
  float rli[16];
  #pragma unroll
  for(int r=0;r<16;++r)rli[r]=__builtin_amdgcn_rcpf(wsf[32+crow(r,hi)]);
  bf16*Ow=O+(rowbase+q0+wid*QBLK)*OPITCH+ocol;
  { bf16*stg=(bf16*)(shm+LDS_OST)+wid*2048;
    #pragma unroll
    for(int r=0;r<16;++r){const int orow=crow(r,hi);
      #pragma unroll
      for(int d0=0;d0<2;++d0)stg[orow*64+d0*32+r32]=__float2bfloat16(o[d0][r]*rli[r]);}
    asm volatile("s_waitcnt lgkmcnt(0)":::"memory");
    int ln2_=lane; asm volatile("":"+v"(ln2_));
    #pragma unroll
    for(int i=0;i<4;++i){const int row=i*8+(ln2_>>3),ch=ln2_&7; const u32x4 v=*(const u32x4*)(stg+row*64+ch*8); ATTN_STORE16(Ow+(long)row*OPITCH+ch*8,v);} }
  asm volatile("s_waitcnt lgkmcnt(0)\n\ts_barrier":::"memory");
  #undef DMA_K
  #undef DMA_V
  #undef CMASK
  #undef CINIT
  #undef CINIT0
  #undef CINIT1
  #undef START
  #undef RESC
  #undef ROT
}
constexpr int ATTN_LDS_BYTES=LDS_BYTES;
struct AttnTensors { const bf16* Q; const bf16* K; const bf16* V; bf16* O; };
template<int THRL=8> __device__ __forceinline__ void attn_phase(char*lds,const AttnTensors&T,int vcu,int G){
  for(int s=vcu;s<256;s+=G){
    const int b=s>>5,h=(s>>2)&7,c=(s>>1)&1,g=s&1;
    const float sl2=__uint_as_float(__builtin_amdgcn_readfirstlane(__float_as_uint(__builtin_amdgcn_exp2f(-(float)(h+1))*1.4426950408889634f)));
    for(int i=0;i<NQB;++i) attn_unit<THRL>(b,2*h+c,2*h+g,c*1024+h*128+g*64,NQB-1-i,sl2,T.Q,T.K,T.V,T.O,lds);
  }
}
#undef SBAR
#undef WAIT_BAR
}
#define GAS __attribute__((address_space(1)))
#define LAS __attribute__((address_space(3)))
typedef unsigned short bf16;
typedef unsigned v4u __attribute__((ext_vector_type(4)));
typedef float f32x4 __attribute__((ext_vector_type(4)));
typedef short bf16x8 __attribute__((ext_vector_type(8)));
typedef GAS unsigned gu32;
typedef GAS unsigned long long gu64;
#define RLX_AGENT __ATOMIC_RELAXED, __HIP_MEMORY_SCOPE_AGENT
#define LDS_WAIT() asm volatile("s_waitcnt lgkmcnt(0)" ::: "memory")
#define VM_WAIT() asm volatile("s_waitcnt vmcnt(0)" ::: "memory")
__device__ __forceinline__ unsigned long long rt() { return __builtin_amdgcn_s_memrealtime(); }
__device__ __forceinline__ unsigned f2bf(float f) { unsigned u = __builtin_bit_cast(unsigned, f); return (u + 0x7fffu + ((u >> 16) & 1u)) >> 16; }
__device__ __forceinline__ unsigned pk2(float lo, float hi) { return f2bf(lo) | (f2bf(hi) << 16); }

#define XB_TMO      128
#define XB_XCNT(j)  (256  + 64 * (j))
#define XB_XSUB(j)  (1280 + 64 * (j))
#define XB_XGEN(j)  (2304 + 64 * (j))
#define XB_TOP      3328
#define XB_TOPGEN   3392
#define XCD_BAR_WORDS 3456
#define XB_SPIN_CAP (1u << 18)

__device__ __forceinline__ unsigned xb_ld(unsigned* p)              { return __hip_atomic_load(p, __ATOMIC_RELAXED, __HIP_MEMORY_SCOPE_AGENT); }
__device__ __forceinline__ unsigned xb_add(unsigned* p, unsigned v) { return __hip_atomic_fetch_add(p, v, __ATOMIC_RELAXED, __HIP_MEMORY_SCOPE_AGENT); }
__device__ __forceinline__ unsigned xb_xcc_id() { return (unsigned)__builtin_amdgcn_s_getreg((3 << 11) | 20) & 0xFu; }
#define XB_SPIN(cond, bar) do { unsigned _sp = 0; while (cond) { __builtin_amdgcn_s_sleep(1); \
    if ((++_sp & 255u) == 0u) { if (xb_ld(&(bar)[XB_TMO])) break; if (_sp > XB_SPIN_CAP) { atomicAdd(&(bar)[XB_TMO], 1u); break; } } } } while (0)

struct XcdBarrier {
    unsigned* bar; unsigned x;
    volatile LAS unsigned* st;
};

__device__ __forceinline__ XcdBarrier xcd_barrier_post(unsigned* bar, volatile LAS unsigned* st) {
    XcdBarrier b; b.bar = bar; b.x = xb_xcc_id(); b.st = st;
    if (threadIdx.x == 0) (void)xb_add(&bar[XB_XCNT(b.x)], 1u);
    return b;
}
__device__ __forceinline__ void xcd_barrier_complete(unsigned* bar, unsigned x, unsigned& nloc, unsigned& nx) {
    const unsigned G = gridDim.x * gridDim.y * gridDim.z;
    unsigned sum, cnt, mine, sp = 0u;
    for (;;) {
        sum = 0u; cnt = 0u; mine = 0u;
#pragma unroll
        for (unsigned j = 0; j < 16; ++j) { const unsigned c = xb_ld(&bar[XB_XCNT(j)]); sum += c; cnt += (c > 0u) ? 1u : 0u; mine = (j == x) ? c : mine; }
        if (sum == G) break;
        __builtin_amdgcn_s_sleep(1);
        if ((++sp & 255u) == 0u) { if (xb_ld(&bar[XB_TMO])) break; if (sp > XB_SPIN_CAP) { atomicAdd(&bar[XB_TMO], 1u); break; } }
    }
    nloc = mine > 0u ? mine : 1u; nx = cnt > 0u ? cnt : 1u;
}

__device__ __forceinline__ void xcd_barrier(const XcdBarrier& b) {
    asm volatile("s_waitcnt vmcnt(0)" ::: "memory");
    __syncthreads();
    if (threadIdx.x == 0) {
        unsigned* bar = b.bar;
        __builtin_amdgcn_s_waitcnt(0);
        unsigned nloc = b.st[0], nx = b.st[1];
        if (nloc == 0u) { xcd_barrier_complete(bar, b.x, nloc, nx); b.st[0] = nloc; b.st[1] = nx; }
        const unsigned old = xb_add(&bar[XB_XSUB(b.x)], 1u);
        const unsigned gen = old / nloc;
        if (old + 1u == (gen + 1u) * nloc) {
            __builtin_amdgcn_fence(__ATOMIC_RELEASE, "agent");
            asm volatile("s_waitcnt vmcnt(0)" ::: "memory");
            const unsigned og = xb_add(&bar[XB_TOP], 1u);
            const unsigned tg = og / nx;
            if (og + 1u == (tg + 1u) * nx) xb_add(&bar[XB_TOPGEN], 1u);
            else XB_SPIN(xb_ld(&bar[XB_TOPGEN]) == tg, bar);
            __builtin_amdgcn_fence(__ATOMIC_ACQUIRE, "agent");
            xb_add(&bar[XB_XGEN(b.x)], 1u);
            asm volatile("s_waitcnt vmcnt(0)" ::: "memory");
        } else {
            XB_SPIN(xb_ld(&bar[XB_XGEN(b.x)]) == gen, bar);
            __builtin_amdgcn_fence(__ATOMIC_ACQUIRE, "agent");
            asm volatile("s_waitcnt vmcnt(0)" ::: "memory");
        }
    }
    __syncthreads();
}
constexpr int NWAVES = 8, NTHREADS = 512;
constexpr int BATCH = 8, SEQ = 4096, DM = 1024, NTOK = BATCH * SEQ, DEPTH = 4;
constexpr int DIN = 8208, NPROJ = 8192;
constexpr int NEXP = 32, DEXP = 512, LISTCAP = 32768, MOE_MAXT = 288;
constexpr float LN_EPS = 1e-5f, DN_ALPHA = 1.6817928305074292f;
constexpr size_t MiB = 1u << 20;
constexpr size_t WS_CTL = 0, CTL_ZERO_BYTES = 1 * MiB;
constexpr size_t WS_ADA = 1 * MiB;
constexpr size_t WS_ABWT = 2 * MiB;
constexpr size_t WS_RWT = 2 * MiB + 256 * 1024;
constexpr size_t WS_TOKINFO = 3 * MiB;
constexpr size_t WS_LIST = 4 * MiB;
constexpr size_t WS_SSQ = 8 * MiB;
constexpr size_t WS_PRM = 16 * MiB;
constexpr int PO_BGATES = 0, PO_WALPHA = 8192, PO_BALPHA = 40960, PO_LQ1 = 43008, PO_LK1 = 43264, PO_LQ2 = 43520, PO_LK2 = 43776, PO_DIFFG = 44032, PO_GLAG = 44544,
              PO_LN1G = 45568, PO_LN1B = 49664, PO_BRG = 53760, PO_BRE = 53776, PO_LN2G = 53904, PO_LN2B = 58000, PO_END = 62096;
constexpr size_t WS_WIN = 32 * MiB;
constexpr size_t WS_WBA = 96 * MiB, WS_WBB = 104 * MiB, WS_WOUT = 112 * MiB;
constexpr size_t WS_W1 = 120 * MiB;
constexpr size_t WS_WD = 376 * MiB;
constexpr size_t WS_U = 504 * MiB;
constexpr size_t WS_QB = 568 * MiB, WS_KB = 632 * MiB, WS_VB = 696 * MiB;
constexpr size_t WS_GQ = 760 * MiB, WS_GK = 792 * MiB;
constexpr size_t WS_GV = 824 * MiB, WS_SG = 888 * MiB;
constexpr size_t WS_GT = 952 * MiB;
constexpr size_t WS_LA = 1080 * MiB;
constexpr size_t WS_END = 1144 * MiB;
constexpr size_t WS_OB = WS_U;
constexpr size_t WS_OP = WS_GQ;
constexpr size_t WS_OA2 = WS_QB, WS_OB2 = WS_KB;
constexpr size_t WS_TMP = WS_VB, WS_MIX = WS_GQ;
constexpr size_t WS_H = WS_QB;
constexpr size_t WS_YB = WS_QB + 72 * MiB;
constexpr int CW_TMO = 0, CW_CODE = 1, CW_BAR = 4096, CW_CNT = 8192;
constexpr int RING_OFF = 0, RING_BYTES = 131072;
constexpr int LDSCTL_OFF = RING_BYTES, MISC_OFF = LDSCTL_OFF + 320;
constexpr int TAB_CNT = RING_BYTES + 512, TAB_BASE = RING_BYTES + 640, TAB_IDX = RING_BYTES + 1024, IDX_UNITS = 8;
constexpr int LDS_BYTES = 147456;
static_assert(TAB_IDX + IDX_UNITS * 256 * 4 <= LDS_BYTES, "LDS map");
struct Frame {
    LAS unsigned char* lds;
    gu32* ctl;
    int tid, lane, wave, vcu, G;
    float* out; unsigned char* ws; const float* prm;
};
enum { I_X = 0, I_C, I_WADA, I_BADA, I_WIN, I_BGATES, I_WALPHA, I_BALPHA, I_LQ1, I_LK1, I_LQ2, I_LK2, I_DIFFG, I_GLAG, I_WBA, I_WBB, I_WOUT, I_LN1G, I_LN1B,
       I_WRG, I_BRG, I_WRE, I_BRE, I_WGE, I_WUE, I_WDE, I_LN2G, I_LN2B };
__device__ __forceinline__ float wave_sum(float v) {
#pragma unroll
    for (int o = 1; o < 64; o <<= 1) v += __shfl_xor(v, o);
    return v;
}
__device__ __forceinline__ float siluf_(float x) { return x * __builtin_amdgcn_rcpf(1.0f + __expf(-x)); }
__device__ __forceinline__ float bflo(unsigned w) { return __uint_as_float(w << 16); }
__device__ __forceinline__ float bfhi(unsigned w) { return __uint_as_float(w & 0xffff0000u); }

__device__ __forceinline__ void p0_ada(Frame& F, const float* c, const float* wada, const float* bada) {
    LAS float* COND = (LAS float*)(F.lds);
    LAS float* PART = (LAS float*)(F.lds + 32768);
    float* ADA = (float*)(F.ws + WS_ADA);
    for (int i = F.tid; i < 8192; i += NTHREADS) COND[i] = siluf_(c[i]);
    __syncthreads();
    for (int cg = (int)blockIdx.x; cg < 256; cg += F.G) {
        const int l = cg >> 6, j0 = (cg & 63) * 96;
        const int col4 = F.lane % 24, ksub = F.lane / 24;
        f32x4 acc[8];
#pragma unroll
        for (int b = 0; b < 8; ++b) acc[b] = (f32x4){0.f, 0.f, 0.f, 0.f};
        if (ksub < 2) {
            const float* wp = wada + ((size_t)l * 1024 + (size_t)(F.wave * 128 + ksub)) * 6144 + j0 + 4 * col4;
#pragma unroll 8
            for (int kk = 0; kk < 64; ++kk) {
                const f32x4 wv = *(const GAS f32x4*)(wp + (size_t)kk * 2 * 6144); const int k = F.wave * 128 + 2 * kk + ksub;
#pragma unroll
                for (int b = 0; b < 8; ++b) acc[b] += wv * COND[b * 1024 + k];
            }
#pragma unroll
            for (int b = 0; b < 8; ++b) *(LAS f32x4*)(PART + ((F.wave * 2 + ksub) * 8 + b) * 96 + 4 * col4) = acc[b];
        }
        __syncthreads();
        for (int idx = F.tid; idx < 768; idx += NTHREADS) { const int b = idx / 96, col = idx % 96; float s = 0.f;
#pragma unroll
            for (int p = 0; p < 16; ++p) s += PART[(p * 8 + b) * 96 + col];
            ADA[((size_t)l * 8 + b) * 6144 + j0 + col] = s + bada[l * 6144 + j0 + col]; }
        __syncthreads();
    }
}
struct RmIdent { __device__ __forceinline__ int operator()(int n) const { return n; } };
struct RmWin { __device__ __forceinline__ int operator()(int n) const { return n < 6144 ? n : (n < 6160 ? -1 : n - 16); } };
struct RmGateUp { int up; __device__ __forceinline__ int operator()(int n) const { return (n >> 7) * 256 + up * 128 + (n & 127); } };
template <class RowMap>
__device__ __forceinline__ void p0_transpose_item(const float* W, int K, int N, bf16* WT, const RowMap rm, LAS float* scr, int kb, int nb, int lane) {
    const int k0 = 64 * kb, n0 = 32 * nb; const int nl = n0 + (lane & 31);
#pragma unroll 8
    for (int i = 0; i < 32; ++i) { const int kk = 2 * i + (lane >> 5); scr[kk * 33 + (lane & 31)] = (nl < N) ? W[(size_t)(k0 + kk) * N + nl] : 0.f; }
    LDS_WAIT(); asm volatile("" ::: "memory");
    const int c = lane & 7;
#pragma unroll
    for (int j = 0; j < 4; ++j) { const int nn = (lane >> 3) + 8 * j, n = n0 + nn; const LAS float* s = scr + (8 * c) * 33 + nn;
        v4u o; o.x = pk2(s[0 * 33], s[1 * 33]); o.y = pk2(s[2 * 33], s[3 * 33]); o.z = pk2(s[4 * 33], s[5 * 33]); o.w = pk2(s[6 * 33], s[7 * 33]);
        const int r = (n < N) ? rm(n) : -1;
        if (r >= 0) *(GAS v4u*)(WT + (size_t)r * K + k0 + 8 * c) = o; }
    LDS_WAIT(); asm volatile("" ::: "memory");
}
struct SmallPrm { const float *bgates, *walpha, *balpha, *lq1, *lk1, *lq2, *lk2, *diffg, *glag, *ln1g, *ln1b, *brg, *bre, *ln2g, *ln2b; };
__device__ __forceinline__ void p0_copy(float* dst, const float* src, int n, int gt, int NGT) { for (int i = gt; i < n; i += NGT) dst[i] = src[i]; }
__device__ __forceinline__ void p0_weights(Frame& F, const float* win, const float* wba, const float* wbb, const float* wout, const float* wge, const float* wue, const float* wde, const float* wrg, const float* wre, const SmallPrm sp) {
    LAS float* scr = (LAS float*)(F.lds + RING_OFF + F.wave * 16384);
    const int gw = F.vcu * NWAVES + F.wave, NGW = F.G * NWAVES;
    constexpr int I_IN = 4 * 16 * 257, I_SQ = 12 * 16 * 32, I_E = 128 * 16 * 16, I_D = 128 * 8 * 32;
    constexpr int NITEMS = I_IN + I_SQ + 2 * I_E + I_D;
    for (int it = gw; it < NITEMS; it += NGW) {
        int r = it;
        if (r < I_IN) { const int l = r / 4112, q = r % 4112;
            p0_transpose_item(win + (size_t)l * 1024 * DIN, 1024, DIN, (bf16*)(F.ws + WS_WIN) + (size_t)l * NPROJ * 1024, RmWin{}, scr, q / 257, q % 257, F.lane); continue; }
        r -= I_IN;
        if (r < I_SQ) { const int mat = r / 512, q = r % 512, which = mat >> 2, l = mat & 3;
            const float* W = (which == 0 ? wba : (which == 1 ? wbb : wout)) + (size_t)l * 1024 * 1024;
            bf16* WT = (bf16*)(F.ws + (which == 0 ? WS_WBA : (which == 1 ? WS_WBB : WS_WOUT))) + (size_t)l * 1024 * 1024;
            p0_transpose_item(W, 1024, 1024, WT, RmIdent{}, scr, q / 32, q % 32, F.lane); continue; }
        r -= I_SQ;
        if (r < 2 * I_E) { const int up = r >= I_E ? 1 : 0; if (up) r -= I_E; const int me = r / 256, q = r % 256;
            p0_transpose_item((up ? wue : wge) + (size_t)me * 1024 * 512, 1024, 512, (bf16*)(F.ws + WS_W1) + (size_t)me * 1024 * 1024, RmGateUp{up}, scr, q / 16, q % 16, F.lane); continue; }
        r -= 2 * I_E;
        { const int me = r / 256, q = r % 256;
          p0_transpose_item(wde + (size_t)me * 512 * 1024, 512, 1024, (bf16*)(F.ws + WS_WD) + (size_t)me * 1024 * 512, RmIdent{}, scr, q / 32, q % 32, F.lane); }
    }
    const int gt = F.vcu * NTHREADS + F.tid, NGT = F.G * NTHREADS;
    float* ABWT = (float*)(F.ws + WS_ABWT); float* RWT = (float*)(F.ws + WS_RWT);
    { float* P = (float*)(F.ws + WS_PRM);
      p0_copy(P + PO_BGATES, sp.bgates, 8192, gt, NGT); p0_copy(P + PO_WALPHA, sp.walpha, 32768, gt, NGT); p0_copy(P + PO_BALPHA, sp.balpha, 2048, gt, NGT);
      p0_copy(P + PO_LQ1, sp.lq1, 256, gt, NGT); p0_copy(P + PO_LK1, sp.lk1, 256, gt, NGT); p0_copy(P + PO_LQ2, sp.lq2, 256, gt, NGT); p0_copy(P + PO_LK2, sp.lk2, 256, gt, NGT);
      p0_copy(P + PO_DIFFG, sp.diffg, 512, gt, NGT); p0_copy(P + PO_GLAG, sp.glag, 1024, gt, NGT); p0_copy(P + PO_LN1G, sp.ln1g, 4096, gt, NGT); p0_copy(P + PO_LN1B, sp.ln1b, 4096, gt, NGT);
      p0_copy(P + PO_BRG, sp.brg, 16, gt, NGT); p0_copy(P + PO_BRE, sp.bre, 128, gt, NGT); p0_copy(P + PO_LN2G, sp.ln2g, 4096, gt, NGT); p0_copy(P + PO_LN2B, sp.ln2b, 4096, gt, NGT); }
    for (int i = gt; i < 4 * 16 * 1024; i += NGT) { const int l = i >> 14, r = (i >> 10) & 15, k = i & 1023; ABWT[i] = win[((size_t)l * 1024 + k) * DIN + 6144 + r]; }
    for (int i = gt; i < 4 * 36 * 1024; i += NGT) { const int l = i / 36864, c = (i / 1024) % 36, k = i & 1023;
        RWT[i] = (c < 4) ? wrg[((size_t)l * 1024 + k) * 4 + c] : wre[((size_t)l * 1024 + k) * 32 + (c - 4)]; }
}

typedef f32x4 Row4[4];
__device__ __forceinline__ void row_load(Row4& v, const float* p, int lane) { const GAS f32x4* q = (const GAS f32x4*)p + lane;
#pragma unroll
    for (int j = 0; j < 4; ++j) v[j] = q[64 * j]; }
__device__ __forceinline__ void row_store(const Row4& v, float* p, int lane) { GAS f32x4* q = (GAS f32x4*)p + lane;
#pragma unroll
    for (int j = 0; j < 4; ++j) q[64 * j] = v[j]; }
__device__ __forceinline__ void row_standardize(Row4& v) {
    float s = 0.f;
#pragma unroll
    for (int j = 0; j < 4; ++j) s += (v[j].x + v[j].y) + (v[j].z + v[j].w);
    const float mean = wave_sum(s) * (1.f / DM); float s2 = 0.f;
#pragma unroll
    for (int j = 0; j < 4; ++j) { v[j] = v[j] - mean; s2 += (v[j].x * v[j].x + v[j].y * v[j].y) + (v[j].z * v[j].z + v[j].w * v[j].w); }
    const float rstd = 1.f / sqrtf(wave_sum(s2) * (1.f / DM) + LN_EPS);
#pragma unroll
    for (int j = 0; j < 4; ++j) v[j] = v[j] * rstd;
}
__device__ __forceinline__ void row_affine(Row4& v, const float* g, const float* b, bool one_plus, int lane) {
    asm volatile("" : "+s"(g), "+s"(b));
#pragma unroll
    for (int j = 0; j < 4; ++j) { f32x4 gv = *((const GAS f32x4*)g + lane + 64 * j); const f32x4 bv = *((const GAS f32x4*)b + lane + 64 * j); if (one_plus) gv = gv + 1.0f; v[j] = v[j] * gv + bv; }
}
__device__ __forceinline__ void row_store_bf16(const Row4& v, bf16* p, int lane) { GAS unsigned long long* o8 = (GAS unsigned long long*)p + lane;
#pragma unroll
    for (int j = 0; j < 4; ++j) o8[64 * j] = (unsigned long long)pk2(v[j].x, v[j].y) | ((unsigned long long)pk2(v[j].z, v[j].w) << 32); }
__device__ __forceinline__ int idx16(int L) { return ((L >> 5) & 1) + 2 * ((L >> 4) & 1) + 4 * ((L >> 3) & 1) + 8 * ((L >> 2) & 1) + 16 * ((L >> 1) & 1) + 32 * (L & 1); }
__device__ __forceinline__ int idx4(int L) { return ((L >> 5) & 1) + 2 * ((L >> 4) & 1) + 4 * ((L >> 3) & 1) + 8 * ((L >> 2) & 1); }
template <int NC>
__device__ __forceinline__ float rows4_proj(const Row4 (&u)[4], const float* wT, int lane) {
    float p[4 * NC]; f32x4 wa[4], wb[4];
    asm volatile("" : "+s"(wT));
    const GAS f32x4* wp = (const GAS f32x4*)wT + lane;
#define R4_LDW(DD_, CC_) do { _Pragma("unroll") for (int j = 0; j < 4; ++j) DD_[j] = wp[(CC_) * 256 + 64 * j]; } while (0)
#define R4_DOT(WW_, CC_) do { _Pragma("unroll") for (int r = 0; r < 4; ++r) { float s_ = 0.f; _Pragma("unroll") for (int j = 0; j < 4; ++j) s_ += (u[r][j].x * WW_[j].x + u[r][j].y * WW_[j].y) + (u[r][j].z * WW_[j].z + u[r][j].w * WW_[j].w); p[r * NC + (CC_)] = s_; } } while (0)
    R4_LDW(wa, 0);
#pragma unroll
    for (int c = 0; c < NC; c += 2) {
        R4_LDW(wb, c + 1); __builtin_amdgcn_sched_barrier(0);
        R4_DOT(wa, c);
        if (c + 2 < NC) R4_LDW(wa, c + 2);
        __builtin_amdgcn_sched_barrier(0);
        R4_DOT(wb, c + 1);
        __builtin_amdgcn_sched_barrier(0);
    }
#undef R4_LDW
#undef R4_DOT
    int V = 4 * NC;
#pragma unroll
    for (int M = 32; M >= 1; M >>= 1) {
        if (V > 1) { const bool bit = (lane & M) != 0;
#pragma unroll
            for (int i = 0; i < 32; ++i) if (i < V / 2) { const float a = p[2 * i], b = p[2 * i + 1]; const float send = bit ? a : b; const float recv = __shfl_xor(send, M); p[i] = (bit ? b : a) + recv; }
            V >>= 1; }
        else p[0] += __shfl_xor(p[0], M);
    }
    return p[0];
}
constexpr int WAL_OFF = 16384, BAL_OFF = 16384 + 32768;
__device__ __forceinline__ void load_walpha(Frame& F, int l) {
    const float* walpha_all = F.prm + PO_WALPHA; const float* balpha_all = F.prm + PO_BALPHA;
    LAS float* WAL = (LAS float*)(F.lds + RING_OFF + WAL_OFF); LAS float* BAL = (LAS float*)(F.lds + RING_OFF + BAL_OFF);
    for (int i = F.tid; i < 8192; i += NTHREADS) WAL[i] = walpha_all[(size_t)l * 8192 + i];
    if (F.tid < 512) BAL[F.tid] = balpha_all[l * 512 + F.tid];
    __syncthreads();
}
__device__ __forceinline__ void rows4_mod1(Frame& F, Row4 (&x)[4], int m0, int l, LAS float* scr) {
    const int b = m0 >> 12; const float* ada = (const float*)(F.ws + WS_ADA) + ((size_t)l * 8 + b) * 6144;
#pragma unroll
    for (int r = 0; r < 4; ++r) { row_standardize(x[r]); row_affine(x[r], ada + 1024, ada, true, F.lane); row_store_bf16(x[r], (bf16*)(F.ws + WS_U) + (size_t)(m0 + r) * 1024, F.lane); __builtin_amdgcn_sched_barrier(0); }
    const float abv = rows4_proj<16>(x, (const float*)(F.ws + WS_ABWT) + (size_t)l * 16 * 1024, F.lane);
    __builtin_amdgcn_sched_barrier(0);
    scr[idx16(F.lane)] = abv;
    LDS_WAIT(); asm volatile("" ::: "memory");
    const LAS float* WAL = (const LAS float*)(F.lds + RING_OFF + WAL_OFF); const LAS float* BAL = (const LAS float*)(F.lds + RING_OFF + BAL_OFF); float* LA = (float*)(F.ws + WS_LA);
    asm volatile("" : "+s"(WAL), "+s"(BAL));
    float z[4][8];
#pragma unroll
    for (int i = 0; i < 8; ++i) { const float bb = BAL[F.lane + 64 * i];
#pragma unroll
        for (int r = 0; r < 4; ++r) z[r][i] = bb; }
#pragma unroll
    for (int rr = 0; rr < 16; ++rr) { float a[4];
#pragma unroll
        for (int r = 0; r < 4; ++r) a[r] = scr[r * 16 + rr];
#pragma unroll
        for (int i = 0; i < 8; ++i) { const float w_ = WAL[rr * 512 + F.lane + 64 * i];
#pragma unroll
            for (int r = 0; r < 4; ++r) z[r][i] += a[r] * w_; }
        __builtin_amdgcn_sched_barrier(0); }
#pragma unroll
    for (int r = 0; r < 4; ++r) {
#pragma unroll
        for (int i = 0; i < 8; ++i) { const float zz = z[r][i]; const float ls = fminf(zz, 0.f) - __logf(1.0f + __expf(-fabsf(zz)));
            LA[(size_t)(m0 + r) * 512 + F.lane + 64 * i] = ls * (1.0f / 16.0f); }
        __builtin_amdgcn_sched_barrier(0); }
    LDS_WAIT(); asm volatile("" ::: "memory");
}
__device__ __forceinline__ void phase_r0(Frame& F, const float* xin) {
    LAS float* scr = (LAS float*)(F.lds + RING_OFF) + F.wave * 256;
    load_walpha(F, 0);
    for (int gi = F.vcu * NWAVES + F.wave; gi < NTOK / 4; gi += F.G * NWAVES) { const int m0 = 4 * gi; Row4 x[4];
#pragma unroll
        for (int r = 0; r < 4; ++r) { row_load(x[r], xin + (size_t)(m0 + r) * 1024, F.lane); row_store(x[r], F.out + (size_t)(m0 + r) * 1024, F.lane); }
        __builtin_amdgcn_sched_barrier(0);
        rows4_mod1(F, x, m0, 0, scr); }
}
__device__ __forceinline__ void phase_r1(Frame& F, int l) {
    LAS float* scr = (LAS float*)(F.lds + RING_OFF) + F.wave * 256;
    const float* g1 = F.prm + PO_LN1G + l * 1024; const float* b1 = F.prm + PO_LN1B + l * 1024; const float* RWT = (const float*)(F.ws + WS_RWT) + (size_t)l * 36 * 1024;
    const float* brg = F.prm + PO_BRG + l * 4; const float* bre = F.prm + PO_BRE + l * 32;
    gu32* cnt = F.ctl + CW_CNT + l * 32 * 64; int* LIST = (int*)(F.ws + WS_LIST); unsigned* TI = (unsigned*)(F.ws + WS_TOKINFO);
    for (int gi = F.vcu * NWAVES + F.wave; gi < NTOK / 4; gi += F.G * NWAVES) { const int m0 = 4 * gi, b = m0 >> 12; Row4 x[4];
        const float* ada = (const float*)(F.ws + WS_ADA) + ((size_t)l * 8 + b) * 6144;
#pragma unroll
        for (int r = 0; r < 4; ++r) { row_load(x[r], F.out + (size_t)(m0 + r) * 1024, F.lane); row_standardize(x[r]); row_affine(x[r], g1, b1, false, F.lane); row_store(x[r], F.out + (size_t)(m0 + r) * 1024, F.lane);
            row_standardize(x[r]); row_affine(x[r], ada + 4 * 1024, ada + 3 * 1024, true, F.lane); row_store_bf16(x[r], (bf16*)(F.ws + WS_U) + (size_t)(m0 + r) * 1024, F.lane); __builtin_amdgcn_sched_barrier(0); }
        const float vg = rows4_proj<4>(x, RWT, F.lane);
        __builtin_amdgcn_sched_barrier(0);
        const float va = rows4_proj<16>(x, RWT + 4 * 1024, F.lane);
        __builtin_amdgcn_sched_barrier(0);
        const float vb = rows4_proj<16>(x, RWT + 20 * 1024, F.lane);
        __builtin_amdgcn_sched_barrier(0);
        { const int i4 = idx4(F.lane), i16 = idx16(F.lane); scr[(i4 >> 2) * 40 + (i4 & 3)] = vg; scr[(i16 >> 4) * 40 + 4 + (i16 & 15)] = va; scr[(i16 >> 4) * 40 + 20 + (i16 & 15)] = vb; }
        LDS_WAIT(); asm volatile("" ::: "memory");
        if (F.lane < 4) { const LAS float* s = scr + F.lane * 40; const int m = m0 + F.lane;
            float gl[4];
#pragma unroll
            for (int j = 0; j < 4; ++j) gl[j] = s[j] + brg[j];
            int gidx = 0; float gmax = gl[0];
#pragma unroll
            for (int j = 1; j < 4; ++j) if (gl[j] > gmax) { gmax = gl[j]; gidx = j; }
            float den = 0.f;
#pragma unroll
            for (int j = 0; j < 4; ++j) den += __expf(gl[j] - gmax);
            const float gw = 1.0f / den;
            float el[8];
#pragma unroll
            for (int j = 0; j < 8; ++j) el[j] = s[4 + gidx * 8 + j] + bre[gidx * 8 + j];
            int i0 = 0; float v0 = el[0];
#pragma unroll
            for (int j = 1; j < 8; ++j) if (el[j] > v0) { v0 = el[j]; i0 = j; }
            int i1 = -1; float v1 = -INFINITY;
#pragma unroll
            for (int j = 0; j < 8; ++j) if (j != i0 && el[j] > v1) { v1 = el[j]; i1 = j; }
            if (i1 < 0) i1 = (i0 + 1) & 7;
            const float ex = __expf(v1 - v0), inv = 1.0f / (1.0f + ex); const float w0 = inv * gw, w1 = ex * inv * gw;
            const int e0 = gidx * 8 + i0, e1 = gidx * 8 + i1;
            const unsigned p0 = __hip_atomic_fetch_add(cnt + e0 * 64, 1u, RLX_AGENT), p1 = __hip_atomic_fetch_add(cnt + e1 * 64, 1u, RLX_AGENT);
            LIST[(size_t)e0 * LISTCAP + p0] = m; LIST[(size_t)e1 * LISTCAP + p1] = m;
            *(GAS v4u*)(TI + (size_t)m * 8) = (v4u){(unsigned)e0, p0, (unsigned)e1, p1}; *(GAS v4u*)(TI + (size_t)m * 8 + 4) = (v4u){__float_as_uint(w0), __float_as_uint(w1), 0u, 0u};
        }
        LDS_WAIT(); asm volatile("" ::: "memory");
    }
}
__device__ __forceinline__ void moe_tables(Frame& F, int l) {
    LAS int* CNT = (LAS int*)(F.lds + TAB_CNT); LAS int* BASE = (LAS int*)(F.lds + TAB_BASE);
    if (F.tid < 32) CNT[F.tid] = (int)__hip_atomic_load(F.ctl + CW_CNT + (l * 32 + F.tid) * 64, RLX_AGENT);
    __syncthreads();
    if (F.tid == 0) { int a = 0; for (int e = 0; e < 32; ++e) { BASE[e] = a; a += (CNT[e] + 255) >> 8; } BASE[32] = a; }
    __syncthreads();
}
__device__ __forceinline__ void phase_r2(Frame& F, int l) {
    LAS float* scr = (LAS float*)(F.lds + RING_OFF) + F.wave * 256; const LAS int* BASE = (const LAS int*)(F.lds + TAB_BASE);
    if (l + 1 < DEPTH) load_walpha(F, l + 1);
    const float* g2 = F.prm + PO_LN2G + l * 1024; const float* b2 = F.prm + PO_LN2B + l * 1024; const unsigned* TI = (const unsigned*)(F.ws + WS_TOKINFO); const bf16* YB = (const bf16*)(F.ws + WS_YB);
    for (int gi = F.vcu * NWAVES + F.wave; gi < NTOK / 4; gi += F.G * NWAVES) { const int m0 = 4 * gi, b = m0 >> 12; Row4 x[4];
        const float* gate = (const float*)(F.ws + WS_ADA) + ((size_t)l * 8 + b) * 6144 + 5 * 1024;
#pragma unroll
        for (int r = 0; r < 4; ++r) { const int m = m0 + r;
            const v4u ta = *(const GAS v4u*)(TI + (size_t)m * 8); const v4u tb = *(const GAS v4u*)(TI + (size_t)m * 8 + 4);
            const size_t r0 = (size_t)BASE[ta.x & 31] * 256 + ta.y, r1 = (size_t)BASE[ta.z & 31] * 256 + ta.w; const float w0 = __uint_as_float(tb.x), w1 = __uint_as_float(tb.y);
            row_load(x[r], F.out + (size_t)m * 1024, F.lane);
            const GAS unsigned long long* y0 = (const GAS unsigned long long*)(YB + r0 * 1024) + F.lane; const GAS unsigned long long* y1 = (const GAS unsigned long long*)(YB + r1 * 1024) + F.lane;
#pragma unroll
            for (int j = 0; j < 4; ++j) { const unsigned long long a = y0[64 * j], c = y1[64 * j]; const f32x4 gv = *((const GAS f32x4*)gate + F.lane + 64 * j);
                const f32x4 ya = (f32x4){bflo((unsigned)a), bfhi((unsigned)a), bflo((unsigned)(a >> 32)), bfhi((unsigned)(a >> 32))};
                const f32x4 yc = (f32x4){bflo((unsigned)c), bfhi((unsigned)c), bflo((unsigned)(c >> 32)), bfhi((unsigned)(c >> 32))};
                x[r][j] = x[r][j] * DN_ALPHA + gv * (ya * w0 + yc * w1); }
            row_standardize(x[r]); row_affine(x[r], g2, b2, false, F.lane); row_store(x[r], F.out + (size_t)m * 1024, F.lane); __builtin_amdgcn_sched_barrier(0); }
        if (l + 1 < DEPTH) rows4_mod1(F, x, m0, l + 1, scr);
    }
}
typedef short s16x8 __attribute__((ext_vector_type(8)));
#define MFMA16(a, b, c) __builtin_amdgcn_mfma_f32_16x16x32_bf16((a), (b), (c), 0, 0, 0)
__device__ __forceinline__ void phase_gla(Frame& F) {
    constexpr int QE_OFF = 0, KE_OFF = 17408, KLT_OFF = 34816, VT_OFF = 53248, SBT_OFF = 57856, ATT_OFF = 66560, TOT_OFF = 75776, DEC_OFF = 77824;
    constexpr int QS = 272, TS = 144;
    LAS unsigned char* L = F.lds + RING_OFF;
    LAS float* TOT = (LAS float*)(L + TOT_OFF); LAS float* DEC = (LAS float*)(L + DEC_OFF);
    const int tid = F.tid, lane = F.lane, w = F.wave, k = tid & 127, tg = tid >> 7, fr = lane & 15, fq = lane >> 4;
    const bf16* GQ = (const bf16*)(F.ws + WS_GQ); const bf16* GK = (const bf16*)(F.ws + WS_GK); const bf16* GV = (const bf16*)(F.ws + WS_GV);
    const float* LA = (const float*)(F.ws + WS_LA); bf16* OB = (bf16*)(F.ws + WS_OB); float* SSQ = (float*)(F.ws + WS_SSQ);
    for (int item = F.vcu; item < 256; item += F.G) {
        const int s = item & 7, hg = (item >> 3) & 3, b = item >> 5; const size_t row0 = (size_t)b * SEQ;
        const bf16* gq = GQ + (row0 + tg * 16) * 512 + hg * 128 + k; const bf16* gk = GK + (row0 + tg * 16) * 512 + hg * 128 + k; const float* la = LA + (row0 + tg * 16) * 512 + hg * 128 + k;
        const bf16* gv = GV + (row0 + (tid >> 3)) * 1024 + hg * 256 + s * 32 + (tid & 7) * 4;
        bf16* ob = OB + row0 * 1024 + hg * 256 + s * 32; float* ssq = SSQ + row0 * 64 + hg * 16 + s * 2;
        for (int i = tid; i < 8704 / 4; i += NTHREADS) ((LAS unsigned*)(L + SBT_OFF))[i] = 0u;
        f32x4 accS[2]; accS[0] = (f32x4){0.f, 0.f, 0.f, 0.f}; accS[1] = accS[0];
        float lar[16]; bf16 qv[16], kv[16]; unsigned long long vr;
#pragma unroll
        for (int i = 0; i < 16; ++i) { lar[i] = la[(size_t)i * 512]; qv[i] = gq[(size_t)i * 512]; kv[i] = gk[(size_t)i * 512]; }
        vr = *(const GAS unsigned long long*)gv;
        __syncthreads();
        for (int c = 0; c < 64; ++c) {
            float cs[16]; { float run = 0.f;
#pragma unroll
                for (int i = 0; i < 16; ++i) { run += lar[i]; cs[i] = run; }
                TOT[tg * 128 + k] = run; }
            __syncthreads();
            { float off = 0.f, last = 0.f;
#pragma unroll
              for (int g = 0; g < 4; ++g) { const float tv = TOT[g * 128 + k]; if (g < tg) off += tv; last += tv; }
              unsigned klw[8];
#pragma unroll
              for (int i = 0; i < 16; ++i) { const float cum = cs[i] + off; const float e1 = __expf(cum), e2 = __expf(-cum), e3 = __expf(last - cum);
                  const float qf = __uint_as_float((unsigned)qv[i] << 16), kf = __uint_as_float((unsigned)kv[i] << 16); const int t = tg * 16 + i;
                  *(LAS bf16*)(L + QE_OFF + t * QS + k * 2) = (bf16)f2bf(qf * e1); *(LAS bf16*)(L + KE_OFF + t * QS + k * 2) = (bf16)f2bf(kf * e2);
                  const unsigned kl = f2bf(kf * e3); if (i & 1) klw[i >> 1] |= kl << 16; else klw[i >> 1] = kl; }
              *(LAS v4u*)(L + KLT_OFF + k * TS + tg * 32) = (v4u){klw[0], klw[1], klw[2], klw[3]}; *(LAS v4u*)(L + KLT_OFF + k * TS + tg * 32 + 16) = (v4u){klw[4], klw[5], klw[6], klw[7]};
              if (tg == 0) DEC[k] = __expf(last);
              const int t = tid >> 3, w0 = (tid & 7) * 4;
#pragma unroll
              for (int i = 0; i < 4; ++i) *(LAS bf16*)(L + VT_OFF + (w0 + i) * TS + t * 2) = (bf16)((vr >> (16 * i)) & 0xffffu);
            }
            if (c + 1 < 64) { const size_t o = (size_t)(c + 1) * 64;
#pragma unroll
                for (int i = 0; i < 16; ++i) { lar[i] = la[(o + i) * 512]; qv[i] = gq[(o + i) * 512]; kv[i] = gk[(o + i) * 512]; }
                vr = *(const GAS unsigned long long*)(gv + o * 1024); }
            __syncthreads();
            const int ti = w >> 1, wi = w & 1; f32x4 acco = (f32x4){0.f, 0.f, 0.f, 0.f};
            {
#pragma unroll
              for (int s2 = 0; s2 < 2; ++s2) { const int si = wi * 2 + s2; f32x4 a4 = (f32x4){0.f, 0.f, 0.f, 0.f};
                  if (si <= ti) {
#pragma unroll
                      for (int kk = 0; kk < 4; ++kk) { const s16x8 a = *(const LAS s16x8*)(L + QE_OFF + (ti * 16 + fr) * QS + (kk * 32 + 8 * fq) * 2); const s16x8 bb = *(const LAS s16x8*)(L + KE_OFF + (si * 16 + fr) * QS + (kk * 32 + 8 * fq) * 2);
                          a4 = MFMA16(a, bb, a4); } }
#pragma unroll
                  for (int r = 0; r < 4; ++r) { const int t = ti * 16 + fq * 4 + r, sc = si * 16 + fr; const float v = (sc <= t) ? a4[r] : 0.f; *(LAS bf16*)(L + ATT_OFF + t * TS + sc * 2) = (bf16)f2bf(v); } }
#pragma unroll
              for (int kk = 0; kk < 4; ++kk) { const s16x8 a = *(const LAS s16x8*)(L + QE_OFF + (ti * 16 + fr) * QS + (kk * 32 + 8 * fq) * 2); const s16x8 bb = *(const LAS s16x8*)(L + SBT_OFF + (wi * 16 + fr) * QS + (kk * 32 + 8 * fq) * 2);
                  acco = MFMA16(a, bb, acco); }
            }
            __syncthreads();
            {
#pragma unroll
              for (int kk = 0; kk < 2; ++kk) { const s16x8 a = *(const LAS s16x8*)(L + ATT_OFF + (ti * 16 + fr) * TS + (kk * 32 + 8 * fq) * 2); const s16x8 bb = *(const LAS s16x8*)(L + VT_OFF + (wi * 16 + fr) * TS + (kk * 32 + 8 * fq) * 2);
                  acco = MFMA16(a, bb, acco); }
#pragma unroll
              for (int r = 0; r < 4; ++r) { const int t = c * 64 + ti * 16 + fq * 4 + r; ob[(size_t)t * 1024 + wi * 16 + fr] = (bf16)f2bf(acco[r]);
                  float q = acco[r] * acco[r]; q += __shfl_xor(q, 1); q += __shfl_xor(q, 2); q += __shfl_xor(q, 4); q += __shfl_xor(q, 8);
                  if (fr == 0) ssq[(size_t)t * 64 + wi] = q; }
#pragma unroll
              for (int w2 = 0; w2 < 2; ++w2) {
#pragma unroll
                  for (int r = 0; r < 4; ++r) accS[w2][r] *= DEC[w * 16 + fq * 4 + r];
#pragma unroll
                  for (int kk = 0; kk < 2; ++kk) { const s16x8 a = *(const LAS s16x8*)(L + KLT_OFF + (w * 16 + fr) * TS + (kk * 32 + 8 * fq) * 2); const s16x8 bb = *(const LAS s16x8*)(L + VT_OFF + (w2 * 16 + fr) * TS + (kk * 32 + 8 * fq) * 2);
                      accS[w2] = MFMA16(a, bb, accS[w2]); }
                  *(LAS unsigned long long*)(L + SBT_OFF + (w2 * 16 + fr) * QS + (w * 16 + fq * 4) * 2) = (unsigned long long)pk2(accS[w2][0], accS[w2][1]) | ((unsigned long long)pk2(accS[w2][2], accS[w2][3]) << 32); }
            }
        }
        __syncthreads();
    }
}
__device__ __forceinline__ void unpack8(const v4u w, float* d) { d[0] = bflo(w.x); d[1] = bfhi(w.x); d[2] = bflo(w.y); d[3] = bfhi(w.y); d[4] = bflo(w.z); d[5] = bfhi(w.z); d[6] = bflo(w.w); d[7] = bfhi(w.w); }
__device__ __forceinline__ v4u pack8(const float* d) { v4u o; o.x = pk2(d[0], d[1]); o.y = pk2(d[2], d[3]); o.z = pk2(d[4], d[5]); o.w = pk2(d[6], d[7]); return o; }
__device__ __forceinline__ void phase_post(Frame& F, int l) {
    const float* lq1 = F.prm + PO_LQ1; const float* lk1 = F.prm + PO_LK1; const float* lq2 = F.prm + PO_LQ2; const float* lk2 = F.prm + PO_LK2; const float* diffg = F.prm + PO_DIFFG; const float* glag = F.prm + PO_GLAG;
    const int lane = F.lane;
    const float lam_init = 0.8f - 0.6f * expf(-0.3f * (float)l);
    const float d1 = lq1[l * 64 + lane] * lk1[l * 64 + lane], d2 = lq2[l * 64 + lane] * lk2[l * 64 + lane];
    const float lam = expf(wave_sum(d1)) - expf(wave_sum(d2)) + lam_init, osc = 1.0f - lam_init;
    float dgr[16], ggr[16];
#pragma unroll
    for (int i = 0; i < 16; ++i) { dgr[i] = diffg[l * 128 + 16 * (lane & 7) + i] * osc; ggr[i] = glag[l * 256 + 16 * (lane & 15) + i]; }
    const bf16* OP = (const bf16*)(F.ws + WS_OP); const bf16* OB = (const bf16*)(F.ws + WS_OB); const bf16* SG = (const bf16*)(F.ws + WS_SG); const float* SSQ = (const float*)(F.ws + WS_SSQ);
    bf16* OA2 = (bf16*)(F.ws + WS_OA2); bf16* OB2 = (bf16*)(F.ws + WS_OB2);
    for (int m = F.vcu * NWAVES + F.wave; m < NTOK; m += F.G * NWAVES) {
        float o0[16], o1[16], d[16];
        { const GAS v4u* p0 = (const GAS v4u*)(OP + (size_t)m * 2048 + 16 * lane); const GAS v4u* p1 = (const GAS v4u*)(OP + (size_t)m * 2048 + 1024 + 16 * lane);
          unpack8(p0[0], o0); unpack8(p0[1], o0 + 8); unpack8(p1[0], o1); unpack8(p1[1], o1 + 8); }
        float ss = 0.f;
#pragma unroll
        for (int i = 0; i < 16; ++i) { d[i] = o0[i] - lam * o1[i]; ss += d[i] * d[i]; }
        ss += __shfl_xor(ss, 1); ss += __shfl_xor(ss, 2); ss += __shfl_xor(ss, 4);
        { const float r = 1.0f / sqrtf(ss * (1.0f / 128.0f) + LN_EPS);
#pragma unroll
          for (int i = 0; i < 16; ++i) d[i] = d[i] * r * dgr[i];
          GAS v4u* q = (GAS v4u*)(OA2 + (size_t)m * 1024 + 16 * lane); q[0] = pack8(d); q[1] = pack8(d + 8); }
        { const GAS v4u* p0 = (const GAS v4u*)(OB + (size_t)m * 1024 + 16 * lane); const GAS v4u* p1 = (const GAS v4u*)(SG + (size_t)m * 1024 + 16 * lane);
          unpack8(p0[0], o0); unpack8(p0[1], o0 + 8); unpack8(p1[0], o1); unpack8(p1[1], o1 + 8); }
        { const GAS f32x4* sp = (const GAS f32x4*)(SSQ + (size_t)m * 64 + (lane >> 4) * 16); float sq = 0.f;
#pragma unroll
          for (int j = 0; j < 4; ++j) { const f32x4 v = sp[j]; sq += v.x; sq += v.y; sq += v.z; sq += v.w; }
          const float r = 1.0f / sqrtf(sq * (1.0f / 256.0f) + LN_EPS);
#pragma unroll
          for (int i = 0; i < 16; ++i) d[i] = o0[i] * r * ggr[i] * o1[i];
          GAS v4u* q = (GAS v4u*)(OB2 + (size_t)m * 1024 + 16 * lane); q[0] = pack8(d); q[1] = pack8(d + 8); }
    }
}
struct MoeOrder {
    const LAS int* BASE; int total4, G, c;
    __device__ __forceinline__ bool next(int i, pg8::Unit& u) const {
        const int Lx = i * G + c; if (Lx >= total4) return false;
        const int rt = Lx >> 2, pn = Lx & 3; int e = 0;
        for (int j = 1; j < 32; ++j) if (BASE[j] <= rt) e = j;
        e = __builtin_amdgcn_readfirstlane(e);
        u.pm = rt; u.pn = pn; u.pb = e * 4 + pn; return true;
    }
};

#ifndef PHMASK
#define PHMASK 0xFFFF
#endif
struct Args { const float* in[28]; float* out; unsigned char* ws; };
__global__ void __launch_bounds__(NTHREADS, 2) mk_fwd(Args args) {
    extern __shared__ __attribute__((aligned(16))) unsigned char lds[];
    Frame F;
    F.lds = (LAS unsigned char*)lds;
    F.tid = threadIdx.x; F.lane = F.tid & 63; F.wave = __builtin_amdgcn_readfirstlane(F.tid >> 6);
    F.G = gridDim.x; { const int bx = blockIdx.x; F.vcu = (F.G % 8 == 0) ? (bx % 8) * (F.G / 8) + bx / 8 : bx; }
    F.out = args.out; F.ws = args.ws; F.ctl = (gu32*)(args.ws + WS_CTL); F.prm = (const float*)(args.ws + WS_PRM);
    unsigned char* ws = args.ws;
    for (int u = F.tid; u < (LDS_BYTES - LDSCTL_OFF) / 4; u += NTHREADS) ((LAS unsigned*)(F.lds + LDSCTL_OFF))[u] = 0u;
    __syncthreads();
    volatile LAS unsigned* MISC = (volatile LAS unsigned*)(F.lds + MISC_OFF);
    XcdBarrier bar = xcd_barrier_post((unsigned*)(F.ctl + CW_BAR), MISC + 8);
#define GRID_BAR() do { GAS unsigned char* bw_ = (GAS unsigned char*)args.ws; asm volatile("" : "+s"(bw_)); XcdBarrier b_ = bar; b_.bar = (unsigned*)(bw_ + WS_CTL) + CW_BAR; xcd_barrier(b_); } while (0)
#define PHASE_ENTER() do { int t_ = threadIdx.x; asm volatile("" : "+v"(t_)); F.tid = t_; F.lane = t_ & 63; F.wave = __builtin_amdgcn_readfirstlane(t_ >> 6); \
        GAS unsigned char* w_ = (GAS unsigned char*)args.ws; GAS float* o_ = (GAS float*)args.out; asm volatile("" : "+s"(w_), "+s"(o_));   \
        F.ws = (unsigned char*)w_; F.out = (float*)o_; ws = (unsigned char*)w_; F.ctl = (gu32*)(w_ + WS_CTL); F.prm = (const float*)(w_ + WS_PRM); } while (0)
    typedef pg8::bf16_t pb;
    if (PHMASK & 1) { PHASE_ENTER(); p0_ada(F, args.in[I_C], args.in[I_WADA], args.in[I_BADA]);
        p0_weights(F, args.in[I_WIN], args.in[I_WBA], args.in[I_WBB], args.in[I_WOUT], args.in[I_WGE], args.in[I_WUE], args.in[I_WDE], args.in[I_WRG], args.in[I_WRE],
                   SmallPrm{args.in[I_BGATES], args.in[I_WALPHA], args.in[I_BALPHA], args.in[I_LQ1], args.in[I_LK1], args.in[I_LQ2], args.in[I_LK2], args.in[I_DIFFG], args.in[I_GLAG], args.in[I_LN1G], args.in[I_LN1B], args.in[I_BRG], args.in[I_BRE], args.in[I_LN2G], args.in[I_LN2B]}); }
    GRID_BAR();
    if (PHMASK & 2) { PHASE_ENTER(); phase_r0(F, args.in[I_X]); }
    GRID_BAR();
    for (int l = 0; l < DEPTH; ++l) {
        if (PHMASK & 4) { PHASE_ENTER(); pg8::Gemm g{(const pb*)(ws + WS_U), (const pb*)(ws + WS_WIN) + (size_t)l * NPROJ * 1024, NTOK, NPROJ, 1024}; pg8::StaticOrder S; S.init(NTOK, NPROJ, F.G, (int)blockIdx.x);
          pg8::EpiProj E{(pb*)(ws + WS_QB), (pb*)(ws + WS_KB), (pb*)(ws + WS_VB), (pb*)(ws + WS_GQ), (pb*)(ws + WS_GK), (pb*)(ws + WS_GV), (pb*)(ws + WS_SG), (pb*)(ws + WS_GT), F.prm + PO_BGATES + l * 2048};
          pg8::gemm_phase<pg8::EpiProj, pg8::StaticOrder, true, false>(F.lds + RING_OFF, g, S, E, nullptr); }
        GRID_BAR();
        if (PHMASK & 8) { PHASE_ENTER(); phase_gla(F); }
        GRID_BAR();
        if (PHMASK & 16) { PHASE_ENTER(); const attn_body::AttnTensors AT{(const attn_body::bf16*)(ws + WS_QB), (const attn_body::bf16*)(ws + WS_KB), (const attn_body::bf16*)(ws + WS_VB), (attn_body::bf16*)(ws + WS_OP)};
          attn_body::attn_phase<8>((char*)lds + RING_OFF, AT, F.vcu, F.G); }
        GRID_BAR();
        if (PHMASK & 32) { PHASE_ENTER(); phase_post(F, l); }
        GRID_BAR();
        if (PHMASK & 64) { PHASE_ENTER(); pg8::StaticOrder S; S.init(NTOK, 1024, F.G, (int)blockIdx.x);
          { pg8::Gemm g{(const pb*)(ws + WS_OA2), (const pb*)(ws + WS_WBA) + (size_t)l * 1024 * 1024, NTOK, 1024, 1024};
            pg8::EpiGate<0> E{(pb*)(ws + WS_TMP), 1024, nullptr, (const pb*)(ws + WS_GT), 2048, 0};
            pg8::gemm_phase<pg8::EpiGate<0>, pg8::StaticOrder, true, false>(F.lds + RING_OFF, g, S, E, nullptr); }
          { pg8::Gemm g{(const pb*)(ws + WS_OB2), (const pb*)(ws + WS_WBB) + (size_t)l * 1024 * 1024, NTOK, 1024, 1024};
            pg8::EpiGate<1> E{(pb*)(ws + WS_MIX), 1024, (const pb*)(ws + WS_TMP), (const pb*)(ws + WS_GT), 2048, 1024};
            pg8::gemm_phase<pg8::EpiGate<1>, pg8::StaticOrder, true, false>(F.lds + RING_OFF, g, S, E, nullptr); } }
        GRID_BAR();
        if (PHMASK & 128) { PHASE_ENTER(); pg8::Gemm g{(const pb*)(ws + WS_MIX), (const pb*)(ws + WS_WOUT) + (size_t)l * 1024 * 1024, NTOK, 1024, 1024}; pg8::StaticOrder S; S.init(NTOK, 1024, F.G, (int)blockIdx.x);
          pg8::EpiResid E{F.out, (const float*)(ws + WS_ADA) + (size_t)l * 8 * 6144 + 2 * 1024, 6144, DN_ALPHA};
          pg8::gemm_phase<pg8::EpiResid, pg8::StaticOrder, true, false>(F.lds + RING_OFF, g, S, E, nullptr); }
        GRID_BAR();
        if (PHMASK & 256) { PHASE_ENTER(); phase_r1(F, l); }
        GRID_BAR();
        if (PHMASK & 512) { PHASE_ENTER(); moe_tables(F, l); }
        if (PHMASK & 512) { const LAS int* BASE = (const LAS int*)(F.lds + TAB_BASE); const LAS int* CNT = (const LAS int*)(F.lds + TAB_CNT); LAS int* IDX = (LAS int*)(F.lds + TAB_IDX);
          const int total4 = __builtin_amdgcn_readfirstlane(BASE[32]) * 4; const int* LIST = (const int*)(ws + WS_LIST);
          MoeOrder S{BASE, total4, F.G, (int)blockIdx.x};
          for (int ui = 0; ui < IDX_UNITS; ++ui) { pg8::Unit u; if (!S.next(ui, u)) break; const int e = u.pb >> 2;
              if (F.tid < 256) { const int pos = (u.pm - BASE[e]) * 256 + F.tid; IDX[ui * 256 + F.tid] = (pos < CNT[e]) ? LIST[(size_t)e * LISTCAP + pos] : 0; } }
          __syncthreads();
          { pg8::Gemm g{(const pb*)(ws + WS_U), (const pb*)(ws + WS_W1) + (size_t)l * 32 * 1024 * 1024, MOE_MAXT * 256, 1024, 1024};
            pg8::EpiSwiGLU E{(pb*)(ws + WS_H)};
            pg8::gemm_phase<pg8::EpiSwiGLU, MoeOrder, true, true>(F.lds + RING_OFF, g, S, E, IDX); }
          GRID_BAR();
          PHASE_ENTER();
          { pg8::Gemm g{(const pb*)(ws + WS_H), (const pb*)(ws + WS_WD) + (size_t)l * 32 * 1024 * 512, MOE_MAXT * 256, 1024, 512};
            pg8::EpiGate<2> E{(pb*)(ws + WS_YB), 1024, nullptr, nullptr, 0, 0};
            pg8::gemm_phase<pg8::EpiGate<2>, MoeOrder, true, false>(F.lds + RING_OFF, g, S, E, nullptr); }
        }
        GRID_BAR();
        if (PHMASK & 1024) { PHASE_ENTER(); phase_r2(F, l); }
        if (l + 1 < DEPTH) GRID_BAR();
    }
}

extern "C" void kernel_launch(void* const* d_in, const int* in_sizes, int n_in, void* d_out, int out_size, void* d_ws, size_t ws_size, hipStream_t stream) {
    static int grid = 0;
    if (grid == 0) {
        if (n_in != 28 || in_sizes[0] != NTOK * DM || out_size != NTOK * DM || ws_size < WS_END) { fprintf(stderr, "kernel_launch: unexpected shapes (n_in %d, in0 %d, out %d, ws %zu < %zu); nothing launched\n", n_in, n_in > 0 ? in_sizes[0] : -1, out_size, ws_size, (size_t)WS_END); grid = -1; return; }
        int dev = 0, cus = 0, per_cu = 0;
        if (hipGetDevice(&dev) != hipSuccess || hipDeviceGetAttribute(&cus, hipDeviceAttributeMultiprocessorCount, dev) != hipSuccess) { fprintf(stderr, "kernel_launch: device query failed\n"); grid = -1; return; }
        if (hipFuncSetAttribute((const void*)mk_fwd, hipFuncAttributeMaxDynamicSharedMemorySize, LDS_BYTES) != hipSuccess) { fprintf(stderr, "kernel_launch: hipFuncSetAttribute failed\n"); grid = -1; return; }
        if (hipOccupancyMaxActiveBlocksPerMultiprocessor(&per_cu, (const void*)mk_fwd, NTHREADS, LDS_BYTES) != hipSuccess || per_cu < 1) { fprintf(stderr, "kernel_launch: occupancy query says %d\n", per_cu); }
        (void)hipGetLastError();
        grid = cus;
    }
    if (grid < 0) return;
    if (hipMemsetAsync((char*)d_ws + WS_CTL, 0, CTL_ZERO_BYTES, stream) != hipSuccess) { fprintf(stderr, "kernel_launch: memset failed\n"); return; }
    Args a{};
    for (int i = 0; i < 28; ++i) a.in[i] = (const float*)d_in[i];
    a.out = (float*)d_out; a.ws = (unsigned char*)d_ws;
    hipLaunchKernelGGL(mk_fwd, dim3(grid), dim3(NTHREADS), LDS_BYTES, stream, a);
    const hipError_t le = hipPeekAtLastError();
    if (le != hipSuccess) fprintf(stderr, "kernel_launch: launch failed: %s\n", hipGetErrorName(le));
}
```

```cpp
#include <hip/hip_runtime.h>
#include <hip/hip_bf16.h>
#include <cstdio>
#include <cstdint>
#include <cmath>
namespace pg8 {
#define PG8_LAS __attribute__((address_space(3)))
typedef unsigned short bf16_t;
typedef short bf16x8 __attribute__((ext_vector_type(8)));
typedef float f32x4 __attribute__((ext_vector_type(4)));
typedef float f32x2 __attribute__((ext_vector_type(2)));
typedef unsigned u32x4 __attribute__((ext_vector_type(4)));
typedef unsigned u32x2 __attribute__((ext_vector_type(2)));
constexpr int BM = 256, BK = 64, HALF = 128, HTB = HALF * BK * 2  , STAGE_BYTES = 8 * HTB, NXCD = 8, WGM = 8;

__host__ __device__ __forceinline__ int lds_byte(int r, int c) { const int st = (r >> 4) * 2 + (c >> 5), rr = r & 15, cc = c & 31, ob = rr * 64 + cc * 2; return st * 1024 + (ob ^ (((ob >> 9) & 1) << 5)); }
__host__ __device__ __forceinline__ void stage_rc(int b, int& R, int& C) { const int st = b / 1024, sb = b % 1024, swz = sb ^ (((sb >> 9) & 1) << 5); R = (st >> 1) * 16 + swz / 64; C = (st & 1) * 32 + (swz % 64) / 2; }
__host__ __device__ __forceinline__ int perm32(int rho) { const int n = rho >> 4, i = rho & 15; return 8 * (i >> 2) + 4 * n + (i & 3); }

struct Unit { int pm, pn, pb; };
struct Gemm { const bf16_t* A; const bf16_t* Bt; int M, N, K; };

struct StaticOrder {
    int nM, nN, nwg, G, c;
    __host__ __device__ void init(int M, int N, int G_, int c_) { nM = M / BM; nN = N / BM; nwg = nM * nN; G = G_; c = c_; }
    __host__ __device__ bool next(int i, Unit& u) const {
        const long L = (long)i * G + c; if (L >= nwg) return false;
        int wgid = (int)L; { const int q = nwg / NXCD, r = nwg % NXCD, xcd = wgid % NXCD, off = wgid / NXCD; wgid = (xcd < r ? xcd * (q + 1) : r * (q + 1) + (xcd - r) * q) + off; }
        const int nig = WGM * nN, gid = wgid / nig, fm = gid * WGM, gsz = (nM - fm) < WGM ? (nM - fm) : WGM;
        u.pm = fm + ((wgid % nig) % gsz); u.pn = (wgid % nig) / gsz; u.pb = u.pn; return true;
    }
};

__device__ __forceinline__ unsigned cvt_pk_bf16(float lo, float hi) { unsigned r; asm volatile("v_cvt_pk_bf16_f32 %0, %1, %2" : "=v"(r) : "v"(lo), "v"(hi)); return r; }
__device__ __forceinline__ float bf_lo(unsigned w) { return __uint_as_float(w << 16); }
__device__ __forceinline__ float bf_hi(unsigned w) { return __uint_as_float(w & 0xffff0000u); }
__device__ __forceinline__ float sigmoidf_(float x) { return __builtin_amdgcn_rcpf(1.0f + __expf(-x)); }

template <class Epi, class Sched, bool ALIGN_EPI, bool GATHER>
__device__ __forceinline__ void gemm_phase(PG8_LAS unsigned char* lds, const Gemm g, const Sched& S, const Epi& E, const PG8_LAS int* idxtab) {
    int tid_ = threadIdx.x; asm volatile("" : "+v"(tid_));
    const int tid = tid_, wid = __builtin_amdgcn_readfirstlane(tid >> 6), lane = tid & 63, wr = wid >> 2, wc = wid & 3, fr = lane & 15, fq = lane >> 4;
    const int K = g.K, nt = K / BK;
    unsigned voffA[2], voffB[2];
#pragma unroll
    for (int i = 0; i < 2; ++i) { int R, C; stage_rc(tid * 16 + i * 8192, R, C); const int Rb = Epi::PERM ? ((R & ~31) + perm32(R & 31)) : R;
        voffA[i] = (unsigned)(R * K + C) * 2u; voffB[i] = (unsigned)(Rb * K + C) * 2u; }
    const size_t kstep = (size_t)(BK * 2);
    const size_t hstep = (size_t)HALF * K * 2;
    const size_t tstep = 2 * hstep;
    const unsigned ldsw = (unsigned)wid * 1024u;
    const int aoff = lds_byte(wr * 64 + fr, fq * 8), boff = lds_byte(wc * 32 + fr, fq * 8);
    unsigned offAc[2][2];
    int nui = 0;
#define PG8_SA(b, h) (((b) * 2 + (h)) * HTB)
#define PG8_SB(b, h) ((4 + (b) * 2 + (h)) * HTB)
#define PG8_STAGE(bufoff, gbase, voff) do { _Pragma("unroll") for (int _i = 0; _i < 2; ++_i) \
        __builtin_amdgcn_global_load_lds((const unsigned*)((const char*)(gbase) + (voff)[_i]), (PG8_LAS unsigned*)(lds + (bufoff) + ldsw + _i * 8192), 16, 0, 0); } while (0)
#define PG8_GOFF(uix, h, i, tt) ({ int _R, _C; stage_rc((tt) * 16 + (i) * 8192, _R, _C); (unsigned)idxtab[(uix) * 256 + (h) * HALF + _R] * (unsigned)(K * 2) + (unsigned)_C * 2u; })
#define PG8_STAGE_A(bufoff, kb, h, nx) do { if constexpr (GATHER) { unsigned _o[2] = {offAc[h][0], offAc[h][1]}; \
        if (nx) { int _t = tid; asm volatile("" : "+v"(_t)); _o[0] = PG8_GOFF(nui, h, 0, _t); _o[1] = PG8_GOFF(nui, h, 1, _t); } \
        _Pragma("unroll") for (int _i = 0; _i < 2; ++_i) \
        __builtin_amdgcn_global_load_lds((const unsigned*)((const char*)g.A + (size_t)(kb) + _o[_i]), (PG8_LAS unsigned*)(lds + (bufoff) + ldsw + _i * 8192), 16, 0, 0); } \
        else { const char* _b = ((nx) ? nA : cA) + (size_t)(kb) + (size_t)(h) * hstep; PG8_STAGE(bufoff, _b, voffA); } } while (0)
#define PG8_GIDX(dst, uix) do { if constexpr (GATHER) { int _t = tid; asm volatile("" : "+v"(_t)); _Pragma("unroll") for (int _h = 0; _h < 2; ++_h) _Pragma("unroll") for (int _i = 0; _i < 2; ++_i) \
        dst[_h][_i] = PG8_GOFF(uix, _h, _i, _t); } } while (0)
#define PG8_LDA(dst, b, h) do { _Pragma("unroll") for (int m = 0; m < 4; ++m) _Pragma("unroll") for (int k = 0; k < 2; ++k) dst[m][k] = *(const PG8_LAS bf16x8*)(lds + PG8_SA(b, h) + aoff + m * 2048 + k * 1024); } while (0)
#define PG8_LDB(dst, b, h) do { _Pragma("unroll") for (int n = 0; n < 2; ++n) _Pragma("unroll") for (int k = 0; k < 2; ++k) dst[n][k] = *(const PG8_LAS bf16x8*)(lds + PG8_SB(b, h) + boff + n * 2048 + k * 1024); } while (0)
#define PG8_MMA(ai, bj, At, Bt) do { __builtin_amdgcn_s_setprio(1); _Pragma("unroll") for (int m = 0; m < 4; ++m) _Pragma("unroll") for (int n = 0; n < 2; ++n) _Pragma("unroll") for (int k = 0; k < 2; ++k) \
        acc[ai][bj][m][n] = __builtin_amdgcn_mfma_f32_16x16x32_bf16(Bt[n][k], At[m][k], acc[ai][bj][m][n], 0, 0, 0); __builtin_amdgcn_s_setprio(0); } while (0)
#define PG8_WAIT_V(n) asm volatile("s_waitcnt vmcnt(" #n ")" ::: "memory")
#define PG8_WAIT_L(n) asm volatile("s_waitcnt lgkmcnt(" #n ")" ::: "memory")
#define PG8_BAR __builtin_amdgcn_s_barrier()
#define PG8_SCHED __builtin_amdgcn_sched_barrier(0)
    Unit cur, nxt; int ui = 0;
    if (!S.next(0, cur)) return;
    f32x4 acc[2][2][4][2];
#pragma unroll
    for (int a = 0; a < 2; ++a)
#pragma unroll
        for (int b = 0; b < 2; ++b)
#pragma unroll
            for (int m = 0; m < 4; ++m)
#pragma unroll
                for (int n = 0; n < 2; ++n) acc[a][b][m][n] = (f32x4){0.f, 0.f, 0.f, 0.f};
    bf16x8 At[4][2], B0[2][2], B1[2][2];
    const char* cA = (const char*)g.A + (size_t)cur.pm * tstep; const char* cB = (const char*)g.Bt + (size_t)cur.pb * tstep;
    const char* nA = cA;
    PG8_GIDX(offAc, 0);
    PG8_STAGE(PG8_SB(0, 0), cB, voffB); PG8_STAGE(PG8_SB(0, 1), cB + hstep, voffB); PG8_STAGE_A(PG8_SA(0, 0), 0, 0, false); PG8_STAGE_A(PG8_SA(0, 1), 0, 1, false);
    if (wr == 1) PG8_BAR;
    PG8_WAIT_V(2); PG8_BAR;
    PG8_STAGE(PG8_SB(1, 0), cB + kstep, voffB); PG8_STAGE_A(PG8_SA(1, 0), kstep, 0, false); PG8_STAGE(PG8_SB(1, 1), cB + hstep + kstep, voffB);
    PG8_WAIT_V(6); PG8_BAR;
    for (;;) {
        const bool has_next = S.next(ui + 1, nxt);
        nA = has_next ? (const char*)g.A + (size_t)nxt.pm * tstep : cA; const char* nB = has_next ? (const char*)g.Bt + (size_t)nxt.pb * tstep : cB;
        nui = has_next ? ui + 1 : ui;
        for (int t = 0; t < nt; t += 2) {
            const bool last = (t == nt - 2);
            const size_t kb1 = (size_t)(t + 1) * kstep;
            const size_t kb2 = last ? (size_t)0 : (size_t)(t + 2) * kstep, kb3 = kb2 + kstep;
            const char* b2 = last ? nB : cB + (size_t)(t + 2) * kstep; const char* b3 = b2 + kstep;
            PG8_LDB(B0, 0, 0); PG8_LDB(B1, 0, 1); PG8_SCHED; PG8_LDA(At, 0, 0); PG8_STAGE_A(PG8_SA(1, 1), kb1, 1, false);
            PG8_WAIT_V(8); PG8_WAIT_L(0); PG8_BAR; PG8_MMA(0, 0, At, B0); PG8_MMA(0, 1, At, B1); PG8_BAR; PG8_SCHED;
            PG8_LDA(At, 0, 1); PG8_STAGE(PG8_SB(0, 0), b2, voffB); PG8_STAGE(PG8_SB(0, 1), b2 + hstep, voffB); PG8_STAGE_A(PG8_SA(0, 0), kb2, 0, last);
            PG8_WAIT_V(8); PG8_WAIT_L(0); PG8_BAR; PG8_MMA(1, 0, At, B0); PG8_MMA(1, 1, At, B1); PG8_BAR; PG8_SCHED;
            PG8_LDB(B0, 1, 0); PG8_LDB(B1, 1, 1); PG8_SCHED; PG8_LDA(At, 1, 0); PG8_STAGE_A(PG8_SA(0, 1), kb2, 1, last);
            PG8_WAIT_V(8); PG8_WAIT_L(0); PG8_BAR; PG8_MMA(0, 0, At, B0); PG8_MMA(0, 1, At, B1); PG8_BAR; PG8_SCHED;
            PG8_LDA(At, 1, 1); PG8_STAGE(PG8_SB(1, 0), b3, voffB); PG8_STAGE(PG8_SB(1, 1), b3 + hstep, voffB); PG8_STAGE_A(PG8_SA(1, 0), kb3, 0, last);
            PG8_WAIT_V(8); PG8_WAIT_L(0); PG8_BAR; PG8_MMA(1, 0, At, B0); PG8_MMA(1, 1, At, B1); PG8_BAR; PG8_SCHED;
        }
        if constexpr (ALIGN_EPI) { if (wr == 0) PG8_BAR; }
        E(acc, cur, wr, wc, fr, fq);
        if (!has_next) break;
#pragma unroll
        for (int a = 0; a < 2; ++a)
#pragma unroll
            for (int b = 0; b < 2; ++b)
#pragma unroll
                for (int m = 0; m < 4; ++m)
#pragma unroll
                    for (int n = 0; n < 2; ++n) acc[a][b][m][n] = (f32x4){0.f, 0.f, 0.f, 0.f};
        cur = nxt; cA = nA; cB = nB; ++ui;
        PG8_GIDX(offAc, ui);
        if constexpr (ALIGN_EPI) { if (wr == 1) PG8_BAR; }
    }
    PG8_WAIT_V(0);
    if constexpr (!ALIGN_EPI) { if (wr == 0) PG8_BAR; }
    PG8_BAR;
#undef PG8_SA
#undef PG8_SB
#undef PG8_STAGE
#undef PG8_STAGE_A
#undef PG8_GIDX
#undef PG8_GOFF
#undef PG8_LDA
#undef PG8_LDB
#undef PG8_MMA
#undef PG8_WAIT_V
#undef PG8_WAIT_L
#undef PG8_BAR
#undef PG8_SCHED
}
}
namespace pg8 {
constexpr float ATT_C2 = 0.125f * 1.4426950408889634f;
constexpr float GLA_QS = 0.08838834764831845f;
struct EpiProj {
    static constexpr bool PERM = true;
    bf16_t *Qb, *Kb, *Vb, *GQ, *GK, *GV, *SG, *GT; const float* bgates;
    __device__ __forceinline__ void operator()(const f32x4 (&acc)[2][2][4][2], const Unit& u, int wr, int wc, int fr, int fq) const {
        asm volatile("" : "+v"(fr), "+v"(fq));
        const int pn = u.pn; bf16_t* base; int ldc = 1024, ct; int act = 0; float sc = 1.f;
        if (pn < 4) { base = Qb; ct = pn; sc = ATT_C2; }
        else if (pn < 8) { base = Kb; ct = pn - 4; }
        else if (pn < 12) { base = Vb; ct = pn - 8; }
        else if (pn < 14) { base = GQ; ldc = 512; ct = pn - 12; sc = GLA_QS; }
        else if (pn < 16) { base = GK; ldc = 512; ct = pn - 14; }
        else if (pn < 20) { base = GV; ct = pn - 16; }
        else if (pn < 24) { base = SG; ct = pn - 20; act = 1; }
        else { base = GT; ldc = 2048; ct = pn - 24; act = 2; }
        const int row0 = u.pm * BM + wr * 64 + fr, col0 = ct * BM + wc * 32 + 8 * fq;
        f32x4 bv[2][2];
#pragma unroll
        for (int bj = 0; bj < 2; ++bj)
#pragma unroll
            for (int n = 0; n < 2; ++n) bv[bj][n] = (act == 2) ? *(const f32x4*)(bgates + col0 + bj * HALF + 4 * n) : (f32x4){0.f, 0.f, 0.f, 0.f};
#pragma unroll
        for (int ai = 0; ai < 2; ++ai)
#pragma unroll
            for (int m = 0; m < 4; ++m) { bf16_t* rowp = base + (size_t)(row0 + ai * HALF + m * 16) * ldc + col0;
#pragma unroll
                for (int bj = 0; bj < 2; ++bj) { f32x4 v0 = acc[ai][bj][m][0] * sc + bv[bj][0], v1 = acc[ai][bj][m][1] * sc + bv[bj][1];
                    if (act != 0) {
#pragma unroll
                        for (int e = 0; e < 4; ++e) { const float s0 = sigmoidf_(v0[e]), s1 = sigmoidf_(v1[e]); v0[e] = (act == 1) ? v0[e] * s0 : s0; v1[e] = (act == 1) ? v1[e] * s1 : s1; } }
                    u32x4 w; w.x = cvt_pk_bf16(v0[0], v0[1]); w.y = cvt_pk_bf16(v0[2], v0[3]); w.z = cvt_pk_bf16(v1[0], v1[1]); w.w = cvt_pk_bf16(v1[2], v1[3]);
                    *(u32x4*)(rowp + bj * HALF) = w; } }
    }
};
template <int MODE> struct EpiGate {
    static constexpr bool PERM = true;
    bf16_t* O; int ldo; const bf16_t* T; const bf16_t* gate; int ldg, gcol0;
    __device__ __forceinline__ void operator()(const f32x4 (&acc)[2][2][4][2], const Unit& u, int wr, int wc, int fr, int fq) const {
        asm volatile("" : "+v"(fr), "+v"(fq));
        const int row0 = u.pm * BM + wr * 64 + fr, col0 = u.pn * BM + wc * 32 + 8 * fq;
#pragma unroll
        for (int ai = 0; ai < 2; ++ai)
#pragma unroll
            for (int m = 0; m < 4; ++m) { const size_t row = (size_t)(row0 + ai * HALF + m * 16);
#pragma unroll
                for (int bj = 0; bj < 2; ++bj) { f32x4 v0 = acc[ai][bj][m][0], v1 = acc[ai][bj][m][1]; const int col = col0 + bj * HALF;
                    if (MODE != 2) { const u32x4 gw = *(const u32x4*)(gate + row * ldg + gcol0 + col);
                        v0 = v0 * (f32x4){bf_lo(gw.x), bf_hi(gw.x), bf_lo(gw.y), bf_hi(gw.y)}; v1 = v1 * (f32x4){bf_lo(gw.z), bf_hi(gw.z), bf_lo(gw.w), bf_hi(gw.w)}; }
                    if (MODE == 1) { const u32x4 tw = *(const u32x4*)(T + row * ldo + col);
                        v0 = v0 + (f32x4){bf_lo(tw.x), bf_hi(tw.x), bf_lo(tw.y), bf_hi(tw.y)}; v1 = v1 + (f32x4){bf_lo(tw.z), bf_hi(tw.z), bf_lo(tw.w), bf_hi(tw.w)}; }
                    u32x4 w; w.x = cvt_pk_bf16(v0[0], v0[1]); w.y = cvt_pk_bf16(v0[2], v0[3]); w.z = cvt_pk_bf16(v1[0], v1[1]); w.w = cvt_pk_bf16(v1[2], v1[3]);
                    *(u32x4*)(O + row * ldo + col) = w; }
                asm volatile("" ::: "memory"); }
    }
};
struct EpiResid {
    static constexpr bool PERM = false;
    const float* X; float* Xo; const float* gvec; int gstride; float alpha;
    __device__ __forceinline__ void operator()(const f32x4 (&acc)[2][2][4][2], const Unit& u, int wr, int wc, int fr, int fq) const {
        asm volatile("" : "+v"(fr), "+v"(fq));
        const int row0 = u.pm * BM + wr * 64 + fr, col0 = u.pn * BM + wc * 32 + 4 * fq; const float* gv = gvec + (size_t)(u.pm >> 4) * gstride;
        f32x4 g4[2][2];
#pragma unroll
        for (int bj = 0; bj < 2; ++bj)
#pragma unroll
            for (int n = 0; n < 2; ++n) g4[bj][n] = *(const f32x4*)(gv + col0 + bj * HALF + n * 16);
#pragma unroll
        for (int ai = 0; ai < 2; ++ai)
#pragma unroll
            for (int m = 0; m < 4; ++m) { const size_t ro = (size_t)(row0 + ai * HALF + m * 16) * 1024 + col0;
#pragma unroll
                for (int bj = 0; bj < 2; ++bj)
#pragma unroll
                    for (int n = 0; n < 2; ++n) { const size_t o = ro + bj * HALF + n * 16; const f32x4 xv = *(const f32x4*)(X + o); *(f32x4*)(Xo + o) = xv * alpha + g4[bj][n] * acc[ai][bj][m][n]; }
                asm volatile("" ::: "memory"); }
    }
};
struct EpiSwiGLU {
    static constexpr bool PERM = true;
    bf16_t* H;
    __device__ __forceinline__ void operator()(const f32x4 (&acc)[2][2][4][2], const Unit& u, int wr, int wc, int fr, int fq) const {
        asm volatile("" : "+v"(fr), "+v"(fq));
        const int row0 = u.pm * BM + wr * 64 + fr, col0 = u.pn * HALF + wc * 32 + 8 * fq;
#pragma unroll
        for (int ai = 0; ai < 2; ++ai)
#pragma unroll
            for (int m = 0; m < 4; ++m) { f32x4 h0, h1;
#pragma unroll
                for (int e = 0; e < 4; ++e) { const float g0 = acc[ai][0][m][0][e], g1 = acc[ai][0][m][1][e]; h0[e] = g0 * sigmoidf_(g0) * acc[ai][1][m][0][e]; h1[e] = g1 * sigmoidf_(g1) * acc[ai][1][m][1][e]; }
                u32x4 w; w.x = cvt_pk_bf16(h0[0], h0[1]); w.y = cvt_pk_bf16(h0[2], h0[3]); w.z = cvt_pk_bf16(h1[0], h1[1]); w.w = cvt_pk_bf16(h1[2], h1[3]);
                *(u32x4*)(H + (size_t)(row0 + ai * HALF + m * 16) * 512 + col0) = w; }
    }
};
}
#include <hip/hip_bf16.h>
#include <cmath>
namespace attn_body {
using bf16=__hip_bfloat16;
using bf16x8=__attribute__((ext_vector_type(8)))short;
using s16x4=__attribute__((ext_vector_type(4)))short;
using f32x16=__attribute__((ext_vector_type(16)))float;
using u32x4=__attribute__((ext_vector_type(4)))unsigned;
constexpr int BATCH=8,NHEAD=16,SEQ=4096,D=64,DM=NHEAD*D,OPITCH=2048;
constexpr int NW=8,QBLK=32,QB=QBLK*NW,KVBLK=64,NQB=SEQ/QB;
constexpr int ATTN_PITCH=DM, ATTN_UNIT_ROWS=QB;
__device__ __forceinline__ int crow(int r,int hi){return (r&3)+8*(r>>2)+4*hi;}
#define SBAR() __builtin_amdgcn_sched_barrier(0)
__device__ __forceinline__ void cmask(f32x16&p0,f32x16&p1,int jb,int qrel,int hi){
  const float NEG=-INFINITY; int kb=64*jb+4*hi;
  #pragma unroll
  for(int r=0;r<16;++r){int kv=kb+(r&3)+8*(r>>2); if(kv>qrel)p0[r]=NEG; if(kv+32>qrel)p1[r]=NEG;}
}

constexpr int NSLOT=3, SLOTB=8192;
constexpr int LDS_K=0, LDS_V=NSLOT*SLOTB, LDS_WS=3*NSLOT*SLOTB, LDS_OST=LDS_WS+NW*64*4, LDS_BYTES=LDS_OST+NW*4096;
constexpr float C2=0.125f*1.4426950408889634f;
__device__ __forceinline__ void glds16s(const void*sbase,unsigned voff,unsigned lds_dst){unsigned keep;
  asm volatile("s_mov_b32 %0, m0\n\ts_mov_b32 m0, %2\n\ts_nop 0\n\tglobal_load_lds_dwordx4 %1, %3\n\ts_mov_b32 m0, %0":"=&s"(keep):"v"(voff),"s"(lds_dst),"s"(sbase):"memory");}
__device__ __forceinline__ void glds16(const void*gsrc,unsigned lds_dst){unsigned keep;
  asm volatile("s_mov_b32 %0, m0\n\ts_mov_b32 m0, %2\n\ts_nop 0\n\tglobal_load_lds_dwordx4 %1, off\n\ts_mov_b32 m0, %0":"=&s"(keep):"v"(gsrc),"s"(lds_dst):"memory");}
__device__ __forceinline__ float max3f(float a,float b,float c){float r;asm("v_max3_f32 %0, %1, %2, %3":"=v"(r):"v"(a),"v"(b),"v"(c));return r;}
__device__ __forceinline__ float max2f(float a,float b){float r;asm("v_max_f32_e32 %0, %1, %2":"=v"(r):"v"(a),"v"(b));return r;}
__device__ __forceinline__ float fadd_s(float a,float b){float r;asm("v_add_f32_e32 %0, %1, %2":"=v"(r):"v"(a),"v"(b));return r;}
__device__ __forceinline__ float fsub_s(float a,float b){float r;asm("v_sub_f32_e32 %0, %1, %2":"=v"(r):"v"(a),"v"(b));return r;}
typedef float f32x2_t __attribute__((ext_vector_type(2))); typedef __bf16 bf16x2_t __attribute__((ext_vector_type(2)));
__device__ __forceinline__ unsigned cvtpk_s(float lo,float hi){f32x2_t v={lo,hi};bf16x2_t b=__builtin_convertvector(v,bf16x2_t);return __builtin_bit_cast(unsigned,b);}
#define WAIT_BAR(N) asm volatile("s_waitcnt vmcnt(" #N ") lgkmcnt(0)\n\ts_barrier":::"memory")

__device__ __forceinline__ void qkt(f32x16&p0,f32x16&p1,const char*Kslot,const bf16x8*qr,const f32x16&c0,const f32x16&c1,int r32,int hi){
  const char*kb=Kslot+hi*1024+r32*16;
  #pragma unroll
  for(int d0=0;d0<4;++d0){
    const bf16x8 b0=*reinterpret_cast<const bf16x8*>(kb+d0*2048);
    const bf16x8 b1=*reinterpret_cast<const bf16x8*>(kb+d0*2048+512);
    if(d0==0){p0=__builtin_amdgcn_mfma_f32_32x32x16_bf16(b0,qr[0],c0,0,0,0);p1=__builtin_amdgcn_mfma_f32_32x32x16_bf16(b1,qr[0],c1,0,0,0);}
    else{p0=__builtin_amdgcn_mfma_f32_32x32x16_bf16(b0,qr[d0],p0,0,0,0);p1=__builtin_amdgcn_mfma_f32_32x32x16_bf16(b1,qr[d0],p1,0,0,0);}}
}
typedef __attribute__((address_space(3))) const char* lds_cptr;
typedef short v4i16_t __attribute__((ext_vector_type(4)));
__device__ __forceinline__ void kload8(bf16x8*kf,lds_cptr kp){
  kf[0]=*(const __attribute__((address_space(3))) bf16x8*)(kp);      kf[1]=*(const __attribute__((address_space(3))) bf16x8*)(kp+512);
  kf[2]=*(const __attribute__((address_space(3))) bf16x8*)(kp+2048); kf[3]=*(const __attribute__((address_space(3))) bf16x8*)(kp+2560);
  kf[4]=*(const __attribute__((address_space(3))) bf16x8*)(kp+4096); kf[5]=*(const __attribute__((address_space(3))) bf16x8*)(kp+4608);
  kf[6]=*(const __attribute__((address_space(3))) bf16x8*)(kp+6144); kf[7]=*(const __attribute__((address_space(3))) bf16x8*)(kp+6656);
}
__device__ __forceinline__ void kload2(bf16x8*kf,lds_cptr kp,int j){ kf[2*j]=*(const __attribute__((address_space(3))) bf16x8*)(kp+j*2048); kf[2*j+1]=*(const __attribute__((address_space(3))) bf16x8*)(kp+j*2048+512); }
__device__ __forceinline__ s16x4 vtr(lds_cptr p){ return __builtin_bit_cast(s16x4,__builtin_amdgcn_ds_read_tr16_b64_v4i16((__attribute__((address_space(3))) v4i16_t*)p)); }
__device__ __forceinline__ float rowmax(const f32x16&p0,const f32x16&p1){
  float a=max3f(p0[0],p0[1],p1[0]),b=max3f(p0[2],p0[3],p1[1]);a=max3f(a,p1[2],p1[3]);
  #pragma unroll
  for(int r=4;r<16;r+=4){a=max3f(a,p0[r],p0[r+1]);b=max3f(b,p0[r+2],p0[r+3]);a=max3f(a,p1[r],p1[r+1]);b=max3f(b,p1[r+2],p1[r+3]);}
  const float m=max2f(a,b);
  auto rr=__builtin_amdgcn_permlane32_swap(__float_as_uint(m),__float_as_uint(m),false,false);
  return max2f(__uint_as_float(rr[0]),__uint_as_float(rr[1]));
}
__device__ __forceinline__ void pv(f32x16*o,int vb,bf16x8 pa0,bf16x8 pa1,bf16x8 pa2,bf16x8 pa3){
  #pragma unroll
  for(int d0=0;d0<4;++d0){s16x4 lo[4],hi[4];
    #pragma unroll
    for(int ks=0;ks<4;++ks){
      asm volatile("ds_read_b64_tr_b16 %0,%1 offset:%c2":"=&v"(lo[ks]):"v"(vb),"i"(d0*4096+ks*1024):"memory");
      asm volatile("ds_read_b64_tr_b16 %0,%1 offset:%c2":"=&v"(hi[ks]):"v"(vb),"i"(d0*4096+ks*1024+512):"memory");}
    asm volatile("s_waitcnt lgkmcnt(0)":::"memory");SBAR();
    #define PK(k) (bf16x8){lo[k][0],lo[k][1],lo[k][2],lo[k][3],hi[k][0],hi[k][1],hi[k][2],hi[k][3]}
    o[d0]=__builtin_amdgcn_mfma_f32_32x32x16_bf16(pa0,PK(0),o[d0],0,0,0);
    o[d0]=__builtin_amdgcn_mfma_f32_32x32x16_bf16(pa1,PK(1),o[d0],0,0,0);
    o[d0]=__builtin_amdgcn_mfma_f32_32x32x16_bf16(pa2,PK(2),o[d0],0,0,0);
    o[d0]=__builtin_amdgcn_mfma_f32_32x32x16_bf16(pa3,PK(3),o[d0],0,0,0);
    #undef PK
  }
}

#ifndef ATTN_STORE16
#define ATTN_STORE16(p,v) (*(u32x4*)(p)=(v))
#endif
template<int THRL> __device__ __forceinline__ void attn_unit(int b,int hq,int hv,int ocol,int qb,float sl2,const bf16*Q,const bf16*__restrict__ K,const bf16*__restrict__ V,bf16*O,char*shm){
  int tid_=threadIdx.x; asm volatile("":"+v"(tid_));
  const int tid=tid_,lane=tid&63,r32=lane&31,hi=lane>>5; const int wid=__builtin_amdgcn_readfirstlane(tid>>6);
  const long rowbase=(long)b*SEQ; const int q0=qb*QB;
  const bf16*Qw=Q+(rowbase+q0+wid*QBLK)*DM+hq*D;
  const bf16*Kh=K+rowbase*DM+hq*D,*Vh=V+rowbase*DM+hv*D;
  const unsigned lds0=(unsigned)(uintptr_t)shm;
  float*wsf=(float*)(shm+LDS_WS)+wid*64;
  const unsigned kvoff=(unsigned)(lane*DM+wid*8)*2u;
  const unsigned vvoff=(unsigned)((16*(wid&3)+(lane>>2))*DM+(wid>>2)*32+(lane&3)*8)*2u;
  const unsigned kdst=lds0+LDS_K+wid*1024, vdst=lds0+LDS_V+wid*1024;
  #define DMA_K(t,slot) glds16s(Kh+(long)(t)*KVBLK*DM,kvoff,(unsigned)__builtin_amdgcn_readfirstlane(kdst+(slot)))
  #define DMA_V(t,slot) do{ glds16s(Vh+(long)(t)*KVBLK*DM,vvoff,(unsigned)__builtin_amdgcn_readfirstlane(vdst+2*(slot))); glds16s(Vh+(long)(t)*KVBLK*DM+64,vvoff,(unsigned)__builtin_amdgcn_readfirstlane(vdst+2*(slot)+8192)); }while(0)
  const int vb0=(int)(lds0+LDS_V)+((lane>>4)&1)*32+(lane&3)*8+(4*hi+((lane&15)>>2))*64;
  const char*Kbase=shm+LDS_K; bf16x8 kf[8];
  const lds_cptr shm3=(lds_cptr)shm; const lds_cptr kp0=shm3+LDS_K+hi*1024+r32*16; const lds_cptr vp0=shm3+LDS_V+((lane>>4)&1)*32+(lane&3)*8+(4*hi+((lane&15)>>2))*64;
  const int NT=(q0+QB)/KVBLK;
  DMA_K(0,0);DMA_V(0,0);DMA_K(1,SLOTB);
  bf16x8 qr[4];
  #pragma unroll
  for(int d0=0;d0<4;++d0)qr[d0]=*reinterpret_cast<const bf16x8*>(&Qw[(long)r32*DM+d0*16+hi*8]);
  float mhat=0.f,l_reg=0.f;f32x16 o[4];o[0]=f32x16{};o[1]=f32x16{};o[2]=f32x16{};o[3]=f32x16{};
  #define CINIT0(C0_,t_) do{ const float bt_=sl2*(float)(64*(t_)-q0+4*hi)-mhat; _Pragma("unroll") for(int r=0;r<16;++r){C0_[r]=__builtin_fmaf(sl2,(float)((r&3)+8*(r>>2)),bt_);} }while(0)
  #define CINIT1(C1_,t_) do{ const float bt_=sl2*(float)(64*(t_)-q0+4*hi)-mhat; _Pragma("unroll") for(int r=0;r<16;++r){C1_[r]=__builtin_fmaf(sl2,(float)((r&3)+8*(r>>2)+32),bt_);} }while(0)
  #define CINIT(C0_,C1_,t_) do{ CINIT0(C0_,t_); CINIT1(C1_,t_); }while(0)
  const int qrel=wid*QBLK+r32;
  #define CMASK(P0,P1,t) do{int jb_=(t)-(NT-4); if(jb_>=0)cmask(P0,P1,jb_,qrel,hi);}while(0)
  bool resc=false;
  #define START(P0,P1) do{ const float rm=rowmax(P0,P1); resc=false; \
    { const float dl=rm; mhat=fadd_s(mhat,dl); \
      _Pragma("unroll") for(int r=0;r<16;++r){P0[r]=fsub_s(P0[r],dl);P1[r]=fsub_s(P1[r],dl);} } \
    _Pragma("unroll") for(int r=0;r<16;++r)P0[r]=__builtin_amdgcn_exp2f(P0[r]); }while(0)
  #define RESC() do{ if(resc){ asm volatile("s_waitcnt lgkmcnt(0)":::"memory"); \
      _Pragma("unroll") for(int d_=0;d_<4;++d_) _Pragma("unroll") for(int r=0;r<16;++r)o[d_][r]*=wsf[crow(r,hi)]; } }while(0)
  f32x16 pA0,pA1,pB0,pB1;
  int sl_prev=0,sl_cur=0,sl_next=SLOTB;
  #define ROT() do{sl_prev=sl_cur;sl_cur=sl_next;sl_next=(sl_next==(NSLOT-1)*SLOTB)?0:sl_next+SLOTB;}while(0)
  DMA_K(2,2*SLOTB);
  WAIT_BAR(4);
  { f32x16 c0_,c1_; CINIT(c0_,c1_,0); qkt(pA0,pA1,Kbase,qr,c0_,c1_,r32,hi); } asm volatile("s_nop 15\n\ts_nop 7":"+v"(pA0),"+v"(pA1));CMASK(pA0,pA1,0);
  START(pA0,pA1);
  _Pragma("unroll") for(int r=0;r<16;++r)pA1[r]=__builtin_amdgcn_exp2f(pA1[r]);
  WAIT_BAR(0);
  DMA_K(3,0);DMA_V(1,SLOTB);
  ROT();
  kload8(kf,kp0+sl_cur);
  WAIT_BAR(3);
  s16x4 vlo[8],vhi[8]; u32x4 pw0,pw1,pw2,pw3;
  #define PKW(P,B) cvtpk_s(P[B],P[B+1])
  #define PAF(k) __builtin_bit_cast(bf16x8,pw##k)
  #define VFR(i) (bf16x8){vlo[i][0],vlo[i][1],vlo[i][2],vlo[i][3],vhi[i][0],vhi[i][1],vhi[i][2],vhi[i][3]}
  #define PIN(x) asm volatile("":"+v"(x))
  #define MX3(a,b,c) __builtin_fmaxf(__builtin_fmaxf((a),(b)),(c))
  #define GAPA(MF,A0,A1,A2,A3,W0,W1,PW) do{ MF; sacc+=A0; sacc+=A1; sacc+=A2; sacc+=A3; PIN(sacc); W0; W1; PIN(PW); SBAR(); }while(0)
  #define EX(v) __builtin_amdgcn_exp2f(v)
  #define GAPB(MF,X,B) do{ MF; X[B]=EX(X[B]); X[B+1]=EX(X[B+1]); PIN(X); SBAR(); }while(0)
  #define VRD2(sl,fr) do{ vlo[sl]=vtr(vp_+(((fr)>>2)*4096+((fr)&3)*1024)); vhi[sl]=vtr(vp_+(((fr)>>2)*4096+((fr)&3)*1024+512)); SBAR(); }while(0)
  #define VRD(i) do{ vlo[i]=vtr(vp_+(((i)>>2)*4096+((i)&3)*1024)); vhi[i]=vtr(vp_+(((i)>>2)*4096+((i)&3)*1024+512)); }while(0)
  #define KRD(G,j) do{ if(G){ kload2(kf,kp0+sl_next,j); SBAR(); } }while(0)
  #define STEP(C0,C1,P0,P1,t,GK,GV,GL) do{ CINIT0(C0,t); SBAR(); \
    const lds_cptr vp_=vp0+2*sl_prev; \
    VRD(0); SBAR(); float sacc=(P0[0]+P0[1]); \
    GAPA(C0=__builtin_amdgcn_mfma_f32_32x32x16_bf16(kf[0],qr[0],C0,0,0,0), P0[2],P0[3],P0[4],P0[5],     pw0[0]=PKW(P0,0), pw0[1]=PKW(P0,2), pw0); \
    CINIT1(C1,t); VRD(4); SBAR(); GAPA(C1=__builtin_amdgcn_mfma_f32_32x32x16_bf16(kf[1],qr[0],C1,0,0,0), P0[6],P0[7],P0[8],P0[9],     pw0[2]=PKW(P0,4), pw0[3]=PKW(P0,6), pw0); \
    VRD(1); SBAR(); GAPA(C0=__builtin_amdgcn_mfma_f32_32x32x16_bf16(kf[2],qr[1],C0,0,0,0),   P0[10],P0[11],P0[12],P0[13], pw1[0]=PKW(P0,8), pw1[1]=PKW(P0,10), pw1); \
    VRD(5); SBAR(); GAPA(C1=__builtin_amdgcn_mfma_f32_32x32x16_bf16(kf[3],qr[1],C1,0,0,0),   P0[14],P0[15],P1[0],P1[1],   pw1[2]=PKW(P0,12),pw1[3]=PKW(P0,14), pw1); \
    VRD(2); SBAR(); GAPA(C0=__builtin_amdgcn_mfma_f32_32x32x16_bf16(kf[4],qr[2],C0,0,0,0),   P1[2],P1[3],P1[4],P1[5],     pw2[0]=PKW(P1,0), pw2[1]=PKW(P1,2), pw2); \
    VRD(6); SBAR(); GAPA(C1=__builtin_amdgcn_mfma_f32_32x32x16_bf16(kf[5],qr[2],C1,0,0,0),   P1[6],P1[7],P1[8],P1[9],     pw2[2]=PKW(P1,4), pw2[3]=PKW(P1,6), pw2); \
    VRD(3); SBAR(); GAPA(C0=__builtin_amdgcn_mfma_f32_32x32x16_bf16(kf[6],qr[3],C0,0,0,0),   P1[10],P1[11],P1[12],P1[13], pw3[0]=PKW(P1,8), pw3[1]=PKW(P1,10), pw3); \
    VRD(7); SBAR(); GAPA(C1=__builtin_amdgcn_mfma_f32_32x32x16_bf16(kf[7],qr[3],C1,0,0,0),   P1[14],P1[15],0.f,0.f,       pw3[2]=PKW(P1,12),pw3[3]=PKW(P1,14), pw3); \
    l_reg+=sacc; \
    if(GK){DMA_K((t)+3,sl_cur);} if(GV){DMA_V((t)+1,sl_next);} \
    CMASK(C0,C1,t); \
    { float a=MX3(C0[0],C0[1],C1[0]),b=MX3(C0[2],C0[3],C1[1]); a=MX3(a,C1[2],C1[3]); \
      _Pragma("unroll") for(int r=4;r<16;r+=4){a=MX3(a,C0[r],C0[r+1]);b=MX3(b,C0[r+2],C0[r+3]);a=MX3(a,C1[r],C1[r+1]);b=MX3(b,C1[r+2],C1[r+3]);} \
      float rm=__builtin_fmaxf(a,b); { auto rr=__builtin_amdgcn_permlane32_swap(__float_as_uint(rm),__float_as_uint(rm),false,false); rm=__builtin_fmaxf(__uint_as_float(rr[0]),__uint_as_float(rr[1])); } \
      resc=false; \
      if(__builtin_expect(__any(rm>(float)THRL),0)){ const float dl=__builtin_fmaxf(rm,0.f); mhat+=dl; \
        _Pragma("unroll") for(int r=0;r<16;++r){C0[r]-=dl;C1[r]-=dl;} \
        const float f=__builtin_amdgcn_exp2f(-dl); l_reg*=f; if(hi==0)wsf[r32]=f; resc=true; } } \
    SBAR(); \
    GAPB(o[0]=__builtin_amdgcn_mfma_f32_32x32x16_bf16(PAF(0),VFR(0),o[0],0,0,0), C0,0);  VRD2(0,8); \
    GAPB(o[1]=__builtin_amdgcn_mfma_f32_32x32x16_bf16(PAF(0),VFR(4),o[1],0,0,0), C0,2);  VRD2(4,12); \
    KRD(GL,0); GAPB(o[0]=__builtin_amdgcn_mfma_f32_32x32x16_bf16(PAF(1),VFR(1),o[0],0,0,0), C0,4);  VRD2(1,9); \
    KRD(GL,1); GAPB(o[1]=__builtin_amdgcn_mfma_f32_32x32x16_bf16(PAF(1),VFR(5),o[1],0,0,0), C0,6);  VRD2(5,13); \
    KRD(GL,2); GAPB(o[0]=__builtin_amdgcn_mfma_f32_32x32x16_bf16(PAF(2),VFR(2),o[0],0,0,0), C0,8);  VRD2(2,10); \
    KRD(GL,3); GAPB(o[1]=__builtin_amdgcn_mfma_f32_32x32x16_bf16(PAF(2),VFR(6),o[1],0,0,0), C0,10); VRD2(6,14); \
    GAPB(o[0]=__builtin_amdgcn_mfma_f32_32x32x16_bf16(PAF(3),VFR(3),o[0],0,0,0), C0,12); VRD2(3,11); \
    GAPB(o[1]=__builtin_amdgcn_mfma_f32_32x32x16_bf16(PAF(3),VFR(7),o[1],0,0,0), C0,14); VRD2(7,15); \
    GAPB(o[2]=__builtin_amdgcn_mfma_f32_32x32x16_bf16(PAF(0),VFR(0),o[2],0,0,0), C1,0); \
    GAPB(o[3]=__builtin_amdgcn_mfma_f32_32x32x16_bf16(PAF(0),VFR(4),o[3],0,0,0), C1,2); \
    GAPB(o[2]=__builtin_amdgcn_mfma_f32_32x32x16_bf16(PAF(1),VFR(1),o[2],0,0,0), C1,4); \
    GAPB(o[3]=__builtin_amdgcn_mfma_f32_32x32x16_bf16(PAF(1),VFR(5),o[3],0,0,0), C1,6); \
    GAPB(o[2]=__builtin_amdgcn_mfma_f32_32x32x16_bf16(PAF(2),VFR(2),o[2],0,0,0), C1,8); \
    GAPB(o[3]=__builtin_amdgcn_mfma_f32_32x32x16_bf16(PAF(2),VFR(6),o[3],0,0,0), C1,10); \
    GAPB(o[2]=__builtin_amdgcn_mfma_f32_32x32x16_bf16(PAF(3),VFR(3),o[2],0,0,0), C1,12); \
    GAPB(o[3]=__builtin_amdgcn_mfma_f32_32x32x16_bf16(PAF(3),VFR(7),o[3],0,0,0), C1,14); \
    }while(0)
  int t=1;
  #undef CMASK
  #define CMASK(P0,P1,t) do{}while(0)
  for(;t+5<NT;t+=2){
    STEP(pB0,pB1,pA0,pA1,t,true,true,true);     WAIT_BAR(3); RESC(); ROT();
    STEP(pA0,pA1,pB0,pB1,t+1,true,true,true);   WAIT_BAR(3); RESC(); ROT();
  }
  #undef CMASK
  #define CMASK(P0,P1,t) do{int jb_=(t)-(NT-4); if(jb_>=0)cmask(P0,P1,jb_,qrel,hi);}while(0)
  #define ENDW(tt) do{ if((tt)+3<NT){WAIT_BAR(3);} else if((tt)+2<NT){WAIT_BAR(2);} else {WAIT_BAR(0);} }while(0)
  for(;t+1<NT;t+=2){
    STEP(pB0,pB1,pA0,pA1,t,(t+3<NT),(t+1<NT),(t+1<NT));       ENDW(t);   RESC(); ROT();
    STEP(pA0,pA1,pB0,pB1,t+1,(t+4<NT),(t+2<NT),(t+2<NT));     ENDW(t+1); RESC(); ROT();
  }
  STEP(pB0,pB1,pA0,pA1,NT-1,false,false,false); RESC();
  { float sacc=pB0[0]+pB0[1]; _Pragma("unroll") for(int r=2;r<16;++r)sacc+=pB0[r]; _Pragma("unroll") for(int r=0;r<16;++r)sacc+=pB1[r]; l_reg+=sacc;
    pw0=(u32x4){PKW(pB0,0),PKW(pB0,2),PKW(pB0,4),PKW(pB0,6)};pw1=(u32x4){PKW(pB0,8),PKW(pB0,10),PKW(pB0,12),PKW(pB0,14)};pw2=(u32x4){PKW(pB1,0),PKW(pB1,2),PKW(pB1,4),PKW(pB1,6)};pw3=(u32x4){PKW(pB1,8),PKW(pB1,10),PKW(pB1,12),PKW(pB1,14)};
    SBAR(); pv(o,vb0+2*sl_cur,PAF(0),PAF(1),PAF(2),PAF(3)); }
  #undef PKW
  #undef PAF
  #undef VFR
  #undef PIN
  #undef MX3
  #undef GAPA
  #undef GAPB
  #undef EX
  #undef VRD
  #undef VRD2
  #undef KRD
  #undef STEP
  #undef ENDW
  {auto rr=__builtin_amdgcn_permlane32_swap(__float_as_uint(l_reg),__float_as_uint(l_reg),false,false);l_reg=__uint_as_float(rr[0])+__uint_as_float(rr[1]);}
  if(hi==0)wsf[32+r32]=l_reg;asm volatile("s_waitcnt lgkmcnt(0)":::"memory");
  float rli[16];
  #pragma unroll
  for(int r=0;r<16;++r)rli[r]=__builtin_amdgcn_rcpf(wsf[32+crow(r,hi)]);
  bf16*Ow=O+(rowbase+q0+wid*QBLK)*OPITCH+ocol;
  { bf16*stg=(bf16*)(shm+LDS_OST)+wid*2048;
    int ln2_=lane; asm volatile("":"+v"(ln2_));
    #pragma unroll
    for(int hf=0;hf<2;++hf){
      #pragma unroll
      for(int r=0;r<16;++r){const int orow=crow(r,hi);
        #pragma unroll
        for(int d0=0;d0<2;++d0)stg[orow*64+d0*32+r32]=__float2bfloat16(o[2*hf+d0][r]*rli[r]);}
      asm volatile("s_waitcnt lgkmcnt(0)":::"memory");
      #pragma unroll
      for(int i=0;i<4;++i){const int row=i*8+(ln2_>>3),ch=ln2_&7; const u32x4 v=*(const u32x4*)(stg+row*64+ch*8); ATTN_STORE16(Ow+(long)row*OPITCH+hf*64+ch*8,v);}
      asm volatile("s_waitcnt lgkmcnt(0)":::"memory"); } }
  asm volatile("s_waitcnt lgkmcnt(0)\n\ts_barrier":::"memory");
  #undef DMA_K
  #undef DMA_V
  #undef CMASK
  #undef CINIT
  #undef CINIT0
  #undef CINIT1
  #undef START
  #undef RESC
  #undef ROT
}
constexpr int ATTN_LDS_BYTES=LDS_BYTES;
struct AttnTensors { const bf16* Q; const bf16* K; const bf16* V; bf16* O; };
template<int THRL=8> __device__ __forceinline__ void attn_phase(char*lds,const AttnTensors&T,int vcu,int G){
  for(int s=vcu;s<256;s+=G){
    const int st=s>>1,half=s&1,b=st>>4,h=(st>>1)&7,c=st&1;
    const float sl2=__uint_as_float(__builtin_amdgcn_readfirstlane(__float_as_uint(__builtin_amdgcn_exp2f(-(float)(h+1))*1.4426950408889634f)));
    for(int i=7;i>=0;--i){ const int j=i>>1,od=i&1; const int qb=4*j+(half?(od?2:1):(od?3:0));
      attn_unit<THRL>(b,2*h+c,2*h,c*1024+h*128,qb,sl2,T.Q,T.K,T.V,T.O,lds); }
  }
}
#undef SBAR
#undef WAIT_BAR
}
#define GAS __attribute__((address_space(1)))
#define LAS __attribute__((address_space(3)))
typedef unsigned short bf16;
typedef unsigned v4u __attribute__((ext_vector_type(4)));
typedef float f32x4 __attribute__((ext_vector_type(4)));
typedef short bf16x8 __attribute__((ext_vector_type(8)));
typedef GAS unsigned gu32;
typedef GAS unsigned long long gu64;
#define RLX_AGENT __ATOMIC_RELAXED, __HIP_MEMORY_SCOPE_AGENT
#define LDS_WAIT() asm volatile("s_waitcnt lgkmcnt(0)" ::: "memory")
#define VM_WAIT() asm volatile("s_waitcnt vmcnt(0)" ::: "memory")
__device__ __forceinline__ unsigned long long rt() { return __builtin_amdgcn_s_memrealtime(); }
__device__ __forceinline__ unsigned f2bf(float f) { unsigned u = __builtin_bit_cast(unsigned, f); return (u + 0x7fffu + ((u >> 16) & 1u)) >> 16; }
__device__ __forceinline__ unsigned pk2(float lo, float hi) { return f2bf(lo) | (f2bf(hi) << 16); }

#define XB_TMO      128
#define XB_XCNT(j)  (256  + 64 * (j))
#define XB_XSUB(j)  (1280 + 64 * (j))
#define XB_XGEN(j)  (2304 + 64 * (j))
#define XB_TOP      3328
#define XB_TOPGEN   3392
#define XCD_BAR_WORDS 3456
#define XB_SPIN_CAP (1u << 18)

__device__ __forceinline__ unsigned xb_ld(unsigned* p)              { return __hip_atomic_load(p, __ATOMIC_RELAXED, __HIP_MEMORY_SCOPE_AGENT); }
__device__ __forceinline__ unsigned xb_add(unsigned* p, unsigned v) { return __hip_atomic_fetch_add(p, v, __ATOMIC_RELAXED, __HIP_MEMORY_SCOPE_AGENT); }
__device__ __forceinline__ unsigned xb_xcc_id() { return (unsigned)__builtin_amdgcn_s_getreg((3 << 11) | 20) & 0xFu; }
#define XB_SPIN(cond, bar) do { unsigned _sp = 0; while (cond) { __builtin_amdgcn_s_sleep(1); \
    if ((++_sp & 255u) == 0u) { if (xb_ld(&(bar)[XB_TMO])) break; if (_sp > XB_SPIN_CAP) { atomicAdd(&(bar)[XB_TMO], 1u); break; } } } } while (0)

struct XcdBarrier {
    unsigned* bar; unsigned x;
    volatile LAS unsigned* st;
};

__device__ __forceinline__ XcdBarrier xcd_barrier_post(unsigned* bar, volatile LAS unsigned* st) {
    XcdBarrier b; b.bar = bar; b.x = xb_xcc_id(); b.st = st;
    if (threadIdx.x == 0) (void)xb_add(&bar[XB_XCNT(b.x)], 1u);
    return b;
}
__device__ __forceinline__ void xcd_barrier_complete(unsigned* bar, unsigned x, unsigned& nloc, unsigned& nx) {
    const unsigned G = gridDim.x * gridDim.y * gridDim.z;
    unsigned sum, cnt, mine, sp = 0u;
    for (;;) {
        sum = 0u; cnt = 0u; mine = 0u;
#pragma unroll
        for (unsigned j = 0; j < 16; ++j) { const unsigned c = xb_ld(&bar[XB_XCNT(j)]); sum += c; cnt += (c > 0u) ? 1u : 0u; mine = (j == x) ? c : mine; }
        if (sum == G) break;
        __builtin_amdgcn_s_sleep(1);
        if ((++sp & 255u) == 0u) { if (xb_ld(&bar[XB_TMO])) break; if (sp > XB_SPIN_CAP) { atomicAdd(&bar[XB_TMO], 1u); break; } }
    }
    nloc = mine > 0u ? mine : 1u; nx = cnt > 0u ? cnt : 1u;
}

__device__ __forceinline__ void xcd_barrier(const XcdBarrier& b) {
    asm volatile("s_waitcnt vmcnt(0)" ::: "memory");
    __syncthreads();
    if (threadIdx.x == 0) {
        unsigned* bar = b.bar;
        __builtin_amdgcn_s_waitcnt(0);
        unsigned nloc = b.st[0], nx = b.st[1];
        if (nloc == 0u) { xcd_barrier_complete(bar, b.x, nloc, nx); b.st[0] = nloc; b.st[1] = nx; }
        const unsigned old = xb_add(&bar[XB_XSUB(b.x)], 1u);
        const unsigned gen = old / nloc;
        if (old + 1u == (gen + 1u) * nloc) {
            __builtin_amdgcn_fence(__ATOMIC_RELEASE, "agent");
            asm volatile("s_waitcnt vmcnt(0)" ::: "memory");
            const unsigned og = xb_add(&bar[XB_TOP], 1u);
            const unsigned tg = og / nx;
            if (og + 1u == (tg + 1u) * nx) xb_add(&bar[XB_TOPGEN], 1u);
            else XB_SPIN(xb_ld(&bar[XB_TOPGEN]) == tg, bar);
            __builtin_amdgcn_fence(__ATOMIC_ACQUIRE, "agent");
            xb_add(&bar[XB_XGEN(b.x)], 1u);
            asm volatile("s_waitcnt vmcnt(0)" ::: "memory");
        } else {
            XB_SPIN(xb_ld(&bar[XB_XGEN(b.x)]) == gen, bar);
            __builtin_amdgcn_fence(__ATOMIC_ACQUIRE, "agent");
            asm volatile("s_waitcnt vmcnt(0)" ::: "memory");
        }
    }
    __syncthreads();
}
constexpr int NWAVES = 8, NTHREADS = 512;
constexpr int BATCH = 8, SEQ = 4096, DM = 1024, NTOK = BATCH * SEQ, DEPTH = 4;
constexpr int DIN = 8208, NPROJ = 8192;
constexpr int NEXP = 32, DEXP = 512, LISTCAP = 32768, MOE_MAXT = 288;
constexpr float LN_EPS = 1e-5f, DN_ALPHA = 1.6817928305074292f;
constexpr size_t MiB = 1u << 20;
constexpr size_t WS_CTL = 0, CTL_ZERO_BYTES = 1 * MiB;
constexpr size_t WS_ADA = 1 * MiB;
constexpr size_t WS_ABWT = 2 * MiB;
constexpr size_t WS_RWT = 2 * MiB + 256 * 1024;
constexpr size_t WS_TOKINFO = 3 * MiB;
constexpr size_t WS_LIST = 4 * MiB;
constexpr size_t WS_SSQ = 8 * MiB;
constexpr size_t WS_PRM = 16 * MiB;
constexpr int PO_BGATES = 0, PO_WALPHA = 8192, PO_BALPHA = 40960, PO_LQ1 = 43008, PO_LK1 = 43264, PO_LQ2 = 43520, PO_LK2 = 43776, PO_DIFFG = 44032, PO_GLAG = 44544,
              PO_LN1G = 45568, PO_LN1B = 49664, PO_BRG = 53760, PO_BRE = 53776, PO_LN2G = 53904, PO_LN2B = 58000, PO_END = 62096;
constexpr size_t WS_WIN = 32 * MiB;
constexpr size_t WS_WBA = 96 * MiB, WS_WBB = 104 * MiB, WS_WOUT = 112 * MiB;
constexpr size_t WS_W1 = 120 * MiB;
constexpr size_t WS_WD = 376 * MiB;
constexpr size_t WS_U = 504 * MiB;
constexpr size_t WS_QB = 568 * MiB, WS_KB = 632 * MiB, WS_VB = 696 * MiB;
constexpr size_t WS_GQ = 760 * MiB, WS_GK = 792 * MiB;
constexpr size_t WS_GV = 824 * MiB, WS_SG = 888 * MiB;
constexpr size_t WS_GT = 952 * MiB;
constexpr size_t WS_LA = 1080 * MiB;
constexpr size_t WS_END = 1144 * MiB;
constexpr size_t WS_OB = WS_U;
constexpr size_t WS_OP = WS_GQ;
constexpr size_t WS_OA2 = WS_QB, WS_OB2 = WS_KB;
constexpr size_t WS_TMP = WS_VB, WS_MIX = WS_GQ;
constexpr size_t WS_H = WS_QB;
constexpr size_t WS_YB = WS_QB + 72 * MiB;
constexpr int CW_TMO = 0, CW_CODE = 1, CW_BAR = 4096, CW_CNT = 8192;
constexpr int RING_OFF = 0, RING_BYTES = 131072;
constexpr int LDSCTL_OFF = RING_BYTES, MISC_OFF = LDSCTL_OFF + 320;
constexpr int TAB_CNT = RING_BYTES + 512, TAB_BASE = RING_BYTES + 640, TAB_IDX = RING_BYTES + 1024, IDX_UNITS = 8;
constexpr int LDS_BYTES = 147456;
static_assert(TAB_IDX + IDX_UNITS * 256 * 4 <= LDS_BYTES, "LDS map");
struct Frame {
    LAS unsigned char* lds;
    gu32* ctl;
    int tid, lane, wave, vcu, G;
    float* out; unsigned char* ws; const float* prm;
};
enum { I_X = 0, I_C, I_WADA, I_BADA, I_WIN, I_BGATES, I_WALPHA, I_BALPHA, I_LQ1, I_LK1, I_LQ2, I_LK2, I_DIFFG, I_GLAG, I_WBA, I_WBB, I_WOUT, I_LN1G, I_LN1B,
       I_WRG, I_BRG, I_WRE, I_BRE, I_WGE, I_WUE, I_WDE, I_LN2G, I_LN2B };
__device__ __forceinline__ float wave_sum(float v) {
#pragma unroll
    for (int o = 1; o < 64; o <<= 1) v += __shfl_xor(v, o);
    return v;
}
__device__ __forceinline__ float siluf_(float x) { return x * __builtin_amdgcn_rcpf(1.0f + __expf(-x)); }
__device__ __forceinline__ float bflo(unsigned w) { return __uint_as_float(w << 16); }
__device__ __forceinline__ float bfhi(unsigned w) { return __uint_as_float(w & 0xffff0000u); }

__device__ __forceinline__ void p0_ada(Frame& F, const float* c, const float* wada, const float* bada) {
    LAS float* COND = (LAS float*)(F.lds);
    LAS float* PART = (LAS float*)(F.lds + 32768);
    float* ADA = (float*)(F.ws + WS_ADA);
    for (int i = F.tid; i < 8192; i += NTHREADS) COND[i] = siluf_(c[i]);
    __syncthreads();
    for (int cg = (int)blockIdx.x; cg < 256; cg += F.G) {
        const int l = cg >> 6, j0 = (cg & 63) * 96;
        const int col4 = F.lane % 24, ksub = F.lane / 24;
        f32x4 acc[8];
#pragma unroll
        for (int b = 0; b < 8; ++b) acc[b] = (f32x4){0.f, 0.f, 0.f, 0.f};
        if (ksub < 2) {
            const float* wp = wada + ((size_t)l * 1024 + (size_t)(F.wave * 128 + ksub)) * 6144 + j0 + 4 * col4;
#pragma unroll 8
            for (int kk = 0; kk < 64; ++kk) {
                const f32x4 wv = *(const GAS f32x4*)(wp + (size_t)kk * 2 * 6144); const int k = F.wave * 128 + 2 * kk + ksub;
#pragma unroll
                for (int b = 0; b < 8; ++b) acc[b] += wv * COND[b * 1024 + k];
            }
#pragma unroll
            for (int b = 0; b < 8; ++b) *(LAS f32x4*)(PART + ((F.wave * 2 + ksub) * 8 + b) * 96 + 4 * col4) = acc[b];
        }
        __syncthreads();
        for (int idx = F.tid; idx < 768; idx += NTHREADS) { const int b = idx / 96, col = idx % 96; float s = 0.f;
#pragma unroll
            for (int p = 0; p < 16; ++p) s += PART[(p * 8 + b) * 96 + col];
            ADA[((size_t)l * 8 + b) * 6144 + j0 + col] = s + bada[l * 6144 + j0 + col]; }
        __syncthreads();
    }
}
struct RmIdent { __device__ __forceinline__ int operator()(int n) const { return n; } };
struct RmWin { __device__ __forceinline__ int operator()(int n) const { return n < 6144 ? n : (n < 6160 ? -1 : n - 16); } };
struct RmGateUp { int up; __device__ __forceinline__ int operator()(int n) const { return (n >> 7) * 256 + up * 128 + (n & 127); } };
template <class RowMap>
__device__ __forceinline__ void p0_transpose_item(const float* W, int K, int N, bf16* WT, const RowMap rm, LAS float* scr, int kb, int nb, int lane) {
    const int k0 = 64 * kb, n0 = 32 * nb; const int nl = n0 + (lane & 31);
#pragma unroll 8
    for (int i = 0; i < 32; ++i) { const int kk = 2 * i + (lane >> 5); scr[kk * 33 + (lane & 31)] = (nl < N) ? W[(size_t)(k0 + kk) * N + nl] : 0.f; }
    LDS_WAIT(); asm volatile("" ::: "memory");
    const int c = lane & 7;
#pragma unroll
    for (int j = 0; j < 4; ++j) { const int nn = (lane >> 3) + 8 * j, n = n0 + nn; const LAS float* s = scr + (8 * c) * 33 + nn;
        v4u o; o.x = pk2(s[0 * 33], s[1 * 33]); o.y = pk2(s[2 * 33], s[3 * 33]); o.z = pk2(s[4 * 33], s[5 * 33]); o.w = pk2(s[6 * 33], s[7 * 33]);
        const int r = (n < N) ? rm(n) : -1;
        if (r >= 0) *(GAS v4u*)(WT + (size_t)r * K + k0 + 8 * c) = o; }
    LDS_WAIT(); asm volatile("" ::: "memory");
}
struct SmallPrm { const float *bgates, *walpha, *balpha, *lq1, *lk1, *lq2, *lk2, *diffg, *glag, *ln1g, *ln1b, *brg, *bre, *ln2g, *ln2b; };
__device__ __forceinline__ void p0_copy(float* dst, const float* src, int n, int gt, int NGT) { for (int i = gt; i < n; i += NGT) dst[i] = src[i]; }
__device__ __forceinline__ void p0_weights(Frame& F, const float* win, const float* wba, const float* wbb, const float* wout, const float* wge, const float* wue, const float* wde, const float* wrg, const float* wre, const SmallPrm sp) {
    LAS float* scr = (LAS float*)(F.lds + RING_OFF + F.wave * 16384);
    const int gw = F.vcu * NWAVES + F.wave, NGW = F.G * NWAVES;
    constexpr int I_IN = 4 * 16 * 257, I_SQ = 12 * 16 * 32, I_E = 128 * 16 * 16, I_D = 128 * 8 * 32;
    constexpr int NITEMS = I_IN + I_SQ + 2 * I_E + I_D;
    for (int it = gw; it < NITEMS; it += NGW) {
        int r = it;
        if (r < I_IN) { const int l = r / 4112, q = r % 4112;
            p0_transpose_item(win + (size_t)l * 1024 * DIN, 1024, DIN, (bf16*)(F.ws + WS_WIN) + (size_t)l * NPROJ * 1024, RmWin{}, scr, q / 257, q % 257, F.lane); continue; }
        r -= I_IN;
        if (r < I_SQ) { const int mat = r / 512, q = r % 512, which = mat >> 2, l = mat & 3;
            const float* W = (which == 0 ? wba : (which == 1 ? wbb : wout)) + (size_t)l * 1024 * 1024;
            bf16* WT = (bf16*)(F.ws + (which == 0 ? WS_WBA : (which == 1 ? WS_WBB : WS_WOUT))) + (size_t)l * 1024 * 1024;
            p0_transpose_item(W, 1024, 1024, WT, RmIdent{}, scr, q / 32, q % 32, F.lane); continue; }
        r -= I_SQ;
        if (r < 2 * I_E) { const int up = r >= I_E ? 1 : 0; if (up) r -= I_E; const int me = r / 256, q = r % 256;
            p0_transpose_item((up ? wue : wge) + (size_t)me * 1024 * 512, 1024, 512, (bf16*)(F.ws + WS_W1) + (size_t)me * 1024 * 1024, RmGateUp{up}, scr, q / 16, q % 16, F.lane); continue; }
        r -= 2 * I_E;
        { const int me = r / 256, q = r % 256;
          p0_transpose_item(wde + (size_t)me * 512 * 1024, 512, 1024, (bf16*)(F.ws + WS_WD) + (size_t)me * 1024 * 512, RmIdent{}, scr, q / 32, q % 32, F.lane); }
    }
    const int gt = F.vcu * NTHREADS + F.tid, NGT = F.G * NTHREADS;
    float* ABWT = (float*)(F.ws + WS_ABWT); float* RWT = (float*)(F.ws + WS_RWT);
    { float* P = (float*)(F.ws + WS_PRM);
      p0_copy(P + PO_BGATES, sp.bgates, 8192, gt, NGT); p0_copy(P + PO_WALPHA, sp.walpha, 32768, gt, NGT); p0_copy(P + PO_BALPHA, sp.balpha, 2048, gt, NGT);
      p0_copy(P + PO_LQ1, sp.lq1, 256, gt, NGT); p0_copy(P + PO_LK1, sp.lk1, 256, gt, NGT); p0_copy(P + PO_LQ2, sp.lq2, 256, gt, NGT); p0_copy(P + PO_LK2, sp.lk2, 256, gt, NGT);
      p0_copy(P + PO_DIFFG, sp.diffg, 512, gt, NGT); p0_copy(P + PO_GLAG, sp.glag, 1024, gt, NGT); p0_copy(P + PO_LN1G, sp.ln1g, 4096, gt, NGT); p0_copy(P + PO_LN1B, sp.ln1b, 4096, gt, NGT);
      p0_copy(P + PO_BRG, sp.brg, 16, gt, NGT); p0_copy(P + PO_BRE, sp.bre, 128, gt, NGT); p0_copy(P + PO_LN2G, sp.ln2g, 4096, gt, NGT); p0_copy(P + PO_LN2B, sp.ln2b, 4096, gt, NGT); }
    for (int i = gt; i < 4 * 16 * 1024; i += NGT) { const int l = i >> 14, r = (i >> 10) & 15, k = i & 1023; ABWT[i] = win[((size_t)l * 1024 + k) * DIN + 6144 + r]; }
    for (int i = gt; i < 4 * 36 * 1024; i += NGT) { const int l = i / 36864, c = (i / 1024) % 36, k = i & 1023;
        RWT[i] = (c < 4) ? wrg[((size_t)l * 1024 + k) * 4 + c] : wre[((size_t)l * 1024 + k) * 32 + (c - 4)]; }
}

typedef f32x4 Row4[4];
__device__ __forceinline__ void row_load(Row4& v, const float* p, int lane) { const GAS f32x4* q = (const GAS f32x4*)p + lane;
#pragma unroll
    for (int j = 0; j < 4; ++j) v[j] = q[64 * j]; }
__device__ __forceinline__ void row_store(const Row4& v, float* p, int lane) { GAS f32x4* q = (GAS f32x4*)p + lane;
#pragma unroll
    for (int j = 0; j < 4; ++j) q[64 * j] = v[j]; }
__device__ __forceinline__ void row_standardize(Row4& v) {
    float s = 0.f;
#pragma unroll
    for (int j = 0; j < 4; ++j) s += (v[j].x + v[j].y) + (v[j].z + v[j].w);
    const float mean = wave_sum(s) * (1.f / DM); float s2 = 0.f;
#pragma unroll
    for (int j = 0; j < 4; ++j) { v[j] = v[j] - mean; s2 += (v[j].x * v[j].x + v[j].y * v[j].y) + (v[j].z * v[j].z + v[j].w * v[j].w); }
    const float rstd = 1.f / sqrtf(wave_sum(s2) * (1.f / DM) + LN_EPS);
#pragma unroll
    for (int j = 0; j < 4; ++j) v[j] = v[j] * rstd;
}
__device__ __forceinline__ void row_affine(Row4& v, const float* g, const float* b, bool one_plus, int lane) {
    asm volatile("" : "+s"(g), "+s"(b));
#pragma unroll
    for (int j = 0; j < 4; ++j) { f32x4 gv = *((const GAS f32x4*)g + lane + 64 * j); const f32x4 bv = *((const GAS f32x4*)b + lane + 64 * j); if (one_plus) gv = gv + 1.0f; v[j] = v[j] * gv + bv; }
}
__device__ __forceinline__ void row_store_bf16(const Row4& v, bf16* p, int lane) { GAS unsigned long long* o8 = (GAS unsigned long long*)p + lane;
#pragma unroll
    for (int j = 0; j < 4; ++j) o8[64 * j] = (unsigned long long)pk2(v[j].x, v[j].y) | ((unsigned long long)pk2(v[j].z, v[j].w) << 32); }
__device__ __forceinline__ int idx16(int L) { return ((L >> 5) & 1) + 2 * ((L >> 4) & 1) + 4 * ((L >> 3) & 1) + 8 * ((L >> 2) & 1) + 16 * ((L >> 1) & 1) + 32 * (L & 1); }
__device__ __forceinline__ int idx4(int L) { return ((L >> 5) & 1) + 2 * ((L >> 4) & 1) + 4 * ((L >> 3) & 1) + 8 * ((L >> 2) & 1); }
template <int NC>
__device__ __forceinline__ float rows4_proj(const Row4 (&u)[4], const float* wT, int lane) {
    float p[4 * NC]; f32x4 wa[4], wb[4];
    asm volatile("" : "+s"(wT));
    const GAS f32x4* wp = (const GAS f32x4*)wT + lane;
#define R4_LDW(DD_, CC_) do { _Pragma("unroll") for (int j = 0; j < 4; ++j) DD_[j] = wp[(CC_) * 256 + 64 * j]; } while (0)
#define R4_DOT(WW_, CC_) do { _Pragma("unroll") for (int r = 0; r < 4; ++r) { float s_ = 0.f; _Pragma("unroll") for (int j = 0; j < 4; ++j) s_ += (u[r][j].x * WW_[j].x + u[r][j].y * WW_[j].y) + (u[r][j].z * WW_[j].z + u[r][j].w * WW_[j].w); p[r * NC + (CC_)] = s_; } } while (0)
    R4_LDW(wa, 0);
#pragma unroll
    for (int c = 0; c < NC; c += 2) {
        R4_LDW(wb, c + 1); __builtin_amdgcn_sched_barrier(0);
        R4_DOT(wa, c);
        if (c + 2 < NC) R4_LDW(wa, c + 2);
        __builtin_amdgcn_sched_barrier(0);
        R4_DOT(wb, c + 1);
        __builtin_amdgcn_sched_barrier(0);
    }
#undef R4_LDW
#undef R4_DOT
    int V = 4 * NC;
#pragma unroll
    for (int M = 32; M >= 1; M >>= 1) {
        if (V > 1) { const bool bit = (lane & M) != 0;
#pragma unroll
            for (int i = 0; i < 32; ++i) if (i < V / 2) { const float a = p[2 * i], b = p[2 * i + 1]; const float send = bit ? a : b; const float recv = __shfl_xor(send, M); p[i] = (bit ? b : a) + recv; }
            V >>= 1; }
        else p[0] += __shfl_xor(p[0], M);
    }
    return p[0];
}
constexpr int WAL_OFF = 16384, BAL_OFF = 16384 + 32768;
__device__ __forceinline__ void load_walpha(Frame& F, int l) {
    const float* walpha_all = F.prm + PO_WALPHA; const float* balpha_all = F.prm + PO_BALPHA;
    LAS float* WAL = (LAS float*)(F.lds + RING_OFF + WAL_OFF); LAS float* BAL = (LAS float*)(F.lds + RING_OFF + BAL_OFF);
    for (int i = F.tid; i < 8192; i += NTHREADS) WAL[i] = walpha_all[(size_t)l * 8192 + i];
    if (F.tid < 512) BAL[F.tid] = balpha_all[l * 512 + F.tid];
    __syncthreads();
}
__device__ __forceinline__ void rows4_mod1(Frame& F, Row4 (&x)[4], int m0, int l, LAS float* scr) {
    const int b = m0 >> 12; const float* ada = (const float*)(F.ws + WS_ADA) + ((size_t)l * 8 + b) * 6144;
#pragma unroll
    for (int r = 0; r < 4; ++r) { row_standardize(x[r]); row_affine(x[r], ada + 1024, ada, true, F.lane); row_store_bf16(x[r], (bf16*)(F.ws + WS_U) + (size_t)(m0 + r) * 1024, F.lane); __builtin_amdgcn_sched_barrier(0); }
    const float abv = rows4_proj<16>(x, (const float*)(F.ws + WS_ABWT) + (size_t)l * 16 * 1024, F.lane);
    __builtin_amdgcn_sched_barrier(0);
    scr[idx16(F.lane)] = abv;
    LDS_WAIT(); asm volatile("" ::: "memory");
    const LAS float* WAL = (const LAS float*)(F.lds + RING_OFF + WAL_OFF); const LAS float* BAL = (const LAS float*)(F.lds + RING_OFF + BAL_OFF); float* LA = (float*)(F.ws + WS_LA);
    asm volatile("" : "+s"(WAL), "+s"(BAL));
    float z[4][8];
#pragma unroll
    for (int i = 0; i < 8; ++i) { const float bb = BAL[F.lane + 64 * i];
#pragma unroll
        for (int r = 0; r < 4; ++r) z[r][i] = bb; }
#pragma unroll
    for (int rr = 0; rr < 16; ++rr) { float a[4];
#pragma unroll
        for (int r = 0; r < 4; ++r) a[r] = scr[r * 16 + rr];
#pragma unroll
        for (int i = 0; i < 8; ++i) { const float w_ = WAL[rr * 512 + F.lane + 64 * i];
#pragma unroll
            for (int r = 0; r < 4; ++r) z[r][i] += a[r] * w_; }
        __builtin_amdgcn_sched_barrier(0); }
#pragma unroll
    for (int r = 0; r < 4; ++r) {
#pragma unroll
        for (int i = 0; i < 8; ++i) { const float zz = z[r][i]; const float ls = fminf(zz, 0.f) - __logf(1.0f + __expf(-fabsf(zz)));
            LA[(size_t)(m0 + r) * 512 + F.lane + 64 * i] = ls * (1.0f / 16.0f); }
        __builtin_amdgcn_sched_barrier(0); }
    LDS_WAIT(); asm volatile("" ::: "memory");
}
__device__ __forceinline__ void phase_r0(Frame& F, const float* xin) {
    LAS float* scr = (LAS float*)(F.lds + RING_OFF) + F.wave * 256;
    load_walpha(F, 0);
    for (int gi = F.vcu * NWAVES + F.wave; gi < NTOK / 4; gi += F.G * NWAVES) { const int m0 = 4 * gi; Row4 x[4];
#pragma unroll
        for (int r = 0; r < 4; ++r) { row_load(x[r], xin + (size_t)(m0 + r) * 1024, F.lane); row_store(x[r], F.out + (size_t)(m0 + r) * 1024, F.lane); }
        __builtin_amdgcn_sched_barrier(0);
        rows4_mod1(F, x, m0, 0, scr); }
}
__device__ __forceinline__ void phase_r1(Frame& F, int l) {
    LAS float* scr = (LAS float*)(F.lds + RING_OFF) + F.wave * 256;
    const float* g1 = F.prm + PO_LN1G + l * 1024; const float* b1 = F.prm + PO_LN1B + l * 1024; const float* RWT = (const float*)(F.ws + WS_RWT) + (size_t)l * 36 * 1024;
    const float* brg = F.prm + PO_BRG + l * 4; const float* bre = F.prm + PO_BRE + l * 32;
    gu32* cnt = F.ctl + CW_CNT + l * 32 * 64; int* LIST = (int*)(F.ws + WS_LIST); unsigned* TI = (unsigned*)(F.ws + WS_TOKINFO);
    for (int gi = F.vcu * NWAVES + F.wave; gi < NTOK / 4; gi += F.G * NWAVES) { const int m0 = 4 * gi, b = m0 >> 12; Row4 x[4];
        const float* ada = (const float*)(F.ws + WS_ADA) + ((size_t)l * 8 + b) * 6144;
#pragma unroll
        for (int r = 0; r < 4; ++r) { row_load(x[r], F.out + (size_t)(m0 + r) * 1024, F.lane); row_standardize(x[r]); row_affine(x[r], g1, b1, false, F.lane); row_store(x[r], F.out + (size_t)(m0 + r) * 1024, F.lane);
            row_standardize(x[r]); row_affine(x[r], ada + 4 * 1024, ada + 3 * 1024, true, F.lane); row_store_bf16(x[r], (bf16*)(F.ws + WS_U) + (size_t)(m0 + r) * 1024, F.lane); __builtin_amdgcn_sched_barrier(0); }
        const float vg = rows4_proj<4>(x, RWT, F.lane);
        __builtin_amdgcn_sched_barrier(0);
        const float va = rows4_proj<16>(x, RWT + 4 * 1024, F.lane);
        __builtin_amdgcn_sched_barrier(0);
        const float vb = rows4_proj<16>(x, RWT + 20 * 1024, F.lane);
        __builtin_amdgcn_sched_barrier(0);
        { const int i4 = idx4(F.lane), i16 = idx16(F.lane); scr[(i4 >> 2) * 40 + (i4 & 3)] = vg; scr[(i16 >> 4) * 40 + 4 + (i16 & 15)] = va; scr[(i16 >> 4) * 40 + 20 + (i16 & 15)] = vb; }
        LDS_WAIT(); asm volatile("" ::: "memory");
        if (F.lane < 4) { const LAS float* s = scr + F.lane * 40; const int m = m0 + F.lane;
            float gl[4];
#pragma unroll
            for (int j = 0; j < 4; ++j) gl[j] = s[j] + brg[j];
            int gidx = 0; float gmax = gl[0];
#pragma unroll
            for (int j = 1; j < 4; ++j) if (gl[j] > gmax) { gmax = gl[j]; gidx = j; }
            float den = 0.f;
#pragma unroll
            for (int j = 0; j < 4; ++j) den += __expf(gl[j] - gmax);
            const float gw = 1.0f / den;
            float el[8];
#pragma unroll
            for (int j = 0; j < 8; ++j) el[j] = s[4 + gidx * 8 + j] + bre[gidx * 8 + j];
            int i0 = 0; float v0 = el[0];
#pragma unroll
            for (int j = 1; j < 8; ++j) if (el[j] > v0) { v0 = el[j]; i0 = j; }
            int i1 = -1; float v1 = -INFINITY;
#pragma unroll
            for (int j = 0; j < 8; ++j) if (j != i0 && el[j] > v1) { v1 = el[j]; i1 = j; }
            if (i1 < 0) i1 = (i0 + 1) & 7;
            const float ex = __expf(v1 - v0), inv = 1.0f / (1.0f + ex); const float w0 = inv * gw, w1 = ex * inv * gw;
            const int e0 = gidx * 8 + i0, e1 = gidx * 8 + i1;
            const unsigned p0 = __hip_atomic_fetch_add(cnt + e0 * 64, 1u, RLX_AGENT), p1 = __hip_atomic_fetch_add(cnt + e1 * 64, 1u, RLX_AGENT);
            LIST[(size_t)e0 * LISTCAP + p0] = m; LIST[(size_t)e1 * LISTCAP + p1] = m;
            *(GAS v4u*)(TI + (size_t)m * 8) = (v4u){(unsigned)e0, p0, (unsigned)e1, p1}; *(GAS v4u*)(TI + (size_t)m * 8 + 4) = (v4u){__float_as_uint(w0), __float_as_uint(w1), 0u, 0u};
        }
        LDS_WAIT(); asm volatile("" ::: "memory");
    }
}
__device__ __forceinline__ void moe_tables(Frame& F, int l) {
    LAS int* CNT = (LAS int*)(F.lds + TAB_CNT); LAS int* BASE = (LAS int*)(F.lds + TAB_BASE);
    if (F.tid < 32) CNT[F.tid] = (int)__hip_atomic_load(F.ctl + CW_CNT + (l * 32 + F.tid) * 64, RLX_AGENT);
    __syncthreads();
    if (F.tid == 0) { int a = 0; for (int e = 0; e < 32; ++e) { BASE[e] = a; a += (CNT[e] + 255) >> 8; } BASE[32] = a; }
    __syncthreads();
}
__device__ __forceinline__ void phase_r2(Frame& F, int l) {
    LAS float* scr = (LAS float*)(F.lds + RING_OFF) + F.wave * 256; const LAS int* BASE = (const LAS int*)(F.lds + TAB_BASE);
    if (l + 1 < DEPTH) load_walpha(F, l + 1);
    const float* g2 = F.prm + PO_LN2G + l * 1024; const float* b2 = F.prm + PO_LN2B + l * 1024; const unsigned* TI = (const unsigned*)(F.ws + WS_TOKINFO); const bf16* YB = (const bf16*)(F.ws + WS_YB);
    for (int gi = F.vcu * NWAVES + F.wave; gi < NTOK / 4; gi += F.G * NWAVES) { const int m0 = 4 * gi, b = m0 >> 12; Row4 x[4];
        const float* gate = (const float*)(F.ws + WS_ADA) + ((size_t)l * 8 + b) * 6144 + 5 * 1024;
#pragma unroll
        for (int r = 0; r < 4; ++r) { const int m = m0 + r;
            const v4u ta = *(const GAS v4u*)(TI + (size_t)m * 8); const v4u tb = *(const GAS v4u*)(TI + (size_t)m * 8 + 4);
            const size_t r0 = (size_t)BASE[ta.x & 31] * 256 + ta.y, r1 = (size_t)BASE[ta.z & 31] * 256 + ta.w; const float w0 = __uint_as_float(tb.x), w1 = __uint_as_float(tb.y);
            row_load(x[r], F.out + (size_t)m * 1024, F.lane);
            const GAS unsigned long long* y0 = (const GAS unsigned long long*)(YB + r0 * 1024) + F.lane; const GAS unsigned long long* y1 = (const GAS unsigned long long*)(YB + r1 * 1024) + F.lane;
#pragma unroll
            for (int j = 0; j < 4; ++j) { const unsigned long long a = y0[64 * j], c = y1[64 * j]; const f32x4 gv = *((const GAS f32x4*)gate + F.lane + 64 * j);
                const f32x4 ya = (f32x4){bflo((unsigned)a), bfhi((unsigned)a), bflo((unsigned)(a >> 32)), bfhi((unsigned)(a >> 32))};
                const f32x4 yc = (f32x4){bflo((unsigned)c), bfhi((unsigned)c), bflo((unsigned)(c >> 32)), bfhi((unsigned)(c >> 32))};
                x[r][j] = x[r][j] * DN_ALPHA + gv * (ya * w0 + yc * w1); }
            row_standardize(x[r]); row_affine(x[r], g2, b2, false, F.lane); row_store(x[r], F.out + (size_t)m * 1024, F.lane); __builtin_amdgcn_sched_barrier(0); }
        if (l + 1 < DEPTH) rows4_mod1(F, x, m0, l + 1, scr);
    }
}
typedef short s16x8 __attribute__((ext_vector_type(8)));
#define MFMA16(a, b, c) __builtin_amdgcn_mfma_f32_16x16x32_bf16((a), (b), (c), 0, 0, 0)
__device__ __forceinline__ void phase_gla(Frame& F) {
    constexpr int QE_OFF = 0, KE_OFF = 17408, KLT_OFF = 34816, VT_OFF = 53248, SBT_OFF = 57856, ATT_OFF = 66560, TOT_OFF = 75776, DEC_OFF = 77824;
    constexpr int QS = 272, TS = 144;
    LAS unsigned char* L = F.lds + RING_OFF;
    LAS float* TOT = (LAS float*)(L + TOT_OFF); LAS float* DEC = (LAS float*)(L + DEC_OFF);
    const int tid = F.tid, lane = F.lane, w = F.wave, k = tid & 127, tg = tid >> 7, fr = lane & 15, fq = lane >> 4;
    const bf16* GQ = (const bf16*)(F.ws + WS_GQ); const bf16* GK = (const bf16*)(F.ws + WS_GK); const bf16* GV = (const bf16*)(F.ws + WS_GV);
    const float* LA = (const float*)(F.ws + WS_LA); bf16* OB = (bf16*)(F.ws + WS_OB); float* SSQ = (float*)(F.ws + WS_SSQ);
    for (int item = F.vcu; item < 256; item += F.G) {
        const int s = item & 7, hg = (item >> 3) & 3, b = item >> 5; const size_t row0 = (size_t)b * SEQ;
        const bf16* gq = GQ + (row0 + tg * 16) * 512 + hg * 128 + k; const bf16* gk = GK + (row0 + tg * 16) * 512 + hg * 128 + k; const float* la = LA + (row0 + tg * 16) * 512 + hg * 128 + k;
        const bf16* gv = GV + (row0 + (tid >> 3)) * 1024 + hg * 256 + s * 32 + (tid & 7) * 4;
        bf16* ob = OB + row0 * 1024 + hg * 256 + s * 32; float* ssq = SSQ + row0 * 64 + hg * 16 + s * 2;
        for (int i = tid; i < 8704 / 4; i += NTHREADS) ((LAS unsigned*)(L + SBT_OFF))[i] = 0u;
        f32x4 accS[2]; accS[0] = (f32x4){0.f, 0.f, 0.f, 0.f}; accS[1] = accS[0];
        float lar[16]; bf16 qv[16], kv[16]; unsigned long long vr;
#pragma unroll
        for (int i = 0; i < 16; ++i) { lar[i] = la[(size_t)i * 512]; qv[i] = gq[(size_t)i * 512]; kv[i] = gk[(size_t)i * 512]; }
        vr = *(const GAS unsigned long long*)gv;
        __syncthreads();
        for (int c = 0; c < 64; ++c) {
            float cs[16]; { float run = 0.f;
#pragma unroll
                for (int i = 0; i < 16; ++i) { run += lar[i]; cs[i] = run; }
                TOT[tg * 128 + k] = run; }
            __syncthreads();
            { float off = 0.f, last = 0.f;
#pragma unroll
              for (int g = 0; g < 4; ++g) { const float tv = TOT[g * 128 + k]; if (g < tg) off += tv; last += tv; }
              unsigned klw[8];
#pragma unroll
              for (int i = 0; i < 16; ++i) { const float cum = cs[i] + off; const float e1 = __expf(cum), e2 = __expf(-cum), e3 = __expf(last - cum);
                  const float qf = __uint_as_float((unsigned)qv[i] << 16), kf = __uint_as_float((unsigned)kv[i] << 16); const int t = tg * 16 + i;
                  *(LAS bf16*)(L + QE_OFF + t * QS + k * 2) = (bf16)f2bf(qf * e1); *(LAS bf16*)(L + KE_OFF + t * QS + k * 2) = (bf16)f2bf(kf * e2);
                  const unsigned kl = f2bf(kf * e3); if (i & 1) klw[i >> 1] |= kl << 16; else klw[i >> 1] = kl; }
              *(LAS v4u*)(L + KLT_OFF + k * TS + tg * 32) = (v4u){klw[0], klw[1], klw[2], klw[3]}; *(LAS v4u*)(L + KLT_OFF + k * TS + tg * 32 + 16) = (v4u){klw[4], klw[5], klw[6], klw[7]};
              if (tg == 0) DEC[k] = __expf(last);
              const int t = tid >> 3, w0 = (tid & 7) * 4;
#pragma unroll
              for (int i = 0; i < 4; ++i) *(LAS bf16*)(L + VT_OFF + (w0 + i) * TS + t * 2) = (bf16)((vr >> (16 * i)) & 0xffffu);
            }
            if (c + 1 < 64) { const size_t o = (size_t)(c + 1) * 64;
#pragma unroll
                for (int i = 0; i < 16; ++i) { lar[i] = la[(o + i) * 512]; qv[i] = gq[(o + i) * 512]; kv[i] = gk[(o + i) * 512]; }
                vr = *(const GAS unsigned long long*)(gv + o * 1024); }
            __syncthreads();
            const int ti = w >> 1, wi = w & 1; f32x4 acco = (f32x4){0.f, 0.f, 0.f, 0.f};
            {
#pragma unroll
              for (int s2 = 0; s2 < 2; ++s2) { const int si = wi * 2 + s2; f32x4 a4 = (f32x4){0.f, 0.f, 0.f, 0.f};
                  if (si <= ti) {
#pragma unroll
                      for (int kk = 0; kk < 4; ++kk) { const s16x8 a = *(const LAS s16x8*)(L + QE_OFF + (ti * 16 + fr) * QS + (kk * 32 + 8 * fq) * 2); const s16x8 bb = *(const LAS s16x8*)(L + KE_OFF + (si * 16 + fr) * QS + (kk * 32 + 8 * fq) * 2);
                          a4 = MFMA16(a, bb, a4); } }
#pragma unroll
                  for (int r = 0; r < 4; ++r) { const int t = ti * 16 + fq * 4 + r, sc = si * 16 + fr; const float v = (sc <= t) ? a4[r] : 0.f; *(LAS bf16*)(L + ATT_OFF + t * TS + sc * 2) = (bf16)f2bf(v); } }
#pragma unroll
              for (int kk = 0; kk < 4; ++kk) { const s16x8 a = *(const LAS s16x8*)(L + QE_OFF + (ti * 16 + fr) * QS + (kk * 32 + 8 * fq) * 2); const s16x8 bb = *(const LAS s16x8*)(L + SBT_OFF + (wi * 16 + fr) * QS + (kk * 32 + 8 * fq) * 2);
                  acco = MFMA16(a, bb, acco); }
            }
            __syncthreads();
            {
#pragma unroll
              for (int kk = 0; kk < 2; ++kk) { const s16x8 a = *(const LAS s16x8*)(L + ATT_OFF + (ti * 16 + fr) * TS + (kk * 32 + 8 * fq) * 2); const s16x8 bb = *(const LAS s16x8*)(L + VT_OFF + (wi * 16 + fr) * TS + (kk * 32 + 8 * fq) * 2);
                  acco = MFMA16(a, bb, acco); }
#pragma unroll
              for (int r = 0; r < 4; ++r) { const int t = c * 64 + ti * 16 + fq * 4 + r; ob[(size_t)t * 1024 + wi * 16 + fr] = (bf16)f2bf(acco[r]);
                  float q = acco[r] * acco[r]; q += __shfl_xor(q, 1); q += __shfl_xor(q, 2); q += __shfl_xor(q, 4); q += __shfl_xor(q, 8);
                  if (fr == 0) ssq[(size_t)t * 64 + wi] = q; }
#pragma unroll
              for (int w2 = 0; w2 < 2; ++w2) {
#pragma unroll
                  for (int r = 0; r < 4; ++r) accS[w2][r] *= DEC[w * 16 + fq * 4 + r];
#pragma unroll
                  for (int kk = 0; kk < 2; ++kk) { const s16x8 a = *(const LAS s16x8*)(L + KLT_OFF + (w * 16 + fr) * TS + (kk * 32 + 8 * fq) * 2); const s16x8 bb = *(const LAS s16x8*)(L + VT_OFF + (w2 * 16 + fr) * TS + (kk * 32 + 8 * fq) * 2);
                      accS[w2] = MFMA16(a, bb, accS[w2]); }
                  *(LAS unsigned long long*)(L + SBT_OFF + (w2 * 16 + fr) * QS + (w * 16 + fq * 4) * 2) = (unsigned long long)pk2(accS[w2][0], accS[w2][1]) | ((unsigned long long)pk2(accS[w2][2], accS[w2][3]) << 32); }
            }
        }
        __syncthreads();
    }
}
__device__ __forceinline__ void unpack8(const v4u w, float* d) { d[0] = bflo(w.x); d[1] = bfhi(w.x); d[2] = bflo(w.y); d[3] = bfhi(w.y); d[4] = bflo(w.z); d[5] = bfhi(w.z); d[6] = bflo(w.w); d[7] = bfhi(w.w); }
__device__ __forceinline__ v4u pack8(const float* d) { v4u o; o.x = pk2(d[0], d[1]); o.y = pk2(d[2], d[3]); o.z = pk2(d[4], d[5]); o.w = pk2(d[6], d[7]); return o; }
__device__ __forceinline__ void phase_post(Frame& F, int l) {
    const float* lq1 = F.prm + PO_LQ1; const float* lk1 = F.prm + PO_LK1; const float* lq2 = F.prm + PO_LQ2; const float* lk2 = F.prm + PO_LK2; const float* diffg = F.prm + PO_DIFFG; const float* glag = F.prm + PO_GLAG;
    const int lane = F.lane;
    const float lam_init = 0.8f - 0.6f * expf(-0.3f * (float)l);
    const float d1 = lq1[l * 64 + lane] * lk1[l * 64 + lane], d2 = lq2[l * 64 + lane] * lk2[l * 64 + lane];
    const float lam = expf(wave_sum(d1)) - expf(wave_sum(d2)) + lam_init, osc = 1.0f - lam_init;
    float dgr[16], ggr[16];
#pragma unroll
    for (int i = 0; i < 16; ++i) { dgr[i] = diffg[l * 128 + 16 * (lane & 7) + i] * osc; ggr[i] = glag[l * 256 + 16 * (lane & 15) + i]; }
    const bf16* OP = (const bf16*)(F.ws + WS_OP); const bf16* OB = (const bf16*)(F.ws + WS_OB); const bf16* SG = (const bf16*)(F.ws + WS_SG); const float* SSQ = (const float*)(F.ws + WS_SSQ);
    bf16* OA2 = (bf16*)(F.ws + WS_OA2); bf16* OB2 = (bf16*)(F.ws + WS_OB2);
    for (int m = F.vcu * NWAVES + F.wave; m < NTOK; m += F.G * NWAVES) {
        float o0[16], o1[16], d[16];
        { const GAS v4u* p0 = (const GAS v4u*)(OP + (size_t)m * 2048 + 16 * lane); const GAS v4u* p1 = (const GAS v4u*)(OP + (size_t)m * 2048 + 1024 + 16 * lane);
          unpack8(p0[0], o0); unpack8(p0[1], o0 + 8); unpack8(p1[0], o1); unpack8(p1[1], o1 + 8); }
        float ss = 0.f;
#pragma unroll
        for (int i = 0; i < 16; ++i) { d[i] = o0[i] - lam * o1[i]; ss += d[i] * d[i]; }
        ss += __shfl_xor(ss, 1); ss += __shfl_xor(ss, 2); ss += __shfl_xor(ss, 4);
        { const float r = 1.0f / sqrtf(ss * (1.0f / 128.0f) + LN_EPS);
#pragma unroll
          for (int i = 0; i < 16; ++i) d[i] = d[i] * r * dgr[i];
          GAS v4u* q = (GAS v4u*)(OA2 + (size_t)m * 1024 + 16 * lane); q[0] = pack8(d); q[1] = pack8(d + 8); }
        { const GAS v4u* p0 = (const GAS v4u*)(OB + (size_t)m * 1024 + 16 * lane); const GAS v4u* p1 = (const GAS v4u*)(SG + (size_t)m * 1024 + 16 * lane);
          unpack8(p0[0], o0); unpack8(p0[1], o0 + 8); unpack8(p1[0], o1); unpack8(p1[1], o1 + 8); }
        { const GAS f32x4* sp = (const GAS f32x4*)(SSQ + (size_t)m * 64 + (lane >> 4) * 16); float sq = 0.f;
#pragma unroll
          for (int j = 0; j < 4; ++j) { const f32x4 v = sp[j]; sq += v.x; sq += v.y; sq += v.z; sq += v.w; }
          const float r = 1.0f / sqrtf(sq * (1.0f / 256.0f) + LN_EPS);
#pragma unroll
          for (int i = 0; i < 16; ++i) d[i] = o0[i] * r * ggr[i] * o1[i];
          GAS v4u* q = (GAS v4u*)(OB2 + (size_t)m * 1024 + 16 * lane); q[0] = pack8(d); q[1] = pack8(d + 8); }
    }
}
struct MoeOrder {
    const LAS int* BASE; int total4, G, c;
    __device__ __forceinline__ bool next(int i, pg8::Unit& u) const {
        const int Lx = i * G + c; if (Lx >= total4) return false;
        const int rt = Lx >> 2, pn = Lx & 3; int e = 0;
        for (int j = 1; j < 32; ++j) if (BASE[j] <= rt) e = j;
        e = __builtin_amdgcn_readfirstlane(e);
        u.pm = rt; u.pn = pn; u.pb = e * 4 + pn; return true;
    }
};

#ifndef PHMASK
#define PHMASK 0xFFFF
#endif
#ifndef REPMASK
#define REPMASK 0
#endif
#define REP(bit) for (int rep_ = 0; rep_ < ((REPMASK & (bit)) ? 2 : 1); ++rep_)
struct Args { const float* in[28]; float* out; unsigned char* ws; };
__global__ void __launch_bounds__(NTHREADS, 2) mk_fwd(Args args) {
    extern __shared__ __attribute__((aligned(16))) unsigned char lds[];
    Frame F;
    F.lds = (LAS unsigned char*)lds;
    F.tid = threadIdx.x; F.lane = F.tid & 63; F.wave = __builtin_amdgcn_readfirstlane(F.tid >> 6);
    F.G = gridDim.x; { const int bx = blockIdx.x; F.vcu = (F.G % 8 == 0) ? (bx % 8) * (F.G / 8) + bx / 8 : bx; }
    F.out = args.out; F.ws = args.ws; F.ctl = (gu32*)(args.ws + WS_CTL); F.prm = (const float*)(args.ws + WS_PRM);
    unsigned char* ws = args.ws;
    for (int u = F.tid; u < (LDS_BYTES - LDSCTL_OFF) / 4; u += NTHREADS) ((LAS unsigned*)(F.lds + LDSCTL_OFF))[u] = 0u;
    __syncthreads();
    volatile LAS unsigned* MISC = (volatile LAS unsigned*)(F.lds + MISC_OFF);
    XcdBarrier bar = xcd_barrier_post((unsigned*)(F.ctl + CW_BAR), MISC + 8);
#define GRID_BAR() do { GAS unsigned char* bw_ = (GAS unsigned char*)args.ws; asm volatile("" : "+s"(bw_)); XcdBarrier b_ = bar; b_.bar = (unsigned*)(bw_ + WS_CTL) + CW_BAR; xcd_barrier(b_); if (REPMASK & 4096) xcd_barrier(b_); } while (0)
#define PHASE_ENTER() do { int t_ = threadIdx.x; asm volatile("" : "+v"(t_)); F.tid = t_; F.lane = t_ & 63; F.wave = __builtin_amdgcn_readfirstlane(t_ >> 6); \
        GAS unsigned char* w_ = (GAS unsigned char*)args.ws; GAS float* o_ = (GAS float*)args.out; asm volatile("" : "+s"(w_), "+s"(o_));   \
        F.ws = (unsigned char*)w_; F.out = (float*)o_; ws = (unsigned char*)w_; F.ctl = (gu32*)(w_ + WS_CTL); F.prm = (const float*)(w_ + WS_PRM); } while (0)
    typedef pg8::bf16_t pb;
    REP(1) if (PHMASK & 1) { PHASE_ENTER(); p0_ada(F, args.in[I_C], args.in[I_WADA], args.in[I_BADA]);
        __syncthreads();
        p0_weights(F, args.in[I_WIN], args.in[I_WBA], args.in[I_WBB], args.in[I_WOUT], args.in[I_WGE], args.in[I_WUE], args.in[I_WDE], args.in[I_WRG], args.in[I_WRE],
                   SmallPrm{args.in[I_BGATES], args.in[I_WALPHA], args.in[I_BALPHA], args.in[I_LQ1], args.in[I_LK1], args.in[I_LQ2], args.in[I_LK2], args.in[I_DIFFG], args.in[I_GLAG], args.in[I_LN1G], args.in[I_LN1B], args.in[I_BRG], args.in[I_BRE], args.in[I_LN2G], args.in[I_LN2B]}); __syncthreads(); }
    GRID_BAR();
    REP(2) if (PHMASK & 2) { PHASE_ENTER(); phase_r0(F, args.in[I_X]); }
    GRID_BAR();
    for (int l = 0; l < DEPTH; ++l) {
        REP(4) if (PHMASK & 4) { PHASE_ENTER(); pg8::Gemm g{(const pb*)(ws + WS_U), (const pb*)(ws + WS_WIN) + (size_t)l * NPROJ * 1024, NTOK, NPROJ, 1024}; pg8::StaticOrder S; S.init(NTOK, NPROJ, F.G, (int)blockIdx.x);
          pg8::EpiProj E{(pb*)(ws + WS_QB), (pb*)(ws + WS_KB), (pb*)(ws + WS_VB), (pb*)(ws + WS_GQ), (pb*)(ws + WS_GK), (pb*)(ws + WS_GV), (pb*)(ws + WS_SG), (pb*)(ws + WS_GT), F.prm + PO_BGATES + l * 2048};
          pg8::gemm_phase<pg8::EpiProj, pg8::StaticOrder, true, false>(F.lds + RING_OFF, g, S, E, nullptr); }
        GRID_BAR();
        REP(8) if (PHMASK & 8) { PHASE_ENTER(); phase_gla(F); }
        GRID_BAR();
        REP(16) if (PHMASK & 16) { PHASE_ENTER(); const attn_body::AttnTensors AT{(const attn_body::bf16*)(ws + WS_QB), (const attn_body::bf16*)(ws + WS_KB), (const attn_body::bf16*)(ws + WS_VB), (attn_body::bf16*)(ws + WS_OP)};
          attn_body::attn_phase<8>((char*)lds + RING_OFF, AT, F.vcu, F.G); }
        GRID_BAR();
        REP(32) if (PHMASK & 32) { PHASE_ENTER(); phase_post(F, l); }
        GRID_BAR();
        REP(64) if (PHMASK & 64) { PHASE_ENTER(); pg8::StaticOrder S; S.init(NTOK, 1024, F.G, (int)blockIdx.x);
          { pg8::Gemm g{(const pb*)(ws + WS_OA2), (const pb*)(ws + WS_WBA) + (size_t)l * 1024 * 1024, NTOK, 1024, 1024};
            pg8::EpiGate<0> E{(pb*)(ws + WS_TMP), 1024, nullptr, (const pb*)(ws + WS_GT), 2048, 0};
            pg8::gemm_phase<pg8::EpiGate<0>, pg8::StaticOrder, true, false>(F.lds + RING_OFF, g, S, E, nullptr); }
          { pg8::Gemm g{(const pb*)(ws + WS_OB2), (const pb*)(ws + WS_WBB) + (size_t)l * 1024 * 1024, NTOK, 1024, 1024};
            pg8::EpiGate<1> E{(pb*)(ws + WS_MIX), 1024, (const pb*)(ws + WS_TMP), (const pb*)(ws + WS_GT), 2048, 1024};
            pg8::gemm_phase<pg8::EpiGate<1>, pg8::StaticOrder, true, false>(F.lds + RING_OFF, g, S, E, nullptr); } }
        GRID_BAR();
        if (PHMASK & 128) { PHASE_ENTER(); pg8::Gemm g{(const pb*)(ws + WS_MIX), (const pb*)(ws + WS_WOUT) + (size_t)l * 1024 * 1024, NTOK, 1024, 1024}; pg8::StaticOrder S; S.init(NTOK, 1024, F.G, (int)blockIdx.x);
          REP(128) { pg8::EpiResid E{F.out, ((REPMASK & 128) && rep_ == 0) ? (float*)(ws + WS_QB) : F.out, (const float*)(ws + WS_ADA) + (size_t)l * 8 * 6144 + 2 * 1024, 6144, DN_ALPHA};
          pg8::gemm_phase<pg8::EpiResid, pg8::StaticOrder, true, false>(F.lds + RING_OFF, g, S, E, nullptr); } }
        GRID_BAR();
        if (PHMASK & 256) { PHASE_ENTER(); phase_r1(F, l); }
        GRID_BAR();
        if (PHMASK & 512) { PHASE_ENTER(); moe_tables(F, l); }
        if (PHMASK & 512) { const LAS int* BASE = (const LAS int*)(F.lds + TAB_BASE); const LAS int* CNT = (const LAS int*)(F.lds + TAB_CNT); LAS int* IDX = (LAS int*)(F.lds + TAB_IDX);
          const int total4 = __builtin_amdgcn_readfirstlane(BASE[32]) * 4; const int* LIST = (const int*)(ws + WS_LIST);
          MoeOrder S{BASE, total4, F.G, (int)blockIdx.x};
          for (int ui = 0; ui < IDX_UNITS; ++ui) { pg8::Unit u; if (!S.next(ui, u)) break; const int e = u.pb >> 2;
              if (F.tid < 256) { const int pos = (u.pm - BASE[e]) * 256 + F.tid; IDX[ui * 256 + F.tid] = (pos < CNT[e]) ? LIST[(size_t)e * LISTCAP + pos] : 0; } }
          __syncthreads();
          REP(512) { pg8::Gemm g{(const pb*)(ws + WS_U), (const pb*)(ws + WS_W1) + (size_t)l * 32 * 1024 * 1024, MOE_MAXT * 256, 1024, 1024};
            pg8::EpiSwiGLU E{(pb*)(ws + WS_H)};
            pg8::gemm_phase<pg8::EpiSwiGLU, MoeOrder, true, true>(F.lds + RING_OFF, g, S, E, IDX); }
          GRID_BAR();
          PHASE_ENTER();
          REP(2048) { pg8::Gemm g{(const pb*)(ws + WS_H), (const pb*)(ws + WS_WD) + (size_t)l * 32 * 1024 * 512, MOE_MAXT * 256, 1024, 512};
            pg8::EpiGate<2> E{(pb*)(ws + WS_YB), 1024, nullptr, nullptr, 0, 0};
            pg8::gemm_phase<pg8::EpiGate<2>, MoeOrder, true, false>(F.lds + RING_OFF, g, S, E, nullptr); }
        }
        GRID_BAR();
        if (PHMASK & 1024) { PHASE_ENTER(); phase_r2(F, l); }
        if (l + 1 < DEPTH) GRID_BAR();
    }
}

extern "C" void kernel_launch(void* const* d_in, const int* in_sizes, int n_in, void* d_out, int out_size, void* d_ws, size_t ws_size, hipStream_t stream) {
    static int grid = 0;
    if (grid == 0) {
        if (n_in != 28 || in_sizes[0] != NTOK * DM || out_size != NTOK * DM || ws_size < WS_END) { fprintf(stderr, "kernel_launch: unexpected shapes (n_in %d, in0 %d, out %d, ws %zu < %zu); nothing launched\n", n_in, n_in > 0 ? in_sizes[0] : -1, out_size, ws_size, (size_t)WS_END); grid = -1; return; }
        int dev = 0, cus = 0, per_cu = 0;
        if (hipGetDevice(&dev) != hipSuccess || hipDeviceGetAttribute(&cus, hipDeviceAttributeMultiprocessorCount, dev) != hipSuccess) { fprintf(stderr, "kernel_launch: device query failed\n"); grid = -1; return; }
        if (hipFuncSetAttribute((const void*)mk_fwd, hipFuncAttributeMaxDynamicSharedMemorySize, LDS_BYTES) != hipSuccess) { fprintf(stderr, "kernel_launch: hipFuncSetAttribute failed\n"); grid = -1; return; }
        if (hipOccupancyMaxActiveBlocksPerMultiprocessor(&per_cu, (const void*)mk_fwd, NTHREADS, LDS_BYTES) != hipSuccess || per_cu < 1) { fprintf(stderr, "kernel_launch: occupancy query says %d\n", per_cu); }
        (void)hipGetLastError();
        grid = cus;
    }
    if (grid < 0) return;
    if (hipMemsetAsync((char*)d_ws + WS_CTL, 0, CTL_ZERO_BYTES, stream) != hipSuccess) { fprintf(stderr, "kernel_launch: memset failed\n"); return; }
    Args a{};
    for (int i = 0; i < 28; ++i) a.in[i] = (const float*)d_in[i];
    a.out = (float*)d_out; a.ws = (unsigned char*)d_ws;
    hipLaunchKernelGGL(mk_fwd, dim3(grid), dim3(NTHREADS), LDS_BYTES, stream, a);
    const hipError_t le = hipPeekAtLastError();
    if (le != hipSuccess) fprintf(stderr, "kernel_launch: launch failed: %s\n", hipGetErrorName(le));
}
```

```cpp
#include <hip/hip_runtime.h>
#include <hip/hip_bf16.h>
#include <cstdio>
#include <cstdint>
#include <cmath>
namespace pg8 {
#define PG8_LAS __attribute__((address_space(3)))
typedef unsigned short bf16_t;
typedef short bf16x8 __attribute__((ext_vector_type(8)));
typedef float f32x4 __attribute__((ext_vector_type(4)));
typedef float f32x2 __attribute__((ext_vector_type(2)));
typedef unsigned u32x4 __attribute__((ext_vector_type(4)));
typedef unsigned u32x2 __attribute__((ext_vector_type(2)));
constexpr int BM = 256, BK = 64, HALF = 128, HTB = HALF * BK * 2  , STAGE_BYTES = 8 * HTB, NXCD = 8, WGM = 8;

__host__ __device__ __forceinline__ int lds_byte(int r, int c) { const int st = (r >> 4) * 2 + (c >> 5), rr = r & 15, cc = c & 31, ob = rr * 64 + cc * 2; return st * 1024 + (ob ^ (((ob >> 9) & 1) << 5)); }
__host__ __device__ __forceinline__ void stage_rc(int b, int& R, int& C) { const int st = b / 1024, sb = b % 1024, swz = sb ^ (((sb >> 9) & 1) << 5); R = (st >> 1) * 16 + swz / 64; C = (st & 1) * 32 + (swz % 64) / 2; }
__host__ __device__ __forceinline__ int perm32(int rho) { const int n = rho >> 4, i = rho & 15; return 8 * (i >> 2) + 4 * n + (i & 3); }

struct Unit { int pm, pn, pb; };
struct Gemm { const bf16_t* A; const bf16_t* Bt; int M, N, K; };

struct StaticOrder {
    int nM, nN, nwg, G, c;
    __host__ __device__ void init(int M, int N, int G_, int c_) { nM = M / BM; nN = N / BM; nwg = nM * nN; G = G_; c = c_; }
    __host__ __device__ bool next(int i, Unit& u) const {
        const long L = (long)i * G + c; if (L >= nwg) return false;
        int wgid = (int)L; { const int q = nwg / NXCD, r = nwg % NXCD, xcd = wgid % NXCD, off = wgid / NXCD; wgid = (xcd < r ? xcd * (q + 1) : r * (q + 1) + (xcd - r) * q) + off; }
        const int nig = WGM * nN, gid = wgid / nig, fm = gid * WGM, gsz = (nM - fm) < WGM ? (nM - fm) : WGM;
        u.pm = fm + ((wgid % nig) % gsz); u.pn = (wgid % nig) / gsz; u.pb = u.pn; return true;
    }
};

__device__ __forceinline__ unsigned cvt_pk_bf16(float lo, float hi) { unsigned r; asm volatile("v_cvt_pk_bf16_f32 %0, %1, %2" : "=v"(r) : "v"(lo), "v"(hi)); return r; }
__device__ __forceinline__ float bf_lo(unsigned w) { return __uint_as_float(w << 16); }
__device__ __forceinline__ float bf_hi(unsigned w) { return __uint_as_float(w & 0xffff0000u); }
__device__ __forceinline__ float sigmoidf_(float x) { return __builtin_amdgcn_rcpf(1.0f + __expf(-x)); }

template <class Epi, class Sched, bool ALIGN_EPI, bool GATHER>
__device__ __forceinline__ void gemm_phase(PG8_LAS unsigned char* lds, const Gemm g, const Sched& S, const Epi& E, const PG8_LAS int* idxtab) {
    int tid_ = threadIdx.x; asm volatile("" : "+v"(tid_));
    const int tid = tid_, wid = __builtin_amdgcn_readfirstlane(tid >> 6), lane = tid & 63, wr = wid >> 2, wc = wid & 3, fr = lane & 15, fq = lane >> 4;
    const int K = g.K, nt = K / BK;
    unsigned voffA[2], voffB[2];
#pragma unroll
    for (int i = 0; i < 2; ++i) { int R, C; stage_rc(tid * 16 + i * 8192, R, C); const int Rb = Epi::PERM ? ((R & ~31) + perm32(R & 31)) : R;
        voffA[i] = (unsigned)(R * K + C) * 2u; voffB[i] = (unsigned)(Rb * K + C) * 2u; }
    const size_t kstep = (size_t)(BK * 2);
    const size_t hstep = (size_t)HALF * K * 2;
    const size_t tstep = 2 * hstep;
    const unsigned ldsw = (unsigned)wid * 1024u;
    const int aoff = lds_byte(wr * 64 + fr, fq * 8), boff = lds_byte(wc * 32 + fr, fq * 8);
    unsigned offAc[2][2];
    int nui = 0;
#define PG8_SA(b, h) (((b) * 2 + (h)) * HTB)
#define PG8_SB(b, h) ((4 + (b) * 2 + (h)) * HTB)
#define PG8_STAGE(bufoff, gbase, voff) do { _Pragma("unroll") for (int _i = 0; _i < 2; ++_i) \
        __builtin_amdgcn_global_load_lds((const unsigned*)((const char*)(gbase) + (voff)[_i]), (PG8_LAS unsigned*)(lds + (bufoff) + ldsw + _i * 8192), 16, 0, 0); } while (0)
#define PG8_GOFF(uix, h, i, tt) ({ int _R, _C; stage_rc((tt) * 16 + (i) * 8192, _R, _C); (unsigned)idxtab[(uix) * 256 + (h) * HALF + _R] * (unsigned)(K * 2) + (unsigned)_C * 2u; })
#define PG8_STAGE_A(bufoff, kb, h, nx) do { if constexpr (GATHER) { unsigned _o[2] = {offAc[h][0], offAc[h][1]}; \
        if (nx) { int _t = tid; asm volatile("" : "+v"(_t)); _o[0] = PG8_GOFF(nui, h, 0, _t); _o[1] = PG8_GOFF(nui, h, 1, _t); } \
        _Pragma("unroll") for (int _i = 0; _i < 2; ++_i) \
        __builtin_amdgcn_global_load_lds((const unsigned*)((const char*)g.A + (size_t)(kb) + _o[_i]), (PG8_LAS unsigned*)(lds + (bufoff) + ldsw + _i * 8192), 16, 0, 0); } \
        else { const char* _b = ((nx) ? nA : cA) + (size_t)(kb) + (size_t)(h) * hstep; PG8_STAGE(bufoff, _b, voffA); } } while (0)
#define PG8_GIDX(dst, uix) do { if constexpr (GATHER) { int _t = tid; asm volatile("" : "+v"(_t)); _Pragma("unroll") for (int _h = 0; _h < 2; ++_h) _Pragma("unroll") for (int _i = 0; _i < 2; ++_i) \
        dst[_h][_i] = PG8_GOFF(uix, _h, _i, _t); } } while (0)
#define PG8_LDA(dst, b, h) do { _Pragma("unroll") for (int m = 0; m < 4; ++m) _Pragma("unroll") for (int k = 0; k < 2; ++k) dst[m][k] = *(const PG8_LAS bf16x8*)(lds + PG8_SA(b, h) + aoff + m * 2048 + k * 1024); } while (0)
#define PG8_LDB(dst, b, h) do { _Pragma("unroll") for (int n = 0; n < 2; ++n) _Pragma("unroll") for (int k = 0; k < 2; ++k) dst[n][k] = *(const PG8_LAS bf16x8*)(lds + PG8_SB(b, h) + boff + n * 2048 + k * 1024); } while (0)
#define PG8_MMA(ai, bj, At, Bt) do { __builtin_amdgcn_s_setprio(1); _Pragma("unroll") for (int m = 0; m < 4; ++m) _Pragma("unroll") for (int n = 0; n < 2; ++n) _Pragma("unroll") for (int k = 0; k < 2; ++k) \
        acc[ai][bj][m][n] = __builtin_amdgcn_mfma_f32_16x16x32_bf16(Bt[n][k], At[m][k], acc[ai][bj][m][n], 0, 0, 0); __builtin_amdgcn_s_setprio(0); } while (0)
#define PG8_WAIT_V(n) asm volatile("s_waitcnt vmcnt(" #n ")" ::: "memory")
#define PG8_WAIT_L(n) asm volatile("s_waitcnt lgkmcnt(" #n ")" ::: "memory")
#define PG8_BAR __builtin_amdgcn_s_barrier()
#define PG8_SCHED __builtin_amdgcn_sched_barrier(0)
    Unit cur, nxt; int ui = 0;
    if (!S.next(0, cur)) return;
    f32x4 acc[2][2][4][2];
#pragma unroll
    for (int a = 0; a < 2; ++a)
#pragma unroll
        for (int b = 0; b < 2; ++b)
#pragma unroll
            for (int m = 0; m < 4; ++m)
#pragma unroll
                for (int n = 0; n < 2; ++n) acc[a][b][m][n] = (f32x4){0.f, 0.f, 0.f, 0.f};
    bf16x8 At[4][2], B0[2][2], B1[2][2];
    const char* cA = (const char*)g.A + (size_t)cur.pm * tstep; const char* cB = (const char*)g.Bt + (size_t)cur.pb * tstep;
    const char* nA = cA;
    PG8_GIDX(offAc, 0);
    PG8_STAGE(PG8_SB(0, 0), cB, voffB); PG8_STAGE(PG8_SB(0, 1), cB + hstep, voffB); PG8_STAGE_A(PG8_SA(0, 0), 0, 0, false); PG8_STAGE_A(PG8_SA(0, 1), 0, 1, false);
    if (wr == 1) PG8_BAR;
    PG8_WAIT_V(2); PG8_BAR;
    PG8_STAGE(PG8_SB(1, 0), cB + kstep, voffB); PG8_STAGE_A(PG8_SA(1, 0), kstep, 0, false); PG8_STAGE(PG8_SB(1, 1), cB + hstep + kstep, voffB);
    PG8_WAIT_V(6); PG8_BAR;
    for (;;) {
        const bool has_next = S.next(ui + 1, nxt);
        nA = has_next ? (const char*)g.A + (size_t)nxt.pm * tstep : cA; const char* nB = has_next ? (const char*)g.Bt + (size_t)nxt.pb * tstep : cB;
        nui = has_next ? ui + 1 : ui;
        for (int t = 0; t < nt; t += 2) {
            const bool last = (t == nt - 2);
            const size_t kb1 = (size_t)(t + 1) * kstep;
            const size_t kb2 = last ? (size_t)0 : (size_t)(t + 2) * kstep, kb3 = kb2 + kstep;
            const char* b2 = last ? nB : cB + (size_t)(t + 2) * kstep; const char* b3 = b2 + kstep;
            PG8_LDB(B0, 0, 0); PG8_LDB(B1, 0, 1); PG8_SCHED; PG8_LDA(At, 0, 0); PG8_STAGE_A(PG8_SA(1, 1), kb1, 1, false);
            PG8_WAIT_V(8); PG8_WAIT_L(0); PG8_BAR; PG8_MMA(0, 0, At, B0); PG8_MMA(0, 1, At, B1); PG8_BAR; PG8_SCHED;
            PG8_LDA(At, 0, 1); PG8_STAGE(PG8_SB(0, 0), b2, voffB); PG8_STAGE(PG8_SB(0, 1), b2 + hstep, voffB); PG8_STAGE_A(PG8_SA(0, 0), kb2, 0, last);
            PG8_WAIT_V(8); PG8_WAIT_L(0); PG8_BAR; PG8_MMA(1, 0, At, B0); PG8_MMA(1, 1, At, B1); PG8_BAR; PG8_SCHED;
            PG8_LDB(B0, 1, 0); PG8_LDB(B1, 1, 1); PG8_SCHED; PG8_LDA(At, 1, 0); PG8_STAGE_A(PG8_SA(0, 1), kb2, 1, last);
            PG8_WAIT_V(8); PG8_WAIT_L(0); PG8_BAR; PG8_MMA(0, 0, At, B0); PG8_MMA(0, 1, At, B1); PG8_BAR; PG8_SCHED;
            PG8_LDA(At, 1, 1); PG8_STAGE(PG8_SB(1, 0), b3, voffB); PG8_STAGE(PG8_SB(1, 1), b3 + hstep, voffB); PG8_STAGE_A(PG8_SA(1, 0), kb3, 0, last);
            PG8_WAIT_V(8); PG8_WAIT_L(0); PG8_BAR; PG8_MMA(1, 0, At, B0); PG8_MMA(1, 1, At, B1); PG8_BAR; PG8_SCHED;
        }
        if constexpr (ALIGN_EPI) { if (wr == 0) PG8_BAR; }
        E(acc, cur, wr, wc, fr, fq);
        if (!has_next) break;
#pragma unroll
        for (int a = 0; a < 2; ++a)
#pragma unroll
            for (int b = 0; b < 2; ++b)
#pragma unroll
                for (int m = 0; m < 4; ++m)
#pragma unroll
                    for (int n = 0; n < 2; ++n) acc[a][b][m][n] = (f32x4){0.f, 0.f, 0.f, 0.f};
        cur = nxt; cA = nA; cB = nB; ++ui;
        PG8_GIDX(offAc, ui);
        if constexpr (ALIGN_EPI) { if (wr == 1) PG8_BAR; }
    }
    PG8_WAIT_V(0);
    if constexpr (!ALIGN_EPI) { if (wr == 0) PG8_BAR; }
    PG8_BAR;
#undef PG8_SA
#undef PG8_SB
#undef PG8_STAGE
#undef PG8_STAGE_A
#undef PG8_GIDX
#undef PG8_GOFF
#undef PG8_LDA
#undef PG8_LDB
#undef PG8_MMA
#undef PG8_WAIT_V
#undef PG8_WAIT_L
#undef PG8_BAR
#undef PG8_SCHED
}
}
namespace pg8 {
constexpr float ATT_C2 = 0.125f * 1.4426950408889634f;
constexpr float GLA_QS = 0.08838834764831845f;
struct EpiProj {
    static constexpr bool PERM = true;
    bf16_t *Qb, *Kb, *Vb, *GQ, *GK, *GV, *SG, *GT; const float* bgates;
    __device__ __forceinline__ void operator()(const f32x4 (&acc)[2][2][4][2], const Unit& u, int wr, int wc, int fr, int fq) const {
        asm volatile("" : "+v"(fr), "+v"(fq));
        const int pn = u.pn; bf16_t* base; int ldc = 1024, ct; int act = 0; float sc = 1.f;
        if (pn < 4) { base = Qb; ct = pn; sc = ATT_C2; }
        else if (pn < 8) { base = Kb; ct = pn - 4; }
        else if (pn < 12) { base = Vb; ct = pn - 8; }
        else if (pn < 14) { base = GQ; ldc = 512; ct = pn - 12; sc = GLA_QS; }
        else if (pn < 16) { base = GK; ldc = 512; ct = pn - 14; }
        else if (pn < 20) { base = GV; ct = pn - 16; }
        else if (pn < 24) { base = SG; ct = pn - 20; act = 1; }
        else { base = GT; ldc = 2048; ct = pn - 24; act = 2; }
        const int row0 = u.pm * BM + wr * 64 + fr, col0 = ct * BM + wc * 32 + 8 * fq;
        f32x4 bv[2][2];
#pragma unroll
        for (int bj = 0; bj < 2; ++bj)
#pragma unroll
            for (int n = 0; n < 2; ++n) bv[bj][n] = (act == 2) ? *(const f32x4*)(bgates + col0 + bj * HALF + 4 * n) : (f32x4){0.f, 0.f, 0.f, 0.f};
#pragma unroll
        for (int ai = 0; ai < 2; ++ai)
#pragma unroll
            for (int m = 0; m < 4; ++m) { bf16_t* rowp = base + (size_t)(row0 + ai * HALF + m * 16) * ldc + col0;
#pragma unroll
                for (int bj = 0; bj < 2; ++bj) { f32x4 v0 = acc[ai][bj][m][0] * sc + bv[bj][0], v1 = acc[ai][bj][m][1] * sc + bv[bj][1];
                    if (act != 0) {
#pragma unroll
                        for (int e = 0; e < 4; ++e) { const float s0 = sigmoidf_(v0[e]), s1 = sigmoidf_(v1[e]); v0[e] = (act == 1) ? v0[e] * s0 : s0; v1[e] = (act == 1) ? v1[e] * s1 : s1; } }
                    u32x4 w; w.x = cvt_pk_bf16(v0[0], v0[1]); w.y = cvt_pk_bf16(v0[2], v0[3]); w.z = cvt_pk_bf16(v1[0], v1[1]); w.w = cvt_pk_bf16(v1[2], v1[3]);
                    *(u32x4*)(rowp + bj * HALF) = w; } }
    }
};
template <int MODE> struct EpiGate {
    static constexpr bool PERM = true;
    bf16_t* O; int ldo; const bf16_t* T; const bf16_t* gate; int ldg, gcol0;
    __device__ __forceinline__ void operator()(const f32x4 (&acc)[2][2][4][2], const Unit& u, int wr, int wc, int fr, int fq) const {
        asm volatile("" : "+v"(fr), "+v"(fq));
        const int row0 = u.pm * BM + wr * 64 + fr, col0 = u.pn * BM + wc * 32 + 8 * fq;
#pragma unroll
        for (int ai = 0; ai < 2; ++ai)
#pragma unroll
            for (int m = 0; m < 4; ++m) { const size_t row = (size_t)(row0 + ai * HALF + m * 16);
#pragma unroll
                for (int bj = 0; bj < 2; ++bj) { f32x4 v0 = acc[ai][bj][m][0], v1 = acc[ai][bj][m][1]; const int col = col0 + bj * HALF;
                    if (MODE != 2) { const u32x4 gw = *(const u32x4*)(gate + row * ldg + gcol0 + col);
                        v0 = v0 * (f32x4){bf_lo(gw.x), bf_hi(gw.x), bf_lo(gw.y), bf_hi(gw.y)}; v1 = v1 * (f32x4){bf_lo(gw.z), bf_hi(gw.z), bf_lo(gw.w), bf_hi(gw.w)}; }
                    if (MODE == 1) { const u32x4 tw = *(const u32x4*)(T + row * ldo + col);
                        v0 = v0 + (f32x4){bf_lo(tw.x), bf_hi(tw.x), bf_lo(tw.y), bf_hi(tw.y)}; v1 = v1 + (f32x4){bf_lo(tw.z), bf_hi(tw.z), bf_lo(tw.w), bf_hi(tw.w)}; }
                    u32x4 w; w.x = cvt_pk_bf16(v0[0], v0[1]); w.y = cvt_pk_bf16(v0[2], v0[3]); w.z = cvt_pk_bf16(v1[0], v1[1]); w.w = cvt_pk_bf16(v1[2], v1[3]);
                    *(u32x4*)(O + row * ldo + col) = w; }
                asm volatile("" ::: "memory"); }
    }
};
struct EpiResid {
    static constexpr bool PERM = false;
    const float* X; float* Xo; const float* gvec; int gstride; float alpha;
    __device__ __forceinline__ void operator()(const f32x4 (&acc)[2][2][4][2], const Unit& u, int wr, int wc, int fr, int fq) const {
        asm volatile("" : "+v"(fr), "+v"(fq));
        const int row0 = u.pm * BM + wr * 64 + fr, col0 = u.pn * BM + wc * 32 + 4 * fq; const float* gv = gvec + (size_t)(u.pm >> 4) * gstride;
        f32x4 g4[2][2];
#pragma unroll
        for (int bj = 0; bj < 2; ++bj)
#pragma unroll
            for (int n = 0; n < 2; ++n) g4[bj][n] = *(const f32x4*)(gv + col0 + bj * HALF + n * 16);
#pragma unroll
        for (int ai = 0; ai < 2; ++ai)
#pragma unroll
            for (int m = 0; m < 4; ++m) { const size_t ro = (size_t)(row0 + ai * HALF + m * 16) * 1024 + col0;
#pragma unroll
                for (int bj = 0; bj < 2; ++bj)
#pragma unroll
                    for (int n = 0; n < 2; ++n) { const size_t o = ro + bj * HALF + n * 16; const f32x4 xv = *(const f32x4*)(X + o); *(f32x4*)(Xo + o) = xv * alpha + g4[bj][n] * acc[ai][bj][m][n]; }
                asm volatile("" ::: "memory"); }
    }
};
struct EpiSwiGLU {
    static constexpr bool PERM = true;
    bf16_t* H;
    __device__ __forceinline__ void operator()(const f32x4 (&acc)[2][2][4][2], const Unit& u, int wr, int wc, int fr, int fq) const {
        asm volatile("" : "+v"(fr), "+v"(fq));
        const int row0 = u.pm * BM + wr * 64 + fr, col0 = u.pn * HALF + wc * 32 + 8 * fq;
#pragma unroll
        for (int ai = 0; ai < 2; ++ai)
#pragma unroll
            for (int m = 0; m < 4; ++m) { f32x4 h0, h1;
#pragma unroll
                for (int e = 0; e < 4; ++e) { const float g0 = acc[ai][0][m][0][e], g1 = acc[ai][0][m][1][e]; h0[e] = g0 * sigmoidf_(g0) * acc[ai][1][m][0][e]; h1[e] = g1 * sigmoidf_(g1) * acc[ai][1][m][1][e]; }
                u32x4 w; w.x = cvt_pk_bf16(h0[0], h0[1]); w.y = cvt_pk_bf16(h0[2], h0[3]); w.z = cvt_pk_bf16(h1[0], h1[1]); w.w = cvt_pk_bf16(h1[2], h1[3]);
                *(u32x4*)(H + (size_t)(row0 + ai * HALF + m * 16) * 512 + col0) = w; }
    }
};
}
#include <hip/hip_bf16.h>
#include <cmath>
namespace attn_body {
using bf16=__hip_bfloat16;
using bf16x8=__attribute__((ext_vector_type(8)))short;
using s16x4=__attribute__((ext_vector_type(4)))short;
using f32x16=__attribute__((ext_vector_type(16)))float;
using u32x4=__attribute__((ext_vector_type(4)))unsigned;
constexpr int BATCH=8,NHEAD=16,SEQ=4096,D=64,DM=NHEAD*D,OPITCH=2048;
constexpr int NW=8,QBLK=32,QB=QBLK*NW,KVBLK=64,NQB=SEQ/QB;
constexpr int ATTN_PITCH=DM, ATTN_UNIT_ROWS=QB;
__device__ __forceinline__ int crow(int r,int hi){return (r&3)+8*(r>>2)+4*hi;}
#define SBAR() __builtin_amdgcn_sched_barrier(0)
__device__ __forceinline__ void cmask(f32x16&p0,f32x16&p1,int jb,int qrel,int hi){
  const float NEG=-INFINITY; int kb=64*jb+4*hi;
  #pragma unroll
  for(int r=0;r<16;++r){int kv=kb+(r&3)+8*(r>>2); if(kv>qrel)p0[r]=NEG; if(kv+32>qrel)p1[r]=NEG;}
}

constexpr int NSLOT=3, SLOTB=8192;
constexpr int LDS_K=0, LDS_V=NSLOT*SLOTB, LDS_WS=3*NSLOT*SLOTB, LDS_OST=LDS_WS+NW*64*4, LDS_BYTES=LDS_OST+NW*4096;
constexpr float C2=0.125f*1.4426950408889634f;
__device__ __forceinline__ void glds16s(const void*sbase,unsigned voff,unsigned lds_dst){unsigned keep;
  asm volatile("s_mov_b32 %0, m0\n\ts_mov_b32 m0, %2\n\ts_nop 0\n\tglobal_load_lds_dwordx4 %1, %3\n\ts_mov_b32 m0, %0":"=&s"(keep):"v"(voff),"s"(lds_dst),"s"(sbase):"memory");}
__device__ __forceinline__ void glds16(const void*gsrc,unsigned lds_dst){unsigned keep;
  asm volatile("s_mov_b32 %0, m0\n\ts_mov_b32 m0, %2\n\ts_nop 0\n\tglobal_load_lds_dwordx4 %1, off\n\ts_mov_b32 m0, %0":"=&s"(keep):"v"(gsrc),"s"(lds_dst):"memory");}
__device__ __forceinline__ float max3f(float a,float b,float c){float r;asm("v_max3_f32 %0, %1, %2, %3":"=v"(r):"v"(a),"v"(b),"v"(c));return r;}
__device__ __forceinline__ float max2f(float a,float b){float r;asm("v_max_f32_e32 %0, %1, %2":"=v"(r):"v"(a),"v"(b));return r;}
__device__ __forceinline__ float fadd_s(float a,float b){float r;asm("v_add_f32_e32 %0, %1, %2":"=v"(r):"v"(a),"v"(b));return r;}
__device__ __forceinline__ float fsub_s(float a,float b){float r;asm("v_sub_f32_e32 %0, %1, %2":"=v"(r):"v"(a),"v"(b));return r;}
typedef float f32x2_t __attribute__((ext_vector_type(2))); typedef __bf16 bf16x2_t __attribute__((ext_vector_type(2)));
__device__ __forceinline__ unsigned cvtpk_s(float lo,float hi){f32x2_t v={lo,hi};bf16x2_t b=__builtin_convertvector(v,bf16x2_t);return __builtin_bit_cast(unsigned,b);}
#define WAIT_BAR(N) asm volatile("s_waitcnt vmcnt(" #N ") lgkmcnt(0)\n\ts_barrier":::"memory")

__device__ __forceinline__ void qkt(f32x16&p0,f32x16&p1,const char*Kslot,const bf16x8*qr,const f32x16&c0,const f32x16&c1,int r32,int hi){
  const char*kb=Kslot+hi*1024+r32*16;
  #pragma unroll
  for(int d0=0;d0<4;++d0){
    const bf16x8 b0=*reinterpret_cast<const bf16x8*>(kb+d0*2048);
    const bf16x8 b1=*reinterpret_cast<const bf16x8*>(kb+d0*2048+512);
    if(d0==0){p0=__builtin_amdgcn_mfma_f32_32x32x16_bf16(b0,qr[0],c0,0,0,0);p1=__builtin_amdgcn_mfma_f32_32x32x16_bf16(b1,qr[0],c1,0,0,0);}
    else{p0=__builtin_amdgcn_mfma_f32_32x32x16_bf16(b0,qr[d0],p0,0,0,0);p1=__builtin_amdgcn_mfma_f32_32x32x16_bf16(b1,qr[d0],p1,0,0,0);}}
}
typedef __attribute__((address_space(3))) const char* lds_cptr;
typedef short v4i16_t __attribute__((ext_vector_type(4)));
__device__ __forceinline__ void kload8(bf16x8*kf,lds_cptr kp){
  kf[0]=*(const __attribute__((address_space(3))) bf16x8*)(kp);      kf[1]=*(const __attribute__((address_space(3))) bf16x8*)(kp+512);
  kf[2]=*(const __attribute__((address_space(3))) bf16x8*)(kp+2048); kf[3]=*(const __attribute__((address_space(3))) bf16x8*)(kp+2560);
  kf[4]=*(const __attribute__((address_space(3))) bf16x8*)(kp+4096); kf[5]=*(const __attribute__((address_space(3))) bf16x8*)(kp+4608);
  kf[6]=*(const __attribute__((address_space(3))) bf16x8*)(kp+6144); kf[7]=*(const __attribute__((address_space(3))) bf16x8*)(kp+6656);
}
__device__ __forceinline__ void kload2(bf16x8*kf,lds_cptr kp,int j){ kf[2*j]=*(const __attribute__((address_space(3))) bf16x8*)(kp+j*2048); kf[2*j+1]=*(const __attribute__((address_space(3))) bf16x8*)(kp+j*2048+512); }
__device__ __forceinline__ s16x4 vtr(lds_cptr p){ return __builtin_bit_cast(s16x4,__builtin_amdgcn_ds_read_tr16_b64_v4i16((__attribute__((address_space(3))) v4i16_t*)p)); }
__device__ __forceinline__ float rowmax(const f32x16&p0,const f32x16&p1){
  float a=max3f(p0[0],p0[1],p1[0]),b=max3f(p0[2],p0[3],p1[1]);a=max3f(a,p1[2],p1[3]);
  #pragma unroll
  for(int r=4;r<16;r+=4){a=max3f(a,p0[r],p0[r+1]);b=max3f(b,p0[r+2],p0[r+3]);a=max3f(a,p1[r],p1[r+1]);b=max3f(b,p1[r+2],p1[r+3]);}
  const float m=max2f(a,b);
  auto rr=__builtin_amdgcn_permlane32_swap(__float_as_uint(m),__float_as_uint(m),false,false);
  return max2f(__uint_as_float(rr[0]),__uint_as_float(rr[1]));
}
__device__ __forceinline__ void pv(f32x16*o,int vb,bf16x8 pa0,bf16x8 pa1,bf16x8 pa2,bf16x8 pa3){
  #pragma unroll
  for(int d0=0;d0<4;++d0){s16x4 lo[4],hi[4];
    #pragma unroll
    for(int ks=0;ks<4;++ks){
      asm volatile("ds_read_b64_tr_b16 %0,%1 offset:%c2":"=&v"(lo[ks]):"v"(vb),"i"(d0*4096+ks*1024):"memory");
      asm volatile("ds_read_b64_tr_b16 %0,%1 offset:%c2":"=&v"(hi[ks]):"v"(vb),"i"(d0*4096+ks*1024+512):"memory");}
    asm volatile("s_waitcnt lgkmcnt(0)":::"memory");SBAR();
    #define PK(k) (bf16x8){lo[k][0],lo[k][1],lo[k][2],lo[k][3],hi[k][0],hi[k][1],hi[k][2],hi[k][3]}
    o[d0]=__builtin_amdgcn_mfma_f32_32x32x16_bf16(pa0,PK(0),o[d0],0,0,0);
    o[d0]=__builtin_amdgcn_mfma_f32_32x32x16_bf16(pa1,PK(1),o[d0],0,0,0);
    o[d0]=__builtin_amdgcn_mfma_f32_32x32x16_bf16(pa2,PK(2),o[d0],0,0,0);
    o[d0]=__builtin_amdgcn_mfma_f32_32x32x16_bf16(pa3,PK(3),o[d0],0,0,0);
    #undef PK
  }
}

#ifndef ATTN_STORE16
#define ATTN_STORE16(p,v) (*(u32x4*)(p)=(v))
#endif
template<int THRL> __device__ __forceinline__ void attn_unit(int b,int hq,int hv,int ocol,int qb,int nfar,float sl2,const bf16*Q,const bf16*__restrict__ K,const bf16*__restrict__ V,bf16*O,char*shm){
  int tid_=threadIdx.x; asm volatile("":"+v"(tid_));
  const int tid=tid_,lane=tid&63,r32=lane&31,hi=lane>>5; const int wid=__builtin_amdgcn_readfirstlane(tid>>6);
  const long rowbase=(long)b*SEQ; const int q0=qb*QB;
  const bf16*Qw=Q+(rowbase+q0+wid*QBLK)*DM+hq*D;
  const int NTf=(q0+QB)/KVBLK, NT=(NTf<4+nfar)?NTf:4+nfar, t0=NTf-NT, q0c=q0-64*t0;
  const bf16*Kh=K+(rowbase+64*t0)*DM+hq*D,*Vh=V+(rowbase+64*t0)*DM+hv*D;
  const unsigned lds0=(unsigned)(uintptr_t)shm;
  float*wsf=(float*)(shm+LDS_WS)+wid*64;
  const unsigned kvoff=(unsigned)(lane*DM+wid*8)*2u;
  const unsigned vvoff=(unsigned)((16*(wid&3)+(lane>>2))*DM+(wid>>2)*32+(lane&3)*8)*2u;
  const unsigned kdst=lds0+LDS_K+wid*1024, vdst=lds0+LDS_V+wid*1024;
  #define DMA_K(t,slot) glds16s(Kh+(long)(t)*KVBLK*DM,kvoff,(unsigned)__builtin_amdgcn_readfirstlane(kdst+(slot)))
  #define DMA_V(t,slot) do{ glds16s(Vh+(long)(t)*KVBLK*DM,vvoff,(unsigned)__builtin_amdgcn_readfirstlane(vdst+2*(slot))); glds16s(Vh+(long)(t)*KVBLK*DM+64,vvoff,(unsigned)__builtin_amdgcn_readfirstlane(vdst+2*(slot)+8192)); }while(0)
  const int vb0=(int)(lds0+LDS_V)+((lane>>4)&1)*32+(lane&3)*8+(4*hi+((lane&15)>>2))*64;
  const char*Kbase=shm+LDS_K; bf16x8 kf[8];
  const lds_cptr shm3=(lds_cptr)shm; const lds_cptr kp0=shm3+LDS_K+hi*1024+r32*16; const lds_cptr vp0=shm3+LDS_V+((lane>>4)&1)*32+(lane&3)*8+(4*hi+((lane&15)>>2))*64;
  DMA_K(0,0);DMA_V(0,0);DMA_K(1,SLOTB);
  bf16x8 qr[4];
  #pragma unroll
  for(int d0=0;d0<4;++d0)qr[d0]=*reinterpret_cast<const bf16x8*>(&Qw[(long)r32*DM+d0*16+hi*8]);
  float mhat=0.f,l_reg=0.f;f32x16 o[4];o[0]=f32x16{};o[1]=f32x16{};o[2]=f32x16{};o[3]=f32x16{};
  #define CINIT0(C0_,t_) do{ const float bt_=sl2*(float)(64*(t_)-q0c+4*hi)-mhat; _Pragma("unroll") for(int r=0;r<16;++r){C0_[r]=__builtin_fmaf(sl2,(float)((r&3)+8*(r>>2)),bt_);} }while(0)
  #define CINIT1(C1_,t_) do{ const float bt_=sl2*(float)(64*(t_)-q0c+4*hi)-mhat; _Pragma("unroll") for(int r=0;r<16;++r){C1_[r]=__builtin_fmaf(sl2,(float)((r&3)+8*(r>>2)+32),bt_);} }while(0)
  #define CINIT(C0_,C1_,t_) do{ CINIT0(C0_,t_); CINIT1(C1_,t_); }while(0)
  const int qrel=wid*QBLK+r32;
  #define CMASK(P0,P1,t) do{int jb_=(t)-(NT-4); if(jb_>=0)cmask(P0,P1,jb_,qrel,hi);}while(0)
  bool resc=false;
  #define START(P0,P1) do{ const float rm=rowmax(P0,P1); resc=false; \
    { const float dl=rm; mhat=fadd_s(mhat,dl); \
      _Pragma("unroll") for(int r=0;r<16;++r){P0[r]=fsub_s(P0[r],dl);P1[r]=fsub_s(P1[r],dl);} } \
    _Pragma("unroll") for(int r=0;r<16;++r)P0[r]=__builtin_amdgcn_exp2f(P0[r]); }while(0)
  #define RESC() do{ if(resc){ asm volatile("s_waitcnt lgkmcnt(0)":::"memory"); \
      _Pragma("unroll") for(int d_=0;d_<4;++d_) _Pragma("unroll") for(int r=0;r<16;++r)o[d_][r]*=wsf[crow(r,hi)]; } }while(0)
  f32x16 pA0,pA1,pB0,pB1;
  int sl_prev=0,sl_cur=0,sl_next=SLOTB;
  #define ROT() do{sl_prev=sl_cur;sl_cur=sl_next;sl_next=(sl_next==(NSLOT-1)*SLOTB)?0:sl_next+SLOTB;}while(0)
  DMA_K(2,2*SLOTB);
  WAIT_BAR(4);
  { f32x16 c0_,c1_; CINIT(c0_,c1_,0); qkt(pA0,pA1,Kbase,qr,c0_,c1_,r32,hi); } asm volatile("s_nop 15\n\ts_nop 7":"+v"(pA0),"+v"(pA1));CMASK(pA0,pA1,0);
  START(pA0,pA1);
  _Pragma("unroll") for(int r=0;r<16;++r)pA1[r]=__builtin_amdgcn_exp2f(pA1[r]);
  WAIT_BAR(0);
  DMA_K(3,0);DMA_V(1,SLOTB);
  ROT();
  kload8(kf,kp0+sl_cur);
  WAIT_BAR(3);
  s16x4 vlo[8],vhi[8]; u32x4 pw0,pw1,pw2,pw3;
  #define PKW(P,B) cvtpk_s(P[B],P[B+1])
  #define PAF(k) __builtin_bit_cast(bf16x8,pw##k)
  #define VFR(i) (bf16x8){vlo[i][0],vlo[i][1],vlo[i][2],vlo[i][3],vhi[i][0],vhi[i][1],vhi[i][2],vhi[i][3]}
  #define PIN(x) asm volatile("":"+v"(x))
  #define MX3(a,b,c) __builtin_fmaxf(__builtin_fmaxf((a),(b)),(c))
  #define GAPA(MF,A0,A1,A2,A3,W0,W1,PW) do{ MF; sacc+=A0; sacc+=A1; sacc+=A2; sacc+=A3; PIN(sacc); W0; W1; PIN(PW); SBAR(); }while(0)
  #define EX(v) __builtin_amdgcn_exp2f(v)
  #define GAPB(MF,X,B) do{ MF; X[B]=EX(X[B]); X[B+1]=EX(X[B+1]); PIN(X); SBAR(); }while(0)
  #define VRD2(sl,fr) do{ vlo[sl]=vtr(vp_+(((fr)>>2)*4096+((fr)&3)*1024)); vhi[sl]=vtr(vp_+(((fr)>>2)*4096+((fr)&3)*1024+512)); SBAR(); }while(0)
  #define VRD(i) do{ vlo[i]=vtr(vp_+(((i)>>2)*4096+((i)&3)*1024)); vhi[i]=vtr(vp_+(((i)>>2)*4096+((i)&3)*1024+512)); }while(0)
  #define KRD(G,j) do{ if(G){ kload2(kf,kp0+sl_next,j); SBAR(); } }while(0)
  #define STEP(C0,C1,P0,P1,t,GK,GV,GL) do{ CINIT0(C0,t); SBAR(); \
    const lds_cptr vp_=vp0+2*sl_prev; \
    VRD(0); SBAR(); float sacc=(P0[0]+P0[1]); \
    GAPA(C0=__builtin_amdgcn_mfma_f32_32x32x16_bf16(kf[0],qr[0],C0,0,0,0), P0[2],P0[3],P0[4],P0[5],     pw0[0]=PKW(P0,0), pw0[1]=PKW(P0,2), pw0); \
    CINIT1(C1,t); VRD(4); SBAR(); GAPA(C1=__builtin_amdgcn_mfma_f32_32x32x16_bf16(kf[1],qr[0],C1,0,0,0), P0[6],P0[7],P0[8],P0[9],     pw0[2]=PKW(P0,4), pw0[3]=PKW(P0,6), pw0); \
    VRD(1); SBAR(); GAPA(C0=__builtin_amdgcn_mfma_f32_32x32x16_bf16(kf[2],qr[1],C0,0,0,0),   P0[10],P0[11],P0[12],P0[13], pw1[0]=PKW(P0,8), pw1[1]=PKW(P0,10), pw1); \
    VRD(5); SBAR(); GAPA(C1=__builtin_amdgcn_mfma_f32_32x32x16_bf16(kf[3],qr[1],C1,0,0,0),   P0[14],P0[15],P1[0],P1[1],   pw1[2]=PKW(P0,12),pw1[3]=PKW(P0,14), pw1); \
    VRD(2); SBAR(); GAPA(C0=__builtin_amdgcn_mfma_f32_32x32x16_bf16(kf[4],qr[2],C0,0,0,0),   P1[2],P1[3],P1[4],P1[5],     pw2[0]=PKW(P1,0), pw2[1]=PKW(P1,2), pw2); \
    VRD(6); SBAR(); GAPA(C1=__builtin_amdgcn_mfma_f32_32x32x16_bf16(kf[5],qr[2],C1,0,0,0),   P1[6],P1[7],P1[8],P1[9],     pw2[2]=PKW(P1,4), pw2[3]=PKW(P1,6), pw2); \
    VRD(3); SBAR(); GAPA(C0=__builtin_amdgcn_mfma_f32_32x32x16_bf16(kf[6],qr[3],C0,0,0,0),   P1[10],P1[11],P1[12],P1[13], pw3[0]=PKW(P1,8), pw3[1]=PKW(P1,10), pw3); \
    VRD(7); SBAR(); GAPA(C1=__builtin_amdgcn_mfma_f32_32x32x16_bf16(kf[7],qr[3],C1,0,0,0),   P1[14],P1[15],0.f,0.f,       pw3[2]=PKW(P1,12),pw3[3]=PKW(P1,14), pw3); \
    l_reg+=sacc; \
    if(GK){DMA_K((t)+3,sl_cur);} if(GV){DMA_V((t)+1,sl_next);} \
    CMASK(C0,C1,t); \
    { float a=MX3(C0[0],C0[1],C1[0]),b=MX3(C0[2],C0[3],C1[1]); a=MX3(a,C1[2],C1[3]); \
      _Pragma("unroll") for(int r=4;r<16;r+=4){a=MX3(a,C0[r],C0[r+1]);b=MX3(b,C0[r+2],C0[r+3]);a=MX3(a,C1[r],C1[r+1]);b=MX3(b,C1[r+2],C1[r+3]);} \
      float rm=__builtin_fmaxf(a,b); { auto rr=__builtin_amdgcn_permlane32_swap(__float_as_uint(rm),__float_as_uint(rm),false,false); rm=__builtin_fmaxf(__uint_as_float(rr[0]),__uint_as_float(rr[1])); } \
      resc=false; \
      if(__builtin_expect(__any(rm>(float)THRL),0)){ const float dl=__builtin_fmaxf(rm,0.f); mhat+=dl; \
        _Pragma("unroll") for(int r=0;r<16;++r){C0[r]-=dl;C1[r]-=dl;} \
        const float f=__builtin_amdgcn_exp2f(-dl); l_reg*=f; if(hi==0)wsf[r32]=f; resc=true; } } \
    SBAR(); \
    GAPB(o[0]=__builtin_amdgcn_mfma_f32_32x32x16_bf16(PAF(0),VFR(0),o[0],0,0,0), C0,0);  VRD2(0,8); \
    GAPB(o[1]=__builtin_amdgcn_mfma_f32_32x32x16_bf16(PAF(0),VFR(4),o[1],0,0,0), C0,2);  VRD2(4,12); \
    KRD(GL,0); GAPB(o[0]=__builtin_amdgcn_mfma_f32_32x32x16_bf16(PAF(1),VFR(1),o[0],0,0,0), C0,4);  VRD2(1,9); \
    KRD(GL,1); GAPB(o[1]=__builtin_amdgcn_mfma_f32_32x32x16_bf16(PAF(1),VFR(5),o[1],0,0,0), C0,6);  VRD2(5,13); \
    KRD(GL,2); GAPB(o[0]=__builtin_amdgcn_mfma_f32_32x32x16_bf16(PAF(2),VFR(2),o[0],0,0,0), C0,8);  VRD2(2,10); \
    KRD(GL,3); GAPB(o[1]=__builtin_amdgcn_mfma_f32_32x32x16_bf16(PAF(2),VFR(6),o[1],0,0,0), C0,10); VRD2(6,14); \
    GAPB(o[0]=__builtin_amdgcn_mfma_f32_32x32x16_bf16(PAF(3),VFR(3),o[0],0,0,0), C0,12); VRD2(3,11); \
    GAPB(o[1]=__builtin_amdgcn_mfma_f32_32x32x16_bf16(PAF(3),VFR(7),o[1],0,0,0), C0,14); VRD2(7,15); \
    GAPB(o[2]=__builtin_amdgcn_mfma_f32_32x32x16_bf16(PAF(0),VFR(0),o[2],0,0,0), C1,0); \
    GAPB(o[3]=__builtin_amdgcn_mfma_f32_32x32x16_bf16(PAF(0),VFR(4),o[3],0,0,0), C1,2); \
    GAPB(o[2]=__builtin_amdgcn_mfma_f32_32x32x16_bf16(PAF(1),VFR(1),o[2],0,0,0), C1,4); \
    GAPB(o[3]=__builtin_amdgcn_mfma_f32_32x32x16_bf16(PAF(1),VFR(5),o[3],0,0,0), C1,6); \
    GAPB(o[2]=__builtin_amdgcn_mfma_f32_32x32x16_bf16(PAF(2),VFR(2),o[2],0,0,0), C1,8); \
    GAPB(o[3]=__builtin_amdgcn_mfma_f32_32x32x16_bf16(PAF(2),VFR(6),o[3],0,0,0), C1,10); \
    GAPB(o[2]=__builtin_amdgcn_mfma_f32_32x32x16_bf16(PAF(3),VFR(3),o[2],0,0,0), C1,12); \
    GAPB(o[3]=__builtin_amdgcn_mfma_f32_32x32x16_bf16(PAF(3),VFR(7),o[3],0,0,0), C1,14); \
    }while(0)
  int t=1;
  #undef CMASK
  #define CMASK(P0,P1,t) do{}while(0)
  for(;t+5<NT;t+=2){
    STEP(pB0,pB1,pA0,pA1,t,true,true,true);     WAIT_BAR(3); RESC(); ROT();
    STEP(pA0,pA1,pB0,pB1,t+1,true,true,true);   WAIT_BAR(3); RESC(); ROT();
  }
  #undef CMASK
  #define CMASK(P0,P1,t) do{int jb_=(t)-(NT-4); if(jb_>=0)cmask(P0,P1,jb_,qrel,hi);}while(0)
  #define ENDW(tt) do{ if((tt)+3<NT){WAIT_BAR(3);} else if((tt)+2<NT){WAIT_BAR(2);} else {WAIT_BAR(0);} }while(0)
  for(;t+1<NT;t+=2){
    STEP(pB0,pB1,pA0,pA1,t,(t+3<NT),(t+1<NT),(t+1<NT));       ENDW(t);   RESC(); ROT();
    STEP(pA0,pA1,pB0,pB1,t+1,(t+4<NT),(t+2<NT),(t+2<NT));     ENDW(t+1); RESC(); ROT();
  }
  STEP(pB0,pB1,pA0,pA1,NT-1,false,false,false); RESC();
  { float sacc=pB0[0]+pB0[1]; _Pragma("unroll") for(int r=2;r<16;++r)sacc+=pB0[r]; _Pragma("unroll") for(int r=0;r<16;++r)sacc+=pB1[r]; l_reg+=sacc;
    pw0=(u32x4){PKW(pB0,0),PKW(pB0,2),PKW(pB0,4),PKW(pB0,6)};pw1=(u32x4){PKW(pB0,8),PKW(pB0,10),PKW(pB0,12),PKW(pB0,14)};pw2=(u32x4){PKW(pB1,0),PKW(pB1,2),PKW(pB1,4),PKW(pB1,6)};pw3=(u32x4){PKW(pB1,8),PKW(pB1,10),PKW(pB1,12),PKW(pB1,14)};
    SBAR(); pv(o,vb0+2*sl_cur,PAF(0),PAF(1),PAF(2),PAF(3)); }
  #undef PKW
  #undef PAF
  #undef VFR
  #undef PIN
  #undef MX3
  #undef GAPA
  #undef GAPB
  #undef EX
  #undef VRD
  #undef VRD2
  #undef KRD
  #undef STEP
  #undef ENDW
  {auto rr=__builtin_amdgcn_permlane32_swap(__float_as_uint(l_reg),__float_as_uint(l_reg),false,false);l_reg=__uint_as_float(rr[0])+__uint_as_float(rr[1]);}
  if(hi==0)wsf[32+r32]=l_reg;asm volatile("s_waitcnt lgkmcnt(0)":::"memory");
  float rli[16];
  #pragma unroll
  for(int r=0;r<16;++r)rli[r]=__builtin_amdgcn_rcpf(wsf[32+crow(r,hi)]);
  bf16*Ow=O+(rowbase+q0+wid*QBLK)*OPITCH+ocol;
  { bf16*stg=(bf16*)(shm+LDS_OST)+wid*2048;
    int ln2_=lane; asm volatile("":"+v"(ln2_));
    #pragma unroll
    for(int hf=0;hf<2;++hf){
      #pragma unroll
      for(int r=0;r<16;++r){const int orow=crow(r,hi);
        #pragma unroll
        for(int d0=0;d0<2;++d0)stg[orow*64+d0*32+r32]=__float2bfloat16(o[2*hf+d0][r]*rli[r]);}
      asm volatile("s_waitcnt lgkmcnt(0)":::"memory");
      #pragma unroll
      for(int i=0;i<4;++i){const int row=i*8+(ln2_>>3),ch=ln2_&7; const u32x4 v=*(const u32x4*)(stg+row*64+ch*8); ATTN_STORE16(Ow+(long)row*OPITCH+hf*64+ch*8,v);}
      asm volatile("s_waitcnt lgkmcnt(0)":::"memory"); } }
  asm volatile("s_waitcnt lgkmcnt(0)\n\ts_barrier":::"memory");
  #undef DMA_K
  #undef DMA_V
  #undef CMASK
  #undef CINIT
  #undef CINIT0
  #undef CINIT1
  #undef START
  #undef RESC
  #undef ROT
}
constexpr int ATTN_LDS_BYTES=LDS_BYTES;
struct AttnTensors { const bf16* Q; const bf16* K; const bf16* V; bf16* O; };
template<int THRL=8> __device__ __forceinline__ void attn_phase(char*lds,const AttnTensors&T,unsigned*qw,volatile __attribute__((address_space(3))) unsigned*qs){
  for(;;){
    if(threadIdx.x==0) qs[0]=__hip_atomic_fetch_add(qw,1u,__ATOMIC_RELAXED,__HIP_MEMORY_SCOPE_AGENT);
    __syncthreads();
    const int idx=__builtin_amdgcn_readfirstlane((int)qs[0]);
    __syncthreads();
    if(idx>=2048)break;
    const int c=idx&1,b=(idx>>1)&7,h=7-((idx>>4)&7),qb=15-(idx>>7);
    const float sl2=__uint_as_float(__builtin_amdgcn_readfirstlane(__float_as_uint(__builtin_amdgcn_exp2f(-(float)(h+1))*1.4426950408889634f)));
    const int nfar=(h==0)?6:(h==1)?10:(h==2)?20:(h==3)?38:64;
    attn_unit<THRL>(b,2*h+c,2*h,c*1024+h*128,qb,nfar,sl2,T.Q,T.K,T.V,T.O,lds);
  }
}
#undef SBAR
#undef WAIT_BAR
}
#define GAS __attribute__((address_space(1)))
#define LAS __attribute__((address_space(3)))
typedef unsigned short bf16;
typedef unsigned v4u __attribute__((ext_vector_type(4)));
typedef float f32x4 __attribute__((ext_vector_type(4)));
typedef short bf16x8 __attribute__((ext_vector_type(8)));
typedef GAS unsigned gu32;
typedef GAS unsigned long long gu64;
#define RLX_AGENT __ATOMIC_RELAXED, __HIP_MEMORY_SCOPE_AGENT
#define LDS_WAIT() asm volatile("s_waitcnt lgkmcnt(0)" ::: "memory")
#define VM_WAIT() asm volatile("s_waitcnt vmcnt(0)" ::: "memory")
__device__ __forceinline__ unsigned long long rt() { return __builtin_amdgcn_s_memrealtime(); }
__device__ __forceinline__ unsigned f2bf(float f) { unsigned u = __builtin_bit_cast(unsigned, f); return (u + 0x7fffu + ((u >> 16) & 1u)) >> 16; }
__device__ __forceinline__ unsigned pk2(float lo, float hi) { return f2bf(lo) | (f2bf(hi) << 16); }

#define XB_TMO      128
#define XB_XCNT(j)  (256  + 64 * (j))
#define XB_XSUB(j)  (1280 + 64 * (j))
#define XB_XGEN(j)  (2304 + 64 * (j))
#define XB_TOP      3328
#define XB_TOPGEN   3392
#define XCD_BAR_WORDS 3456
#define XB_SPIN_CAP (1u << 18)

__device__ __forceinline__ unsigned xb_ld(unsigned* p)              { return __hip_atomic_load(p, __ATOMIC_RELAXED, __HIP_MEMORY_SCOPE_AGENT); }
__device__ __forceinline__ unsigned xb_add(unsigned* p, unsigned v) { return __hip_atomic_fetch_add(p, v, __ATOMIC_RELAXED, __HIP_MEMORY_SCOPE_AGENT); }
__device__ __forceinline__ unsigned xb_xcc_id() { return (unsigned)__builtin_amdgcn_s_getreg((3 << 11) | 20) & 0xFu; }
#define XB_SPIN(cond, bar) do { unsigned _sp = 0; while (cond) { __builtin_amdgcn_s_sleep(1); \
    if ((++_sp & 255u) == 0u) { if (xb_ld(&(bar)[XB_TMO])) break; if (_sp > XB_SPIN_CAP) { atomicAdd(&(bar)[XB_TMO], 1u); break; } } } } while (0)

struct XcdBarrier {
    unsigned* bar; unsigned x;
    volatile LAS unsigned* st;
};

__device__ __forceinline__ XcdBarrier xcd_barrier_post(unsigned* bar, volatile LAS unsigned* st) {
    XcdBarrier b; b.bar = bar; b.x = xb_xcc_id(); b.st = st;
    if (threadIdx.x == 0) (void)xb_add(&bar[XB_XCNT(b.x)], 1u);
    return b;
}
__device__ __forceinline__ void xcd_barrier_complete(unsigned* bar, unsigned x, unsigned& nloc, unsigned& nx) {
    const unsigned G = gridDim.x * gridDim.y * gridDim.z;
    unsigned sum, cnt, mine, sp = 0u;
    for (;;) {
        sum = 0u; cnt = 0u; mine = 0u;
#pragma unroll
        for (unsigned j = 0; j < 16; ++j) { const unsigned c = xb_ld(&bar[XB_XCNT(j)]); sum += c; cnt += (c > 0u) ? 1u : 0u; mine = (j == x) ? c : mine; }
        if (sum == G) break;
        __builtin_amdgcn_s_sleep(1);
        if ((++sp & 255u) == 0u) { if (xb_ld(&bar[XB_TMO])) break; if (sp > XB_SPIN_CAP) { atomicAdd(&bar[XB_TMO], 1u); break; } }
    }
    nloc = mine > 0u ? mine : 1u; nx = cnt > 0u ? cnt : 1u;
}

__device__ __forceinline__ void xcd_barrier(const XcdBarrier& b) {
    asm volatile("s_waitcnt vmcnt(0)" ::: "memory");
    __syncthreads();
    if (threadIdx.x == 0) {
        unsigned* bar = b.bar;
        __builtin_amdgcn_s_waitcnt(0);
        unsigned nloc = b.st[0], nx = b.st[1];
        if (nloc == 0u) { xcd_barrier_complete(bar, b.x, nloc, nx); b.st[0] = nloc; b.st[1] = nx; }
        const unsigned old = xb_add(&bar[XB_XSUB(b.x)], 1u);
        const unsigned gen = old / nloc;
        if (old + 1u == (gen + 1u) * nloc) {
            __builtin_amdgcn_fence(__ATOMIC_RELEASE, "agent");
            asm volatile("s_waitcnt vmcnt(0)" ::: "memory");
            const unsigned og = xb_add(&bar[XB_TOP], 1u);
            const unsigned tg = og / nx;
            if (og + 1u == (tg + 1u) * nx) xb_add(&bar[XB_TOPGEN], 1u);
            else XB_SPIN(xb_ld(&bar[XB_TOPGEN]) == tg, bar);
            __builtin_amdgcn_fence(__ATOMIC_ACQUIRE, "agent");
            xb_add(&bar[XB_XGEN(b.x)], 1u);
            asm volatile("s_waitcnt vmcnt(0)" ::: "memory");
        } else {
            XB_SPIN(xb_ld(&bar[XB_XGEN(b.x)]) == gen, bar);
            __builtin_amdgcn_fence(__ATOMIC_ACQUIRE, "agent");
            asm volatile("s_waitcnt vmcnt(0)" ::: "memory");
        }
    }
    __syncthreads();
}
constexpr int NWAVES = 8, NTHREADS = 512;
constexpr int BATCH = 8, SEQ = 4096, DM = 1024, NTOK = BATCH * SEQ, DEPTH = 4;
constexpr int DIN = 8208, NPROJ = 8192;
constexpr int NEXP = 32, DEXP = 512, LISTCAP = 32768, MOE_MAXT = 288;
constexpr float LN_EPS = 1e-5f, DN_ALPHA = 1.6817928305074292f;
constexpr size_t MiB = 1u << 20;
constexpr size_t WS_CTL = 0, CTL_ZERO_BYTES = 1 * MiB;
constexpr size_t WS_ADA = 1 * MiB;
constexpr size_t WS_ABWT = 2 * MiB;
constexpr size_t WS_RWT = 2 * MiB + 256 * 1024;
constexpr size_t WS_TOKINFO = 3 * MiB;
constexpr size_t WS_LIST = 4 * MiB;
constexpr size_t WS_SSQ = 8 * MiB;
constexpr size_t WS_PRM = 16 * MiB;
constexpr int PO_BGATES = 0, PO_WALPHA = 8192, PO_BALPHA = 40960, PO_LQ1 = 43008, PO_LK1 = 43264, PO_LQ2 = 43520, PO_LK2 = 43776, PO_DIFFG = 44032, PO_GLAG = 44544,
              PO_LN1G = 45568, PO_LN1B = 49664, PO_BRG = 53760, PO_BRE = 53776, PO_LN2G = 53904, PO_LN2B = 58000, PO_END = 62096;
constexpr size_t WS_WIN = 32 * MiB;
constexpr size_t WS_WBA = 96 * MiB, WS_WBB = 104 * MiB, WS_WOUT = 112 * MiB;
constexpr size_t WS_W1 = 120 * MiB;
constexpr size_t WS_WD = 376 * MiB;
constexpr size_t WS_U = 504 * MiB;
constexpr size_t WS_QB = 568 * MiB, WS_KB = 632 * MiB, WS_VB = 696 * MiB;
constexpr size_t WS_GQ = 760 * MiB, WS_GK = 792 * MiB;
constexpr size_t WS_GV = 824 * MiB, WS_SG = 888 * MiB;
constexpr size_t WS_GT = 952 * MiB;
constexpr size_t WS_LA = 1080 * MiB;
constexpr size_t WS_END = 1144 * MiB;
constexpr size_t WS_OB = WS_U;
constexpr size_t WS_OP = WS_GQ;
constexpr size_t WS_OA2 = WS_QB, WS_OB2 = WS_KB;
constexpr size_t WS_TMP = WS_VB, WS_MIX = WS_GQ;
constexpr size_t WS_H = WS_QB;
constexpr size_t WS_YB = WS_QB + 72 * MiB;
constexpr int CW_ATQ = 32768;
constexpr int CW_TMO = 0, CW_CODE = 1, CW_BAR = 4096, CW_CNT = 8192;
constexpr int RING_OFF = 0, RING_BYTES = 131072;
constexpr int LDSCTL_OFF = RING_BYTES, MISC_OFF = LDSCTL_OFF + 320;
constexpr int TAB_CNT = RING_BYTES + 512, TAB_BASE = RING_BYTES + 640, TAB_IDX = RING_BYTES + 1024, IDX_UNITS = 8;
constexpr int LDS_BYTES = 147456;
static_assert(TAB_IDX + IDX_UNITS * 256 * 4 <= LDS_BYTES, "LDS map");
struct Frame {
    LAS unsigned char* lds;
    gu32* ctl;
    int tid, lane, wave, vcu, G;
    float* out; unsigned char* ws; const float* prm;
    float* xst; bf16* Ubuf; float* LAbuf; int dry;
};
enum { I_X = 0, I_C, I_WADA, I_BADA, I_WIN, I_BGATES, I_WALPHA, I_BALPHA, I_LQ1, I_LK1, I_LQ2, I_LK2, I_DIFFG, I_GLAG, I_WBA, I_WBB, I_WOUT, I_LN1G, I_LN1B,
       I_WRG, I_BRG, I_WRE, I_BRE, I_WGE, I_WUE, I_WDE, I_LN2G, I_LN2B };
__device__ __forceinline__ float wave_sum(float v) {
#pragma unroll
    for (int o = 1; o < 64; o <<= 1) v += __shfl_xor(v, o);
    return v;
}
__device__ __forceinline__ float siluf_(float x) { return x * __builtin_amdgcn_rcpf(1.0f + __expf(-x)); }
__device__ __forceinline__ float bflo(unsigned w) { return __uint_as_float(w << 16); }
__device__ __forceinline__ float bfhi(unsigned w) { return __uint_as_float(w & 0xffff0000u); }

__device__ __forceinline__ void p0_ada(Frame& F, const float* c, const float* wada, const float* bada) {
    LAS float* COND = (LAS float*)(F.lds);
    LAS float* PART = (LAS float*)(F.lds + 32768);
    float* ADA = (float*)(F.ws + WS_ADA);
    for (int i = F.tid; i < 8192; i += NTHREADS) COND[i] = siluf_(c[i]);
    __syncthreads();
    for (int cg = (int)blockIdx.x; cg < 256; cg += F.G) {
        const int l = cg >> 6, j0 = (cg & 63) * 96;
        const int col4 = F.lane % 24, ksub = F.lane / 24;
        f32x4 acc[8];
#pragma unroll
        for (int b = 0; b < 8; ++b) acc[b] = (f32x4){0.f, 0.f, 0.f, 0.f};
        if (ksub < 2) {
            const float* wp = wada + ((size_t)l * 1024 + (size_t)(F.wave * 128 + ksub)) * 6144 + j0 + 4 * col4;
#pragma unroll 8
            for (int kk = 0; kk < 64; ++kk) {
                const f32x4 wv = *(const GAS f32x4*)(wp + (size_t)kk * 2 * 6144); const int k = F.wave * 128 + 2 * kk + ksub;
#pragma unroll
                for (int b = 0; b < 8; ++b) acc[b] += wv * COND[b * 1024 + k];
            }
#pragma unroll
            for (int b = 0; b < 8; ++b) *(LAS f32x4*)(PART + ((F.wave * 2 + ksub) * 8 + b) * 96 + 4 * col4) = acc[b];
        }
        __syncthreads();
        for (int idx = F.tid; idx < 768; idx += NTHREADS) { const int b = idx / 96, col = idx % 96; float s = 0.f;
#pragma unroll
            for (int p = 0; p < 16; ++p) s += PART[(p * 8 + b) * 96 + col];
            ADA[((size_t)l * 8 + b) * 6144 + j0 + col] = s + bada[l * 6144 + j0 + col]; }
        __syncthreads();
    }
}
struct RmIdent { __device__ __forceinline__ int operator()(int n) const { return n; } };
struct RmWin { __device__ __forceinline__ int operator()(int n) const { return n < 6144 ? n : (n < 6160 ? -1 : n - 16); } };
struct RmGateUp { int up; __device__ __forceinline__ int operator()(int n) const { return (n >> 7) * 256 + up * 128 + (n & 127); } };
template <class RowMap>
__device__ __forceinline__ void p0_transpose_item(const float* W, int K, int N, bf16* WT, const RowMap rm, LAS float* scr, int kb, int nb, int lane) {
    const int k0 = 64 * kb, n0 = 32 * nb; const int nl = n0 + (lane & 31);
#pragma unroll 8
    for (int i = 0; i < 32; ++i) { const int kk = 2 * i + (lane >> 5); scr[kk * 33 + (lane & 31)] = (nl < N) ? W[(size_t)(k0 + kk) * N + nl] : 0.f; }
    LDS_WAIT(); asm volatile("" ::: "memory");
    const int c = lane & 7;
#pragma unroll
    for (int j = 0; j < 4; ++j) { const int nn = (lane >> 3) + 8 * j, n = n0 + nn; const LAS float* s = scr + (8 * c) * 33 + nn;
        v4u o; o.x = pk2(s[0 * 33], s[1 * 33]); o.y = pk2(s[2 * 33], s[3 * 33]); o.z = pk2(s[4 * 33], s[5 * 33]); o.w = pk2(s[6 * 33], s[7 * 33]);
        const int r = (n < N) ? rm(n) : -1;
        if (r >= 0) *(GAS v4u*)(WT + (size_t)r * K + k0 + 8 * c) = o; }
    LDS_WAIT(); asm volatile("" ::: "memory");
}
struct SmallPrm { const float *bgates, *walpha, *balpha, *lq1, *lk1, *lq2, *lk2, *diffg, *glag, *ln1g, *ln1b, *brg, *bre, *ln2g, *ln2b; };
__device__ __forceinline__ void p0_copy(float* dst, const float* src, int n, int gt, int NGT) { for (int i = gt; i < n; i += NGT) dst[i] = src[i]; }
__device__ __forceinline__ void p0_weights(Frame& F, const float* win, const float* wba, const float* wbb, const float* wout, const float* wge, const float* wue, const float* wde, const float* wrg, const float* wre, const SmallPrm sp) {
    LAS float* scr = (LAS float*)(F.lds + RING_OFF + F.wave * 16384);
    const int gw = F.vcu * NWAVES + F.wave, NGW = F.G * NWAVES;
    constexpr int I_IN = 4 * 16 * 257, I_SQ = 12 * 16 * 32, I_E = 128 * 16 * 16, I_D = 128 * 8 * 32;
    constexpr int NITEMS = I_IN + I_SQ + 2 * I_E + I_D;
    for (int it = gw; it < NITEMS; it += NGW) {
        int r = it;
        if (r < I_IN) { const int l = r / 4112, q = r % 4112;
            p0_transpose_item(win + (size_t)l * 1024 * DIN, 1024, DIN, (bf16*)(F.ws + WS_WIN) + (size_t)l * NPROJ * 1024, RmWin{}, scr, q / 257, q % 257, F.lane); continue; }
        r -= I_IN;
        if (r < I_SQ) { const int mat = r / 512, q = r % 512, which = mat >> 2, l = mat & 3;
            const float* W = (which == 0 ? wba : (which == 1 ? wbb : wout)) + (size_t)l * 1024 * 1024;
            bf16* WT = (bf16*)(F.ws + (which == 0 ? WS_WBA : (which == 1 ? WS_WBB : WS_WOUT))) + (size_t)l * 1024 * 1024;
            p0_transpose_item(W, 1024, 1024, WT, RmIdent{}, scr, q / 32, q % 32, F.lane); continue; }
        r -= I_SQ;
        if (r < 2 * I_E) { const int up = r >= I_E ? 1 : 0; if (up) r -= I_E; const int me = r / 256, q = r % 256;
            p0_transpose_item((up ? wue : wge) + (size_t)me * 1024 * 512, 1024, 512, (bf16*)(F.ws + WS_W1) + (size_t)me * 1024 * 1024, RmGateUp{up}, scr, q / 16, q % 16, F.lane); continue; }
        r -= 2 * I_E;
        { const int me = r / 256, q = r % 256;
          p0_transpose_item(wde + (size_t)me * 512 * 1024, 512, 1024, (bf16*)(F.ws + WS_WD) + (size_t)me * 1024 * 512, RmIdent{}, scr, q / 32, q % 32, F.lane); }
    }
    const int gt = F.vcu * NTHREADS + F.tid, NGT = F.G * NTHREADS;
    float* ABWT = (float*)(F.ws + WS_ABWT); float* RWT = (float*)(F.ws + WS_RWT);
    { float* P = (float*)(F.ws + WS_PRM);
      p0_copy(P + PO_BGATES, sp.bgates, 8192, gt, NGT); p0_copy(P + PO_WALPHA, sp.walpha, 32768, gt, NGT); p0_copy(P + PO_BALPHA, sp.balpha, 2048, gt, NGT);
      p0_copy(P + PO_LQ1, sp.lq1, 256, gt, NGT); p0_copy(P + PO_LK1, sp.lk1, 256, gt, NGT); p0_copy(P + PO_LQ2, sp.lq2, 256, gt, NGT); p0_copy(P + PO_LK2, sp.lk2, 256, gt, NGT);
      p0_copy(P + PO_DIFFG, sp.diffg, 512, gt, NGT); p0_copy(P + PO_GLAG, sp.glag, 1024, gt, NGT); p0_copy(P + PO_LN1G, sp.ln1g, 4096, gt, NGT); p0_copy(P + PO_LN1B, sp.ln1b, 4096, gt, NGT);
      p0_copy(P + PO_BRG, sp.brg, 16, gt, NGT); p0_copy(P + PO_BRE, sp.bre, 128, gt, NGT); p0_copy(P + PO_LN2G, sp.ln2g, 4096, gt, NGT); p0_copy(P + PO_LN2B, sp.ln2b, 4096, gt, NGT); }
    for (int i = gt; i < 4 * 16 * 1024; i += NGT) { const int l = i >> 14, r = (i >> 10) & 15, k = i & 1023; ABWT[i] = win[((size_t)l * 1024 + k) * DIN + 6144 + r]; }
    for (int i = gt; i < 4 * 36 * 1024; i += NGT) { const int l = i / 36864, c = (i / 1024) % 36, k = i & 1023;
        RWT[i] = (c < 4) ? wrg[((size_t)l * 1024 + k) * 4 + c] : wre[((size_t)l * 1024 + k) * 32 + (c - 4)]; }
}

typedef f32x4 Row4[4];
__device__ __forceinline__ void row_load(Row4& v, const float* p, int lane) { const GAS f32x4* q = (const GAS f32x4*)p + lane;
#pragma unroll
    for (int j = 0; j < 4; ++j) v[j] = q[64 * j]; }
__device__ __forceinline__ void row_store(const Row4& v, float* p, int lane) { GAS f32x4* q = (GAS f32x4*)p + lane;
#pragma unroll
    for (int j = 0; j < 4; ++j) q[64 * j] = v[j]; }
__device__ __forceinline__ void row_standardize(Row4& v) {
    float s = 0.f;
#pragma unroll
    for (int j = 0; j < 4; ++j) s += (v[j].x + v[j].y) + (v[j].z + v[j].w);
    const float mean = wave_sum(s) * (1.f / DM); float s2 = 0.f;
#pragma unroll
    for (int j = 0; j < 4; ++j) { v[j] = v[j] - mean; s2 += (v[j].x * v[j].x + v[j].y * v[j].y) + (v[j].z * v[j].z + v[j].w * v[j].w); }
    const float rstd = 1.f / sqrtf(wave_sum(s2) * (1.f / DM) + LN_EPS);
#pragma unroll
    for (int j = 0; j < 4; ++j) v[j] = v[j] * rstd;
}
__device__ __forceinline__ void row_affine(Row4& v, const float* g, const float* b, bool one_plus, int lane) {
    asm volatile("" : "+s"(g), "+s"(b));
#pragma unroll
    for (int j = 0; j < 4; ++j) { f32x4 gv = *((const GAS f32x4*)g + lane + 64 * j); const f32x4 bv = *((const GAS f32x4*)b + lane + 64 * j); if (one_plus) gv = gv + 1.0f; v[j] = v[j] * gv + bv; }
}
__device__ __forceinline__ void row_store_bf16(const Row4& v, bf16* p, int lane) { GAS unsigned long long* o8 = (GAS unsigned long long*)p + lane;
#pragma unroll
    for (int j = 0; j < 4; ++j) o8[64 * j] = (unsigned long long)pk2(v[j].x, v[j].y) | ((unsigned long long)pk2(v[j].z, v[j].w) << 32); }
__device__ __forceinline__ int idx16(int L) { return ((L >> 5) & 1) + 2 * ((L >> 4) & 1) + 4 * ((L >> 3) & 1) + 8 * ((L >> 2) & 1) + 16 * ((L >> 1) & 1) + 32 * (L & 1); }
__device__ __forceinline__ int idx4(int L) { return ((L >> 5) & 1) + 2 * ((L >> 4) & 1) + 4 * ((L >> 3) & 1) + 8 * ((L >> 2) & 1); }
template <int NC>
__device__ __forceinline__ float rows4_proj(const Row4 (&u)[4], const float* wT, int lane) {
    float p[4 * NC]; f32x4 wa[4], wb[4];
    asm volatile("" : "+s"(wT));
    const GAS f32x4* wp = (const GAS f32x4*)wT + lane;
#define R4_LDW(DD_, CC_) do { _Pragma("unroll") for (int j = 0; j < 4; ++j) DD_[j] = wp[(CC_) * 256 + 64 * j]; } while (0)
#define R4_DOT(WW_, CC_) do { _Pragma("unroll") for (int r = 0; r < 4; ++r) { pg8::f32x2 s_ = (pg8::f32x2){0.f, 0.f}; _Pragma("unroll") for (int j = 0; j < 4; ++j) { \
        s_ = __builtin_elementwise_fma((pg8::f32x2){u[r][j].x, u[r][j].y}, (pg8::f32x2){WW_[j].x, WW_[j].y}, s_); s_ = __builtin_elementwise_fma((pg8::f32x2){u[r][j].z, u[r][j].w}, (pg8::f32x2){WW_[j].z, WW_[j].w}, s_); } \
        p[r * NC + (CC_)] = s_.x + s_.y; } } while (0)
    R4_LDW(wa, 0);
#pragma unroll
    for (int c = 0; c < NC; c += 2) {
        R4_LDW(wb, c + 1); __builtin_amdgcn_sched_barrier(0);
        R4_DOT(wa, c);
        if (c + 2 < NC) R4_LDW(wa, c + 2);
        __builtin_amdgcn_sched_barrier(0);
        R4_DOT(wb, c + 1);
        __builtin_amdgcn_sched_barrier(0);
    }
#undef R4_LDW
#undef R4_DOT
    int V = 4 * NC;
#pragma unroll
    for (int M = 32; M >= 1; M >>= 1) {
        if (V > 1) { const bool bit = (lane & M) != 0;
#pragma unroll
            for (int i = 0; i < 32; ++i) if (i < V / 2) { const float a = p[2 * i], b = p[2 * i + 1]; const float send = bit ? a : b; const float recv = __shfl_xor(send, M); p[i] = (bit ? b : a) + recv; }
            V >>= 1; }
        else p[0] += __shfl_xor(p[0], M);
    }
    return p[0];
}
constexpr int WAL_OFF = 16384, BAL_OFF = 16384 + 32768;
__device__ __forceinline__ void load_walpha(Frame& F, int l) {
    const float* walpha_all = F.prm + PO_WALPHA; const float* balpha_all = F.prm + PO_BALPHA;
    LAS float* WAL = (LAS float*)(F.lds + RING_OFF + WAL_OFF); LAS float* BAL = (LAS float*)(F.lds + RING_OFF + BAL_OFF);
    for (int i = F.tid; i < 8192; i += NTHREADS) WAL[i] = walpha_all[(size_t)l * 8192 + i];
    if (F.tid < 512) BAL[F.tid] = balpha_all[l * 512 + F.tid];
    __syncthreads();
}
__device__ __forceinline__ void rows4_mod1(Frame& F, Row4 (&x)[4], int m0, int l, LAS float* scr) {
    const int b = m0 >> 12; const float* ada = (const float*)(F.ws + WS_ADA) + ((size_t)l * 8 + b) * 6144;
#pragma unroll
    for (int r = 0; r < 4; ++r) { row_standardize(x[r]); row_affine(x[r], ada + 1024, ada, true, F.lane); row_store_bf16(x[r], F.Ubuf + (size_t)(m0 + r) * 1024, F.lane); __builtin_amdgcn_sched_barrier(0); }
    const float abv = rows4_proj<16>(x, (const float*)(F.ws + WS_ABWT) + (size_t)l * 16 * 1024, F.lane);
    __builtin_amdgcn_sched_barrier(0);
    scr[idx16(F.lane)] = abv;
    LDS_WAIT(); asm volatile("" ::: "memory");
    const LAS float* WAL = (const LAS float*)(F.lds + RING_OFF + WAL_OFF); const LAS float* BAL = (const LAS float*)(F.lds + RING_OFF + BAL_OFF); float* LA = F.LAbuf;
    asm volatile("" : "+s"(WAL), "+s"(BAL));
    float z[4][8];
#pragma unroll
    for (int i = 0; i < 8; ++i) { const float bb = BAL[F.lane + 64 * i];
#pragma unroll
        for (int r = 0; r < 4; ++r) z[r][i] = bb; }
#pragma unroll
    for (int rr = 0; rr < 16; ++rr) { float a[4];
#pragma unroll
        for (int r = 0; r < 4; ++r) a[r] = scr[r * 16 + rr];
#pragma unroll
        for (int i = 0; i < 8; ++i) { const float w_ = WAL[rr * 512 + F.lane + 64 * i];
#pragma unroll
            for (int r = 0; r < 4; ++r) z[r][i] += a[r] * w_; }
        __builtin_amdgcn_sched_barrier(0); }
#pragma unroll
    for (int r = 0; r < 4; ++r) {
#pragma unroll
        for (int i = 0; i < 8; ++i) { const float zz = z[r][i]; const float ls = fminf(zz, 0.f) - __logf(1.0f + __expf(-fabsf(zz)));
            LA[(size_t)(m0 + r) * 512 + F.lane + 64 * i] = __expf(ls * (1.0f / 16.0f)); }
        __builtin_amdgcn_sched_barrier(0); }
    LDS_WAIT(); asm volatile("" ::: "memory");
}
__device__ __forceinline__ void phase_r0(Frame& F, const float* xin) {
    LAS float* scr = (LAS float*)(F.lds + RING_OFF) + F.wave * 256;
    load_walpha(F, 0);
    for (int gi = F.vcu * NWAVES + F.wave; gi < NTOK / 4; gi += F.G * NWAVES) { const int m0 = 4 * gi; Row4 x[4];
#pragma unroll
        for (int r = 0; r < 4; ++r) { row_load(x[r], xin + (size_t)(m0 + r) * 1024, F.lane); row_store(x[r], F.xst + (size_t)(m0 + r) * 1024, F.lane); }
        __builtin_amdgcn_sched_barrier(0);
        rows4_mod1(F, x, m0, 0, scr); }
}
__device__ __forceinline__ void phase_r1(Frame& F, int l) {
    LAS float* scr = (LAS float*)(F.lds + RING_OFF) + F.wave * 256;
    const float* g1 = F.prm + PO_LN1G + l * 1024; const float* b1 = F.prm + PO_LN1B + l * 1024; const float* RWT = (const float*)(F.ws + WS_RWT) + (size_t)l * 36 * 1024;
    const float* brg = F.prm + PO_BRG + l * 4; const float* bre = F.prm + PO_BRE + l * 32;
    gu32* cnt = F.ctl + CW_CNT + l * 32 * 64 + (F.dry ? 16384 : 0); int* LIST = (int*)(F.ws + (F.dry ? WS_SSQ : WS_LIST)); unsigned* TI = (unsigned*)(F.ws + (F.dry ? WS_SSQ + 4 * MiB : WS_TOKINFO));
    for (int gi = F.vcu * NWAVES + F.wave; gi < NTOK / 4; gi += F.G * NWAVES) { const int m0 = 4 * gi, b = m0 >> 12; Row4 x[4];
        const float* ada = (const float*)(F.ws + WS_ADA) + ((size_t)l * 8 + b) * 6144;
#pragma unroll
        for (int r = 0; r < 4; ++r) { row_load(x[r], F.out + (size_t)(m0 + r) * 1024, F.lane); row_standardize(x[r]); row_affine(x[r], g1, b1, false, F.lane); row_store(x[r], F.xst + (size_t)(m0 + r) * 1024, F.lane);
            row_standardize(x[r]); row_affine(x[r], ada + 4 * 1024, ada + 3 * 1024, true, F.lane); row_store_bf16(x[r], F.Ubuf + (size_t)(m0 + r) * 1024, F.lane); __builtin_amdgcn_sched_barrier(0); }
        const float vg = rows4_proj<4>(x, RWT, F.lane);
        __builtin_amdgcn_sched_barrier(0);
        const float va = rows4_proj<16>(x, RWT + 4 * 1024, F.lane);
        __builtin_amdgcn_sched_barrier(0);
        const float vb = rows4_proj<16>(x, RWT + 20 * 1024, F.lane);
        __builtin_amdgcn_sched_barrier(0);
        { const int i4 = idx4(F.lane), i16 = idx16(F.lane); scr[(i4 >> 2) * 40 + (i4 & 3)] = vg; scr[(i16 >> 4) * 40 + 4 + (i16 & 15)] = va; scr[(i16 >> 4) * 40 + 20 + (i16 & 15)] = vb; }
        LDS_WAIT(); asm volatile("" ::: "memory");
        if (F.lane < 4) { const LAS float* s = scr + F.lane * 40; const int m = m0 + F.lane;
            float gl[4];
#pragma unroll
            for (int j = 0; j < 4; ++j) gl[j] = s[j] + brg[j];
            int gidx = 0; float gmax = gl[0];
#pragma unroll
            for (int j = 1; j < 4; ++j) if (gl[j] > gmax) { gmax = gl[j]; gidx = j; }
            float den = 0.f;
#pragma unroll
            for (int j = 0; j < 4; ++j) den += __expf(gl[j] - gmax);
            const float gw = 1.0f / den;
            float el[8];
#pragma unroll
            for (int j = 0; j < 8; ++j) el[j] = s[4 + gidx * 8 + j] + bre[gidx * 8 + j];
            int i0 = 0; float v0 = el[0];
#pragma unroll
            for (int j = 1; j < 8; ++j) if (el[j] > v0) { v0 = el[j]; i0 = j; }
            int i1 = -1; float v1 = -INFINITY;
#pragma unroll
            for (int j = 0; j < 8; ++j) if (j != i0 && el[j] > v1) { v1 = el[j]; i1 = j; }
            if (i1 < 0) i1 = (i0 + 1) & 7;
            const float ex = __expf(v1 - v0), inv = 1.0f / (1.0f + ex); const float w0 = inv * gw, w1 = ex * inv * gw;
            const int e0 = gidx * 8 + i0, e1 = gidx * 8 + i1;
            const unsigned p0 = __hip_atomic_fetch_add(cnt + e0 * 64, 1u, RLX_AGENT), p1 = __hip_atomic_fetch_add(cnt + e1 * 64, 1u, RLX_AGENT);
            LIST[(size_t)e0 * LISTCAP + p0] = m; LIST[(size_t)e1 * LISTCAP + p1] = m;
            *(GAS v4u*)(TI + (size_t)m * 8) = (v4u){(unsigned)e0, p0, (unsigned)e1, p1}; *(GAS v4u*)(TI + (size_t)m * 8 + 4) = (v4u){__float_as_uint(w0), __float_as_uint(w1), 0u, 0u};
        }
        LDS_WAIT(); asm volatile("" ::: "memory");
    }
}
__device__ __forceinline__ void moe_tables(Frame& F, int l) {
    LAS int* CNT = (LAS int*)(F.lds + TAB_CNT); LAS int* BASE = (LAS int*)(F.lds + TAB_BASE);
    if (F.tid < 32) CNT[F.tid] = (int)__hip_atomic_load(F.ctl + CW_CNT + (l * 32 + F.tid) * 64, RLX_AGENT);
    __syncthreads();
    if (F.tid == 0) { int a = 0; for (int e = 0; e < 32; ++e) { BASE[e] = a; a += (CNT[e] + 255) >> 8; } BASE[32] = a; }
    __syncthreads();
}
__device__ __forceinline__ void phase_r2(Frame& F, int l) {
    LAS float* scr = (LAS float*)(F.lds + RING_OFF) + F.wave * 256; const LAS int* BASE = (const LAS int*)(F.lds + TAB_BASE);
    if (l + 1 < DEPTH) load_walpha(F, l + 1);
    const float* g2 = F.prm + PO_LN2G + l * 1024; const float* b2 = F.prm + PO_LN2B + l * 1024; const unsigned* TI = (const unsigned*)(F.ws + WS_TOKINFO); const bf16* YB = (const bf16*)(F.ws + WS_YB);
    for (int gi = F.vcu * NWAVES + F.wave; gi < NTOK / 4; gi += F.G * NWAVES) { const int m0 = 4 * gi, b = m0 >> 12; Row4 x[4];
        const float* gate = (const float*)(F.ws + WS_ADA) + ((size_t)l * 8 + b) * 6144 + 5 * 1024;
#pragma unroll
        for (int r = 0; r < 4; ++r) { const int m = m0 + r;
            const v4u ta = *(const GAS v4u*)(TI + (size_t)m * 8); const v4u tb = *(const GAS v4u*)(TI + (size_t)m * 8 + 4);
            const size_t r0 = (size_t)BASE[ta.x & 31] * 256 + ta.y, r1 = (size_t)BASE[ta.z & 31] * 256 + ta.w; const float w0 = __uint_as_float(tb.x), w1 = __uint_as_float(tb.y);
            row_load(x[r], F.out + (size_t)m * 1024, F.lane);
            const GAS unsigned long long* y0 = (const GAS unsigned long long*)(YB + r0 * 1024) + F.lane; const GAS unsigned long long* y1 = (const GAS unsigned long long*)(YB + r1 * 1024) + F.lane;
#pragma unroll
            for (int j = 0; j < 4; ++j) { const unsigned long long a = y0[64 * j], c = y1[64 * j]; const f32x4 gv = *((const GAS f32x4*)gate + F.lane + 64 * j);
                const f32x4 ya = (f32x4){bflo((unsigned)a), bfhi((unsigned)a), bflo((unsigned)(a >> 32)), bfhi((unsigned)(a >> 32))};
                const f32x4 yc = (f32x4){bflo((unsigned)c), bfhi((unsigned)c), bflo((unsigned)(c >> 32)), bfhi((unsigned)(c >> 32))};
                x[r][j] = x[r][j] * DN_ALPHA + gv * (ya * w0 + yc * w1); }
            row_standardize(x[r]); row_affine(x[r], g2, b2, false, F.lane); row_store(x[r], F.xst + (size_t)m * 1024, F.lane); __builtin_amdgcn_sched_barrier(0); }
        if (l + 1 < DEPTH) rows4_mod1(F, x, m0, l + 1, scr);
    }
}
typedef short s16x8 __attribute__((ext_vector_type(8)));
#define MFMA16(a, b, c) __builtin_amdgcn_mfma_f32_16x16x32_bf16((a), (b), (c), 0, 0, 0)
__device__ __forceinline__ void phase_gla(Frame& F) {
    constexpr int QK0_OFF = 0, QK1_OFF = 16384, LAR_OFF = 32768, KLT_OFF = 65536, VT_OFF = 83968  , SBT_OFF = 93184, ATT_OFF = 101888, TOT_OFF = 111104, DEC_OFF = 113152;
    constexpr int QS = 272, TS = 144;
    LAS unsigned char* L = F.lds + RING_OFF;
    LAS float* TOT = (LAS float*)(L + TOT_OFF); LAS float* DEC = (LAS float*)(L + DEC_OFF);
    const int tid = F.tid, lane = F.lane, w = F.wave, k = tid & 127, tg = tid >> 7, fr = lane & 15, fq = lane >> 4;
    const bf16* GQ = (const bf16*)(F.ws + WS_GQ); const bf16* GK = (const bf16*)(F.ws + WS_GK); const bf16* GV = (const bf16*)(F.ws + WS_GV);
    const float* LA = (const float*)(F.ws + WS_LA); bf16* OB = (bf16*)(F.ws + WS_OB); float* SSQ = (float*)(F.ws + WS_SSQ);
    const int cr = tid >> 4, cc = tid & 15, lr = tid >> 5, lc = tid & 31;
    const int qk_dst = cr * 256 + ((cc ^ (cr & 15)) << 4);
    const int kc = k >> 3, kb2 = (k & 7) * 2;
    for (int item = F.vcu; item < 256; item += F.G) {
        const int s = item & 7, hg = (item >> 3) & 3, b = item >> 5; const size_t row0 = (size_t)b * SEQ;
        const bf16* gq = GQ + (row0 + cr) * 512 + hg * 128 + cc * 8; const bf16* gk = GK + (row0 + cr) * 512 + hg * 128 + cc * 8; const float* la = LA + (row0 + lr) * 512 + hg * 128 + lc * 4;
        const bf16* gv = GV + (row0 + (tid >> 3)) * 1024 + hg * 256 + s * 32 + (tid & 7) * 4;
        bf16* ob = OB + row0 * 1024 + hg * 256 + s * 32; float* ssq = SSQ + row0 * 64 + hg * 16 + s * 2;
        for (int i = tid; i < 8704 / 4; i += NTHREADS) ((LAS unsigned*)(L + SBT_OFF))[i] = 0u;
        f32x4 accS[2]; accS[0] = (f32x4){0.f, 0.f, 0.f, 0.f}; accS[1] = accS[0];
        v4u rq[2], rk[2]; f32x4 rl[4]; unsigned long long vr;
#define GLA_BAR() asm volatile("s_waitcnt lgkmcnt(0)\n\ts_barrier" ::: "memory")
#define GLA_LOAD(c_) do { const size_t o_ = (size_t)(c_) * 64; rq[0] = *(const GAS v4u*)(gq + o_ * 512); rq[1] = *(const GAS v4u*)(gq + (o_ + 32) * 512); rk[0] = *(const GAS v4u*)(gk + o_ * 512); rk[1] = *(const GAS v4u*)(gk + (o_ + 32) * 512); \
        _Pragma("unroll") for (int i_ = 0; i_ < 4; ++i_) rl[i_] = *(const GAS f32x4*)(la + (o_ + 16 * i_) * 512); vr = *(const GAS unsigned long long*)(gv + o_ * 1024); } while (0)
        GLA_LOAD(0);
        __syncthreads();
        for (int c = 0; c < 64; ++c) {
            *(LAS v4u*)(L + QK0_OFF + qk_dst) = rq[0]; *(LAS v4u*)(L + QK0_OFF + qk_dst + 8192) = rq[1]; *(LAS v4u*)(L + QK1_OFF + qk_dst) = rk[0]; *(LAS v4u*)(L + QK1_OFF + qk_dst + 8192) = rk[1];
#pragma unroll
            for (int i = 0; i < 4; ++i) *(LAS f32x4*)(L + LAR_OFF + (lr + 16 * i) * 512 + lc * 16) = rl[i];
            const int vto = VT_OFF + (c & 1) * 4608;
            { const int t = tid >> 3, w0 = (tid & 7) * 4;
#pragma unroll
              for (int i = 0; i < 4; ++i) *(LAS bf16*)(L + vto + (w0 + i) * TS + t * 2) = (bf16)((vr >> (16 * i)) & 0xffffu); }
            if (c + 1 < 64) GLA_LOAD(c + 1);
            GLA_BAR();
            float cs[16]; { float run = 1.f;
#pragma unroll
                for (int i = 0; i < 16; ++i) { run *= *(const LAS float*)(L + LAR_OFF + (tg * 16 + i) * 512 + k * 4); cs[i] = run; }
                TOT[tg * 128 + k] = run; }
            GLA_BAR();
            { float off = 1.f, last = 1.f;
#pragma unroll
              for (int g = 0; g < 4; ++g) { const float tv = TOT[g * 128 + k]; if (g < tg) off *= tv; last *= tv; }
              unsigned klw[8]; float klp = 0.f;
#pragma unroll
              for (int i = 0; i < 16; ++i) { const float e1 = cs[i] * off, e2 = __builtin_amdgcn_rcpf(e1), e3 = last * e2;
                  const int eo = (tg * 16 + i) * 256 + ((kc ^ i) << 4) + kb2;
                  const float qf = __uint_as_float((unsigned)(*(const LAS bf16*)(L + QK0_OFF + eo)) << 16), kf = __uint_as_float((unsigned)(*(const LAS bf16*)(L + QK1_OFF + eo)) << 16);
                  const unsigned qk = pg8::cvt_pk_bf16(qf * e1, kf * e2);
                  *(LAS bf16*)(L + QK0_OFF + eo) = (bf16)(qk & 0xffffu); *(LAS bf16*)(L + QK1_OFF + eo) = (bf16)(qk >> 16);
                  if (i & 1) klw[i >> 1] = pg8::cvt_pk_bf16(klp, kf * e3); else klp = kf * e3; }
              *(LAS v4u*)(L + KLT_OFF + k * TS + tg * 32) = (v4u){klw[0], klw[1], klw[2], klw[3]}; *(LAS v4u*)(L + KLT_OFF + k * TS + tg * 32 + 16) = (v4u){klw[4], klw[5], klw[6], klw[7]};
              if (tg == 0) DEC[k] = last;
            }
            GLA_BAR();
            const int ti = w >> 1, wi = w & 1; f32x4 acco = (f32x4){0.f, 0.f, 0.f, 0.f};
            { s16x8 aq[4];
#pragma unroll
              for (int kk = 0; kk < 4; ++kk) aq[kk] = *(const LAS s16x8*)(L + QK0_OFF + (ti * 16 + fr) * 256 + (((kk * 4 + fq) ^ fr) << 4));
#pragma unroll
              for (int s2 = 0; s2 < 2; ++s2) { const int si = wi * 2 + s2; f32x4 a4 = (f32x4){0.f, 0.f, 0.f, 0.f};
                  if (si <= ti) {
#pragma unroll
                      for (int kk = 0; kk < 4; ++kk) { const s16x8 bb = *(const LAS s16x8*)(L + QK1_OFF + (si * 16 + fr) * 256 + (((kk * 4 + fq) ^ fr) << 4)); a4 = MFMA16(aq[kk], bb, a4); } }
#pragma unroll
                  for (int r = 0; r < 4; ++r) { const int t = ti * 16 + fq * 4 + r, sc = si * 16 + fr; const float v = (sc <= t) ? a4[r] : 0.f; *(LAS bf16*)(L + ATT_OFF + t * TS + sc * 2) = (bf16)f2bf(v); } }
#pragma unroll
              for (int kk = 0; kk < 4; ++kk) { const s16x8 bb = *(const LAS s16x8*)(L + SBT_OFF + (wi * 16 + fr) * QS + (kk * 32 + 8 * fq) * 2); acco = MFMA16(aq[kk], bb, acco); }
            }
            GLA_BAR();
            {
#pragma unroll
              for (int kk = 0; kk < 2; ++kk) { const s16x8 a = *(const LAS s16x8*)(L + ATT_OFF + (ti * 16 + fr) * TS + (kk * 32 + 8 * fq) * 2); const s16x8 bb = *(const LAS s16x8*)(L + vto + (wi * 16 + fr) * TS + (kk * 32 + 8 * fq) * 2);
                  acco = MFMA16(a, bb, acco); }
#pragma unroll
              for (int r = 0; r < 4; ++r) { const int t = c * 64 + ti * 16 + fq * 4 + r; ob[(size_t)t * 1024 + wi * 16 + fr] = (bf16)f2bf(acco[r]);
                  float q = acco[r] * acco[r]; q += __shfl_xor(q, 1); q += __shfl_xor(q, 2); q += __shfl_xor(q, 4); q += __shfl_xor(q, 8);
                  if (fr == 0) ssq[(size_t)t * 64 + wi] = q; }
#pragma unroll
              for (int w2 = 0; w2 < 2; ++w2) {
#pragma unroll
                  for (int r = 0; r < 4; ++r) accS[w2][r] *= DEC[w * 16 + fq * 4 + r];
#pragma unroll
                  for (int kk = 0; kk < 2; ++kk) { const s16x8 a = *(const LAS s16x8*)(L + KLT_OFF + (w * 16 + fr) * TS + (kk * 32 + 8 * fq) * 2); const s16x8 bb = *(const LAS s16x8*)(L + vto + (w2 * 16 + fr) * TS + (kk * 32 + 8 * fq) * 2);
                      accS[w2] = MFMA16(a, bb, accS[w2]); }
                  *(LAS unsigned long long*)(L + SBT_OFF + (w2 * 16 + fr) * QS + (w * 16 + fq * 4) * 2) = (unsigned long long)pk2(accS[w2][0], accS[w2][1]) | ((unsigned long long)pk2(accS[w2][2], accS[w2][3]) << 32); }
            }
        }
#undef GLA_LOAD
#undef GLA_BAR
        __syncthreads();
    }
}
__device__ __forceinline__ void unpack8(const v4u w, float* d) { d[0] = bflo(w.x); d[1] = bfhi(w.x); d[2] = bflo(w.y); d[3] = bfhi(w.y); d[4] = bflo(w.z); d[5] = bfhi(w.z); d[6] = bflo(w.w); d[7] = bfhi(w.w); }
__device__ __forceinline__ v4u pack8(const float* d) { v4u o; o.x = pk2(d[0], d[1]); o.y = pk2(d[2], d[3]); o.z = pk2(d[4], d[5]); o.w = pk2(d[6], d[7]); return o; }
__device__ __forceinline__ void phase_post(Frame& F, int l) {
    const float* lq1 = F.prm + PO_LQ1; const float* lk1 = F.prm + PO_LK1; const float* lq2 = F.prm + PO_LQ2; const float* lk2 = F.prm + PO_LK2; const float* diffg = F.prm + PO_DIFFG; const float* glag = F.prm + PO_GLAG;
    const int lane = F.lane;
    const float lam_init = 0.8f - 0.6f * expf(-0.3f * (float)l);
    const float d1 = lq1[l * 64 + lane] * lk1[l * 64 + lane], d2 = lq2[l * 64 + lane] * lk2[l * 64 + lane];
    const float lam = expf(wave_sum(d1)) - expf(wave_sum(d2)) + lam_init, osc = 1.0f - lam_init;
    float dgr[16], ggr[16];
#pragma unroll
    for (int i = 0; i < 16; ++i) { dgr[i] = diffg[l * 128 + 16 * (lane & 7) + i] * osc; ggr[i] = glag[l * 256 + 16 * (lane & 15) + i]; }
    const bf16* OP = (const bf16*)(F.ws + WS_OP); const bf16* OB = (const bf16*)(F.ws + WS_OB); const bf16* SG = (const bf16*)(F.ws + WS_SG); const float* SSQ = (const float*)(F.ws + WS_SSQ);
    bf16* OA2 = (bf16*)(F.ws + WS_OA2); bf16* OB2 = (bf16*)(F.ws + WS_OB2);
    for (int m = F.vcu * NWAVES + F.wave; m < NTOK; m += F.G * NWAVES) {
        float o0[16], o1[16], d[16];
        { const GAS v4u* p0 = (const GAS v4u*)(OP + (size_t)m * 2048 + 16 * lane); const GAS v4u* p1 = (const GAS v4u*)(OP + (size_t)m * 2048 + 1024 + 16 * lane);
          unpack8(p0[0], o0); unpack8(p0[1], o0 + 8); unpack8(p1[0], o1); unpack8(p1[1], o1 + 8); }
        float ss = 0.f;
#pragma unroll
        for (int i = 0; i < 16; ++i) { d[i] = o0[i] - lam * o1[i]; ss += d[i] * d[i]; }
        ss += __shfl_xor(ss, 1); ss += __shfl_xor(ss, 2); ss += __shfl_xor(ss, 4);
        { const float r = 1.0f / sqrtf(ss * (1.0f / 128.0f) + LN_EPS);
#pragma unroll
          for (int i = 0; i < 16; ++i) d[i] = d[i] * r * dgr[i];
          GAS v4u* q = (GAS v4u*)(OA2 + (size_t)m * 1024 + 16 * lane); q[0] = pack8(d); q[1] = pack8(d + 8); }
        { const GAS v4u* p0 = (const GAS v4u*)(OB + (size_t)m * 1024 + 16 * lane); const GAS v4u* p1 = (const GAS v4u*)(SG + (size_t)m * 1024 + 16 * lane);
          unpack8(p0[0], o0); unpack8(p0[1], o0 + 8); unpack8(p1[0], o1); unpack8(p1[1], o1 + 8); }
        { const GAS f32x4* sp = (const GAS f32x4*)(SSQ + (size_t)m * 64 + (lane >> 4) * 16); float sq = 0.f;
#pragma unroll
          for (int j = 0; j < 4; ++j) { const f32x4 v = sp[j]; sq += v.x; sq += v.y; sq += v.z; sq += v.w; }
          const float r = 1.0f / sqrtf(sq * (1.0f / 256.0f) + LN_EPS);
#pragma unroll
          for (int i = 0; i < 16; ++i) d[i] = o0[i] * r * ggr[i] * o1[i];
          GAS v4u* q = (GAS v4u*)(OB2 + (size_t)m * 1024 + 16 * lane); q[0] = pack8(d); q[1] = pack8(d + 8); }
    }
}
struct MoeOrder {
    const LAS int* BASE; int total4, G, c;
    __device__ __forceinline__ bool next(int i, pg8::Unit& u) const {
        const int Lx = i * G + c; if (Lx >= total4) return false;
        const int rt = Lx >> 2, pn = Lx & 3; int e = 0;
        for (int j = 1; j < 32; ++j) if (BASE[j] <= rt) e = j;
        e = __builtin_amdgcn_readfirstlane(e);
        u.pm = rt; u.pn = pn; u.pb = e * 4 + pn; return true;
    }
};

#ifndef PHMASK
#define PHMASK 0xFFFF
#endif
#ifndef REPMASK
#define REPMASK 0
#endif
#define REP(bit) for (int rep_ = 0; rep_ < ((REPMASK & (bit)) ? 2 : 1); ++rep_)
struct Args { const float* in[28]; float* out; unsigned char* ws; };
__global__ void __launch_bounds__(NTHREADS, 2) mk_fwd(Args args) {
    extern __shared__ __attribute__((aligned(16))) unsigned char lds[];
    Frame F;
    F.lds = (LAS unsigned char*)lds;
    F.tid = threadIdx.x; F.lane = F.tid & 63; F.wave = __builtin_amdgcn_readfirstlane(F.tid >> 6);
    F.G = gridDim.x; { const int bx = blockIdx.x; F.vcu = (F.G % 8 == 0) ? (bx % 8) * (F.G / 8) + bx / 8 : bx; }
    F.out = args.out; F.ws = args.ws; F.ctl = (gu32*)(args.ws + WS_CTL); F.prm = (const float*)(args.ws + WS_PRM);
    unsigned char* ws = args.ws;
    for (int u = F.tid; u < (LDS_BYTES - LDSCTL_OFF) / 4; u += NTHREADS) ((LAS unsigned*)(F.lds + LDSCTL_OFF))[u] = 0u;
    __syncthreads();
    volatile LAS unsigned* MISC = (volatile LAS unsigned*)(F.lds + MISC_OFF);
    XcdBarrier bar = xcd_barrier_post((unsigned*)(F.ctl + CW_BAR), MISC + 8);
#define GRID_BAR() do { GAS unsigned char* bw_ = (GAS unsigned char*)args.ws; asm volatile("" : "+s"(bw_)); unsigned bx_ = bar.x; asm volatile("" : "+s"(bx_)); XcdBarrier b_ = bar; b_.x = bx_; b_.bar = (unsigned*)(bw_ + WS_CTL) + CW_BAR; xcd_barrier(b_); if (REPMASK & 4096) xcd_barrier(b_); } while (0)
#define PHASE_ENTER() do { int t_ = threadIdx.x; asm volatile("" : "+v"(t_)); F.tid = t_; F.lane = t_ & 63; F.wave = __builtin_amdgcn_readfirstlane(t_ >> 6); \
        GAS unsigned char* w_ = (GAS unsigned char*)args.ws; GAS float* o_ = (GAS float*)args.out; asm volatile("" : "+s"(w_), "+s"(o_));   \
        F.ws = (unsigned char*)w_; F.out = (float*)o_; ws = (unsigned char*)w_; F.ctl = (gu32*)(w_ + WS_CTL); F.prm = (const float*)(w_ + WS_PRM); F.xst = (float*)o_; F.Ubuf = (bf16*)(w_ + WS_U); F.LAbuf = (float*)(w_ + WS_LA); F.dry = 0; } while (0)
    typedef pg8::bf16_t pb;
    REP(1) if (PHMASK & 1) { PHASE_ENTER(); p0_ada(F, args.in[I_C], args.in[I_WADA], args.in[I_BADA]);
        __syncthreads();
        p0_weights(F, args.in[I_WIN], args.in[I_WBA], args.in[I_WBB], args.in[I_WOUT], args.in[I_WGE], args.in[I_WUE], args.in[I_WDE], args.in[I_WRG], args.in[I_WRE],
                   SmallPrm{args.in[I_BGATES], args.in[I_WALPHA], args.in[I_BALPHA], args.in[I_LQ1], args.in[I_LK1], args.in[I_LQ2], args.in[I_LK2], args.in[I_DIFFG], args.in[I_GLAG], args.in[I_LN1G], args.in[I_LN1B], args.in[I_BRG], args.in[I_BRE], args.in[I_LN2G], args.in[I_LN2B]}); __syncthreads(); }
    GRID_BAR();
    REP(2) if (PHMASK & 2) { PHASE_ENTER(); phase_r0(F, args.in[I_X]); }
    GRID_BAR();
    for (int l = 0; l < DEPTH; ++l) {
        REP(4) if (PHMASK & 4) { PHASE_ENTER(); pg8::Gemm g{(const pb*)(ws + WS_U), (const pb*)(ws + WS_WIN) + (size_t)l * NPROJ * 1024, NTOK, NPROJ, 1024}; pg8::StaticOrder S; S.init(NTOK, NPROJ, F.G, (int)blockIdx.x);
          pg8::EpiProj E{(pb*)(ws + WS_QB), (pb*)(ws + WS_KB), (pb*)(ws + WS_VB), (pb*)(ws + WS_GQ), (pb*)(ws + WS_GK), (pb*)(ws + WS_GV), (pb*)(ws + WS_SG), (pb*)(ws + WS_GT), F.prm + PO_BGATES + l * 2048};
          pg8::gemm_phase<pg8::EpiProj, pg8::StaticOrder, true, false>(F.lds + RING_OFF, g, S, E, nullptr); }
        GRID_BAR();
        REP(8) if (PHMASK & 8) { PHASE_ENTER(); phase_gla(F); }
        GRID_BAR();
        REP(16) if (PHMASK & 16) { PHASE_ENTER(); const attn_body::AttnTensors AT{(const attn_body::bf16*)(ws + WS_QB), (const attn_body::bf16*)(ws + WS_KB), (const attn_body::bf16*)(ws + WS_VB), (attn_body::bf16*)(ws + WS_OP)};
          attn_body::attn_phase<8>((char*)lds + RING_OFF, AT, (unsigned*)(F.ctl + CW_ATQ + (l * 2 + ((REPMASK & 16) ? rep_ : 0)) * 64), MISC + 16); }
        GRID_BAR();
        REP(32) if (PHMASK & 32) { PHASE_ENTER(); phase_post(F, l); }
        GRID_BAR();
        REP(64) if (PHMASK & 64) { PHASE_ENTER(); pg8::StaticOrder S; S.init(NTOK, 1024, F.G, (int)blockIdx.x);
          { pg8::Gemm g{(const pb*)(ws + WS_OA2), (const pb*)(ws + WS_WBA) + (size_t)l * 1024 * 1024, NTOK, 1024, 1024};
            pg8::EpiGate<0> E{(pb*)(ws + WS_TMP), 1024, nullptr, (const pb*)(ws + WS_GT), 2048, 0};
            pg8::gemm_phase<pg8::EpiGate<0>, pg8::StaticOrder, true, false>(F.lds + RING_OFF, g, S, E, nullptr); }
          { pg8::Gemm g{(const pb*)(ws + WS_OB2), (const pb*)(ws + WS_WBB) + (size_t)l * 1024 * 1024, NTOK, 1024, 1024};
            pg8::EpiGate<1> E{(pb*)(ws + WS_MIX), 1024, (const pb*)(ws + WS_TMP), (const pb*)(ws + WS_GT), 2048, 1024};
            pg8::gemm_phase<pg8::EpiGate<1>, pg8::StaticOrder, true, false>(F.lds + RING_OFF, g, S, E, nullptr); } }
        GRID_BAR();
        if (PHMASK & 128) { PHASE_ENTER(); pg8::Gemm g{(const pb*)(ws + WS_MIX), (const pb*)(ws + WS_WOUT) + (size_t)l * 1024 * 1024, NTOK, 1024, 1024}; pg8::StaticOrder S; S.init(NTOK, 1024, F.G, (int)blockIdx.x);
          REP(128) { pg8::EpiResid E{F.out, ((REPMASK & 128) && rep_ == 0) ? (float*)(ws + WS_QB) : F.out, (const float*)(ws + WS_ADA) + (size_t)l * 8 * 6144 + 2 * 1024, 6144, DN_ALPHA};
          pg8::gemm_phase<pg8::EpiResid, pg8::StaticOrder, true, false>(F.lds + RING_OFF, g, S, E, nullptr); } }
        GRID_BAR();
        REP(256) if (PHMASK & 256) { PHASE_ENTER(); if ((REPMASK & 256) && rep_ == 0) { F.dry = 1; F.xst = (float*)(ws + WS_QB); F.Ubuf = (bf16*)(ws + WS_VB); } phase_r1(F, l); }
        GRID_BAR();
        if (PHMASK & 512) { PHASE_ENTER(); moe_tables(F, l); }
        if (PHMASK & 512) { const LAS int* BASE = (const LAS int*)(F.lds + TAB_BASE); const LAS int* CNT = (const LAS int*)(F.lds + TAB_CNT); LAS int* IDX = (LAS int*)(F.lds + TAB_IDX);
          const int total4 = __builtin_amdgcn_readfirstlane(BASE[32]) * 4; const int* LIST = (const int*)(ws + WS_LIST);
          MoeOrder S{BASE, total4, F.G, (int)blockIdx.x};
          for (int ui = 0; ui < IDX_UNITS; ++ui) { pg8::Unit u; if (!S.next(ui, u)) break; const int e = u.pb >> 2;
              if (F.tid < 256) { const int pos = (u.pm - BASE[e]) * 256 + F.tid; IDX[ui * 256 + F.tid] = (pos < CNT[e]) ? LIST[(size_t)e * LISTCAP + pos] : 0; } }
          __syncthreads();
          REP(512) { pg8::Gemm g{(const pb*)(ws + WS_U), (const pb*)(ws + WS_W1) + (size_t)l * 32 * 1024 * 1024, MOE_MAXT * 256, 1024, 1024};
            pg8::EpiSwiGLU E{(pb*)(ws + WS_H)};
            pg8::gemm_phase<pg8::EpiSwiGLU, MoeOrder, true, true>(F.lds + RING_OFF, g, S, E, IDX); }
          GRID_BAR();
          PHASE_ENTER();
          REP(2048) { pg8::Gemm g{(const pb*)(ws + WS_H), (const pb*)(ws + WS_WD) + (size_t)l * 32 * 1024 * 512, MOE_MAXT * 256, 1024, 512};
            pg8::EpiGate<2> E{(pb*)(ws + WS_YB), 1024, nullptr, nullptr, 0, 0};
            pg8::gemm_phase<pg8::EpiGate<2>, MoeOrder, true, false>(F.lds + RING_OFF, g, S, E, nullptr); }
        }
        GRID_BAR();
        REP(1024) if (PHMASK & 1024) { PHASE_ENTER(); if ((REPMASK & 1024) && rep_ == 0) { F.dry = 1; F.xst = (float*)(ws + WS_GT); F.Ubuf = (bf16*)(ws + WS_SG); F.LAbuf = (float*)(ws + WS_GV); } phase_r2(F, l); }
        if (l + 1 < DEPTH) GRID_BAR();
    }
}

extern "C" void kernel_launch(void* const* d_in, const int* in_sizes, int n_in, void* d_out, int out_size, void* d_ws, size_t ws_size, hipStream_t stream) {
    static int grid = 0;
    if (grid == 0) {
        if (n_in != 28 || in_sizes[0] != NTOK * DM || out_size != NTOK * DM || ws_size < WS_END) { fprintf(stderr, "kernel_launch: unexpected shapes (n_in %d, in0 %d, out %d, ws %zu < %zu); nothing launched\n", n_in, n_in > 0 ? in_sizes[0] : -1, out_size, ws_size, (size_t)WS_END); grid = -1; return; }
        int dev = 0, cus = 0, per_cu = 0;
        if (hipGetDevice(&dev) != hipSuccess || hipDeviceGetAttribute(&cus, hipDeviceAttributeMultiprocessorCount, dev) != hipSuccess) { fprintf(stderr, "kernel_launch: device query failed\n"); grid = -1; return; }
        if (hipFuncSetAttribute((const void*)mk_fwd, hipFuncAttributeMaxDynamicSharedMemorySize, LDS_BYTES) != hipSuccess) { fprintf(stderr, "kernel_launch: hipFuncSetAttribute failed\n"); grid = -1; return; }
        if (hipOccupancyMaxActiveBlocksPerMultiprocessor(&per_cu, (const void*)mk_fwd, NTHREADS, LDS_BYTES) != hipSuccess || per_cu < 1) { fprintf(stderr, "kernel_launch: occupancy query says %d\n", per_cu); }
        (void)hipGetLastError();
        grid = cus;
    }
    if (grid < 0) return;
    if (hipMemsetAsync((char*)d_ws + WS_CTL, 0, CTL_ZERO_BYTES, stream) != hipSuccess) { fprintf(stderr, "kernel_launch: memset failed\n"); return; }
    Args a{};
    for (int i = 0; i < 28; ++i) a.in[i] = (const float*)d_in[i];
    a.out = (float*)d_out; a.ws = (unsigned char*)d_ws;
    hipLaunchKernelGGL(mk_fwd, dim3(grid), dim3(NTHREADS), LDS_BYTES, stream, a);
    const hipError_t le = hipPeekAtLastError();
    if (le != hipSuccess) fprintf(stderr, "kernel_launch: launch failed: %s\n", hipGetErrorName(le));
}
```

```cpp
#include <hip/hip_runtime.h>
#include <hip/hip_bf16.h>
#include <cstdio>
#include <cstdint>
#include <cmath>
namespace pg8 {
#define PG8_LAS __attribute__((address_space(3)))
typedef unsigned short bf16_t;
typedef short bf16x8 __attribute__((ext_vector_type(8)));
typedef float f32x4 __attribute__((ext_vector_type(4)));
typedef float f32x2 __attribute__((ext_vector_type(2)));
typedef unsigned u32x4 __attribute__((ext_vector_type(4)));
typedef unsigned u32x2 __attribute__((ext_vector_type(2)));
constexpr int BM = 256, BK = 64, HALF = 128, HTB = HALF * BK * 2  , STAGE_BYTES = 8 * HTB, NXCD = 8, WGM = 8;

__host__ __device__ __forceinline__ int lds_byte(int r, int c) { const int st = (r >> 4) * 2 + (c >> 5), rr = r & 15, cc = c & 31, ob = rr * 64 + cc * 2; return st * 1024 + (ob ^ (((ob >> 9) & 1) << 5)); }
__host__ __device__ __forceinline__ void stage_rc(int b, int& R, int& C) { const int st = b / 1024, sb = b % 1024, swz = sb ^ (((sb >> 9) & 1) << 5); R = (st >> 1) * 16 + swz / 64; C = (st & 1) * 32 + (swz % 64) / 2; }
__host__ __device__ __forceinline__ int perm32(int rho) { const int n = rho >> 4, i = rho & 15; return 8 * (i >> 2) + 4 * n + (i & 3); }

struct Unit { int pm, pn, pb; };
struct Gemm { const bf16_t* A; const bf16_t* Bt; int M, N, K; };

struct StaticOrder {
    int nM, nN, nwg, G, c;
    __host__ __device__ __forceinline__ void init(int M, int N, int G_, int c_) { nM = M / BM; nN = N / BM; nwg = nM * nN; G = G_; c = c_; }
    __host__ __device__ __forceinline__ bool next(int i, Unit& u) const {
        const long L = (long)i * G + c; if (L >= nwg) return false;
        int wgid = (int)L; { const int q = nwg / NXCD, r = nwg % NXCD, xcd = wgid % NXCD, off = wgid / NXCD; wgid = (xcd < r ? xcd * (q + 1) : r * (q + 1) + (xcd - r) * q) + off; }
        const int nig = WGM * nN, gid = wgid / nig, fm = gid * WGM, gsz = (nM - fm) < WGM ? (nM - fm) : WGM;
        u.pm = fm + ((wgid % nig) % gsz); u.pn = (wgid % nig) / gsz; u.pb = u.pn; return true;
    }
};

__device__ __forceinline__ unsigned cvt_pk_bf16(float lo, float hi) { unsigned r; asm volatile("v_cvt_pk_bf16_f32 %0, %1, %2" : "=v"(r) : "v"(lo), "v"(hi)); return r; }
typedef __bf16 bf16x2_c __attribute__((ext_vector_type(2)));
__device__ __forceinline__ unsigned cvt_pk_bf16_c(float lo, float hi) { const f32x2 v = {lo, hi}; const bf16x2_c b = __builtin_convertvector(v, bf16x2_c); return __builtin_bit_cast(unsigned, b); }
__device__ __forceinline__ float bf_lo(unsigned w) { return __uint_as_float(w << 16); }
__device__ __forceinline__ float bf_hi(unsigned w) { return __uint_as_float(w & 0xffff0000u); }
__device__ __forceinline__ float sigmoidf_(float x) { return __builtin_amdgcn_rcpf(1.0f + __expf(-x)); }

template <class Epi, class Sched, bool ALIGN_EPI, bool GATHER>
__device__ __forceinline__ void gemm_phase(PG8_LAS unsigned char* lds, const Gemm g, const Sched& S, const Epi& E, const PG8_LAS int* idxtab) {
    int tid_ = threadIdx.x; asm volatile("" : "+v"(tid_));
    const int tid = tid_, wid = __builtin_amdgcn_readfirstlane(tid >> 6), lane = tid & 63, wr = wid >> 2, wc = wid & 3, fr = lane & 15, fq = lane >> 4;
    const int K = g.K, nt = K / BK;
    unsigned voffA[2], voffB[2];
#pragma unroll
    for (int i = 0; i < 2; ++i) { int R, C; stage_rc(tid * 16 + i * 8192, R, C); const int Rb = Epi::PERM ? ((R & ~31) + perm32(R & 31)) : R;
        voffA[i] = (unsigned)(R * K + C) * 2u; voffB[i] = (unsigned)(Rb * K + C) * 2u; }
    const size_t kstep = (size_t)(BK * 2);
    const size_t hstep = (size_t)HALF * K * 2;
    const size_t tstep = 2 * hstep;
    const unsigned ldsw = (unsigned)wid * 1024u;
    const int aoff = lds_byte(wr * 64 + fr, fq * 8), boff = lds_byte(wc * 32 + fr, fq * 8);
    unsigned offAc[2][2];
    int nui = 0;
#define PG8_SA(b, h) (((b) * 2 + (h)) * HTB)
#define PG8_SB(b, h) ((4 + (b) * 2 + (h)) * HTB)
#define PG8_STAGE(bufoff, gbase, voff) do { _Pragma("unroll") for (int _i = 0; _i < 2; ++_i) \
        __builtin_amdgcn_global_load_lds((const unsigned*)((const char*)(gbase) + (voff)[_i]), (PG8_LAS unsigned*)(lds + (bufoff) + ldsw + _i * 8192), 16, 0, 0); } while (0)
#define PG8_GOFF(uix, h, i, tt) ({ int _R, _C; stage_rc((tt) * 16 + (i) * 8192, _R, _C); (unsigned)idxtab[(uix) * 256 + (h) * HALF + _R] * (unsigned)(K * 2) + (unsigned)_C * 2u; })
#define PG8_STAGE_A(bufoff, kb, h, nx) do { if constexpr (GATHER) { unsigned _o[2] = {offAc[h][0], offAc[h][1]}; \
        if (nx) { int _t = tid; asm volatile("" : "+v"(_t)); _o[0] = PG8_GOFF(nui, h, 0, _t); _o[1] = PG8_GOFF(nui, h, 1, _t); } \
        _Pragma("unroll") for (int _i = 0; _i < 2; ++_i) \
        __builtin_amdgcn_global_load_lds((const unsigned*)((const char*)g.A + (size_t)(kb) + _o[_i]), (PG8_LAS unsigned*)(lds + (bufoff) + ldsw + _i * 8192), 16, 0, 0); } \
        else { const char* _b = ((nx) ? nA : cA) + (size_t)(kb) + (size_t)(h) * hstep; PG8_STAGE(bufoff, _b, voffA); } } while (0)
#define PG8_GIDX(dst, uix) do { if constexpr (GATHER) { int _t = tid; asm volatile("" : "+v"(_t)); _Pragma("unroll") for (int _h = 0; _h < 2; ++_h) _Pragma("unroll") for (int _i = 0; _i < 2; ++_i) \
        dst[_h][_i] = PG8_GOFF(uix, _h, _i, _t); } } while (0)
#define PG8_LDA(dst, b, h) do { _Pragma("unroll") for (int m = 0; m < 4; ++m) _Pragma("unroll") for (int k = 0; k < 2; ++k) dst[m][k] = *(const PG8_LAS bf16x8*)(lds + PG8_SA(b, h) + aoff + m * 2048 + k * 1024); } while (0)
#define PG8_LDB(dst, b, h) do { _Pragma("unroll") for (int n = 0; n < 2; ++n) _Pragma("unroll") for (int k = 0; k < 2; ++k) dst[n][k] = *(const PG8_LAS bf16x8*)(lds + PG8_SB(b, h) + boff + n * 2048 + k * 1024); } while (0)
#define PG8_MMA(ai, bj, At, Bt) do { __builtin_amdgcn_s_setprio(1); _Pragma("unroll") for (int m = 0; m < 4; ++m) _Pragma("unroll") for (int n = 0; n < 2; ++n) _Pragma("unroll") for (int k = 0; k < 2; ++k) \
        acc[ai][bj][m][n] = __builtin_amdgcn_mfma_f32_16x16x32_bf16(Bt[n][k], At[m][k], acc[ai][bj][m][n], 0, 0, 0); __builtin_amdgcn_s_setprio(0); } while (0)
#define PG8_WAIT_V(n) asm volatile("s_waitcnt vmcnt(" #n ")" ::: "memory")
#define PG8_WAIT_L(n) asm volatile("s_waitcnt lgkmcnt(" #n ")" ::: "memory")
#define PG8_BAR __builtin_amdgcn_s_barrier()
#define PG8_SCHED __builtin_amdgcn_sched_barrier(0)
    Unit cur, nxt; int ui = 0;
    if (!S.next(0, cur)) return;
    f32x4 acc[2][2][4][2];
#pragma unroll
    for (int a = 0; a < 2; ++a)
#pragma unroll
        for (int b = 0; b < 2; ++b)
#pragma unroll
            for (int m = 0; m < 4; ++m)
#pragma unroll
                for (int n = 0; n < 2; ++n) acc[a][b][m][n] = (f32x4){0.f, 0.f, 0.f, 0.f};
    bf16x8 At[4][2], B0[2][2], B1[2][2];
    const char* cA = (const char*)g.A + (size_t)cur.pm * tstep; const char* cB = (const char*)g.Bt + (size_t)cur.pb * tstep;
    const char* nA = cA;
    PG8_GIDX(offAc, 0);
    PG8_STAGE(PG8_SB(0, 0), cB, voffB); PG8_STAGE(PG8_SB(0, 1), cB + hstep, voffB); PG8_STAGE_A(PG8_SA(0, 0), 0, 0, false); PG8_STAGE_A(PG8_SA(0, 1), 0, 1, false);
    if (wr == 1) PG8_BAR;
    PG8_WAIT_V(2); PG8_BAR;
    PG8_STAGE(PG8_SB(1, 0), cB + kstep, voffB); PG8_STAGE_A(PG8_SA(1, 0), kstep, 0, false); PG8_STAGE(PG8_SB(1, 1), cB + hstep + kstep, voffB);
    PG8_WAIT_V(6); PG8_BAR;
    for (;;) {
        const bool has_next = S.next(ui + 1, nxt);
        nA = has_next ? (const char*)g.A + (size_t)nxt.pm * tstep : cA; const char* nB = has_next ? (const char*)g.Bt + (size_t)nxt.pb * tstep : cB;
        nui = has_next ? ui + 1 : ui;
        for (int t = 0; t < nt; t += 2) {
            const bool last = (t == nt - 2);
            const size_t kb1 = (size_t)(t + 1) * kstep;
            const size_t kb2 = last ? (size_t)0 : (size_t)(t + 2) * kstep, kb3 = kb2 + kstep;
            const char* b2 = last ? nB : cB + (size_t)(t + 2) * kstep; const char* b3 = b2 + kstep;
            PG8_LDB(B0, 0, 0); PG8_LDB(B1, 0, 1); PG8_SCHED; PG8_LDA(At, 0, 0); PG8_STAGE_A(PG8_SA(1, 1), kb1, 1, false);
            PG8_WAIT_V(8); PG8_WAIT_L(0); PG8_BAR; PG8_MMA(0, 0, At, B0); PG8_MMA(0, 1, At, B1); PG8_BAR; PG8_SCHED;
            PG8_LDA(At, 0, 1); PG8_STAGE(PG8_SB(0, 0), b2, voffB); PG8_STAGE(PG8_SB(0, 1), b2 + hstep, voffB); PG8_STAGE_A(PG8_SA(0, 0), kb2, 0, last);
            PG8_WAIT_V(8); PG8_WAIT_L(0); PG8_BAR; PG8_MMA(1, 0, At, B0); PG8_MMA(1, 1, At, B1); PG8_BAR; PG8_SCHED;
            PG8_LDB(B0, 1, 0); PG8_LDB(B1, 1, 1); PG8_SCHED; PG8_LDA(At, 1, 0); PG8_STAGE_A(PG8_SA(0, 1), kb2, 1, last);
            PG8_WAIT_V(8); PG8_WAIT_L(0); PG8_BAR; PG8_MMA(0, 0, At, B0); PG8_MMA(0, 1, At, B1); PG8_BAR; PG8_SCHED;
            PG8_LDA(At, 1, 1); PG8_STAGE(PG8_SB(1, 0), b3, voffB); PG8_STAGE(PG8_SB(1, 1), b3 + hstep, voffB); PG8_STAGE_A(PG8_SA(1, 0), kb3, 0, last);
            PG8_WAIT_V(8); PG8_WAIT_L(0); PG8_BAR; PG8_MMA(1, 0, At, B0); PG8_MMA(1, 1, At, B1); PG8_BAR; PG8_SCHED;
        }
        if constexpr (ALIGN_EPI) { if (wr == 0) PG8_BAR; }
        E(acc, cur, wr, wc, fr, fq);
        if (!has_next) break;
#pragma unroll
        for (int a = 0; a < 2; ++a)
#pragma unroll
            for (int b = 0; b < 2; ++b)
#pragma unroll
                for (int m = 0; m < 4; ++m)
#pragma unroll
                    for (int n = 0; n < 2; ++n) acc[a][b][m][n] = (f32x4){0.f, 0.f, 0.f, 0.f};
        cur = nxt; cA = nA; cB = nB; ++ui;
        PG8_GIDX(offAc, ui);
        if constexpr (ALIGN_EPI) { if (wr == 1) PG8_BAR; }
    }
    PG8_WAIT_V(0);
    if constexpr (!ALIGN_EPI) { if (wr == 0) PG8_BAR; }
    PG8_BAR;
#undef PG8_SA
#undef PG8_SB
#undef PG8_STAGE
#undef PG8_STAGE_A
#undef PG8_GIDX
#undef PG8_GOFF
#undef PG8_LDA
#undef PG8_LDB
#undef PG8_MMA
#undef PG8_WAIT_V
#undef PG8_WAIT_L
#undef PG8_BAR
#undef PG8_SCHED
}
}
namespace pg8 {
constexpr float ATT_C2 = 0.125f * 1.4426950408889634f;
constexpr float GLA_QS = 0.08838834764831845f;
struct EpiProj {
    static constexpr bool PERM = true;
    bf16_t *Qb, *Kb, *Vb, *GQ, *GK, *GV, *SG, *GT; const float* bgates;
    __device__ __forceinline__ void operator()(const f32x4 (&acc)[2][2][4][2], const Unit& u, int wr, int wc, int fr, int fq) const {
        asm volatile("" : "+v"(fr), "+v"(fq));
        const int pn = u.pn; bf16_t* base; int ldc = 1024, ct; int act = 0; float sc = 1.f;
        if (pn < 4) { base = Qb; ct = pn; sc = ATT_C2; }
        else if (pn < 8) { base = Kb; ct = pn - 4; }
        else if (pn < 12) { base = Vb; ct = pn - 8; }
        else if (pn < 14) { base = GQ; ldc = 512; ct = pn - 12; sc = GLA_QS; }
        else if (pn < 16) { base = GK; ldc = 512; ct = pn - 14; }
        else if (pn < 20) { base = GV; ct = pn - 16; }
        else if (pn < 24) { base = SG; ct = pn - 20; act = 1; }
        else { base = GT; ldc = 2048; ct = pn - 24; act = 2; }
        const int row0 = u.pm * BM + wr * 64 + fr, col0 = ct * BM + wc * 32 + 8 * fq;
        f32x4 bv[2][2];
#pragma unroll
        for (int bj = 0; bj < 2; ++bj)
#pragma unroll
            for (int n = 0; n < 2; ++n) bv[bj][n] = (act == 2) ? *(const f32x4*)(bgates + col0 + bj * HALF + 4 * n) : (f32x4){0.f, 0.f, 0.f, 0.f};
#pragma unroll
        for (int ai = 0; ai < 2; ++ai)
#pragma unroll
            for (int m = 0; m < 4; ++m) { bf16_t* rowp = base + (size_t)(row0 + ai * HALF + m * 16) * ldc + col0;
#pragma unroll
                for (int bj = 0; bj < 2; ++bj) { f32x4 v0 = acc[ai][bj][m][0] * sc + bv[bj][0], v1 = acc[ai][bj][m][1] * sc + bv[bj][1];
                    if (act != 0) {
#pragma unroll
                        for (int e = 0; e < 4; ++e) { const float s0 = sigmoidf_(v0[e]), s1 = sigmoidf_(v1[e]); v0[e] = (act == 1) ? v0[e] * s0 : s0; v1[e] = (act == 1) ? v1[e] * s1 : s1; } }
                    u32x4 w; w.x = cvt_pk_bf16(v0[0], v0[1]); w.y = cvt_pk_bf16(v0[2], v0[3]); w.z = cvt_pk_bf16(v1[0], v1[1]); w.w = cvt_pk_bf16(v1[2], v1[3]);
                    *(u32x4*)(rowp + bj * HALF) = w; } }
    }
};
template <int MODE> struct EpiGate {
    static constexpr bool PERM = true;
    bf16_t* O; int ldo; const bf16_t* T; const bf16_t* gate; int ldg, gcol0;
    __device__ __forceinline__ void operator()(const f32x4 (&acc)[2][2][4][2], const Unit& u, int wr, int wc, int fr, int fq) const {
        asm volatile("" : "+v"(fr), "+v"(fq));
        const int row0 = u.pm * BM + wr * 64 + fr, col0 = u.pn * BM + wc * 32 + 8 * fq;
#pragma unroll
        for (int ai = 0; ai < 2; ++ai)
#pragma unroll
            for (int m = 0; m < 4; ++m) { const size_t row = (size_t)(row0 + ai * HALF + m * 16);
#pragma unroll
                for (int bj = 0; bj < 2; ++bj) { f32x4 v0 = acc[ai][bj][m][0], v1 = acc[ai][bj][m][1]; const int col = col0 + bj * HALF;
                    if (MODE != 2) { const u32x4 gw = *(const u32x4*)(gate + row * ldg + gcol0 + col);
                        v0 = v0 * (f32x4){bf_lo(gw.x), bf_hi(gw.x), bf_lo(gw.y), bf_hi(gw.y)}; v1 = v1 * (f32x4){bf_lo(gw.z), bf_hi(gw.z), bf_lo(gw.w), bf_hi(gw.w)}; }
                    if (MODE == 1) { const u32x4 tw = *(const u32x4*)(T + row * ldo + col);
                        v0 = v0 + (f32x4){bf_lo(tw.x), bf_hi(tw.x), bf_lo(tw.y), bf_hi(tw.y)}; v1 = v1 + (f32x4){bf_lo(tw.z), bf_hi(tw.z), bf_lo(tw.w), bf_hi(tw.w)}; }
                    u32x4 w; w.x = cvt_pk_bf16(v0[0], v0[1]); w.y = cvt_pk_bf16(v0[2], v0[3]); w.z = cvt_pk_bf16(v1[0], v1[1]); w.w = cvt_pk_bf16(v1[2], v1[3]);
                    *(u32x4*)(O + row * ldo + col) = w; }
                asm volatile("" ::: "memory"); }
    }
};
struct EpiGatePair {
    static constexpr bool PERM = true;
    bf16_t* TMP; long mix_delta; const bf16_t* gate;
    __device__ __forceinline__ void operator()(const f32x4 (&acc)[2][2][4][2], const Unit& u, int wr, int wc, int fr, int fq) const {
        asm volatile("" : "+v"(fr), "+v"(fq));
        const int kind = u.pm >= 128 ? 1 : 0; const int row0 = (u.pm - 128 * kind) * BM + wr * 64 + fr, col0 = u.pn * BM + wc * 32 + 8 * fq;
#pragma unroll
        for (int ai = 0; ai < 2; ++ai)
#pragma unroll
            for (int m = 0; m < 4; ++m) { const size_t row = (size_t)(row0 + ai * HALF + m * 16);
#pragma unroll
                for (int bj = 0; bj < 2; ++bj) { f32x4 v0 = acc[ai][bj][m][0], v1 = acc[ai][bj][m][1]; const int col = col0 + bj * HALF;
                    { const u32x4 gw = *(const u32x4*)(gate + row * 2048 + kind * 1024 + col);
                      v0 = v0 * (f32x4){bf_lo(gw.x), bf_hi(gw.x), bf_lo(gw.y), bf_hi(gw.y)}; v1 = v1 * (f32x4){bf_lo(gw.z), bf_hi(gw.z), bf_lo(gw.w), bf_hi(gw.w)}; }
                    if (kind) { const u32x4 tw = *(const u32x4*)(TMP + row * 1024 + col);
                        v0 = v0 + (f32x4){bf_lo(tw.x), bf_hi(tw.x), bf_lo(tw.y), bf_hi(tw.y)}; v1 = v1 + (f32x4){bf_lo(tw.z), bf_hi(tw.z), bf_lo(tw.w), bf_hi(tw.w)}; }
                    u32x4 w; w.x = cvt_pk_bf16(v0[0], v0[1]); w.y = cvt_pk_bf16(v0[2], v0[3]); w.z = cvt_pk_bf16(v1[0], v1[1]); w.w = cvt_pk_bf16(v1[2], v1[3]);
                    *(u32x4*)(TMP + (long)kind * mix_delta + row * 1024 + col) = w; }
                asm volatile("" ::: "memory"); }
    }
};
struct PairOrder {
    StaticOrder S;
    __device__ __forceinline__ bool next(int i, Unit& u) const { if (!S.next(i >> 1, u)) return false; const int kind = i & 1; u.pm += 128 * kind; u.pb = u.pn + 16 * kind; return true; }
};
struct EpiResid {
    static constexpr bool PERM = false;
    const float* X; float* Xo; const float* gvec; int gstride; float alpha;
    __device__ __forceinline__ void operator()(const f32x4 (&acc)[2][2][4][2], const Unit& u, int wr, int wc, int fr, int fq) const {
        asm volatile("" : "+v"(fr), "+v"(fq));
        const int row0 = u.pm * BM + wr * 64 + fr, col0 = u.pn * BM + wc * 32 + 4 * fq; const float* gv = gvec + (size_t)(u.pm >> 4) * gstride;
        f32x4 g4[2][2];
#pragma unroll
        for (int bj = 0; bj < 2; ++bj)
#pragma unroll
            for (int n = 0; n < 2; ++n) g4[bj][n] = *(const f32x4*)(gv + col0 + bj * HALF + n * 16);
#pragma unroll
        for (int ai = 0; ai < 2; ++ai)
#pragma unroll
            for (int m = 0; m < 4; ++m) { const size_t ro = (size_t)(row0 + ai * HALF + m * 16) * 1024 + col0;
#pragma unroll
                for (int bj = 0; bj < 2; ++bj)
#pragma unroll
                    for (int n = 0; n < 2; ++n) { const size_t o = ro + bj * HALF + n * 16; const f32x4 xv = *(const f32x4*)(X + o); *(f32x4*)(Xo + o) = xv * alpha + g4[bj][n] * acc[ai][bj][m][n]; }
                asm volatile("" ::: "memory"); }
    }
};
struct EpiSwiGLU {
    static constexpr bool PERM = true;
    bf16_t* H;
    __device__ __forceinline__ void operator()(const f32x4 (&acc)[2][2][4][2], const Unit& u, int wr, int wc, int fr, int fq) const {
        asm volatile("" : "+v"(fr), "+v"(fq));
        const int row0 = u.pm * BM + wr * 64 + fr, col0 = u.pn * HALF + wc * 32 + 8 * fq;
#pragma unroll
        for (int ai = 0; ai < 2; ++ai)
#pragma unroll
            for (int m = 0; m < 4; ++m) { f32x4 h0, h1;
#pragma unroll
                for (int e = 0; e < 4; ++e) { const float g0 = acc[ai][0][m][0][e], g1 = acc[ai][0][m][1][e]; h0[e] = g0 * sigmoidf_(g0) * acc[ai][1][m][0][e]; h1[e] = g1 * sigmoidf_(g1) * acc[ai][1][m][1][e]; }
                u32x4 w; w.x = cvt_pk_bf16(h0[0], h0[1]); w.y = cvt_pk_bf16(h0[2], h0[3]); w.z = cvt_pk_bf16(h1[0], h1[1]); w.w = cvt_pk_bf16(h1[2], h1[3]);
                *(u32x4*)(H + (size_t)(row0 + ai * HALF + m * 16) * 512 + col0) = w; }
    }
};
}
#include <hip/hip_bf16.h>
#include <cmath>
namespace attn_body {
using bf16=__hip_bfloat16;
using bf16x8=__attribute__((ext_vector_type(8)))short;
using s16x4=__attribute__((ext_vector_type(4)))short;
using f32x16=__attribute__((ext_vector_type(16)))float;
using u32x4=__attribute__((ext_vector_type(4)))unsigned;
constexpr int BATCH=8,NHEAD=16,SEQ=4096,D=64,DM=NHEAD*D,OPITCH=2048;
constexpr int NW=8,QBLK=32,QB=QBLK*NW,KVBLK=64,NQB=SEQ/QB;
constexpr int ATTN_PITCH=DM, ATTN_UNIT_ROWS=QB;
__device__ __forceinline__ int crow(int r,int hi){return (r&3)+8*(r>>2)+4*hi;}
#define SBAR() __builtin_amdgcn_sched_barrier(0)
__device__ __forceinline__ void cmask(f32x16&p0,f32x16&p1,int jb,int qrel,int hi){
  const float NEG=-INFINITY; int kb=64*jb+4*hi;
  #pragma unroll
  for(int r=0;r<16;++r){int kv=kb+(r&3)+8*(r>>2); if(kv>qrel)p0[r]=NEG; if(kv+32>qrel)p1[r]=NEG;}
}

constexpr int NSLOT=3, SLOTB=8192;
constexpr int LDS_K=0, LDS_V=NSLOT*SLOTB, LDS_WS=3*NSLOT*SLOTB, LDS_OST=LDS_WS+NW*64*4, LDS_BYTES=LDS_OST+NW*4096;
constexpr float C2=0.125f*1.4426950408889634f;
__device__ __forceinline__ void glds16s(const void*sbase,unsigned voff,unsigned lds_dst){unsigned keep;
  asm volatile("s_mov_b32 %0, m0\n\ts_mov_b32 m0, %2\n\ts_nop 0\n\tglobal_load_lds_dwordx4 %1, %3\n\ts_mov_b32 m0, %0":"=&s"(keep):"v"(voff),"s"(lds_dst),"s"(sbase):"memory");}
__device__ __forceinline__ void glds16(const void*gsrc,unsigned lds_dst){unsigned keep;
  asm volatile("s_mov_b32 %0, m0\n\ts_mov_b32 m0, %2\n\ts_nop 0\n\tglobal_load_lds_dwordx4 %1, off\n\ts_mov_b32 m0, %0":"=&s"(keep):"v"(gsrc),"s"(lds_dst):"memory");}
__device__ __forceinline__ float max3f(float a,float b,float c){float r;asm("v_max3_f32 %0, %1, %2, %3":"=v"(r):"v"(a),"v"(b),"v"(c));return r;}
__device__ __forceinline__ float max2f(float a,float b){float r;asm("v_max_f32_e32 %0, %1, %2":"=v"(r):"v"(a),"v"(b));return r;}
__device__ __forceinline__ float fadd_s(float a,float b){float r;asm("v_add_f32_e32 %0, %1, %2":"=v"(r):"v"(a),"v"(b));return r;}
__device__ __forceinline__ float fsub_s(float a,float b){float r;asm("v_sub_f32_e32 %0, %1, %2":"=v"(r):"v"(a),"v"(b));return r;}
typedef float f32x2_t __attribute__((ext_vector_type(2))); typedef __bf16 bf16x2_t __attribute__((ext_vector_type(2)));
__device__ __forceinline__ unsigned cvtpk_s(float lo,float hi){f32x2_t v={lo,hi};bf16x2_t b=__builtin_convertvector(v,bf16x2_t);return __builtin_bit_cast(unsigned,b);}
#define WAIT_BAR(N) asm volatile("s_waitcnt vmcnt(" #N ") lgkmcnt(0)\n\ts_barrier":::"memory")

__device__ __forceinline__ void qkt(f32x16&p0,f32x16&p1,const char*Kslot,const bf16x8*qr,const f32x16&c0,const f32x16&c1,int r32,int hi){
  const char*kb=Kslot+hi*1024+r32*16;
  #pragma unroll
  for(int d0=0;d0<4;++d0){
    const bf16x8 b0=*reinterpret_cast<const bf16x8*>(kb+d0*2048);
    const bf16x8 b1=*reinterpret_cast<const bf16x8*>(kb+d0*2048+512);
    if(d0==0){p0=__builtin_amdgcn_mfma_f32_32x32x16_bf16(b0,qr[0],c0,0,0,0);p1=__builtin_amdgcn_mfma_f32_32x32x16_bf16(b1,qr[0],c1,0,0,0);}
    else{p0=__builtin_amdgcn_mfma_f32_32x32x16_bf16(b0,qr[d0],p0,0,0,0);p1=__builtin_amdgcn_mfma_f32_32x32x16_bf16(b1,qr[d0],p1,0,0,0);}}
}
typedef __attribute__((address_space(3))) const char* lds_cptr;
typedef short v4i16_t __attribute__((ext_vector_type(4)));
__device__ __forceinline__ void kload8(bf16x8*kf,lds_cptr kp){
  kf[0]=*(const __attribute__((address_space(3))) bf16x8*)(kp);      kf[1]=*(const __attribute__((address_space(3))) bf16x8*)(kp+512);
  kf[2]=*(const __attribute__((address_space(3))) bf16x8*)(kp+2048); kf[3]=*(const __attribute__((address_space(3))) bf16x8*)(kp+2560);
  kf[4]=*(const __attribute__((address_space(3))) bf16x8*)(kp+4096); kf[5]=*(const __attribute__((address_space(3))) bf16x8*)(kp+4608);
  kf[6]=*(const __attribute__((address_space(3))) bf16x8*)(kp+6144); kf[7]=*(const __attribute__((address_space(3))) bf16x8*)(kp+6656);
}
__device__ __forceinline__ void kload2(bf16x8*kf,lds_cptr kp,int j){ kf[2*j]=*(const __attribute__((address_space(3))) bf16x8*)(kp+j*2048); kf[2*j+1]=*(const __attribute__((address_space(3))) bf16x8*)(kp+j*2048+512); }
__device__ __forceinline__ s16x4 vtr(lds_cptr p){ return __builtin_bit_cast(s16x4,__builtin_amdgcn_ds_read_tr16_b64_v4i16((__attribute__((address_space(3))) v4i16_t*)p)); }
__device__ __forceinline__ float rowmax(const f32x16&p0,const f32x16&p1){
  float a=max3f(p0[0],p0[1],p1[0]),b=max3f(p0[2],p0[3],p1[1]);a=max3f(a,p1[2],p1[3]);
  #pragma unroll
  for(int r=4;r<16;r+=4){a=max3f(a,p0[r],p0[r+1]);b=max3f(b,p0[r+2],p0[r+3]);a=max3f(a,p1[r],p1[r+1]);b=max3f(b,p1[r+2],p1[r+3]);}
  const float m=max2f(a,b);
  auto rr=__builtin_amdgcn_permlane32_swap(__float_as_uint(m),__float_as_uint(m),false,false);
  return max2f(__uint_as_float(rr[0]),__uint_as_float(rr[1]));
}
__device__ __forceinline__ void pv(f32x16*o,int vb,bf16x8 pa0,bf16x8 pa1,bf16x8 pa2,bf16x8 pa3){
  #pragma unroll
  for(int d0=0;d0<4;++d0){s16x4 lo[4],hi[4];
    #pragma unroll
    for(int ks=0;ks<4;++ks){
      asm volatile("ds_read_b64_tr_b16 %0,%1 offset:%c2":"=&v"(lo[ks]):"v"(vb),"i"(d0*4096+ks*1024):"memory");
      asm volatile("ds_read_b64_tr_b16 %0,%1 offset:%c2":"=&v"(hi[ks]):"v"(vb),"i"(d0*4096+ks*1024+512):"memory");}
    asm volatile("s_waitcnt lgkmcnt(0)":::"memory");SBAR();
    #define PK(k) (bf16x8){lo[k][0],lo[k][1],lo[k][2],lo[k][3],hi[k][0],hi[k][1],hi[k][2],hi[k][3]}
    o[d0]=__builtin_amdgcn_mfma_f32_32x32x16_bf16(pa0,PK(0),o[d0],0,0,0);
    o[d0]=__builtin_amdgcn_mfma_f32_32x32x16_bf16(pa1,PK(1),o[d0],0,0,0);
    o[d0]=__builtin_amdgcn_mfma_f32_32x32x16_bf16(pa2,PK(2),o[d0],0,0,0);
    o[d0]=__builtin_amdgcn_mfma_f32_32x32x16_bf16(pa3,PK(3),o[d0],0,0,0);
    #undef PK
  }
}

#ifndef ATTN_STORE16
#define ATTN_STORE16(p,v) (*(u32x4*)(p)=(v))
#endif
template<int THRL> __device__ __forceinline__ void attn_unit(int b,int hq,int hv,int ocol,int qb,int nfar,float sl2,const bf16*Q,const bf16*__restrict__ K,const bf16*__restrict__ V,bf16*O,char*shm){
  int tid_=threadIdx.x; asm volatile("":"+v"(tid_));
  const int tid=tid_,lane=tid&63,r32=lane&31,hi=lane>>5; const int wid=__builtin_amdgcn_readfirstlane(tid>>6);
  const long rowbase=(long)b*SEQ; const int q0=qb*QB;
  const bf16*Qw=Q+(rowbase+q0+wid*QBLK)*DM+hq*D;
  const int NTf=(q0+QB)/KVBLK, NT=(NTf<4+nfar)?NTf:4+nfar, t0=NTf-NT, q0c=q0-64*t0;
  const bf16*Kh=K+(rowbase+64*t0)*DM+hq*D,*Vh=V+(rowbase+64*t0)*DM+hv*D;
  const unsigned lds0=(unsigned)(uintptr_t)shm;
  float*wsf=(float*)(shm+LDS_WS)+wid*64;
  const unsigned kvoff=(unsigned)(lane*DM+wid*8)*2u;
  const unsigned vvoff=(unsigned)((16*(wid&3)+(lane>>2))*DM+(wid>>2)*32+(lane&3)*8)*2u;
  const unsigned kdst=lds0+LDS_K+wid*1024, vdst=lds0+LDS_V+wid*1024;
  #define DMA_K(t,slot) glds16s(Kh+(long)(t)*KVBLK*DM,kvoff,(unsigned)__builtin_amdgcn_readfirstlane(kdst+(slot)))
  #define DMA_V(t,slot) do{ glds16s(Vh+(long)(t)*KVBLK*DM,vvoff,(unsigned)__builtin_amdgcn_readfirstlane(vdst+2*(slot))); glds16s(Vh+(long)(t)*KVBLK*DM+64,vvoff,(unsigned)__builtin_amdgcn_readfirstlane(vdst+2*(slot)+8192)); }while(0)
  const int vb0=(int)(lds0+LDS_V)+((lane>>4)&1)*32+(lane&3)*8+(4*hi+((lane&15)>>2))*64;
  const char*Kbase=shm+LDS_K; bf16x8 kf[8];
  const lds_cptr shm3=(lds_cptr)shm; const lds_cptr kp0=shm3+LDS_K+hi*1024+r32*16; const lds_cptr vp0=shm3+LDS_V+((lane>>4)&1)*32+(lane&3)*8+(4*hi+((lane&15)>>2))*64;
  DMA_K(0,0);DMA_V(0,0);DMA_K(1,SLOTB);
  bf16x8 qr[4];
  #pragma unroll
  for(int d0=0;d0<4;++d0)qr[d0]=*reinterpret_cast<const bf16x8*>(&Qw[(long)r32*DM+d0*16+hi*8]);
  float mhat=0.f,l_reg=0.f;f32x16 o[4];o[0]=f32x16{};o[1]=f32x16{};o[2]=f32x16{};o[3]=f32x16{};
  #define CINIT0(C0_,t_) do{ const float bt_=sl2*(float)(64*(t_)-q0c+4*hi)-mhat; _Pragma("unroll") for(int r=0;r<16;++r){C0_[r]=__builtin_fmaf(sl2,(float)((r&3)+8*(r>>2)),bt_);} }while(0)
  #define CINIT1(C1_,t_) do{ const float bt_=sl2*(float)(64*(t_)-q0c+4*hi)-mhat; _Pragma("unroll") for(int r=0;r<16;++r){C1_[r]=__builtin_fmaf(sl2,(float)((r&3)+8*(r>>2)+32),bt_);} }while(0)
  #define CINIT(C0_,C1_,t_) do{ CINIT0(C0_,t_); CINIT1(C1_,t_); }while(0)
  const int qrel=wid*QBLK+r32;
  #define CMASK(P0,P1,t) do{int jb_=(t)-(NT-4); if(jb_>=0)cmask(P0,P1,jb_,qrel,hi);}while(0)
  bool resc=false;
  #define START(P0,P1) do{ const float rm=rowmax(P0,P1); resc=false; \
    { const float dl=rm; mhat=fadd_s(mhat,dl); \
      _Pragma("unroll") for(int r=0;r<16;++r){P0[r]=fsub_s(P0[r],dl);P1[r]=fsub_s(P1[r],dl);} } \
    _Pragma("unroll") for(int r=0;r<16;++r)P0[r]=__builtin_amdgcn_exp2f(P0[r]); }while(0)
  #define RESC() do{ if(resc){ asm volatile("s_waitcnt lgkmcnt(0)":::"memory"); \
      _Pragma("unroll") for(int d_=0;d_<4;++d_) _Pragma("unroll") for(int r=0;r<16;++r)o[d_][r]*=wsf[crow(r,hi)]; } }while(0)
  f32x16 pA0,pA1,pB0,pB1;
  int sl_prev=0,sl_cur=0,sl_next=SLOTB;
  #define ROT() do{sl_prev=sl_cur;sl_cur=sl_next;sl_next=(sl_next==(NSLOT-1)*SLOTB)?0:sl_next+SLOTB;}while(0)
  DMA_K(2,2*SLOTB);
  WAIT_BAR(4);
  { f32x16 c0_,c1_; CINIT(c0_,c1_,0); qkt(pA0,pA1,Kbase,qr,c0_,c1_,r32,hi); } asm volatile("s_nop 15\n\ts_nop 7":"+v"(pA0),"+v"(pA1));CMASK(pA0,pA1,0);
  START(pA0,pA1);
  _Pragma("unroll") for(int r=0;r<16;++r)pA1[r]=__builtin_amdgcn_exp2f(pA1[r]);
  WAIT_BAR(0);
  DMA_K(3,0);DMA_V(1,SLOTB);
  ROT();
  kload8(kf,kp0+sl_cur);
  WAIT_BAR(3);
  s16x4 vlo[8],vhi[8]; u32x4 pw0,pw1,pw2,pw3;
  #define PKW(P,B) cvtpk_s(P[B],P[B+1])
  #define PAF(k) __builtin_bit_cast(bf16x8,pw##k)
  #define VFR(i) (bf16x8){vlo[i][0],vlo[i][1],vlo[i][2],vlo[i][3],vhi[i][0],vhi[i][1],vhi[i][2],vhi[i][3]}
  #define PIN(x) asm volatile("":"+v"(x))
  #define MX3(a,b,c) __builtin_fmaxf(__builtin_fmaxf((a),(b)),(c))
  #define GAPA(MF,A0,A1,A2,A3,W0,W1,PW) do{ MF; sacc+=A0; sacc+=A1; sacc+=A2; sacc+=A3; PIN(sacc); W0; W1; PIN(PW); SBAR(); }while(0)
  #define EX(v) __builtin_amdgcn_exp2f(v)
  #define GAPB(MF,X,B) do{ MF; X[B]=EX(X[B]); X[B+1]=EX(X[B+1]); PIN(X); SBAR(); }while(0)
  #define VRD2(sl,fr) do{ vlo[sl]=vtr(vp_+(((fr)>>2)*4096+((fr)&3)*1024)); vhi[sl]=vtr(vp_+(((fr)>>2)*4096+((fr)&3)*1024+512)); SBAR(); }while(0)
  #define VRD(i) do{ vlo[i]=vtr(vp_+(((i)>>2)*4096+((i)&3)*1024)); vhi[i]=vtr(vp_+(((i)>>2)*4096+((i)&3)*1024+512)); }while(0)
  #define KRD(G,j) do{ if(G){ kload2(kf,kp0+sl_next,j); SBAR(); } }while(0)
  #define STEP(C0,C1,P0,P1,t,GK,GV,GL) do{ CINIT0(C0,t); SBAR(); \
    const lds_cptr vp_=vp0+2*sl_prev; \
    VRD(0); SBAR(); float sacc=(P0[0]+P0[1]); \
    GAPA(C0=__builtin_amdgcn_mfma_f32_32x32x16_bf16(kf[0],qr[0],C0,0,0,0), P0[2],P0[3],P0[4],P0[5],     pw0[0]=PKW(P0,0), pw0[1]=PKW(P0,2), pw0); \
    CINIT1(C1,t); VRD(4); SBAR(); GAPA(C1=__builtin_amdgcn_mfma_f32_32x32x16_bf16(kf[1],qr[0],C1,0,0,0), P0[6],P0[7],P0[8],P0[9],     pw0[2]=PKW(P0,4), pw0[3]=PKW(P0,6), pw0); \
    VRD(1); SBAR(); GAPA(C0=__builtin_amdgcn_mfma_f32_32x32x16_bf16(kf[2],qr[1],C0,0,0,0),   P0[10],P0[11],P0[12],P0[13], pw1[0]=PKW(P0,8), pw1[1]=PKW(P0,10), pw1); \
    VRD(5); SBAR(); GAPA(C1=__builtin_amdgcn_mfma_f32_32x32x16_bf16(kf[3],qr[1],C1,0,0,0),   P0[14],P0[15],P1[0],P1[1],   pw1[2]=PKW(P0,12),pw1[3]=PKW(P0,14), pw1); \
    VRD(2); SBAR(); GAPA(C0=__builtin_amdgcn_mfma_f32_32x32x16_bf16(kf[4],qr[2],C0,0,0,0),   P1[2],P1[3],P1[4],P1[5],     pw2[0]=PKW(P1,0), pw2[1]=PKW(P1,2), pw2); \
    VRD(6); SBAR(); GAPA(C1=__builtin_amdgcn_mfma_f32_32x32x16_bf16(kf[5],qr[2],C1,0,0,0),   P1[6],P1[7],P1[8],P1[9],     pw2[2]=PKW(P1,4), pw2[3]=PKW(P1,6), pw2); \
    VRD(3); SBAR(); GAPA(C0=__builtin_amdgcn_mfma_f32_32x32x16_bf16(kf[6],qr[3],C0,0,0,0),   P1[10],P1[11],P1[12],P1[13], pw3[0]=PKW(P1,8), pw3[1]=PKW(P1,10), pw3); \
    VRD(7); SBAR(); GAPA(C1=__builtin_amdgcn_mfma_f32_32x32x16_bf16(kf[7],qr[3],C1,0,0,0),   P1[14],P1[15],0.f,0.f,       pw3[2]=PKW(P1,12),pw3[3]=PKW(P1,14), pw3); \
    l_reg+=sacc; \
    if(GK){DMA_K((t)+3,sl_cur);} if(GV){DMA_V((t)+1,sl_next);} \
    CMASK(C0,C1,t); \
    { float a=MX3(C0[0],C0[1],C1[0]),b=MX3(C0[2],C0[3],C1[1]); a=MX3(a,C1[2],C1[3]); \
      _Pragma("unroll") for(int r=4;r<16;r+=4){a=MX3(a,C0[r],C0[r+1]);b=MX3(b,C0[r+2],C0[r+3]);a=MX3(a,C1[r],C1[r+1]);b=MX3(b,C1[r+2],C1[r+3]);} \
      float rm=__builtin_fmaxf(a,b); { auto rr=__builtin_amdgcn_permlane32_swap(__float_as_uint(rm),__float_as_uint(rm),false,false); rm=__builtin_fmaxf(__uint_as_float(rr[0]),__uint_as_float(rr[1])); } \
      resc=false; \
      if(__builtin_expect(__any(rm>(float)THRL),0)){ const float dl=__builtin_fmaxf(rm,0.f); mhat+=dl; \
        _Pragma("unroll") for(int r=0;r<16;++r){C0[r]-=dl;C1[r]-=dl;} \
        const float f=__builtin_amdgcn_exp2f(-dl); l_reg*=f; if(hi==0)wsf[r32]=f; resc=true; } } \
    SBAR(); \
    GAPB(o[0]=__builtin_amdgcn_mfma_f32_32x32x16_bf16(PAF(0),VFR(0),o[0],0,0,0), C0,0);  VRD2(0,8); \
    GAPB(o[1]=__builtin_amdgcn_mfma_f32_32x32x16_bf16(PAF(0),VFR(4),o[1],0,0,0), C0,2);  VRD2(4,12); \
    KRD(GL,0); GAPB(o[0]=__builtin_amdgcn_mfma_f32_32x32x16_bf16(PAF(1),VFR(1),o[0],0,0,0), C0,4);  VRD2(1,9); \
    KRD(GL,1); GAPB(o[1]=__builtin_amdgcn_mfma_f32_32x32x16_bf16(PAF(1),VFR(5),o[1],0,0,0), C0,6);  VRD2(5,13); \
    KRD(GL,2); GAPB(o[0]=__builtin_amdgcn_mfma_f32_32x32x16_bf16(PAF(2),VFR(2),o[0],0,0,0), C0,8);  VRD2(2,10); \
    KRD(GL,3); GAPB(o[1]=__builtin_amdgcn_mfma_f32_32x32x16_bf16(PAF(2),VFR(6),o[1],0,0,0), C0,10); VRD2(6,14); \
    GAPB(o[0]=__builtin_amdgcn_mfma_f32_32x32x16_bf16(PAF(3),VFR(3),o[0],0,0,0), C0,12); VRD2(3,11); \
    GAPB(o[1]=__builtin_amdgcn_mfma_f32_32x32x16_bf16(PAF(3),VFR(7),o[1],0,0,0), C0,14); VRD2(7,15); \
    GAPB(o[2]=__builtin_amdgcn_mfma_f32_32x32x16_bf16(PAF(0),VFR(0),o[2],0,0,0), C1,0); \
    GAPB(o[3]=__builtin_amdgcn_mfma_f32_32x32x16_bf16(PAF(0),VFR(4),o[3],0,0,0), C1,2); \
    GAPB(o[2]=__builtin_amdgcn_mfma_f32_32x32x16_bf16(PAF(1),VFR(1),o[2],0,0,0), C1,4); \
    GAPB(o[3]=__builtin_amdgcn_mfma_f32_32x32x16_bf16(PAF(1),VFR(5),o[3],0,0,0), C1,6); \
    GAPB(o[2]=__builtin_amdgcn_mfma_f32_32x32x16_bf16(PAF(2),VFR(2),o[2],0,0,0), C1,8); \
    GAPB(o[3]=__builtin_amdgcn_mfma_f32_32x32x16_bf16(PAF(2),VFR(6),o[3],0,0,0), C1,10); \
    GAPB(o[2]=__builtin_amdgcn_mfma_f32_32x32x16_bf16(PAF(3),VFR(3),o[2],0,0,0), C1,12); \
    GAPB(o[3]=__builtin_amdgcn_mfma_f32_32x32x16_bf16(PAF(3),VFR(7),o[3],0,0,0), C1,14); \
    }while(0)
  int t=1;
  #undef CMASK
  #define CMASK(P0,P1,t) do{}while(0)
  for(;t+5<NT;t+=2){
    STEP(pB0,pB1,pA0,pA1,t,true,true,true);     WAIT_BAR(3); RESC(); ROT();
    STEP(pA0,pA1,pB0,pB1,t+1,true,true,true);   WAIT_BAR(3); RESC(); ROT();
  }
  #undef CMASK
  #define CMASK(P0,P1,t) do{int jb_=(t)-(NT-4); if(jb_>=0)cmask(P0,P1,jb_,qrel,hi);}while(0)
  #define ENDW(tt) do{ if((tt)+3<NT){WAIT_BAR(3);} else if((tt)+2<NT){WAIT_BAR(2);} else {WAIT_BAR(0);} }while(0)
  for(;t+1<NT;t+=2){
    STEP(pB0,pB1,pA0,pA1,t,(t+3<NT),(t+1<NT),(t+1<NT));       ENDW(t);   RESC(); ROT();
    STEP(pA0,pA1,pB0,pB1,t+1,(t+4<NT),(t+2<NT),(t+2<NT));     ENDW(t+1); RESC(); ROT();
  }
  STEP(pB0,pB1,pA0,pA1,NT-1,false,false,false); RESC();
  { float sacc=pB0[0]+pB0[1]; _Pragma("unroll") for(int r=2;r<16;++r)sacc+=pB0[r]; _Pragma("unroll") for(int r=0;r<16;++r)sacc+=pB1[r]; l_reg+=sacc;
    pw0=(u32x4){PKW(pB0,0),PKW(pB0,2),PKW(pB0,4),PKW(pB0,6)};pw1=(u32x4){PKW(pB0,8),PKW(pB0,10),PKW(pB0,12),PKW(pB0,14)};pw2=(u32x4){PKW(pB1,0),PKW(pB1,2),PKW(pB1,4),PKW(pB1,6)};pw3=(u32x4){PKW(pB1,8),PKW(pB1,10),PKW(pB1,12),PKW(pB1,14)};
    SBAR(); pv(o,vb0+2*sl_cur,PAF(0),PAF(1),PAF(2),PAF(3)); }
  #undef PKW
  #undef PAF
  #undef VFR
  #undef PIN
  #undef MX3
  #undef GAPA
  #undef GAPB
  #undef EX
  #undef VRD
  #undef VRD2
  #undef KRD
  #undef STEP
  #undef ENDW
  {auto rr=__builtin_amdgcn_permlane32_swap(__float_as_uint(l_reg),__float_as_uint(l_reg),false,false);l_reg=__uint_as_float(rr[0])+__uint_as_float(rr[1]);}
  if(hi==0)wsf[32+r32]=l_reg;asm volatile("s_waitcnt lgkmcnt(0)":::"memory");
  float rli[16];
  #pragma unroll
  for(int r=0;r<16;++r)rli[r]=__builtin_amdgcn_rcpf(wsf[32+crow(r,hi)]);
  bf16*Ow=O+(rowbase+q0+wid*QBLK)*OPITCH+ocol;
  { bf16*stg=(bf16*)(shm+LDS_OST)+wid*2048;
    int ln2_=lane; asm volatile("":"+v"(ln2_));
    #pragma unroll
    for(int hf=0;hf<2;++hf){
      #pragma unroll
      for(int r=0;r<16;++r){const int orow=crow(r,hi);
        #pragma unroll
        for(int d0=0;d0<2;++d0)stg[orow*64+d0*32+r32]=__float2bfloat16(o[2*hf+d0][r]*rli[r]);}
      asm volatile("s_waitcnt lgkmcnt(0)":::"memory");
      #pragma unroll
      for(int i=0;i<4;++i){const int row=i*8+(ln2_>>3),ch=ln2_&7; const u32x4 v=*(const u32x4*)(stg+row*64+ch*8); ATTN_STORE16(Ow+(long)row*OPITCH+hf*64+ch*8,v);}
      asm volatile("s_waitcnt lgkmcnt(0)":::"memory"); } }
  asm volatile("s_waitcnt lgkmcnt(0)\n\ts_barrier":::"memory");
  #undef DMA_K
  #undef DMA_V
  #undef CMASK
  #undef CINIT
  #undef CINIT0
  #undef CINIT1
  #undef START
  #undef RESC
  #undef ROT
}
constexpr int ATTN_LDS_BYTES=LDS_BYTES;
struct AttnTensors { const bf16* Q; const bf16* K; const bf16* V; bf16* O; };
template<int THRL=8> __device__ __forceinline__ void attn_phase(char*lds,const AttnTensors&T,unsigned*qw,volatile __attribute__((address_space(3))) unsigned*qs){
  for(;;){
    if(threadIdx.x==0) qs[0]=__hip_atomic_fetch_add(qw,2u,__ATOMIC_RELAXED,__HIP_MEMORY_SCOPE_AGENT);
    __syncthreads();
    const int idx0=__builtin_amdgcn_readfirstlane((int)qs[0]);
    __syncthreads();
    if(idx0>=2048)break;
    for(int idx=idx0;idx<idx0+2;++idx){
      const int c=idx&1,b=(idx>>1)&7,h=7-((idx>>4)&7),qb=15-(idx>>7);
      const float sl2=__uint_as_float(__builtin_amdgcn_readfirstlane(__float_as_uint(__builtin_amdgcn_exp2f(-(float)(h+1))*1.4426950408889634f)));
      const int nfar=(h==0)?6:(h==1)?10:(h==2)?20:(h==3)?38:64;
      attn_unit<THRL>(b,2*h+c,2*h,c*1024+h*128,qb,nfar,sl2,T.Q,T.K,T.V,T.O,lds);
    }
  }
}
#undef SBAR
#undef WAIT_BAR
}
#define GAS __attribute__((address_space(1)))
#define LAS __attribute__((address_space(3)))
typedef unsigned short bf16;
typedef unsigned v4u __attribute__((ext_vector_type(4)));
typedef float f32x4 __attribute__((ext_vector_type(4)));
typedef short bf16x8 __attribute__((ext_vector_type(8)));
typedef GAS unsigned gu32;
typedef GAS unsigned long long gu64;
#define RLX_AGENT __ATOMIC_RELAXED, __HIP_MEMORY_SCOPE_AGENT
#define LDS_WAIT() asm volatile("s_waitcnt lgkmcnt(0)" ::: "memory")
#define VM_WAIT() asm volatile("s_waitcnt vmcnt(0)" ::: "memory")
__device__ __forceinline__ unsigned long long rt() { return __builtin_amdgcn_s_memrealtime(); }
__device__ __forceinline__ unsigned f2bf(float f) { unsigned u = __builtin_bit_cast(unsigned, f); return (u + 0x7fffu + ((u >> 16) & 1u)) >> 16; }
__device__ __forceinline__ unsigned pk2(float lo, float hi) { return f2bf(lo) | (f2bf(hi) << 16); }

#define XB_TMO      128
#define XB_XCNT(j)  (256  + 64 * (j))
#define XB_XSUB(j)  (1280 + 64 * (j))
#define XB_XGEN(j)  (2304 + 64 * (j))
#define XB_TOP      3328
#define XB_TOPGEN   3392
#define XCD_BAR_WORDS 3456
#define XB_SPIN_CAP (1u << 18)

__device__ __forceinline__ unsigned xb_ld(unsigned* p)              { return __hip_atomic_load(p, __ATOMIC_RELAXED, __HIP_MEMORY_SCOPE_AGENT); }
__device__ __forceinline__ unsigned xb_add(unsigned* p, unsigned v) { return __hip_atomic_fetch_add(p, v, __ATOMIC_RELAXED, __HIP_MEMORY_SCOPE_AGENT); }
__device__ __forceinline__ unsigned xb_xcc_id() { return (unsigned)__builtin_amdgcn_s_getreg((3 << 11) | 20) & 0xFu; }
#define XB_SPIN(cond, bar) do { unsigned _sp = 0; while (cond) { __builtin_amdgcn_s_sleep(1); \
    if ((++_sp & 255u) == 0u) { if (xb_ld(&(bar)[XB_TMO])) break; if (_sp > XB_SPIN_CAP) { atomicAdd(&(bar)[XB_TMO], 1u); break; } } } } while (0)

struct XcdBarrier {
    unsigned* bar; unsigned x;
    volatile LAS unsigned* st;
};

__device__ __forceinline__ XcdBarrier xcd_barrier_post(unsigned* bar, volatile LAS unsigned* st) {
    XcdBarrier b; b.bar = bar; b.x = xb_xcc_id(); b.st = st;
    if (threadIdx.x == 0) (void)xb_add(&bar[XB_XCNT(b.x)], 1u);
    return b;
}
__device__ __forceinline__ void xcd_barrier_complete(unsigned* bar, unsigned x, unsigned& nloc, unsigned& nx) {
    const unsigned G = gridDim.x * gridDim.y * gridDim.z;
    unsigned sum, cnt, mine, sp = 0u;
    for (;;) {
        sum = 0u; cnt = 0u; mine = 0u;
#pragma unroll
        for (unsigned j = 0; j < 16; ++j) { const unsigned c = xb_ld(&bar[XB_XCNT(j)]); sum += c; cnt += (c > 0u) ? 1u : 0u; mine = (j == x) ? c : mine; }
        if (sum == G) break;
        __builtin_amdgcn_s_sleep(1);
        if ((++sp & 255u) == 0u) { if (xb_ld(&bar[XB_TMO])) break; if (sp > XB_SPIN_CAP) { atomicAdd(&bar[XB_TMO], 1u); break; } }
    }
    nloc = mine > 0u ? mine : 1u; nx = cnt > 0u ? cnt : 1u;
}

__device__ __forceinline__ void xcd_barrier(const XcdBarrier& b) {
    asm volatile("s_waitcnt vmcnt(0)" ::: "memory");
    __syncthreads();
    if (threadIdx.x == 0) {
        unsigned* bar = b.bar;
        __builtin_amdgcn_s_waitcnt(0);
        unsigned nloc = b.st[0], nx = b.st[1];
        if (nloc == 0u) { xcd_barrier_complete(bar, b.x, nloc, nx); b.st[0] = nloc; b.st[1] = nx; }
        const unsigned old = xb_add(&bar[XB_XSUB(b.x)], 1u);
        const unsigned gen = old / nloc;
        if (old + 1u == (gen + 1u) * nloc) {
            __builtin_amdgcn_fence(__ATOMIC_RELEASE, "agent");
            asm volatile("s_waitcnt vmcnt(0)" ::: "memory");
            const unsigned og = xb_add(&bar[XB_TOP], 1u);
            const unsigned tg = og / nx;
            if (og + 1u == (tg + 1u) * nx) xb_add(&bar[XB_TOPGEN], 1u);
            else XB_SPIN(xb_ld(&bar[XB_TOPGEN]) == tg, bar);
            __builtin_amdgcn_fence(__ATOMIC_ACQUIRE, "agent");
            xb_add(&bar[XB_XGEN(b.x)], 1u);
            asm volatile("s_waitcnt vmcnt(0)" ::: "memory");
        } else {
            XB_SPIN(xb_ld(&bar[XB_XGEN(b.x)]) == gen, bar);
            __builtin_amdgcn_fence(__ATOMIC_ACQUIRE, "agent");
            asm volatile("s_waitcnt vmcnt(0)" ::: "memory");
        }
    }
    __syncthreads();
}
constexpr int NWAVES = 8, NTHREADS = 512;
constexpr int BATCH = 8, SEQ = 4096, DM = 1024, NTOK = BATCH * SEQ, DEPTH = 4;
constexpr int DIN = 8208, NPROJ = 8192;
constexpr int NEXP = 32, DEXP = 512, LISTCAP = 32768, MOE_MAXT = 288;
constexpr float LN_EPS = 1e-5f, DN_ALPHA = 1.6817928305074292f;
constexpr size_t MiB = 1u << 20;
constexpr size_t WS_CTL = 0, CTL_ZERO_BYTES = 1 * MiB;
constexpr size_t WS_ADA = 1 * MiB;
constexpr size_t WS_ABWT = 2 * MiB;
constexpr size_t WS_RWT = 2 * MiB + 256 * 1024;
constexpr size_t WS_TOKINFO = 3 * MiB;
constexpr size_t WS_LIST = 4 * MiB;
constexpr size_t WS_SSQ = 8 * MiB;
constexpr size_t WS_PRM = 16 * MiB;
constexpr int PO_BGATES = 0, PO_WALPHA = 8192, PO_BALPHA = 40960, PO_LQ1 = 43008, PO_LK1 = 43264, PO_LQ2 = 43520, PO_LK2 = 43776, PO_DIFFG = 44032, PO_GLAG = 44544,
              PO_LN1G = 45568, PO_LN1B = 49664, PO_BRG = 53760, PO_BRE = 53776, PO_LN2G = 53904, PO_LN2B = 58000, PO_END = 62096;
constexpr size_t WS_WIN = 32 * MiB;
constexpr size_t WS_WBA = 96 * MiB, WS_WBB = 104 * MiB, WS_WOUT = 112 * MiB;
constexpr size_t WS_W1 = 120 * MiB;
constexpr size_t WS_WD = 376 * MiB;
constexpr size_t WS_U = 504 * MiB;
constexpr size_t WS_QB = 568 * MiB, WS_KB = 632 * MiB, WS_VB = 696 * MiB;
constexpr size_t WS_GQ = 760 * MiB, WS_GK = 792 * MiB;
constexpr size_t WS_GV = 824 * MiB, WS_SG = 888 * MiB;
constexpr size_t WS_GT = 952 * MiB;
constexpr size_t WS_LA = 1080 * MiB;
constexpr size_t WS_END = 1144 * MiB;
constexpr size_t WS_OB = WS_U;
constexpr size_t WS_OP = WS_GQ;
constexpr size_t WS_OA2 = WS_QB, WS_OB2 = WS_KB;
constexpr size_t WS_TMP = WS_VB, WS_MIX = WS_GQ;
constexpr size_t WS_H = WS_QB;
constexpr size_t WS_YB = WS_QB + 72 * MiB;
constexpr int CW_ATQ = 32768;
constexpr int CW_TMO = 0, CW_CODE = 1, CW_BAR = 4096, CW_CNT = 8192;
constexpr int RING_OFF = 0, RING_BYTES = 131072;
constexpr int LDSCTL_OFF = RING_BYTES, MISC_OFF = LDSCTL_OFF + 320;
constexpr int TAB_CNT = RING_BYTES + 512, TAB_BASE = RING_BYTES + 640, TAB_IDX = RING_BYTES + 1024, IDX_UNITS = 8;
constexpr int LDS_BYTES = 147456;
static_assert(TAB_IDX + IDX_UNITS * 256 * 4 <= LDS_BYTES, "LDS map");
struct Frame {
    LAS unsigned char* lds;
    gu32* ctl;
    int tid, lane, wave, vcu, G;
    float* out; unsigned char* ws; const float* prm;
    float* xst; bf16* Ubuf; float* LAbuf; int dry;
};
enum { I_X = 0, I_C, I_WADA, I_BADA, I_WIN, I_BGATES, I_WALPHA, I_BALPHA, I_LQ1, I_LK1, I_LQ2, I_LK2, I_DIFFG, I_GLAG, I_WBA, I_WBB, I_WOUT, I_LN1G, I_LN1B,
       I_WRG, I_BRG, I_WRE, I_BRE, I_WGE, I_WUE, I_WDE, I_LN2G, I_LN2B };
__device__ __forceinline__ float dpp_add(float v, const int ctrl_sel) {
    const int x = __float_as_int(v); int y;
    if (ctrl_sel == 0) y = __builtin_amdgcn_update_dpp(x, x, 0xB1, 0xF, 0xF, false);
    else if (ctrl_sel == 1) y = __builtin_amdgcn_update_dpp(x, x, 0x4E, 0xF, 0xF, false);
    else if (ctrl_sel == 2) y = __builtin_amdgcn_update_dpp(x, x, 0x141, 0xF, 0xF, false);
    else y = __builtin_amdgcn_update_dpp(x, x, 0x140, 0xF, 0xF, false);
    return v + __int_as_float(y);
}
__device__ __forceinline__ float wave_sum(float v) {
    v = dpp_add(v, 0); v = dpp_add(v, 1); v = dpp_add(v, 2); v = dpp_add(v, 3);
    { auto rr = __builtin_amdgcn_permlane16_swap(__float_as_uint(v), __float_as_uint(v), false, false); v = __uint_as_float(rr[0]) + __uint_as_float(rr[1]); }
    { auto rr = __builtin_amdgcn_permlane32_swap(__float_as_uint(v), __float_as_uint(v), false, false); v = __uint_as_float(rr[0]) + __uint_as_float(rr[1]); }
    return v;
}
__device__ __forceinline__ float siluf_(float x) { return x * __builtin_amdgcn_rcpf(1.0f + __expf(-x)); }
__device__ __forceinline__ float bflo(unsigned w) { return __uint_as_float(w << 16); }
__device__ __forceinline__ float bfhi(unsigned w) { return __uint_as_float(w & 0xffff0000u); }

__device__ __forceinline__ void p0_ada(Frame& F, const float* c, const float* wada, const float* bada) {
    LAS float* COND = (LAS float*)(F.lds);
    LAS float* PART = (LAS float*)(F.lds + 32768);
    float* ADA = (float*)(F.ws + WS_ADA);
    for (int i = F.tid; i < 8192; i += NTHREADS) COND[i] = siluf_(c[i]);
    __syncthreads();
    for (int cg = (int)blockIdx.x; cg < 256; cg += F.G) {
        const int l = cg >> 6, j0 = (cg & 63) * 96;
        const int col4 = F.lane % 24, ksub = F.lane / 24;
        f32x4 acc[8];
#pragma unroll
        for (int b = 0; b < 8; ++b) acc[b] = (f32x4){0.f, 0.f, 0.f, 0.f};
        if (ksub < 2) {
            const float* wp = wada + ((size_t)l * 1024 + (size_t)(F.wave * 128 + ksub)) * 6144 + j0 + 4 * col4;
#pragma unroll 8
            for (int kk = 0; kk < 64; ++kk) {
                const f32x4 wv = *(const GAS f32x4*)(wp + (size_t)kk * 2 * 6144); const int k = F.wave * 128 + 2 * kk + ksub;
#pragma unroll
                for (int b = 0; b < 8; ++b) acc[b] += wv * COND[b * 1024 + k];
            }
#pragma unroll
            for (int b = 0; b < 8; ++b) *(LAS f32x4*)(PART + ((F.wave * 2 + ksub) * 8 + b) * 96 + 4 * col4) = acc[b];
        }
        __syncthreads();
        for (int idx = F.tid; idx < 768; idx += NTHREADS) { const int b = idx / 96, col = idx % 96; float s = 0.f;
#pragma unroll
            for (int p = 0; p < 16; ++p) s += PART[(p * 8 + b) * 96 + col];
            ADA[((size_t)l * 8 + b) * 6144 + j0 + col] = s + bada[l * 6144 + j0 + col]; }
        __syncthreads();
    }
}
struct RmIdent { __device__ __forceinline__ int operator()(int n) const { return n; } };
struct RmWin { __device__ __forceinline__ int operator()(int n) const { return n < 6144 ? n : (n < 6160 ? -1 : n - 16); } };
struct RmGateUp { int up; __device__ __forceinline__ int operator()(int n) const { return (n >> 7) * 256 + up * 128 + (n & 127); } };
template <class RowMap>
__device__ __forceinline__ void p0_transpose_item(const float* W, int K, int N, bf16* WT, const RowMap rm, LAS float* scr, int kb, int nb, int lane) {
    const int k0 = 64 * kb, n0 = 32 * nb; const int nl = n0 + (lane & 31);
#pragma unroll 8
    for (int i = 0; i < 32; ++i) { const int kk = 2 * i + (lane >> 5); scr[kk * 33 + (lane & 31)] = (nl < N) ? W[(size_t)(k0 + kk) * N + nl] : 0.f; }
    LDS_WAIT(); asm volatile("" ::: "memory");
    const int c = lane & 7;
#pragma unroll
    for (int j = 0; j < 4; ++j) { const int nn = (lane >> 3) + 8 * j, n = n0 + nn; const LAS float* s = scr + (8 * c) * 33 + nn;
        v4u o; o.x = pk2(s[0 * 33], s[1 * 33]); o.y = pk2(s[2 * 33], s[3 * 33]); o.z = pk2(s[4 * 33], s[5 * 33]); o.w = pk2(s[6 * 33], s[7 * 33]);
        const int r = (n < N) ? rm(n) : -1;
        if (r >= 0) *(GAS v4u*)(WT + (size_t)r * K + k0 + 8 * c) = o; }
    LDS_WAIT(); asm volatile("" ::: "memory");
}
struct SmallPrm { const float *bgates, *walpha, *balpha, *lq1, *lk1, *lq2, *lk2, *diffg, *glag, *ln1g, *ln1b, *brg, *bre, *ln2g, *ln2b; };
__device__ __forceinline__ void p0_copy(float* dst, const float* src, int n, int gt, int NGT) { for (int i = gt; i < n; i += NGT) dst[i] = src[i]; }
__device__ __forceinline__ void p0_weights(Frame& F, const float* win, const float* wba, const float* wbb, const float* wout, const float* wge, const float* wue, const float* wde, const float* wrg, const float* wre, const SmallPrm sp) {
    LAS float* scr = (LAS float*)(F.lds + RING_OFF + F.wave * 16384);
    const int gw = F.vcu * NWAVES + F.wave, NGW = F.G * NWAVES;
    constexpr int I_IN = 4 * 16 * 257, I_SQ = 12 * 16 * 32, I_E = 128 * 16 * 16, I_D = 128 * 8 * 32;
    constexpr int NITEMS = I_IN + I_SQ + 2 * I_E + I_D;
    for (int it = gw; it < NITEMS; it += NGW) {
        int r = it;
        if (r < I_IN) { const int l = r / 4112, q = r % 4112;
            p0_transpose_item(win + (size_t)l * 1024 * DIN, 1024, DIN, (bf16*)(F.ws + WS_WIN) + (size_t)l * NPROJ * 1024, RmWin{}, scr, q / 257, q % 257, F.lane); continue; }
        r -= I_IN;
        if (r < I_SQ) { const int mat = r / 512, q = r % 512, which = mat >> 2, l = mat & 3;
            const float* W = (which == 0 ? wba : (which == 1 ? wbb : wout)) + (size_t)l * 1024 * 1024;
            bf16* WT = (bf16*)(F.ws + (which == 0 ? WS_WBA : (which == 1 ? WS_WBB : WS_WOUT))) + (size_t)l * 1024 * 1024;
            p0_transpose_item(W, 1024, 1024, WT, RmIdent{}, scr, q / 32, q % 32, F.lane); continue; }
        r -= I_SQ;
        if (r < 2 * I_E) { const int up = r >= I_E ? 1 : 0; if (up) r -= I_E; const int me = r / 256, q = r % 256;
            p0_transpose_item((up ? wue : wge) + (size_t)me * 1024 * 512, 1024, 512, (bf16*)(F.ws + WS_W1) + (size_t)me * 1024 * 1024, RmGateUp{up}, scr, q / 16, q % 16, F.lane); continue; }
        r -= 2 * I_E;
        { const int me = r / 256, q = r % 256;
          p0_transpose_item(wde + (size_t)me * 512 * 1024, 512, 1024, (bf16*)(F.ws + WS_WD) + (size_t)me * 1024 * 512, RmIdent{}, scr, q / 32, q % 32, F.lane); }
    }
    const int gt = F.vcu * NTHREADS + F.tid, NGT = F.G * NTHREADS;
    float* ABWT = (float*)(F.ws + WS_ABWT); float* RWT = (float*)(F.ws + WS_RWT);
    { float* P = (float*)(F.ws + WS_PRM);
      p0_copy(P + PO_BGATES, sp.bgates, 8192, gt, NGT); p0_copy(P + PO_WALPHA, sp.walpha, 32768, gt, NGT); p0_copy(P + PO_BALPHA, sp.balpha, 2048, gt, NGT);
      p0_copy(P + PO_LQ1, sp.lq1, 256, gt, NGT); p0_copy(P + PO_LK1, sp.lk1, 256, gt, NGT); p0_copy(P + PO_LQ2, sp.lq2, 256, gt, NGT); p0_copy(P + PO_LK2, sp.lk2, 256, gt, NGT);
      p0_copy(P + PO_DIFFG, sp.diffg, 512, gt, NGT); p0_copy(P + PO_GLAG, sp.glag, 1024, gt, NGT); p0_copy(P + PO_LN1G, sp.ln1g, 4096, gt, NGT); p0_copy(P + PO_LN1B, sp.ln1b, 4096, gt, NGT);
      p0_copy(P + PO_BRG, sp.brg, 16, gt, NGT); p0_copy(P + PO_BRE, sp.bre, 128, gt, NGT); p0_copy(P + PO_LN2G, sp.ln2g, 4096, gt, NGT); p0_copy(P + PO_LN2B, sp.ln2b, 4096, gt, NGT); }
    for (int i = gt; i < 4 * 16 * 1024; i += NGT) { const int l = i >> 14, r = (i >> 10) & 15, k = i & 1023; ABWT[i] = win[((size_t)l * 1024 + k) * DIN + 6144 + r]; }
    for (int i = gt; i < 4 * 36 * 1024; i += NGT) { const int l = i / 36864, c = (i / 1024) % 36, k = i & 1023;
        RWT[i] = (c < 4) ? wrg[((size_t)l * 1024 + k) * 4 + c] : wre[((size_t)l * 1024 + k) * 32 + (c - 4)]; }
}

typedef f32x4 Row4[4];
__device__ __forceinline__ void row_load(Row4& v, const float* p, int lane) { const GAS f32x4* q = (const GAS f32x4*)p + lane;
#pragma unroll
    for (int j = 0; j < 4; ++j) v[j] = q[64 * j]; }
__device__ __forceinline__ void row_store(const Row4& v, float* p, int lane) { GAS f32x4* q = (GAS f32x4*)p + lane;
#pragma unroll
    for (int j = 0; j < 4; ++j) q[64 * j] = v[j]; }
__device__ __forceinline__ void row_standardize(Row4& v) {
    float s = 0.f;
#pragma unroll
    for (int j = 0; j < 4; ++j) s += (v[j].x + v[j].y) + (v[j].z + v[j].w);
    const float mean = wave_sum(s) * (1.f / DM); float s2 = 0.f;
#pragma unroll
    for (int j = 0; j < 4; ++j) { v[j] = v[j] - mean; s2 += (v[j].x * v[j].x + v[j].y * v[j].y) + (v[j].z * v[j].z + v[j].w * v[j].w); }
    const float rstd = 1.f / sqrtf(wave_sum(s2) * (1.f / DM) + LN_EPS);
#pragma unroll
    for (int j = 0; j < 4; ++j) v[j] = v[j] * rstd;
}
__device__ __forceinline__ void row_affine(Row4& v, const float* g, const float* b, bool one_plus, int lane) {
    asm volatile("" : "+s"(g), "+s"(b));
#pragma unroll
    for (int j = 0; j < 4; ++j) { f32x4 gv = *((const GAS f32x4*)g + lane + 64 * j); const f32x4 bv = *((const GAS f32x4*)b + lane + 64 * j); if (one_plus) gv = gv + 1.0f; v[j] = v[j] * gv + bv; }
}
__device__ __forceinline__ void row_store_bf16(const Row4& v, bf16* p, int lane) { GAS unsigned long long* o8 = (GAS unsigned long long*)p + lane;
#pragma unroll
    for (int j = 0; j < 4; ++j) o8[64 * j] = (unsigned long long)pk2(v[j].x, v[j].y) | ((unsigned long long)pk2(v[j].z, v[j].w) << 32); }
__device__ __forceinline__ int idx16(int L) { return ((L >> 5) & 1) + 2 * ((L >> 4) & 1) + 4 * ((L >> 3) & 1) + 8 * ((L >> 2) & 1) + 16 * ((L >> 1) & 1) + 32 * (L & 1); }
__device__ __forceinline__ int idx4(int L) { return ((L >> 5) & 1) + 2 * ((L >> 4) & 1) + 4 * ((L >> 3) & 1) + 8 * ((L >> 2) & 1); }
template <int NC>
__device__ __forceinline__ float rows4_proj(const Row4 (&u)[4], const float* wT, int lane) {
    float p[4 * NC]; f32x4 wa[4], wb[4];
    asm volatile("" : "+s"(wT));
    const GAS f32x4* wp = (const GAS f32x4*)wT + lane;
#define R4_LDW(DD_, CC_) do { _Pragma("unroll") for (int j = 0; j < 4; ++j) DD_[j] = wp[(CC_) * 256 + 64 * j]; } while (0)
#define R4_DOT(WW_, CC_) do { _Pragma("unroll") for (int r = 0; r < 4; ++r) { pg8::f32x2 s_ = (pg8::f32x2){0.f, 0.f}; _Pragma("unroll") for (int j = 0; j < 4; ++j) { \
        s_ = __builtin_elementwise_fma((pg8::f32x2){u[r][j].x, u[r][j].y}, (pg8::f32x2){WW_[j].x, WW_[j].y}, s_); s_ = __builtin_elementwise_fma((pg8::f32x2){u[r][j].z, u[r][j].w}, (pg8::f32x2){WW_[j].z, WW_[j].w}, s_); } \
        p[r * NC + (CC_)] = s_.x + s_.y; } } while (0)
    R4_LDW(wa, 0);
#pragma unroll
    for (int c = 0; c < NC; c += 2) {
        R4_LDW(wb, c + 1); __builtin_amdgcn_sched_barrier(0);
        R4_DOT(wa, c);
        if (c + 2 < NC) R4_LDW(wa, c + 2);
        __builtin_amdgcn_sched_barrier(0);
        R4_DOT(wb, c + 1);
        __builtin_amdgcn_sched_barrier(0);
    }
#undef R4_LDW
#undef R4_DOT
    int V = 4 * NC;
#pragma unroll
    for (int M = 32; M >= 1; M >>= 1) {
        if (V > 1) { const bool bit = (lane & M) != 0;
#pragma unroll
            for (int i = 0; i < 32; ++i) if (i < V / 2) { const float a = p[2 * i], b = p[2 * i + 1]; const float send = bit ? a : b; const float recv = __shfl_xor(send, M); p[i] = (bit ? b : a) + recv; }
            V >>= 1; }
        else p[0] += __shfl_xor(p[0], M);
    }
    return p[0];
}
constexpr int WAL_OFF = 16384, BAL_OFF = 16384 + 32768;
__device__ __forceinline__ void load_walpha(Frame& F, int l) {
    const float* walpha_all = F.prm + PO_WALPHA; const float* balpha_all = F.prm + PO_BALPHA;
    LAS float* WAL = (LAS float*)(F.lds + RING_OFF + WAL_OFF); LAS float* BAL = (LAS float*)(F.lds + RING_OFF + BAL_OFF);
    for (int i = F.tid; i < 8192; i += NTHREADS) WAL[i] = walpha_all[(size_t)l * 8192 + i];
    if (F.tid < 512) BAL[F.tid] = balpha_all[l * 512 + F.tid];
    __syncthreads();
}
__device__ __forceinline__ void rows4_mod1(Frame& F, Row4 (&x)[4], int m0, int l, LAS float* scr, const float* pf) {
    const int b = m0 >> 12; const float* ada = (const float*)(F.ws + WS_ADA) + ((size_t)l * 8 + b) * 6144;
#pragma unroll
    for (int r = 0; r < 4; ++r) { row_standardize(x[r]); row_affine(x[r], ada + 1024, ada, true, F.lane); row_store_bf16(x[r], F.Ubuf + (size_t)(m0 + r) * 1024, F.lane); __builtin_amdgcn_sched_barrier(0); }
    const float abv = rows4_proj<16>(x, (const float*)(F.ws + WS_ABWT) + (size_t)l * 16 * 1024, F.lane);
    __builtin_amdgcn_sched_barrier(0);
    if (pf) {
#pragma unroll
        for (int r = 0; r < 4; ++r) row_load(x[r], pf + (size_t)r * 1024, F.lane); }
    __builtin_amdgcn_sched_barrier(0);
    scr[idx16(F.lane)] = abv;
    LDS_WAIT(); asm volatile("" ::: "memory");
    const LAS float* WAL = (const LAS float*)(F.lds + RING_OFF + WAL_OFF); const LAS float* BAL = (const LAS float*)(F.lds + RING_OFF + BAL_OFF); float* LA = F.LAbuf;
    asm volatile("" : "+s"(WAL), "+s"(BAL));
    float z[4][8];
#pragma unroll
    for (int i = 0; i < 8; ++i) { const float bb = BAL[F.lane + 64 * i];
#pragma unroll
        for (int r = 0; r < 4; ++r) z[r][i] = bb; }
#pragma unroll
    for (int rr = 0; rr < 16; ++rr) { float a[4];
#pragma unroll
        for (int r = 0; r < 4; ++r) a[r] = scr[r * 16 + rr];
#pragma unroll
        for (int i = 0; i < 8; ++i) { const float w_ = WAL[rr * 512 + F.lane + 64 * i];
#pragma unroll
            for (int r = 0; r < 4; ++r) z[r][i] += a[r] * w_; }
        __builtin_amdgcn_sched_barrier(0); }
#pragma unroll
    for (int r = 0; r < 4; ++r) {
#pragma unroll
        for (int i = 0; i < 8; ++i) { const float zz = z[r][i]; const float ls = fminf(zz, 0.f) - __logf(1.0f + __expf(-fabsf(zz)));
            LA[(size_t)(m0 + r) * 512 + F.lane + 64 * i] = __expf(ls * (1.0f / 16.0f)); }
        __builtin_amdgcn_sched_barrier(0); }
    LDS_WAIT(); asm volatile("" ::: "memory");
}
__device__ __forceinline__ void phase_r0(Frame& F, const float* xin) {
    LAS float* scr = (LAS float*)(F.lds + RING_OFF) + F.wave * 256;
    load_walpha(F, 0);
    const int gstep = F.G * NWAVES; int gi = F.vcu * NWAVES + F.wave; Row4 x[4];
    if (gi < NTOK / 4) {
#pragma unroll
        for (int r = 0; r < 4; ++r) row_load(x[r], xin + (size_t)(4 * gi + r) * 1024, F.lane); }
    for (; gi < NTOK / 4; gi += gstep) { const int m0 = 4 * gi;
#pragma unroll
        for (int r = 0; r < 4; ++r) row_store(x[r], F.xst + (size_t)(m0 + r) * 1024, F.lane);
        __builtin_amdgcn_sched_barrier(0);
        rows4_mod1(F, x, m0, 0, scr, (gi + gstep < NTOK / 4) ? xin + (size_t)(4 * (gi + gstep)) * 1024 : nullptr); }
}
__device__ __forceinline__ void phase_r1(Frame& F, int l) {
    LAS float* scr = (LAS float*)(F.lds + RING_OFF) + F.wave * 256;
    const float* g1 = F.prm + PO_LN1G + l * 1024; const float* b1 = F.prm + PO_LN1B + l * 1024; const float* RWT = (const float*)(F.ws + WS_RWT) + (size_t)l * 36 * 1024;
    const float* brg = F.prm + PO_BRG + l * 4; const float* bre = F.prm + PO_BRE + l * 32;
    LAS unsigned* LCNT = (LAS unsigned*)(F.lds + RING_OFF + 8192); LAS unsigned* BASEW = (LAS unsigned*)(F.lds + RING_OFF + 8320); LAS unsigned* TOKBUF = (LAS unsigned*)(F.lds + RING_OFF + 8448);
    if (F.tid < 32) LCNT[F.tid] = 0u; for (int i = F.tid; i < 256; i += NTHREADS) TOKBUF[i * 8] = 0xffffffffu;
    __syncthreads();
    int giter = 0;
    gu32* cnt = F.ctl + CW_CNT + l * 32 * 64 + (F.dry ? 16384 : 0); int* LIST = (int*)(F.ws + (F.dry ? WS_SSQ : WS_LIST)); unsigned* TI = (unsigned*)(F.ws + (F.dry ? WS_SSQ + 4 * MiB : WS_TOKINFO));
    const int gstep = F.G * NWAVES; int gi = F.vcu * NWAVES + F.wave; Row4 x[4];
    if (gi < NTOK / 4) {
#pragma unroll
        for (int r = 0; r < 4; ++r) row_load(x[r], F.out + (size_t)(4 * gi + r) * 1024, F.lane); }
    for (; gi < NTOK / 4; gi += gstep, ++giter) { const int m0 = 4 * gi, b = m0 >> 12;
        const float* ada = (const float*)(F.ws + WS_ADA) + ((size_t)l * 8 + b) * 6144;
#pragma unroll
        for (int r = 0; r < 4; ++r) { row_standardize(x[r]); row_affine(x[r], g1, b1, false, F.lane); if (F.dry < 3) row_store(x[r], F.xst + (size_t)(m0 + r) * 1024, F.lane);
            row_standardize(x[r]); row_affine(x[r], ada + 4 * 1024, ada + 3 * 1024, true, F.lane); if (F.dry < 3) row_store_bf16(x[r], F.Ubuf + (size_t)(m0 + r) * 1024, F.lane); __builtin_amdgcn_sched_barrier(0); }
        if (F.dry >= 2) { if (F.dry == 3) { float q_ = 0.f;
#pragma unroll
                for (int r = 0; r < 4; ++r) q_ += x[r][0].x; if (q_ == 123.456f) scr[0] = q_; }
            if (gi + gstep < NTOK / 4) {
#pragma unroll
                for (int r = 0; r < 4; ++r) row_load(x[r], F.out + (size_t)(4 * (gi + gstep) + r) * 1024, F.lane); }
            continue; }
        const float vg = rows4_proj<4>(x, RWT, F.lane);
        __builtin_amdgcn_sched_barrier(0);
        const float va = rows4_proj<16>(x, RWT + 4 * 1024, F.lane);
        __builtin_amdgcn_sched_barrier(0);
        const float vb = rows4_proj<16>(x, RWT + 20 * 1024, F.lane);
        __builtin_amdgcn_sched_barrier(0);
        if (gi + gstep < NTOK / 4) {
#pragma unroll
            for (int r = 0; r < 4; ++r) row_load(x[r], F.out + (size_t)(4 * (gi + gstep) + r) * 1024, F.lane); }
        __builtin_amdgcn_sched_barrier(0);
        if (F.dry == 4) { if (vg + va + vb == 123.456f) scr[0] = vg; continue; }
        { const int i4 = idx4(F.lane), i16 = idx16(F.lane); scr[(i4 >> 2) * 40 + (i4 & 3)] = vg; scr[(i16 >> 4) * 40 + 4 + (i16 & 15)] = va; scr[(i16 >> 4) * 40 + 20 + (i16 & 15)] = vb; }
        LDS_WAIT(); asm volatile("" ::: "memory");
        if (F.lane < 4) { const LAS float* s = scr + F.lane * 40; const int m = m0 + F.lane;
            float gl[4];
#pragma unroll
            for (int j = 0; j < 4; ++j) gl[j] = s[j] + brg[j];
            int gidx = 0; float gmax = gl[0];
#pragma unroll
            for (int j = 1; j < 4; ++j) if (gl[j] > gmax) { gmax = gl[j]; gidx = j; }
            float den = 0.f;
#pragma unroll
            for (int j = 0; j < 4; ++j) den += __expf(gl[j] - gmax);
            const float gw = 1.0f / den;
            float el[8];
#pragma unroll
            for (int j = 0; j < 8; ++j) el[j] = s[4 + gidx * 8 + j] + bre[gidx * 8 + j];
            int i0 = 0; float v0 = el[0];
#pragma unroll
            for (int j = 1; j < 8; ++j) if (el[j] > v0) { v0 = el[j]; i0 = j; }
            int i1 = -1; float v1 = -INFINITY;
#pragma unroll
            for (int j = 0; j < 8; ++j) if (j != i0 && el[j] > v1) { v1 = el[j]; i1 = j; }
            if (i1 < 0) i1 = (i0 + 1) & 7;
            const float ex = __expf(v1 - v0), inv = 1.0f / (1.0f + ex); const float w0 = inv * gw, w1 = ex * inv * gw;
            const int e0 = gidx * 8 + i0, e1 = gidx * 8 + i1;
            const unsigned lp0 = __hip_atomic_fetch_add(LCNT + e0, 1u, __ATOMIC_RELAXED, __HIP_MEMORY_SCOPE_WORKGROUP), lp1 = __hip_atomic_fetch_add(LCNT + e1, 1u, __ATOMIC_RELAXED, __HIP_MEMORY_SCOPE_WORKGROUP);
            const int slot = F.wave * 32 + (giter & 7) * 4 + F.lane;
            *(LAS v4u*)(TOKBUF + slot * 8) = (v4u){(unsigned)m, (unsigned)e0 | ((unsigned)e1 << 8), lp0, lp1}; TOKBUF[slot * 8 + 4] = __float_as_uint(w0); TOKBUF[slot * 8 + 5] = __float_as_uint(w1);
        }
        LDS_WAIT(); asm volatile("" ::: "memory");
    }
    __syncthreads();
    if (F.tid < 32) BASEW[F.tid] = __hip_atomic_fetch_add(cnt + F.tid * 64, LCNT[F.tid], RLX_AGENT);
    __syncthreads();
    if (F.tid < 256) { const v4u tk = *(const LAS v4u*)(TOKBUF + F.tid * 8);
        if (tk.x != 0xffffffffu) { const unsigned m = tk.x, e0 = tk.y & 255u, e1 = tk.y >> 8, p0 = BASEW[e0] + tk.z, p1 = BASEW[e1] + tk.w;
            LIST[(size_t)e0 * LISTCAP + p0] = (int)m; LIST[(size_t)e1 * LISTCAP + p1] = (int)m;
            *(GAS v4u*)(TI + (size_t)m * 8) = (v4u){e0, p0, e1, p1}; *(GAS v4u*)(TI + (size_t)m * 8 + 4) = (v4u){TOKBUF[F.tid * 8 + 4], TOKBUF[F.tid * 8 + 5], 0u, 0u}; } }
    __syncthreads();
}
__device__ __forceinline__ void moe_tables(Frame& F, int l) {
    LAS int* CNT = (LAS int*)(F.lds + TAB_CNT); LAS int* BASE = (LAS int*)(F.lds + TAB_BASE);
    if (F.tid < 32) CNT[F.tid] = (int)__hip_atomic_load(F.ctl + CW_CNT + (l * 32 + F.tid) * 64, RLX_AGENT);
    __syncthreads();
    if (F.tid == 0) { int a = 0; for (int e = 0; e < 32; ++e) { BASE[e] = a; a += (CNT[e] + 255) >> 8; } BASE[32] = a; }
    __syncthreads();
}
__device__ __forceinline__ void phase_r2(Frame& F, int l) {
    LAS float* scr = (LAS float*)(F.lds + RING_OFF) + F.wave * 256; const LAS int* BASE = (const LAS int*)(F.lds + TAB_BASE);
    if (l + 1 < DEPTH) load_walpha(F, l + 1);
    const float* g2 = F.prm + PO_LN2G + l * 1024; const float* b2 = F.prm + PO_LN2B + l * 1024; const unsigned* TI = (const unsigned*)(F.ws + WS_TOKINFO); const bf16* YB = (const bf16*)(F.ws + WS_YB);
    const int gstep = F.G * NWAVES;
    for (int gi = F.vcu * NWAVES + F.wave; gi < NTOK / 4; gi += gstep) { const int m0 = 4 * gi, b = m0 >> 12; Row4 x[4];
#pragma unroll
        for (int r = 0; r < 4; ++r) row_load(x[r], F.out + (size_t)(m0 + r) * 1024, F.lane);
        const float* gate = (const float*)(F.ws + WS_ADA) + ((size_t)l * 8 + b) * 6144 + 5 * 1024;
#pragma unroll
        for (int r = 0; r < 4; ++r) { const int m = m0 + r;
            const v4u ta = *(const GAS v4u*)(TI + (size_t)m * 8); const v4u tb = *(const GAS v4u*)(TI + (size_t)m * 8 + 4);
            const size_t r0 = (size_t)BASE[ta.x & 31] * 256 + ta.y, r1 = (size_t)BASE[ta.z & 31] * 256 + ta.w; const float w0 = __uint_as_float(tb.x), w1 = __uint_as_float(tb.y);
            const GAS unsigned long long* y0 = (const GAS unsigned long long*)(YB + r0 * 1024) + F.lane; const GAS unsigned long long* y1 = (const GAS unsigned long long*)(YB + r1 * 1024) + F.lane;
#pragma unroll
            for (int j = 0; j < 4; ++j) { const unsigned long long a = y0[64 * j], c = y1[64 * j]; const f32x4 gv = *((const GAS f32x4*)gate + F.lane + 64 * j);
                const f32x4 ya = (f32x4){bflo((unsigned)a), bfhi((unsigned)a), bflo((unsigned)(a >> 32)), bfhi((unsigned)(a >> 32))};
                const f32x4 yc = (f32x4){bflo((unsigned)c), bfhi((unsigned)c), bflo((unsigned)(c >> 32)), bfhi((unsigned)(c >> 32))};
                x[r][j] = x[r][j] * DN_ALPHA + gv * (ya * w0 + yc * w1); }
            row_standardize(x[r]); row_affine(x[r], g2, b2, false, F.lane); row_store(x[r], F.xst + (size_t)m * 1024, F.lane); __builtin_amdgcn_sched_barrier(0); }
        if (l + 1 < DEPTH) rows4_mod1(F, x, m0, l + 1, scr, nullptr);
    }
}
typedef short s16x8 __attribute__((ext_vector_type(8)));
#define MFMA16(a, b, c) __builtin_amdgcn_mfma_f32_16x16x32_bf16((a), (b), (c), 0, 0, 0)
struct GlaRegs { v4u rq[2], rk[2]; float rl[16]; unsigned long long vr; };
__device__ __forceinline__ void phase_gla(Frame& F, const int glav) {
    constexpr int QK0_OFF = 0, QK1_OFF = 16384, LAR_OFF = 32768, KLT_OFF = 65536, VT_OFF = 83968  , SBT_OFF = 93184, ATT_OFF = 101888, TOT_OFF = 111104, DEC_OFF = 113152;
    constexpr int QS = 272, TS = 144;
    LAS unsigned char* L = F.lds + RING_OFF;
    LAS float* TOT = (LAS float*)(L + TOT_OFF); LAS float* DEC = (LAS float*)(L + DEC_OFF);
    const int tid = F.tid, lane = F.lane, w = F.wave, k = tid & 127, tg = tid >> 7, fr = lane & 15, fq = lane >> 4;
    const bf16* GQ = (const bf16*)(F.ws + WS_GQ); const bf16* GK = (const bf16*)(F.ws + WS_GK); const bf16* GV = (const bf16*)(F.ws + WS_GV);
    const float* LA = (const float*)(F.ws + WS_LA); bf16* OB = (bf16*)(F.ws + WS_OB); float* SSQ = (float*)(F.ws + WS_SSQ);
    const int cr = tid >> 4, cc = tid & 15;
    const int qk_dst = cr * 256 + ((cc ^ (cr & 15)) << 4);
    const int kc = k >> 3, kb2 = (k & 7) * 2;
    for (int item = F.vcu; item < 256; item += F.G) {
        const int s = item & 7, hg = (item >> 3) & 3, b = item >> 5; const size_t row0 = (size_t)b * SEQ;
        const bf16* gq = GQ + (row0 + cr) * 512 + hg * 128 + cc * 8; const bf16* gk = GK + (row0 + cr) * 512 + hg * 128 + cc * 8; const float* la = LA + (row0 + tg * 16) * 512 + hg * 128 + k;
        const bf16* gv = GV + (row0 + (tid >> 3)) * 1024 + hg * 256 + s * 32 + (tid & 7) * 4;
        bf16* ob = OB + row0 * 1024 + hg * 256 + s * 32; float* ssq = SSQ + row0 * 64 + hg * 16 + s * 2;
        for (int i = tid; i < 8704 / 4; i += NTHREADS) ((LAS unsigned*)(L + SBT_OFF))[i] = 0u;
        f32x4 accS[2]; accS[0] = (f32x4){0.f, 0.f, 0.f, 0.f}; accS[1] = accS[0];
        GlaRegs RA, RB;
#define GLA_BAR() asm volatile("s_waitcnt lgkmcnt(0)\n\ts_barrier" ::: "memory")
#define GLA_LOAD(R_, c_) do { const size_t o_ = (size_t)(c_) * 64; R_.rq[0] = *(const GAS v4u*)(gq + o_ * 512); R_.rq[1] = *(const GAS v4u*)(gq + (o_ + 32) * 512); R_.rk[0] = *(const GAS v4u*)(gk + o_ * 512); R_.rk[1] = *(const GAS v4u*)(gk + (o_ + 32) * 512); \
        _Pragma("unroll") for (int i_ = 0; i_ < 16; ++i_) R_.rl[i_] = *(const GAS float*)(la + (o_ + i_) * 512); R_.vr = *(const GAS unsigned long long*)(gv + o_ * 1024); } while (0)
        GLA_LOAD(RA, 0); GLA_LOAD(RB, 1);
        __syncthreads();
        auto chunk = [&](const int c, GlaRegs& R) {
            *(LAS v4u*)(L + QK0_OFF + qk_dst) = R.rq[0]; *(LAS v4u*)(L + QK0_OFF + qk_dst + 8192) = R.rq[1]; *(LAS v4u*)(L + QK1_OFF + qk_dst) = R.rk[0]; *(LAS v4u*)(L + QK1_OFF + qk_dst + 8192) = R.rk[1];
            const int vto = VT_OFF + (c & 1) * 4608;
            { const int t = tid >> 3, w0 = (tid & 7) * 4;
#pragma unroll
              for (int i = 0; i < 4; ++i) *(LAS bf16*)(L + vto + (w0 + i) * TS + t * 2) = (bf16)((R.vr >> (16 * i)) & 0xffffu); }
            float cs[16]; { float run = 1.f;
#pragma unroll
                for (int i = 0; i < 16; ++i) { run *= R.rl[i]; cs[i] = run; }
                TOT[tg * 128 + k] = run; }
            if (c + 2 < 64 && !(glav & 8)) GLA_LOAD(R, c + 2);
            GLA_BAR();
            if (!(glav & 1)) { float off = 1.f, last = 1.f;
#pragma unroll
              for (int g = 0; g < 4; ++g) { const float tv = TOT[g * 128 + k]; if (g < tg) off *= tv; last *= tv; }
              unsigned klw[8]; float klp = 0.f;
#pragma unroll
              for (int i = 0; i < 16; ++i) { const float e1 = cs[i] * off, e2 = __builtin_amdgcn_rcpf(e1), e3 = last * e2;
                  const int eo = (tg * 16 + i) * 256 + ((kc ^ i) << 4) + kb2;
                  const float qf = __uint_as_float((unsigned)(*(const LAS bf16*)(L + QK0_OFF + eo)) << 16), kf = __uint_as_float((unsigned)(*(const LAS bf16*)(L + QK1_OFF + eo)) << 16);
                  const unsigned qk = pg8::cvt_pk_bf16_c(qf * e1, kf * e2);
                  *(LAS bf16*)(L + QK0_OFF + eo) = (bf16)(qk & 0xffffu); *(LAS bf16*)(L + QK1_OFF + eo) = (bf16)(qk >> 16);
                  if (i & 1) klw[i >> 1] = pg8::cvt_pk_bf16_c(klp, kf * e3); else klp = kf * e3; }
              *(LAS v4u*)(L + KLT_OFF + k * TS + tg * 32) = (v4u){klw[0], klw[1], klw[2], klw[3]}; *(LAS v4u*)(L + KLT_OFF + k * TS + tg * 32 + 16) = (v4u){klw[4], klw[5], klw[6], klw[7]};
              if (tg == 0) DEC[k] = last;
            }
            GLA_BAR();
            const int ti = w >> 1, wi = w & 1; f32x4 acco = (f32x4){0.f, 0.f, 0.f, 0.f};
            if (!(glav & 2)) { s16x8 aq[4];
#pragma unroll
              for (int kk = 0; kk < 4; ++kk) aq[kk] = *(const LAS s16x8*)(L + QK0_OFF + (ti * 16 + fr) * 256 + (((kk * 4 + fq) ^ fr) << 4));
#pragma unroll
              for (int s2 = 0; s2 < 2; ++s2) { const int si = wi * 2 + s2; f32x4 a4 = (f32x4){0.f, 0.f, 0.f, 0.f};
                  if (si <= ti) {
#pragma unroll
                      for (int kk = 0; kk < 4; ++kk) { const s16x8 bb = *(const LAS s16x8*)(L + QK1_OFF + (si * 16 + fr) * 256 + (((kk * 4 + fq) ^ fr) << 4)); a4 = MFMA16(aq[kk], bb, a4); } }
#pragma unroll
                  for (int r = 0; r < 4; ++r) { const int t = ti * 16 + fq * 4 + r, sc = si * 16 + fr; const float v = (sc <= t) ? a4[r] : 0.f; *(LAS bf16*)(L + ATT_OFF + t * TS + sc * 2) = (bf16)f2bf(v); } }
#pragma unroll
              for (int kk = 0; kk < 4; ++kk) { const s16x8 bb = *(const LAS s16x8*)(L + SBT_OFF + (wi * 16 + fr) * QS + (kk * 32 + 8 * fq) * 2); acco = MFMA16(aq[kk], bb, acco); }
            }
            GLA_BAR();
            if (!(glav & 4)) {
#pragma unroll
              for (int kk = 0; kk < 2; ++kk) { const s16x8 a = *(const LAS s16x8*)(L + ATT_OFF + (ti * 16 + fr) * TS + (kk * 32 + 8 * fq) * 2); const s16x8 bb = *(const LAS s16x8*)(L + vto + (wi * 16 + fr) * TS + (kk * 32 + 8 * fq) * 2);
                  acco = MFMA16(a, bb, acco); }
              { const unsigned o01 = pg8::cvt_pk_bf16_c(acco[0], acco[1]), o23 = pg8::cvt_pk_bf16_c(acco[2], acco[3]); bf16* obp = ob + (size_t)(c * 64 + ti * 16 + fq * 4) * 1024 + wi * 16 + fr;
                obp[0] = (bf16)(o01 & 0xffffu); obp[1024] = (bf16)(o01 >> 16); obp[2048] = (bf16)(o23 & 0xffffu); obp[3072] = (bf16)(o23 >> 16); }
#pragma unroll
              for (int r = 0; r < 4; ++r) { const int t = c * 64 + ti * 16 + fq * 4 + r;
                  float q = acco[r] * acco[r]; q = dpp_add(q, 0); q = dpp_add(q, 1); q = dpp_add(q, 2); q = dpp_add(q, 3);
                  if (fr == 0) ssq[(size_t)t * 64 + wi] = q; }
#pragma unroll
              for (int w2 = 0; w2 < 2; ++w2) {
#pragma unroll
                  for (int r = 0; r < 4; ++r) accS[w2][r] *= DEC[w * 16 + fq * 4 + r];
#pragma unroll
                  for (int kk = 0; kk < 2; ++kk) { const s16x8 a = *(const LAS s16x8*)(L + KLT_OFF + (w * 16 + fr) * TS + (kk * 32 + 8 * fq) * 2); const s16x8 bb = *(const LAS s16x8*)(L + vto + (w2 * 16 + fr) * TS + (kk * 32 + 8 * fq) * 2);
                      accS[w2] = MFMA16(a, bb, accS[w2]); }
                  *(LAS unsigned long long*)(L + SBT_OFF + (w2 * 16 + fr) * QS + (w * 16 + fq * 4) * 2) = (unsigned long long)pg8::cvt_pk_bf16_c(accS[w2][0], accS[w2][1]) | ((unsigned long long)pg8::cvt_pk_bf16_c(accS[w2][2], accS[w2][3]) << 32); }
            }
        };
        for (int c = 0; c < 64; c += 2) { chunk(c, RA); chunk(c + 1, RB); }
#undef GLA_LOAD
#undef GLA_BAR
        __syncthreads();
    }
}
__device__ __forceinline__ void unpack8(const v4u w, float* d) { d[0] = bflo(w.x); d[1] = bfhi(w.x); d[2] = bflo(w.y); d[3] = bfhi(w.y); d[4] = bflo(w.z); d[5] = bfhi(w.z); d[6] = bflo(w.w); d[7] = bfhi(w.w); }
__device__ __forceinline__ v4u pack8(const float* d) { v4u o; o.x = pk2(d[0], d[1]); o.y = pk2(d[2], d[3]); o.z = pk2(d[4], d[5]); o.w = pk2(d[6], d[7]); return o; }
__device__ __forceinline__ void phase_post(Frame& F, int l) {
    const float* lq1 = F.prm + PO_LQ1; const float* lk1 = F.prm + PO_LK1; const float* lq2 = F.prm + PO_LQ2; const float* lk2 = F.prm + PO_LK2; const float* diffg = F.prm + PO_DIFFG; const float* glag = F.prm + PO_GLAG;
    const int lane = F.lane;
    const float lam_init = 0.8f - 0.6f * expf(-0.3f * (float)l);
    const float d1 = lq1[l * 64 + lane] * lk1[l * 64 + lane], d2 = lq2[l * 64 + lane] * lk2[l * 64 + lane];
    const float lam = expf(wave_sum(d1)) - expf(wave_sum(d2)) + lam_init, osc = 1.0f - lam_init;
    float dgr[16], ggr[16];
#pragma unroll
    for (int i = 0; i < 16; ++i) { dgr[i] = diffg[l * 128 + 16 * (lane & 7) + i] * osc; ggr[i] = glag[l * 256 + 16 * (lane & 15) + i]; }
    const bf16* OP = (const bf16*)(F.ws + WS_OP); const bf16* OB = (const bf16*)(F.ws + WS_OB); const bf16* SG = (const bf16*)(F.ws + WS_SG); const float* SSQ = (const float*)(F.ws + WS_SSQ);
    bf16* OA2 = (bf16*)(F.ws + WS_OA2); bf16* OB2 = (bf16*)(F.ws + WS_OB2);
    for (int m = F.vcu * NWAVES + F.wave; m < NTOK; m += F.G * NWAVES) {
        float o0[16], o1[16], d[16];
        { const GAS v4u* p0 = (const GAS v4u*)(OP + (size_t)m * 2048 + 16 * lane); const GAS v4u* p1 = (const GAS v4u*)(OP + (size_t)m * 2048 + 1024 + 16 * lane);
          unpack8(p0[0], o0); unpack8(p0[1], o0 + 8); unpack8(p1[0], o1); unpack8(p1[1], o1 + 8); }
        float ss = 0.f;
#pragma unroll
        for (int i = 0; i < 16; ++i) { d[i] = o0[i] - lam * o1[i]; ss += d[i] * d[i]; }
        ss += __shfl_xor(ss, 1); ss += __shfl_xor(ss, 2); ss += __shfl_xor(ss, 4);
        { const float r = 1.0f / sqrtf(ss * (1.0f / 128.0f) + LN_EPS);
#pragma unroll
          for (int i = 0; i < 16; ++i) d[i] = d[i] * r * dgr[i];
          GAS v4u* q = (GAS v4u*)(OA2 + (size_t)m * 1024 + 16 * lane); q[0] = pack8(d); q[1] = pack8(d + 8); }
        { const GAS v4u* p0 = (const GAS v4u*)(OB + (size_t)m * 1024 + 16 * lane); const GAS v4u* p1 = (const GAS v4u*)(SG + (size_t)m * 1024 + 16 * lane);
          unpack8(p0[0], o0); unpack8(p0[1], o0 + 8); unpack8(p1[0], o1); unpack8(p1[1], o1 + 8); }
        { const GAS f32x4* sp = (const GAS f32x4*)(SSQ + (size_t)m * 64 + (lane >> 4) * 16); float sq = 0.f;
#pragma unroll
          for (int j = 0; j < 4; ++j) { const f32x4 v = sp[j]; sq += v.x; sq += v.y; sq += v.z; sq += v.w; }
          const float r = 1.0f / sqrtf(sq * (1.0f / 256.0f) + LN_EPS);
#pragma unroll
          for (int i = 0; i < 16; ++i) d[i] = o0[i] * r * ggr[i] * o1[i];
          GAS v4u* q = (GAS v4u*)(OB2 + (size_t)m * 1024 + 16 * lane); q[0] = pack8(d); q[1] = pack8(d + 8); }
    }
}
struct MoeOrder {
    const LAS int* BASE; int total4, G, c;
    __device__ __forceinline__ bool next(int i, pg8::Unit& u) const {
        const int Lx = i * G + c; if (Lx >= total4) return false;
        const int rt = Lx >> 2, pn = Lx & 3; int e = 0;
        for (int j = 1; j < 32; ++j) if (BASE[j] <= rt) e = j;
        e = __builtin_amdgcn_readfirstlane(e);
        u.pm = rt; u.pn = pn; u.pb = e * 4 + pn; return true;
    }
};

#ifndef PHMASK
#define PHMASK 0xFFFF
#endif
#ifndef REPMASK
#define REPMASK 0
#endif
#define REP(bit) for (int rep_ = 0; rep_ < ((REPMASK & (bit)) ? 2 : 1); ++rep_)
struct Args { const float* in[28]; float* out; unsigned char* ws; };
__global__ void __launch_bounds__(NTHREADS, 2) mk_fwd(Args args) {
    extern __shared__ __attribute__((aligned(16))) unsigned char lds[];
    Frame F;
    F.lds = (LAS unsigned char*)lds;
    F.tid = threadIdx.x; F.lane = F.tid & 63; F.wave = __builtin_amdgcn_readfirstlane(F.tid >> 6);
    F.G = gridDim.x; { const int bx = blockIdx.x; F.vcu = (F.G % 8 == 0) ? (bx % 8) * (F.G / 8) + bx / 8 : bx; }
    F.out = args.out; F.ws = args.ws; F.ctl = (gu32*)(args.ws + WS_CTL); F.prm = (const float*)(args.ws + WS_PRM);
    unsigned char* ws = args.ws;
    for (int u = F.tid; u < (LDS_BYTES - LDSCTL_OFF) / 4; u += NTHREADS) ((LAS unsigned*)(F.lds + LDSCTL_OFF))[u] = 0u;
    __syncthreads();
    volatile LAS unsigned* MISC = (volatile LAS unsigned*)(F.lds + MISC_OFF);
    XcdBarrier bar = xcd_barrier_post((unsigned*)(F.ctl + CW_BAR), MISC + 8);
    if ((REPMASK & 16384) && threadIdx.x == 0) MISC[21] = (unsigned)rt();
#ifndef BARSEL
#define BARSEL 0xFFF
#endif
#ifndef PSEL
#define PSEL 0
#endif
#ifndef DRYLVL
#define DRYLVL 1
#endif
#ifndef GLAV
#define GLAV 0
#endif
#define GRID_BAR(id_) do { const unsigned long long tb0_ = (REPMASK & (8192 | 16384)) ? rt() : 0ull; \
        if ((REPMASK & 16384) && ((PSEL >> (id_)) & 1) && threadIdx.x == 0) MISC[20] += (unsigned)tb0_ - MISC[21];     \
        GAS unsigned char* bw_ = (GAS unsigned char*)args.ws; asm volatile("" : "+s"(bw_)); unsigned bx_ = bar.x; asm volatile("" : "+s"(bx_)); XcdBarrier b_ = bar; b_.x = bx_; b_.bar = (unsigned*)(bw_ + WS_CTL) + CW_BAR; xcd_barrier(b_); if (REPMASK & 4096) xcd_barrier(b_); \
        if ((REPMASK & 8192) && ((BARSEL >> (id_)) & 1) && threadIdx.x == 0) MISC[20] += (unsigned)(rt() - tb0_); if ((REPMASK & 16384) && threadIdx.x == 0) MISC[21] = (unsigned)rt(); } while (0)
#define PHASE_ENTER() do { int t_ = threadIdx.x; asm volatile("" : "+v"(t_)); F.tid = t_; F.lane = t_ & 63; F.wave = __builtin_amdgcn_readfirstlane(t_ >> 6); \
        GAS unsigned char* w_ = (GAS unsigned char*)args.ws; GAS float* o_ = (GAS float*)args.out; asm volatile("" : "+s"(w_), "+s"(o_));   \
        F.ws = (unsigned char*)w_; F.out = (float*)o_; ws = (unsigned char*)w_; F.ctl = (gu32*)(w_ + WS_CTL); F.prm = (const float*)(w_ + WS_PRM); F.xst = (float*)o_; F.Ubuf = (bf16*)(w_ + WS_U); F.LAbuf = (float*)(w_ + WS_LA); F.dry = 0; } while (0)
    typedef pg8::bf16_t pb;
    REP(1) if (PHMASK & 1) { PHASE_ENTER(); p0_ada(F, args.in[I_C], args.in[I_WADA], args.in[I_BADA]);
        __syncthreads();
        p0_weights(F, args.in[I_WIN], args.in[I_WBA], args.in[I_WBB], args.in[I_WOUT], args.in[I_WGE], args.in[I_WUE], args.in[I_WDE], args.in[I_WRG], args.in[I_WRE],
                   SmallPrm{args.in[I_BGATES], args.in[I_WALPHA], args.in[I_BALPHA], args.in[I_LQ1], args.in[I_LK1], args.in[I_LQ2], args.in[I_LK2], args.in[I_DIFFG], args.in[I_GLAG], args.in[I_LN1G], args.in[I_LN1B], args.in[I_BRG], args.in[I_BRE], args.in[I_LN2G], args.in[I_LN2B]}); __syncthreads(); }
    GRID_BAR(0);
    REP(2) if (PHMASK & 2) { PHASE_ENTER(); phase_r0(F, args.in[I_X]); }
    GRID_BAR(1);
    for (int l = 0; l < DEPTH; ++l) {
        REP(4) if (PHMASK & 4) { PHASE_ENTER(); pg8::Gemm g{(const pb*)(ws + WS_U), (const pb*)(ws + WS_WIN) + (size_t)l * NPROJ * 1024, NTOK, NPROJ, 1024}; pg8::StaticOrder S; S.init(NTOK, NPROJ, F.G, (int)blockIdx.x);
          pg8::EpiProj E{(pb*)(ws + WS_QB), (pb*)(ws + WS_KB), (pb*)(ws + WS_VB), (pb*)(ws + WS_GQ), (pb*)(ws + WS_GK), (pb*)(ws + WS_GV), (pb*)(ws + WS_SG), (pb*)(ws + WS_GT), F.prm + PO_BGATES + l * 2048};
          pg8::gemm_phase<pg8::EpiProj, pg8::StaticOrder, true, false>(F.lds + RING_OFF, g, S, E, nullptr); }
        GRID_BAR(2);
        REP(8) if (PHMASK & 8) { PHASE_ENTER(); phase_gla(F, ((REPMASK & 8) && rep_ == 0) ? GLAV : 0); }
        GRID_BAR(3);
        REP(16) if (PHMASK & 16) { PHASE_ENTER(); const attn_body::AttnTensors AT{(const attn_body::bf16*)(ws + WS_QB), (const attn_body::bf16*)(ws + WS_KB), (const attn_body::bf16*)(ws + WS_VB), (attn_body::bf16*)(ws + WS_OP)};
          attn_body::attn_phase<8>((char*)lds + RING_OFF, AT, (unsigned*)(F.ctl + CW_ATQ + (l * 2 + ((REPMASK & 16) ? rep_ : 0)) * 64), MISC + 16); }
        GRID_BAR(4);
        REP(32) if (PHMASK & 32) { PHASE_ENTER(); phase_post(F, l); }
        GRID_BAR(5);
        REP(64) if (PHMASK & 64) { PHASE_ENTER(); pg8::PairOrder S; S.S.init(NTOK, 1024, F.G, (int)blockIdx.x);
          static_assert(WS_OB2 == WS_OA2 + (size_t)NTOK * 1024 * 2 && WS_WBB == WS_WBA + 16 * 256 * 1024 * 2, "stacked A / B views of the two branch GEMMs");
          pg8::Gemm g{(const pb*)(ws + WS_OA2), (const pb*)(ws + WS_WBA) + (size_t)l * 1024 * 1024, 2 * NTOK, 1024, 1024};
          pg8::EpiGatePair E{(pb*)(ws + WS_TMP), (long)((WS_MIX - WS_TMP) / 2), (const pb*)(ws + WS_GT)};
          pg8::gemm_phase<pg8::EpiGatePair, pg8::PairOrder, true, false>(F.lds + RING_OFF, g, S, E, nullptr); }
        GRID_BAR(6);
        if (PHMASK & 128) { PHASE_ENTER(); pg8::Gemm g{(const pb*)(ws + WS_MIX), (const pb*)(ws + WS_WOUT) + (size_t)l * 1024 * 1024, NTOK, 1024, 1024}; pg8::StaticOrder S; S.init(NTOK, 1024, F.G, (int)blockIdx.x);
          REP(128) { pg8::EpiResid E{F.out, ((REPMASK & 128) && rep_ == 0) ? (float*)(ws + WS_QB) : F.out, (const float*)(ws + WS_ADA) + (size_t)l * 8 * 6144 + 2 * 1024, 6144, DN_ALPHA};
          pg8::gemm_phase<pg8::EpiResid, pg8::StaticOrder, true, false>(F.lds + RING_OFF, g, S, E, nullptr); } }
        GRID_BAR(7);
        REP(256) if (PHMASK & 256) { PHASE_ENTER(); if ((REPMASK & 256) && rep_ == 0) { F.dry = DRYLVL; F.xst = (float*)(ws + WS_QB); F.Ubuf = (bf16*)(ws + WS_VB); } phase_r1(F, l); }
        GRID_BAR(8);
        if (PHMASK & 512) { PHASE_ENTER(); moe_tables(F, l); }
        if (PHMASK & 512) { const LAS int* BASE = (const LAS int*)(F.lds + TAB_BASE); const LAS int* CNT = (const LAS int*)(F.lds + TAB_CNT); LAS int* IDX = (LAS int*)(F.lds + TAB_IDX);
          const int total4 = __builtin_amdgcn_readfirstlane(BASE[32]) * 4; const int* LIST = (const int*)(ws + WS_LIST);
          MoeOrder S{BASE, total4, F.G, (int)blockIdx.x};
          for (int ui = 0; ui < IDX_UNITS; ++ui) { pg8::Unit u; if (!S.next(ui, u)) break; const int e = u.pb >> 2;
              if (F.tid < 256) { const int pos = (u.pm - BASE[e]) * 256 + F.tid; IDX[ui * 256 + F.tid] = (pos < CNT[e]) ? LIST[(size_t)e * LISTCAP + pos] : 0; } }
          __syncthreads();
          REP(512) { pg8::Gemm g{(const pb*)(ws + WS_U), (const pb*)(ws + WS_W1) + (size_t)l * 32 * 1024 * 1024, MOE_MAXT * 256, 1024, 1024};
            pg8::EpiSwiGLU E{(pb*)(ws + WS_H)};
            pg8::gemm_phase<pg8::EpiSwiGLU, MoeOrder, true, true>(F.lds + RING_OFF, g, S, E, IDX); }
          GRID_BAR(9);
          PHASE_ENTER();
          REP(2048) { pg8::Gemm g{(const pb*)(ws + WS_H), (const pb*)(ws + WS_WD) + (size_t)l * 32 * 1024 * 512, MOE_MAXT * 256, 1024, 512};
            pg8::EpiGate<2> E{(pb*)(ws + WS_YB), 1024, nullptr, nullptr, 0, 0};
            pg8::gemm_phase<pg8::EpiGate<2>, MoeOrder, true, false>(F.lds + RING_OFF, g, S, E, nullptr); }
        }
        GRID_BAR(10);
        REP(1024) if (PHMASK & 1024) { PHASE_ENTER(); if ((REPMASK & 1024) && rep_ == 0) { F.dry = 1; F.xst = (float*)(ws + WS_GT); F.Ubuf = (bf16*)(ws + WS_SG); F.LAbuf = (float*)(ws + WS_GV); } phase_r2(F, l); }
        if (l + 1 < DEPTH) GRID_BAR(11);
    }
    if ((REPMASK & 16384) && ((PSEL >> 11) & 1) && threadIdx.x == 0) MISC[20] += (unsigned)rt() - MISC[21];
    if ((REPMASK & (8192 | 16384)) && blockIdx.x == 0 && threadIdx.x == 0) { const unsigned tw_ = MISC[20]; const unsigned long long ts_ = rt(); while ((unsigned)(rt() - ts_) < tw_) __builtin_amdgcn_s_sleep(8); }
}

extern "C" void kernel_launch(void* const* d_in, const int* in_sizes, int n_in, void* d_out, int out_size, void* d_ws, size_t ws_size, hipStream_t stream) {
    static int grid = 0;
    if (grid == 0) {
        if (n_in != 28 || in_sizes[0] != NTOK * DM || out_size != NTOK * DM || ws_size < WS_END) { fprintf(stderr, "kernel_launch: unexpected shapes (n_in %d, in0 %d, out %d, ws %zu < %zu); nothing launched\n", n_in, n_in > 0 ? in_sizes[0] : -1, out_size, ws_size, (size_t)WS_END); grid = -1; return; }
        int dev = 0, cus = 0, per_cu = 0;
        if (hipGetDevice(&dev) != hipSuccess || hipDeviceGetAttribute(&cus, hipDeviceAttributeMultiprocessorCount, dev) != hipSuccess) { fprintf(stderr, "kernel_launch: device query failed\n"); grid = -1; return; }
        if (hipFuncSetAttribute((const void*)mk_fwd, hipFuncAttributeMaxDynamicSharedMemorySize, LDS_BYTES) != hipSuccess) { fprintf(stderr, "kernel_launch: hipFuncSetAttribute failed\n"); grid = -1; return; }
        if (hipOccupancyMaxActiveBlocksPerMultiprocessor(&per_cu, (const void*)mk_fwd, NTHREADS, LDS_BYTES) != hipSuccess || per_cu < 1) { fprintf(stderr, "kernel_launch: occupancy query says %d\n", per_cu); }
        (void)hipGetLastError();
        grid = cus;
    }
    if (grid < 0) return;
    if (hipMemsetAsync((char*)d_ws + WS_CTL, 0, CTL_ZERO_BYTES, stream) != hipSuccess) { fprintf(stderr, "kernel_launch: memset failed\n"); return; }
    Args a{};
    for (int i = 0; i < 28; ++i) a.in[i] = (const float*)d_in[i];
    a.out = (float*)d_out; a.ws = (unsigned char*)d_ws;
    hipLaunchKernelGGL(mk_fwd, dim3(grid), dim3(NTHREADS), LDS_BYTES, stream, a);
    const hipError_t le = hipPeekAtLastError();
    if (le != hipSuccess) fprintf(stderr, "kernel_launch: launch failed: %s\n", hipGetErrorName(le));
}
```

```cpp
#include <hip/hip_runtime.h>
#include <hip/hip_bf16.h>
#include <cstdio>
#include <cstdint>
#include <cmath>
namespace pg8 {
#define PG8_LAS __attribute__((address_space(3)))
typedef unsigned short bf16_t;
typedef short bf16x8 __attribute__((ext_vector_type(8)));
typedef float f32x4 __attribute__((ext_vector_type(4)));
typedef float f32x2 __attribute__((ext_vector_type(2)));
typedef unsigned u32x4 __attribute__((ext_vector_type(4)));
typedef unsigned u32x2 __attribute__((ext_vector_type(2)));
constexpr int BM = 256, BK = 64, HALF = 128, HTB = HALF * BK * 2  , STAGE_BYTES = 8 * HTB, NXCD = 8, WGM = 8;

__host__ __device__ __forceinline__ int lds_byte(int r, int c) { const int st = (r >> 4) * 2 + (c >> 5), rr = r & 15, cc = c & 31, ob = rr * 64 + cc * 2; return st * 1024 + (ob ^ (((ob >> 9) & 1) << 5)); }
__host__ __device__ __forceinline__ void stage_rc(int b, int& R, int& C) { const int st = b / 1024, sb = b % 1024, swz = sb ^ (((sb >> 9) & 1) << 5); R = (st >> 1) * 16 + swz / 64; C = (st & 1) * 32 + (swz % 64) / 2; }
__host__ __device__ __forceinline__ int perm32(int rho) { const int n = rho >> 4, i = rho & 15; return 8 * (i >> 2) + 4 * n + (i & 3); }

struct Unit { int pm, pn, pb; };
struct Gemm { const bf16_t* A; const bf16_t* Bt; int M, N, K; };

struct StaticOrder {
    int nM, nN, nwg, G, c;
    __host__ __device__ __forceinline__ void init(int M, int N, int G_, int c_) { nM = M / BM; nN = N / BM; nwg = nM * nN; G = G_; c = c_; }
    __host__ __device__ __forceinline__ bool next(int i, Unit& u) const {
        const long L = (long)i * G + c; if (L >= nwg) return false;
        int wgid = (int)L; { const int q = nwg / NXCD, r = nwg % NXCD, xcd = wgid % NXCD, off = wgid / NXCD; wgid = (xcd < r ? xcd * (q + 1) : r * (q + 1) + (xcd - r) * q) + off; }
        const int nig = WGM * nN, gid = wgid / nig, fm = gid * WGM, gsz = (nM - fm) < WGM ? (nM - fm) : WGM;
        u.pm = fm + ((wgid % nig) % gsz); u.pn = (wgid % nig) / gsz; u.pb = u.pn; return true;
    }
};

__device__ __forceinline__ unsigned cvt_pk_bf16(float lo, float hi) { unsigned r; asm volatile("v_cvt_pk_bf16_f32 %0, %1, %2" : "=v"(r) : "v"(lo), "v"(hi)); return r; }
typedef __bf16 bf16x2_c __attribute__((ext_vector_type(2)));
__device__ __forceinline__ unsigned cvt_pk_bf16_c(float lo, float hi) { const f32x2 v = {lo, hi}; const bf16x2_c b = __builtin_convertvector(v, bf16x2_c); return __builtin_bit_cast(unsigned, b); }
__device__ __forceinline__ float bf_lo(unsigned w) { return __uint_as_float(w << 16); }
__device__ __forceinline__ float bf_hi(unsigned w) { return __uint_as_float(w & 0xffff0000u); }
__device__ __forceinline__ float sigmoidf_(float x) { return __builtin_amdgcn_rcpf(1.0f + __expf(-x)); }

template <class Epi, class Sched, bool ALIGN_EPI, bool GATHER>
__device__ __forceinline__ void gemm_phase(PG8_LAS unsigned char* lds, const Gemm g, const Sched& S, const Epi& E, const PG8_LAS int* idxtab) {
    int tid_ = threadIdx.x; asm volatile("" : "+v"(tid_));
    const int tid = tid_, wid = __builtin_amdgcn_readfirstlane(tid >> 6), lane = tid & 63, wr = wid >> 2, wc = wid & 3, fr = lane & 15, fq = lane >> 4;
    const int K = g.K, nt = K / BK;
    unsigned voffA[2], voffB[2];
#pragma unroll
    for (int i = 0; i < 2; ++i) { int R, C; stage_rc(tid * 16 + i * 8192, R, C); const int Rb = Epi::PERM ? ((R & ~31) + perm32(R & 31)) : R;
        voffA[i] = (unsigned)(R * K + C) * 2u; voffB[i] = (unsigned)(Rb * K + C) * 2u; }
    const size_t kstep = (size_t)(BK * 2);
    const size_t hstep = (size_t)HALF * K * 2;
    const size_t tstep = 2 * hstep;
    const unsigned ldsw = (unsigned)wid * 1024u;
    const int aoff = lds_byte(wr * 64 + fr, fq * 8), boff = lds_byte(wc * 32 + fr, fq * 8);
    unsigned offAc[2][2];
    int nui = 0;
#define PG8_SA(b, h) (((b) * 2 + (h)) * HTB)
#define PG8_SB(b, h) ((4 + (b) * 2 + (h)) * HTB)
#define PG8_STAGE(bufoff, gbase, voff) do { _Pragma("unroll") for (int _i = 0; _i < 2; ++_i) \
        __builtin_amdgcn_global_load_lds((const unsigned*)((const char*)(gbase) + (voff)[_i]), (PG8_LAS unsigned*)(lds + (bufoff) + ldsw + _i * 8192), 16, 0, 0); } while (0)
#define PG8_GOFF(uix, h, i, tt) ({ int _R, _C; stage_rc((tt) * 16 + (i) * 8192, _R, _C); (unsigned)idxtab[(uix) * 256 + (h) * HALF + _R] * (unsigned)(K * 2) + (unsigned)_C * 2u; })
#define PG8_STAGE_A(bufoff, kb, h, nx) do { if constexpr (GATHER) { unsigned _o[2] = {offAc[h][0], offAc[h][1]}; \
        if (nx) { int _t = tid; asm volatile("" : "+v"(_t)); _o[0] = PG8_GOFF(nui, h, 0, _t); _o[1] = PG8_GOFF(nui, h, 1, _t); } \
        _Pragma("unroll") for (int _i = 0; _i < 2; ++_i) \
        __builtin_amdgcn_global_load_lds((const unsigned*)((const char*)g.A + (size_t)(kb) + _o[_i]), (PG8_LAS unsigned*)(lds + (bufoff) + ldsw + _i * 8192), 16, 0, 0); } \
        else { const char* _b = ((nx) ? nA : cA) + (size_t)(kb) + (size_t)(h) * hstep; PG8_STAGE(bufoff, _b, voffA); } } while (0)
#define PG8_GIDX(dst, uix) do { if constexpr (GATHER) { int _t = tid; asm volatile("" : "+v"(_t)); _Pragma("unroll") for (int _h = 0; _h < 2; ++_h) _Pragma("unroll") for (int _i = 0; _i < 2; ++_i) \
        dst[_h][_i] = PG8_GOFF(uix, _h, _i, _t); } } while (0)
#define PG8_LDA(dst, b, h) do { _Pragma("unroll") for (int m = 0; m < 4; ++m) _Pragma("unroll") for (int k = 0; k < 2; ++k) dst[m][k] = *(const PG8_LAS bf16x8*)(lds + PG8_SA(b, h) + aoff + m * 2048 + k * 1024); } while (0)
#define PG8_LDB(dst, b, h) do { _Pragma("unroll") for (int n = 0; n < 2; ++n) _Pragma("unroll") for (int k = 0; k < 2; ++k) dst[n][k] = *(const PG8_LAS bf16x8*)(lds + PG8_SB(b, h) + boff + n * 2048 + k * 1024); } while (0)
#define PG8_MMA(ai, bj, At, Bt) do { __builtin_amdgcn_s_setprio(1); _Pragma("unroll") for (int m = 0; m < 4; ++m) _Pragma("unroll") for (int n = 0; n < 2; ++n) _Pragma("unroll") for (int k = 0; k < 2; ++k) \
        acc[ai][bj][m][n] = __builtin_amdgcn_mfma_f32_16x16x32_bf16(Bt[n][k], At[m][k], acc[ai][bj][m][n], 0, 0, 0); __builtin_amdgcn_s_setprio(0); } while (0)
#define PG8_WAIT_V(n) asm volatile("s_waitcnt vmcnt(" #n ")" ::: "memory")
#define PG8_WAIT_L(n) asm volatile("s_waitcnt lgkmcnt(" #n ")" ::: "memory")
#define PG8_BAR __builtin_amdgcn_s_barrier()
#define PG8_SCHED __builtin_amdgcn_sched_barrier(0)
    Unit cur, nxt; int ui = 0;
    if (!S.next(0, cur)) return;
    f32x4 acc[2][2][4][2];
#pragma unroll
    for (int a = 0; a < 2; ++a)
#pragma unroll
        for (int b = 0; b < 2; ++b)
#pragma unroll
            for (int m = 0; m < 4; ++m)
#pragma unroll
                for (int n = 0; n < 2; ++n) acc[a][b][m][n] = (f32x4){0.f, 0.f, 0.f, 0.f};
    bf16x8 At[4][2], B0[2][2], B1[2][2];
    const char* cA = (const char*)g.A + (size_t)cur.pm * tstep; const char* cB = (const char*)g.Bt + (size_t)cur.pb * tstep;
    const char* nA = cA;
    PG8_GIDX(offAc, 0);
    PG8_STAGE(PG8_SB(0, 0), cB, voffB); PG8_STAGE(PG8_SB(0, 1), cB + hstep, voffB); PG8_STAGE_A(PG8_SA(0, 0), 0, 0, false); PG8_STAGE_A(PG8_SA(0, 1), 0, 1, false);
    if (wr == 1) PG8_BAR;
    PG8_WAIT_V(2); PG8_BAR;
    PG8_STAGE(PG8_SB(1, 0), cB + kstep, voffB); PG8_STAGE_A(PG8_SA(1, 0), kstep, 0, false); PG8_STAGE(PG8_SB(1, 1), cB + hstep + kstep, voffB);
    PG8_WAIT_V(6); PG8_BAR;
    for (;;) {
        const bool has_next = S.next(ui + 1, nxt);
        nA = has_next ? (const char*)g.A + (size_t)nxt.pm * tstep : cA; const char* nB = has_next ? (const char*)g.Bt + (size_t)nxt.pb * tstep : cB;
        nui = has_next ? ui + 1 : ui;
        for (int t = 0; t < nt; t += 2) {
            const bool last = (t == nt - 2);
            const size_t kb1 = (size_t)(t + 1) * kstep;
            const size_t kb2 = last ? (size_t)0 : (size_t)(t + 2) * kstep, kb3 = kb2 + kstep;
            const char* b2 = last ? nB : cB + (size_t)(t + 2) * kstep; const char* b3 = b2 + kstep;
            PG8_LDB(B0, 0, 0); PG8_LDB(B1, 0, 1); PG8_SCHED; PG8_LDA(At, 0, 0); PG8_STAGE_A(PG8_SA(1, 1), kb1, 1, false);
            PG8_WAIT_V(8); PG8_WAIT_L(0); PG8_BAR; PG8_MMA(0, 0, At, B0); PG8_MMA(0, 1, At, B1); PG8_BAR; PG8_SCHED;
            PG8_LDA(At, 0, 1); PG8_STAGE(PG8_SB(0, 0), b2, voffB); PG8_STAGE(PG8_SB(0, 1), b2 + hstep, voffB); PG8_STAGE_A(PG8_SA(0, 0), kb2, 0, last);
            PG8_WAIT_V(8); PG8_WAIT_L(0); PG8_BAR; PG8_MMA(1, 0, At, B0); PG8_MMA(1, 1, At, B1); PG8_BAR; PG8_SCHED;
            PG8_LDB(B0, 1, 0); PG8_LDB(B1, 1, 1); PG8_SCHED; PG8_LDA(At, 1, 0); PG8_STAGE_A(PG8_SA(0, 1), kb2, 1, last);
            PG8_WAIT_V(8); PG8_WAIT_L(0); PG8_BAR; PG8_MMA(0, 0, At, B0); PG8_MMA(0, 1, At, B1); PG8_BAR; PG8_SCHED;
            PG8_LDA(At, 1, 1); PG8_STAGE(PG8_SB(1, 0), b3, voffB); PG8_STAGE(PG8_SB(1, 1), b3 + hstep, voffB); PG8_STAGE_A(PG8_SA(1, 0), kb3, 0, last);
            PG8_WAIT_V(8); PG8_WAIT_L(0); PG8_BAR; PG8_MMA(1, 0, At, B0); PG8_MMA(1, 1, At, B1); PG8_BAR; PG8_SCHED;
        }
        if constexpr (ALIGN_EPI) { if (wr == 0) PG8_BAR; }
        E(acc, cur, wr, wc, fr, fq);
        if (!has_next) break;
#pragma unroll
        for (int a = 0; a < 2; ++a)
#pragma unroll
            for (int b = 0; b < 2; ++b)
#pragma unroll
                for (int m = 0; m < 4; ++m)
#pragma unroll
                    for (int n = 0; n < 2; ++n) acc[a][b][m][n] = (f32x4){0.f, 0.f, 0.f, 0.f};
        cur = nxt; cA = nA; cB = nB; ++ui;
        PG8_GIDX(offAc, ui);
        if constexpr (ALIGN_EPI) { if (wr == 1) PG8_BAR; }
    }
    PG8_WAIT_V(0);
    if constexpr (!ALIGN_EPI) { if (wr == 0) PG8_BAR; }
    PG8_BAR;
#undef PG8_SA
#undef PG8_SB
#undef PG8_STAGE
#undef PG8_STAGE_A
#undef PG8_GIDX
#undef PG8_GOFF
#undef PG8_LDA
#undef PG8_LDB
#undef PG8_MMA
#undef PG8_WAIT_V
#undef PG8_WAIT_L
#undef PG8_BAR
#undef PG8_SCHED
}
}
namespace pg8 {
constexpr float ATT_C2 = 0.125f * 1.4426950408889634f;
constexpr float GLA_QS = 0.08838834764831845f;
struct EpiProj {
    static constexpr bool PERM = true;
    bf16_t *Qb, *Kb, *Vb, *GQ, *GK, *GV, *SG, *GT; const float* bgates;
    __device__ __forceinline__ void operator()(const f32x4 (&acc)[2][2][4][2], const Unit& u, int wr, int wc, int fr, int fq) const {
        asm volatile("" : "+v"(fr), "+v"(fq));
        const int pn = u.pn; bf16_t* base; int ldc = 1024, ct; int act = 0; float sc = 1.f;
        if (pn < 4) { base = Qb; ct = pn; sc = ATT_C2; }
        else if (pn < 8) { base = Kb; ct = pn - 4; }
        else if (pn < 12) { base = Vb; ct = pn - 8; }
        else if (pn < 14) { base = GQ; ldc = 512; ct = pn - 12; sc = GLA_QS; }
        else if (pn < 16) { base = GK; ldc = 512; ct = pn - 14; }
        else if (pn < 20) { base = GV; ct = pn - 16; }
        else if (pn < 24) { base = SG; ct = pn - 20; act = 1; }
        else { base = GT; ldc = 2048; ct = pn - 24; act = 2; }
        const int row0 = u.pm * BM + wr * 64 + fr, col0 = ct * BM + wc * 32 + 8 * fq;
        f32x4 bv[2][2];
#pragma unroll
        for (int bj = 0; bj < 2; ++bj)
#pragma unroll
            for (int n = 0; n < 2; ++n) bv[bj][n] = (act == 2) ? *(const f32x4*)(bgates + col0 + bj * HALF + 4 * n) : (f32x4){0.f, 0.f, 0.f, 0.f};
#pragma unroll
        for (int ai = 0; ai < 2; ++ai)
#pragma unroll
            for (int m = 0; m < 4; ++m) { bf16_t* rowp = base + (size_t)(row0 + ai * HALF + m * 16) * ldc + col0;
#pragma unroll
                for (int bj = 0; bj < 2; ++bj) { f32x4 v0 = acc[ai][bj][m][0] * sc + bv[bj][0], v1 = acc[ai][bj][m][1] * sc + bv[bj][1];
                    if (act != 0) {
#pragma unroll
                        for (int e = 0; e < 4; ++e) { const float s0 = sigmoidf_(v0[e]), s1 = sigmoidf_(v1[e]); v0[e] = (act == 1) ? v0[e] * s0 : s0; v1[e] = (act == 1) ? v1[e] * s1 : s1; } }
                    u32x4 w; w.x = cvt_pk_bf16(v0[0], v0[1]); w.y = cvt_pk_bf16(v0[2], v0[3]); w.z = cvt_pk_bf16(v1[0], v1[1]); w.w = cvt_pk_bf16(v1[2], v1[3]);
                    *(u32x4*)(rowp + bj * HALF) = w; } }
    }
};
template <int MODE> struct EpiGate {
    static constexpr bool PERM = true;
    bf16_t* O; int ldo; const bf16_t* T; const bf16_t* gate; int ldg, gcol0;
    __device__ __forceinline__ void operator()(const f32x4 (&acc)[2][2][4][2], const Unit& u, int wr, int wc, int fr, int fq) const {
        asm volatile("" : "+v"(fr), "+v"(fq));
        const int row0 = u.pm * BM + wr * 64 + fr, col0 = u.pn * BM + wc * 32 + 8 * fq;
#pragma unroll
        for (int ai = 0; ai < 2; ++ai)
#pragma unroll
            for (int m = 0; m < 4; ++m) { const size_t row = (size_t)(row0 + ai * HALF + m * 16);
#pragma unroll
                for (int bj = 0; bj < 2; ++bj) { f32x4 v0 = acc[ai][bj][m][0], v1 = acc[ai][bj][m][1]; const int col = col0 + bj * HALF;
                    if (MODE != 2) { const u32x4 gw = *(const u32x4*)(gate + row * ldg + gcol0 + col);
                        v0 = v0 * (f32x4){bf_lo(gw.x), bf_hi(gw.x), bf_lo(gw.y), bf_hi(gw.y)}; v1 = v1 * (f32x4){bf_lo(gw.z), bf_hi(gw.z), bf_lo(gw.w), bf_hi(gw.w)}; }
                    if (MODE == 1) { const u32x4 tw = *(const u32x4*)(T + row * ldo + col);
                        v0 = v0 + (f32x4){bf_lo(tw.x), bf_hi(tw.x), bf_lo(tw.y), bf_hi(tw.y)}; v1 = v1 + (f32x4){bf_lo(tw.z), bf_hi(tw.z), bf_lo(tw.w), bf_hi(tw.w)}; }
                    u32x4 w; w.x = cvt_pk_bf16(v0[0], v0[1]); w.y = cvt_pk_bf16(v0[2], v0[3]); w.z = cvt_pk_bf16(v1[0], v1[1]); w.w = cvt_pk_bf16(v1[2], v1[3]);
                    *(u32x4*)(O + row * ldo + col) = w; }
                asm volatile("" ::: "memory"); }
    }
};
struct EpiGatePair {
    static constexpr bool PERM = true;
    bf16_t* TMP; long mix_delta; const bf16_t* gate;
    __device__ __forceinline__ void operator()(const f32x4 (&acc)[2][2][4][2], const Unit& u, int wr, int wc, int fr, int fq) const {
        asm volatile("" : "+v"(fr), "+v"(fq));
        const int kind = u.pm >= 128 ? 1 : 0; const int row0 = (u.pm - 128 * kind) * BM + wr * 64 + fr, col0 = u.pn * BM + wc * 32 + 8 * fq;
#pragma unroll
        for (int ai = 0; ai < 2; ++ai)
#pragma unroll
            for (int m = 0; m < 4; ++m) { const size_t row = (size_t)(row0 + ai * HALF + m * 16);
#pragma unroll
                for (int bj = 0; bj < 2; ++bj) { f32x4 v0 = acc[ai][bj][m][0], v1 = acc[ai][bj][m][1]; const int col = col0 + bj * HALF;
                    { const u32x4 gw = *(const u32x4*)(gate + row * 2048 + kind * 1024 + col);
                      v0 = v0 * (f32x4){bf_lo(gw.x), bf_hi(gw.x), bf_lo(gw.y), bf_hi(gw.y)}; v1 = v1 * (f32x4){bf_lo(gw.z), bf_hi(gw.z), bf_lo(gw.w), bf_hi(gw.w)}; }
                    if (kind) { const u32x4 tw = *(const u32x4*)(TMP + row * 1024 + col);
                        v0 = v0 + (f32x4){bf_lo(tw.x), bf_hi(tw.x), bf_lo(tw.y), bf_hi(tw.y)}; v1 = v1 + (f32x4){bf_lo(tw.z), bf_hi(tw.z), bf_lo(tw.w), bf_hi(tw.w)}; }
                    u32x4 w; w.x = cvt_pk_bf16(v0[0], v0[1]); w.y = cvt_pk_bf16(v0[2], v0[3]); w.z = cvt_pk_bf16(v1[0], v1[1]); w.w = cvt_pk_bf16(v1[2], v1[3]);
                    *(u32x4*)(TMP + (long)kind * mix_delta + row * 1024 + col) = w; }
                asm volatile("" ::: "memory"); }
    }
};
struct PairOrder {
    StaticOrder S;
    __device__ __forceinline__ bool next(int i, Unit& u) const { if (!S.next(i >> 1, u)) return false; const int kind = i & 1; u.pm += 128 * kind; u.pb = u.pn + 16 * kind; return true; }
};
struct EpiResid {
    static constexpr bool PERM = false;
    const float* X; float* Xo; const float* gvec; int gstride; float alpha;
    __device__ __forceinline__ void operator()(const f32x4 (&acc)[2][2][4][2], const Unit& u, int wr, int wc, int fr, int fq) const {
        asm volatile("" : "+v"(fr), "+v"(fq));
        const int row0 = u.pm * BM + wr * 64 + fr, col0 = u.pn * BM + wc * 32 + 4 * fq; const float* gv = gvec + (size_t)(u.pm >> 4) * gstride;
        f32x4 g4[2][2];
#pragma unroll
        for (int bj = 0; bj < 2; ++bj)
#pragma unroll
            for (int n = 0; n < 2; ++n) g4[bj][n] = *(const f32x4*)(gv + col0 + bj * HALF + n * 16);
#pragma unroll
        for (int ai = 0; ai < 2; ++ai)
#pragma unroll
            for (int m = 0; m < 4; ++m) { const size_t ro = (size_t)(row0 + ai * HALF + m * 16) * 1024 + col0;
#pragma unroll
                for (int bj = 0; bj < 2; ++bj)
#pragma unroll
                    for (int n = 0; n < 2; ++n) { const size_t o = ro + bj * HALF + n * 16; const f32x4 xv = *(const f32x4*)(X + o); *(f32x4*)(Xo + o) = xv * alpha + g4[bj][n] * acc[ai][bj][m][n]; }
                asm volatile("" ::: "memory"); }
    }
};
struct EpiSwiGLU {
    static constexpr bool PERM = true;
    bf16_t* H;
    __device__ __forceinline__ void operator()(const f32x4 (&acc)[2][2][4][2], const Unit& u, int wr, int wc, int fr, int fq) const {
        asm volatile("" : "+v"(fr), "+v"(fq));
        const int row0 = u.pm * BM + wr * 64 + fr, col0 = u.pn * HALF + wc * 32 + 8 * fq;
#pragma unroll
        for (int ai = 0; ai < 2; ++ai)
#pragma unroll
            for (int m = 0; m < 4; ++m) { f32x4 h0, h1;
#pragma unroll
                for (int e = 0; e < 4; ++e) { const float g0 = acc[ai][0][m][0][e], g1 = acc[ai][0][m][1][e]; h0[e] = g0 * sigmoidf_(g0) * acc[ai][1][m][0][e]; h1[e] = g1 * sigmoidf_(g1) * acc[ai][1][m][1][e]; }
                u32x4 w; w.x = cvt_pk_bf16(h0[0], h0[1]); w.y = cvt_pk_bf16(h0[2], h0[3]); w.z = cvt_pk_bf16(h1[0], h1[1]); w.w = cvt_pk_bf16(h1[2], h1[3]);
                *(u32x4*)(H + (size_t)(row0 + ai * HALF + m * 16) * 512 + col0) = w; }
    }
};
}
#include <hip/hip_bf16.h>
#include <cmath>
namespace attn_body {
using bf16=__hip_bfloat16;
using bf16x8=__attribute__((ext_vector_type(8)))short;
using s16x4=__attribute__((ext_vector_type(4)))short;
using f32x16=__attribute__((ext_vector_type(16)))float;
using u32x4=__attribute__((ext_vector_type(4)))unsigned;
constexpr int BATCH=8,NHEAD=16,SEQ=4096,D=64,DM=NHEAD*D,OPITCH=2048;
constexpr int NW=8,QBLK=32,QB=QBLK*NW,KVBLK=64,NQB=SEQ/QB;
constexpr int ATTN_PITCH=DM, ATTN_UNIT_ROWS=QB;
__device__ __forceinline__ int crow(int r,int hi){return (r&3)+8*(r>>2)+4*hi;}
#define SBAR() __builtin_amdgcn_sched_barrier(0)
__device__ __forceinline__ void cmask(f32x16&p0,f32x16&p1,int jb,int qrel,int hi){
  const float NEG=-INFINITY; int kb=64*jb+4*hi;
  #pragma unroll
  for(int r=0;r<16;++r){int kv=kb+(r&3)+8*(r>>2); if(kv>qrel)p0[r]=NEG; if(kv+32>qrel)p1[r]=NEG;}
}

constexpr int NSLOT=3, SLOTB=8192;
constexpr int LDS_K=0, LDS_V=NSLOT*SLOTB, LDS_WS=3*NSLOT*SLOTB, LDS_OST=LDS_WS+NW*64*4, LDS_BYTES=LDS_OST+NW*4096;
constexpr float C2=0.125f*1.4426950408889634f;
__device__ __forceinline__ void glds16s(const void*sbase,unsigned voff,unsigned lds_dst){unsigned keep;
  asm volatile("s_mov_b32 %0, m0\n\ts_mov_b32 m0, %2\n\ts_nop 0\n\tglobal_load_lds_dwordx4 %1, %3\n\ts_mov_b32 m0, %0":"=&s"(keep):"v"(voff),"s"(lds_dst),"s"(sbase):"memory");}
__device__ __forceinline__ void glds16(const void*gsrc,unsigned lds_dst){unsigned keep;
  asm volatile("s_mov_b32 %0, m0\n\ts_mov_b32 m0, %2\n\ts_nop 0\n\tglobal_load_lds_dwordx4 %1, off\n\ts_mov_b32 m0, %0":"=&s"(keep):"v"(gsrc),"s"(lds_dst):"memory");}
__device__ __forceinline__ float max3f(float a,float b,float c){float r;asm("v_max3_f32 %0, %1, %2, %3":"=v"(r):"v"(a),"v"(b),"v"(c));return r;}
__device__ __forceinline__ float max2f(float a,float b){float r;asm("v_max_f32_e32 %0, %1, %2":"=v"(r):"v"(a),"v"(b));return r;}
__device__ __forceinline__ float fadd_s(float a,float b){float r;asm("v_add_f32_e32 %0, %1, %2":"=v"(r):"v"(a),"v"(b));return r;}
__device__ __forceinline__ float fsub_s(float a,float b){float r;asm("v_sub_f32_e32 %0, %1, %2":"=v"(r):"v"(a),"v"(b));return r;}
typedef float f32x2_t __attribute__((ext_vector_type(2))); typedef __bf16 bf16x2_t __attribute__((ext_vector_type(2)));
__device__ __forceinline__ unsigned cvtpk_s(float lo,float hi){f32x2_t v={lo,hi};bf16x2_t b=__builtin_convertvector(v,bf16x2_t);return __builtin_bit_cast(unsigned,b);}
#define WAIT_BAR(N) asm volatile("s_waitcnt vmcnt(" #N ") lgkmcnt(0)\n\ts_barrier":::"memory")

__device__ __forceinline__ void qkt(f32x16&p0,f32x16&p1,const char*Kslot,const bf16x8*qr,const f32x16&c0,const f32x16&c1,int r32,int hi){
  const char*kb=Kslot+hi*1024+r32*16;
  #pragma unroll
  for(int d0=0;d0<4;++d0){
    const bf16x8 b0=*reinterpret_cast<const bf16x8*>(kb+d0*2048);
    const bf16x8 b1=*reinterpret_cast<const bf16x8*>(kb+d0*2048+512);
    if(d0==0){p0=__builtin_amdgcn_mfma_f32_32x32x16_bf16(b0,qr[0],c0,0,0,0);p1=__builtin_amdgcn_mfma_f32_32x32x16_bf16(b1,qr[0],c1,0,0,0);}
    else{p0=__builtin_amdgcn_mfma_f32_32x32x16_bf16(b0,qr[d0],p0,0,0,0);p1=__builtin_amdgcn_mfma_f32_32x32x16_bf16(b1,qr[d0],p1,0,0,0);}}
}
typedef __attribute__((address_space(3))) const char* lds_cptr;
typedef short v4i16_t __attribute__((ext_vector_type(4)));
__device__ __forceinline__ void kload8(bf16x8*kf,lds_cptr kp){
  kf[0]=*(const __attribute__((address_space(3))) bf16x8*)(kp);      kf[1]=*(const __attribute__((address_space(3))) bf16x8*)(kp+512);
  kf[2]=*(const __attribute__((address_space(3))) bf16x8*)(kp+2048); kf[3]=*(const __attribute__((address_space(3))) bf16x8*)(kp+2560);
  kf[4]=*(const __attribute__((address_space(3))) bf16x8*)(kp+4096); kf[5]=*(const __attribute__((address_space(3))) bf16x8*)(kp+4608);
  kf[6]=*(const __attribute__((address_space(3))) bf16x8*)(kp+6144); kf[7]=*(const __attribute__((address_space(3))) bf16x8*)(kp+6656);
}
__device__ __forceinline__ void kload2(bf16x8*kf,lds_cptr kp,int j){ kf[2*j]=*(const __attribute__((address_space(3))) bf16x8*)(kp+j*2048); kf[2*j+1]=*(const __attribute__((address_space(3))) bf16x8*)(kp+j*2048+512); }
__device__ __forceinline__ s16x4 vtr(lds_cptr p){ return __builtin_bit_cast(s16x4,__builtin_amdgcn_ds_read_tr16_b64_v4i16((__attribute__((address_space(3))) v4i16_t*)p)); }
__device__ __forceinline__ float rowmax(const f32x16&p0,const f32x16&p1){
  float a=max3f(p0[0],p0[1],p1[0]),b=max3f(p0[2],p0[3],p1[1]);a=max3f(a,p1[2],p1[3]);
  #pragma unroll
  for(int r=4;r<16;r+=4){a=max3f(a,p0[r],p0[r+1]);b=max3f(b,p0[r+2],p0[r+3]);a=max3f(a,p1[r],p1[r+1]);b=max3f(b,p1[r+2],p1[r+3]);}
  const float m=max2f(a,b);
  auto rr=__builtin_amdgcn_permlane32_swap(__float_as_uint(m),__float_as_uint(m),false,false);
  return max2f(__uint_as_float(rr[0]),__uint_as_float(rr[1]));
}
__device__ __forceinline__ void pv(f32x16*o,int vb,bf16x8 pa0,bf16x8 pa1,bf16x8 pa2,bf16x8 pa3){
  #pragma unroll
  for(int d0=0;d0<4;++d0){s16x4 lo[4],hi[4];
    #pragma unroll
    for(int ks=0;ks<4;++ks){
      asm volatile("ds_read_b64_tr_b16 %0,%1 offset:%c2":"=&v"(lo[ks]):"v"(vb),"i"(d0*4096+ks*1024):"memory");
      asm volatile("ds_read_b64_tr_b16 %0,%1 offset:%c2":"=&v"(hi[ks]):"v"(vb),"i"(d0*4096+ks*1024+512):"memory");}
    asm volatile("s_waitcnt lgkmcnt(0)":::"memory");SBAR();
    #define PK(k) (bf16x8){lo[k][0],lo[k][1],lo[k][2],lo[k][3],hi[k][0],hi[k][1],hi[k][2],hi[k][3]}
    o[d0]=__builtin_amdgcn_mfma_f32_32x32x16_bf16(pa0,PK(0),o[d0],0,0,0);
    o[d0]=__builtin_amdgcn_mfma_f32_32x32x16_bf16(pa1,PK(1),o[d0],0,0,0);
    o[d0]=__builtin_amdgcn_mfma_f32_32x32x16_bf16(pa2,PK(2),o[d0],0,0,0);
    o[d0]=__builtin_amdgcn_mfma_f32_32x32x16_bf16(pa3,PK(3),o[d0],0,0,0);
    #undef PK
  }
}

#ifndef ATTN_STORE16
#define ATTN_STORE16(p,v) (*(u32x4*)(p)=(v))
#endif
template<int THRL> __device__ __forceinline__ void attn_unit(int b,int hq,int hv,int ocol,int qb,int nfar,float sl2,const bf16*Q,const bf16*__restrict__ K,const bf16*__restrict__ V,bf16*O,char*shm){
  int tid_=threadIdx.x; asm volatile("":"+v"(tid_));
  const int tid=tid_,lane=tid&63,r32=lane&31,hi=lane>>5; const int wid=__builtin_amdgcn_readfirstlane(tid>>6);
  const long rowbase=(long)b*SEQ; const int q0=qb*QB;
  const bf16*Qw=Q+(rowbase+q0+wid*QBLK)*DM+hq*D;
  const int NTf=(q0+QB)/KVBLK, NT=(NTf<4+nfar)?NTf:4+nfar, t0=NTf-NT, q0c=q0-64*t0;
  const bf16*Kh=K+(rowbase+64*t0)*DM+hq*D,*Vh=V+(rowbase+64*t0)*DM+hv*D;
  const unsigned lds0=(unsigned)(uintptr_t)shm;
  float*wsf=(float*)(shm+LDS_WS)+wid*64;
  const unsigned kvoff=(unsigned)(lane*DM+wid*8)*2u;
  const unsigned vvoff=(unsigned)((16*(wid&3)+(lane>>2))*DM+(wid>>2)*32+(lane&3)*8)*2u;
  const unsigned kdst=lds0+LDS_K+wid*1024, vdst=lds0+LDS_V+wid*1024;
  #define DMA_K(t,slot) glds16s(Kh+(long)(t)*KVBLK*DM,kvoff,(unsigned)__builtin_amdgcn_readfirstlane(kdst+(slot)))
  #define DMA_V(t,slot) do{ glds16s(Vh+(long)(t)*KVBLK*DM,vvoff,(unsigned)__builtin_amdgcn_readfirstlane(vdst+2*(slot))); glds16s(Vh+(long)(t)*KVBLK*DM+64,vvoff,(unsigned)__builtin_amdgcn_readfirstlane(vdst+2*(slot)+8192)); }while(0)
  const int vb0=(int)(lds0+LDS_V)+((lane>>4)&1)*32+(lane&3)*8+(4*hi+((lane&15)>>2))*64;
  const char*Kbase=shm+LDS_K; bf16x8 kf[8];
  const lds_cptr shm3=(lds_cptr)shm; const lds_cptr kp0=shm3+LDS_K+hi*1024+r32*16; const lds_cptr vp0=shm3+LDS_V+((lane>>4)&1)*32+(lane&3)*8+(4*hi+((lane&15)>>2))*64;
  DMA_K(0,0);DMA_V(0,0);DMA_K(1,SLOTB);
  bf16x8 qr[4];
  #pragma unroll
  for(int d0=0;d0<4;++d0)qr[d0]=*reinterpret_cast<const bf16x8*>(&Qw[(long)r32*DM+d0*16+hi*8]);
  float mhat=0.f,l_reg=0.f;f32x16 o[4];o[0]=f32x16{};o[1]=f32x16{};o[2]=f32x16{};o[3]=f32x16{};
  #define CINIT0(C0_,t_) do{ const float bt_=sl2*(float)(64*(t_)-q0c+4*hi)-mhat; _Pragma("unroll") for(int r=0;r<16;++r){C0_[r]=__builtin_fmaf(sl2,(float)((r&3)+8*(r>>2)),bt_);} }while(0)
  #define CINIT1(C1_,t_) do{ const float bt_=sl2*(float)(64*(t_)-q0c+4*hi)-mhat; _Pragma("unroll") for(int r=0;r<16;++r){C1_[r]=__builtin_fmaf(sl2,(float)((r&3)+8*(r>>2)+32),bt_);} }while(0)
  #define CINIT(C0_,C1_,t_) do{ CINIT0(C0_,t_); CINIT1(C1_,t_); }while(0)
  const int qrel=wid*QBLK+r32;
  #define CMASK(P0,P1,t) do{int jb_=(t)-(NT-4); if(jb_>=0)cmask(P0,P1,jb_,qrel,hi);}while(0)
  bool resc=false;
  #define START(P0,P1) do{ const float rm=rowmax(P0,P1); resc=false; \
    { const float dl=rm; mhat=fadd_s(mhat,dl); \
      _Pragma("unroll") for(int r=0;r<16;++r){P0[r]=fsub_s(P0[r],dl);P1[r]=fsub_s(P1[r],dl);} } \
    _Pragma("unroll") for(int r=0;r<16;++r)P0[r]=__builtin_amdgcn_exp2f(P0[r]); }while(0)
  #define RESC() do{ if(resc){ asm volatile("s_waitcnt lgkmcnt(0)":::"memory"); \
      _Pragma("unroll") for(int d_=0;d_<4;++d_) _Pragma("unroll") for(int r=0;r<16;++r)o[d_][r]*=wsf[crow(r,hi)]; } }while(0)
  f32x16 pA0,pA1,pB0,pB1;
  int sl_prev=0,sl_cur=0,sl_next=SLOTB;
  #define ROT() do{sl_prev=sl_cur;sl_cur=sl_next;sl_next=(sl_next==(NSLOT-1)*SLOTB)?0:sl_next+SLOTB;}while(0)
  DMA_K(2,2*SLOTB);
  WAIT_BAR(4);
  { f32x16 c0_,c1_; CINIT(c0_,c1_,0); qkt(pA0,pA1,Kbase,qr,c0_,c1_,r32,hi); } asm volatile("s_nop 15\n\ts_nop 7":"+v"(pA0),"+v"(pA1));CMASK(pA0,pA1,0);
  START(pA0,pA1);
  _Pragma("unroll") for(int r=0;r<16;++r)pA1[r]=__builtin_amdgcn_exp2f(pA1[r]);
  WAIT_BAR(0);
  DMA_K(3,0);DMA_V(1,SLOTB);
  ROT();
  kload8(kf,kp0+sl_cur);
  WAIT_BAR(3);
  s16x4 vlo[8],vhi[8]; u32x4 pw0,pw1,pw2,pw3;
  #define PKW(P,B) cvtpk_s(P[B],P[B+1])
  #define PAF(k) __builtin_bit_cast(bf16x8,pw##k)
  #define VFR(i) (bf16x8){vlo[i][0],vlo[i][1],vlo[i][2],vlo[i][3],vhi[i][0],vhi[i][1],vhi[i][2],vhi[i][3]}
  #define PIN(x) asm volatile("":"+v"(x))
  #define MX3(a,b,c) __builtin_fmaxf(__builtin_fmaxf((a),(b)),(c))
  #define GAPA(MF,A0,A1,A2,A3,W0,W1,PW) do{ MF; sacc+=A0; sacc+=A1; sacc+=A2; sacc+=A3; PIN(sacc); W0; W1; PIN(PW); SBAR(); }while(0)
  #define EX(v) __builtin_amdgcn_exp2f(v)
  #define GAPB(MF,X,B) do{ MF; X[B]=EX(X[B]); X[B+1]=EX(X[B+1]); PIN(X); SBAR(); }while(0)
  #define VRD2(sl,fr) do{ vlo[sl]=vtr(vp_+(((fr)>>2)*4096+((fr)&3)*1024)); vhi[sl]=vtr(vp_+(((fr)>>2)*4096+((fr)&3)*1024+512)); SBAR(); }while(0)
  #define VRD(i) do{ vlo[i]=vtr(vp_+(((i)>>2)*4096+((i)&3)*1024)); vhi[i]=vtr(vp_+(((i)>>2)*4096+((i)&3)*1024+512)); }while(0)
  #define KRD(G,j) do{ if(G){ kload2(kf,kp0+sl_next,j); SBAR(); } }while(0)
  #define STEP(C0,C1,P0,P1,t,GK,GV,GL) do{ CINIT0(C0,t); SBAR(); \
    const lds_cptr vp_=vp0+2*sl_prev; \
    VRD(0); SBAR(); float sacc=(P0[0]+P0[1]); \
    GAPA(C0=__builtin_amdgcn_mfma_f32_32x32x16_bf16(kf[0],qr[0],C0,0,0,0), P0[2],P0[3],P0[4],P0[5],     pw0[0]=PKW(P0,0), pw0[1]=PKW(P0,2), pw0); \
    CINIT1(C1,t); VRD(4); SBAR(); GAPA(C1=__builtin_amdgcn_mfma_f32_32x32x16_bf16(kf[1],qr[0],C1,0,0,0), P0[6],P0[7],P0[8],P0[9],     pw0[2]=PKW(P0,4), pw0[3]=PKW(P0,6), pw0); \
    VRD(1); SBAR(); GAPA(C0=__builtin_amdgcn_mfma_f32_32x32x16_bf16(kf[2],qr[1],C0,0,0,0),   P0[10],P0[11],P0[12],P0[13], pw1[0]=PKW(P0,8), pw1[1]=PKW(P0,10), pw1); \
    VRD(5); SBAR(); GAPA(C1=__builtin_amdgcn_mfma_f32_32x32x16_bf16(kf[3],qr[1],C1,0,0,0),   P0[14],P0[15],P1[0],P1[1],   pw1[2]=PKW(P0,12),pw1[3]=PKW(P0,14), pw1); \
    VRD(2); SBAR(); GAPA(C0=__builtin_amdgcn_mfma_f32_32x32x16_bf16(kf[4],qr[2],C0,0,0,0),   P1[2],P1[3],P1[4],P1[5],     pw2[0]=PKW(P1,0), pw2[1]=PKW(P1,2), pw2); \
    VRD(6); SBAR(); GAPA(C1=__builtin_amdgcn_mfma_f32_32x32x16_bf16(kf[5],qr[2],C1,0,0,0),   P1[6],P1[7],P1[8],P1[9],     pw2[2]=PKW(P1,4), pw2[3]=PKW(P1,6), pw2); \
    VRD(3); SBAR(); GAPA(C0=__builtin_amdgcn_mfma_f32_32x32x16_bf16(kf[6],qr[3],C0,0,0,0),   P1[10],P1[11],P1[12],P1[13], pw3[0]=PKW(P1,8), pw3[1]=PKW(P1,10), pw3); \
    VRD(7); SBAR(); GAPA(C1=__builtin_amdgcn_mfma_f32_32x32x16_bf16(kf[7],qr[3],C1,0,0,0),   P1[14],P1[15],0.f,0.f,       pw3[2]=PKW(P1,12),pw3[3]=PKW(P1,14), pw3); \
    l_reg+=sacc; \
    if(GK){DMA_K((t)+3,sl_cur);} if(GV){DMA_V((t)+1,sl_next);} \
    CMASK(C0,C1,t); \
    { float a=MX3(C0[0],C0[1],C1[0]),b=MX3(C0[2],C0[3],C1[1]); a=MX3(a,C1[2],C1[3]); \
      _Pragma("unroll") for(int r=4;r<16;r+=4){a=MX3(a,C0[r],C0[r+1]);b=MX3(b,C0[r+2],C0[r+3]);a=MX3(a,C1[r],C1[r+1]);b=MX3(b,C1[r+2],C1[r+3]);} \
      float rm=__builtin_fmaxf(a,b); { auto rr=__builtin_amdgcn_permlane32_swap(__float_as_uint(rm),__float_as_uint(rm),false,false); rm=__builtin_fmaxf(__uint_as_float(rr[0]),__uint_as_float(rr[1])); } \
      resc=false; \
      if(__builtin_expect(__any(rm>(float)THRL),0)){ const float dl=__builtin_fmaxf(rm,0.f); mhat+=dl; \
        _Pragma("unroll") for(int r=0;r<16;++r){C0[r]-=dl;C1[r]-=dl;} \
        const float f=__builtin_amdgcn_exp2f(-dl); l_reg*=f; if(hi==0)wsf[r32]=f; resc=true; } } \
    SBAR(); \
    GAPB(o[0]=__builtin_amdgcn_mfma_f32_32x32x16_bf16(PAF(0),VFR(0),o[0],0,0,0), C0,0);  VRD2(0,8); \
    GAPB(o[1]=__builtin_amdgcn_mfma_f32_32x32x16_bf16(PAF(0),VFR(4),o[1],0,0,0), C0,2);  VRD2(4,12); \
    KRD(GL,0); GAPB(o[0]=__builtin_amdgcn_mfma_f32_32x32x16_bf16(PAF(1),VFR(1),o[0],0,0,0), C0,4);  VRD2(1,9); \
    KRD(GL,1); GAPB(o[1]=__builtin_amdgcn_mfma_f32_32x32x16_bf16(PAF(1),VFR(5),o[1],0,0,0), C0,6);  VRD2(5,13); \
    KRD(GL,2); GAPB(o[0]=__builtin_amdgcn_mfma_f32_32x32x16_bf16(PAF(2),VFR(2),o[0],0,0,0), C0,8);  VRD2(2,10); \
    KRD(GL,3); GAPB(o[1]=__builtin_amdgcn_mfma_f32_32x32x16_bf16(PAF(2),VFR(6),o[1],0,0,0), C0,10); VRD2(6,14); \
    GAPB(o[0]=__builtin_amdgcn_mfma_f32_32x32x16_bf16(PAF(3),VFR(3),o[0],0,0,0), C0,12); VRD2(3,11); \
    GAPB(o[1]=__builtin_amdgcn_mfma_f32_32x32x16_bf16(PAF(3),VFR(7),o[1],0,0,0), C0,14); VRD2(7,15); \
    GAPB(o[2]=__builtin_amdgcn_mfma_f32_32x32x16_bf16(PAF(0),VFR(0),o[2],0,0,0), C1,0); \
    GAPB(o[3]=__builtin_amdgcn_mfma_f32_32x32x16_bf16(PAF(0),VFR(4),o[3],0,0,0), C1,2); \
    GAPB(o[2]=__builtin_amdgcn_mfma_f32_32x32x16_bf16(PAF(1),VFR(1),o[2],0,0,0), C1,4); \
    GAPB(o[3]=__builtin_amdgcn_mfma_f32_32x32x16_bf16(PAF(1),VFR(5),o[3],0,0,0), C1,6); \
    GAPB(o[2]=__builtin_amdgcn_mfma_f32_32x32x16_bf16(PAF(2),VFR(2),o[2],0,0,0), C1,8); \
    GAPB(o[3]=__builtin_amdgcn_mfma_f32_32x32x16_bf16(PAF(2),VFR(6),o[3],0,0,0), C1,10); \
    GAPB(o[2]=__builtin_amdgcn_mfma_f32_32x32x16_bf16(PAF(3),VFR(3),o[2],0,0,0), C1,12); \
    GAPB(o[3]=__builtin_amdgcn_mfma_f32_32x32x16_bf16(PAF(3),VFR(7),o[3],0,0,0), C1,14); \
    }while(0)
  int t=1;
  #undef CMASK
  #define CMASK(P0,P1,t) do{}while(0)
  for(;t+5<NT;t+=2){
    STEP(pB0,pB1,pA0,pA1,t,true,true,true);     WAIT_BAR(3); RESC(); ROT();
    STEP(pA0,pA1,pB0,pB1,t+1,true,true,true);   WAIT_BAR(3); RESC(); ROT();
  }
  #undef CMASK
  #define CMASK(P0,P1,t) do{int jb_=(t)-(NT-4); if(jb_>=0)cmask(P0,P1,jb_,qrel,hi);}while(0)
  #define ENDW(tt) do{ if((tt)+3<NT){WAIT_BAR(3);} else if((tt)+2<NT){WAIT_BAR(2);} else {WAIT_BAR(0);} }while(0)
  for(;t+1<NT;t+=2){
    STEP(pB0,pB1,pA0,pA1,t,(t+3<NT),(t+1<NT),(t+1<NT));       ENDW(t);   RESC(); ROT();
    STEP(pA0,pA1,pB0,pB1,t+1,(t+4<NT),(t+2<NT),(t+2<NT));     ENDW(t+1); RESC(); ROT();
  }
  STEP(pB0,pB1,pA0,pA1,NT-1,false,false,false); RESC();
  { float sacc=pB0[0]+pB0[1]; _Pragma("unroll") for(int r=2;r<16;++r)sacc+=pB0[r]; _Pragma("unroll") for(int r=0;r<16;++r)sacc+=pB1[r]; l_reg+=sacc;
    pw0=(u32x4){PKW(pB0,0),PKW(pB0,2),PKW(pB0,4),PKW(pB0,6)};pw1=(u32x4){PKW(pB0,8),PKW(pB0,10),PKW(pB0,12),PKW(pB0,14)};pw2=(u32x4){PKW(pB1,0),PKW(pB1,2),PKW(pB1,4),PKW(pB1,6)};pw3=(u32x4){PKW(pB1,8),PKW(pB1,10),PKW(pB1,12),PKW(pB1,14)};
    SBAR(); pv(o,vb0+2*sl_cur,PAF(0),PAF(1),PAF(2),PAF(3)); }
  #undef PKW
  #undef PAF
  #undef VFR
  #undef PIN
  #undef MX3
  #undef GAPA
  #undef GAPB
  #undef EX
  #undef VRD
  #undef VRD2
  #undef KRD
  #undef STEP
  #undef ENDW
  {auto rr=__builtin_amdgcn_permlane32_swap(__float_as_uint(l_reg),__float_as_uint(l_reg),false,false);l_reg=__uint_as_float(rr[0])+__uint_as_float(rr[1]);}
  if(hi==0)wsf[32+r32]=l_reg;asm volatile("s_waitcnt lgkmcnt(0)":::"memory");
  float rli[16];
  #pragma unroll
  for(int r=0;r<16;++r)rli[r]=__builtin_amdgcn_rcpf(wsf[32+crow(r,hi)]);
  bf16*Ow=O+(rowbase+q0+wid*QBLK)*OPITCH+ocol;
  { bf16*stg=(bf16*)(shm+LDS_OST)+wid*2048;
    int ln2_=lane; asm volatile("":"+v"(ln2_));
    #pragma unroll
    for(int hf=0;hf<2;++hf){
      #pragma unroll
      for(int r=0;r<16;++r){const int orow=crow(r,hi);
        #pragma unroll
        for(int d0=0;d0<2;++d0)stg[orow*64+d0*32+r32]=__float2bfloat16(o[2*hf+d0][r]*rli[r]);}
      asm volatile("s_waitcnt lgkmcnt(0)":::"memory");
      #pragma unroll
      for(int i=0;i<4;++i){const int row=i*8+(ln2_>>3),ch=ln2_&7; const u32x4 v=*(const u32x4*)(stg+row*64+ch*8); ATTN_STORE16(Ow+(long)row*OPITCH+hf*64+ch*8,v);}
      asm volatile("s_waitcnt lgkmcnt(0)":::"memory"); } }
  asm volatile("s_waitcnt lgkmcnt(0)\n\ts_barrier":::"memory");
  #undef DMA_K
  #undef DMA_V
  #undef CMASK
  #undef CINIT
  #undef CINIT0
  #undef CINIT1
  #undef START
  #undef RESC
  #undef ROT
}
constexpr int ATTN_LDS_BYTES=LDS_BYTES;
struct AttnTensors { const bf16* Q; const bf16* K; const bf16* V; bf16* O; };
template<int THRL=8> __device__ __forceinline__ void attn_phase(char*lds,const AttnTensors&T,unsigned*qw,volatile __attribute__((address_space(3))) unsigned*qs){
  for(;;){
    if(threadIdx.x==0) qs[0]=__hip_atomic_fetch_add(qw,2u,__ATOMIC_RELAXED,__HIP_MEMORY_SCOPE_AGENT);
    __syncthreads();
    const int idx0=__builtin_amdgcn_readfirstlane((int)qs[0]);
    __syncthreads();
    if(idx0>=2048)break;
    for(int idx=idx0;idx<idx0+2;++idx){
      const int c=idx&1,b=(idx>>1)&7,h=7-((idx>>4)&7),qb=15-(idx>>7);
      const float sl2=__uint_as_float(__builtin_amdgcn_readfirstlane(__float_as_uint(__builtin_amdgcn_exp2f(-(float)(h+1))*1.4426950408889634f)));
      const int nfar=(h==0)?6:(h==1)?10:(h==2)?20:(h==3)?38:64;
      attn_unit<THRL>(b,2*h+c,2*h,c*1024+h*128,qb,nfar,sl2,T.Q,T.K,T.V,T.O,lds);
    }
  }
}
#undef SBAR
#undef WAIT_BAR
}
#define GAS __attribute__((address_space(1)))
#define LAS __attribute__((address_space(3)))
typedef unsigned short bf16;
typedef unsigned v4u __attribute__((ext_vector_type(4)));
typedef float f32x4 __attribute__((ext_vector_type(4)));
typedef short bf16x8 __attribute__((ext_vector_type(8)));
typedef GAS unsigned gu32;
typedef GAS unsigned long long gu64;
#define RLX_AGENT __ATOMIC_RELAXED, __HIP_MEMORY_SCOPE_AGENT
#define LDS_WAIT() asm volatile("s_waitcnt lgkmcnt(0)" ::: "memory")
#define VM_WAIT() asm volatile("s_waitcnt vmcnt(0)" ::: "memory")
__device__ __forceinline__ unsigned long long rt() { return __builtin_amdgcn_s_memrealtime(); }
__device__ __forceinline__ unsigned f2bf(float f) { unsigned u = __builtin_bit_cast(unsigned, f); return (u + 0x7fffu + ((u >> 16) & 1u)) >> 16; }
__device__ __forceinline__ unsigned pk2(float lo, float hi) { return f2bf(lo) | (f2bf(hi) << 16); }

#define XB_TMO      128
#define XB_XCNT(j)  (256  + 64 * (j))
#define XB_XSUB(j)  (1280 + 64 * (j))
#define XB_XGEN(j)  (2304 + 64 * (j))
#define XB_TOP      3328
#define XB_TOPGEN   3392
#define XCD_BAR_WORDS 3456
#define XB_SPIN_CAP (1u << 18)

__device__ __forceinline__ unsigned xb_ld(unsigned* p)              { return __hip_atomic_load(p, __ATOMIC_RELAXED, __HIP_MEMORY_SCOPE_AGENT); }
__device__ __forceinline__ unsigned xb_add(unsigned* p, unsigned v) { return __hip_atomic_fetch_add(p, v, __ATOMIC_RELAXED, __HIP_MEMORY_SCOPE_AGENT); }
__device__ __forceinline__ unsigned xb_xcc_id() { return (unsigned)__builtin_amdgcn_s_getreg((3 << 11) | 20) & 0xFu; }
#define XB_SPIN(cond, bar) do { unsigned _sp = 0; while (cond) { __builtin_amdgcn_s_sleep(1); \
    if ((++_sp & 255u) == 0u) { if (xb_ld(&(bar)[XB_TMO])) break; if (_sp > XB_SPIN_CAP) { atomicAdd(&(bar)[XB_TMO], 1u); break; } } } } while (0)

struct XcdBarrier {
    unsigned* bar; unsigned x;
    volatile LAS unsigned* st;
};

__device__ __forceinline__ XcdBarrier xcd_barrier_post(unsigned* bar, volatile LAS unsigned* st) {
    XcdBarrier b; b.bar = bar; b.x = xb_xcc_id(); b.st = st;
    if (threadIdx.x == 0) (void)xb_add(&bar[XB_XCNT(b.x)], 1u);
    return b;
}
__device__ __forceinline__ void xcd_barrier_complete(unsigned* bar, unsigned x, unsigned& nloc, unsigned& nx) {
    const unsigned G = gridDim.x * gridDim.y * gridDim.z;
    unsigned sum, cnt, mine, sp = 0u;
    for (;;) {
        sum = 0u; cnt = 0u; mine = 0u;
#pragma unroll
        for (unsigned j = 0; j < 16; ++j) { const unsigned c = xb_ld(&bar[XB_XCNT(j)]); sum += c; cnt += (c > 0u) ? 1u : 0u; mine = (j == x) ? c : mine; }
        if (sum == G) break;
        __builtin_amdgcn_s_sleep(1);
        if ((++sp & 255u) == 0u) { if (xb_ld(&bar[XB_TMO])) break; if (sp > XB_SPIN_CAP) { atomicAdd(&bar[XB_TMO], 1u); break; } }
    }
    nloc = mine > 0u ? mine : 1u; nx = cnt > 0u ? cnt : 1u;
}

__device__ __forceinline__ void xcd_barrier(const XcdBarrier& b) {
    asm volatile("s_waitcnt vmcnt(0)" ::: "memory");
    __syncthreads();
    if (threadIdx.x == 0) {
        unsigned* bar = b.bar;
        __builtin_amdgcn_s_waitcnt(0);
        unsigned nloc = b.st[0], nx = b.st[1];
        if (nloc == 0u) { xcd_barrier_complete(bar, b.x, nloc, nx); b.st[0] = nloc; b.st[1] = nx; }
        const unsigned old = xb_add(&bar[XB_XSUB(b.x)], 1u);
        const unsigned gen = old / nloc;
        if (old + 1u == (gen + 1u) * nloc) {
            __builtin_amdgcn_fence(__ATOMIC_RELEASE, "agent");
            asm volatile("s_waitcnt vmcnt(0)" ::: "memory");
            const unsigned og = xb_add(&bar[XB_TOP], 1u);
            const unsigned tg = og / nx;
            if (og + 1u == (tg + 1u) * nx) xb_add(&bar[XB_TOPGEN], 1u);
            else XB_SPIN(xb_ld(&bar[XB_TOPGEN]) == tg, bar);
            __builtin_amdgcn_fence(__ATOMIC_ACQUIRE, "agent");
            xb_add(&bar[XB_XGEN(b.x)], 1u);
            asm volatile("s_waitcnt vmcnt(0)" ::: "memory");
        } else {
            XB_SPIN(xb_ld(&bar[XB_XGEN(b.x)]) == gen, bar);
            __builtin_amdgcn_fence(__ATOMIC_ACQUIRE, "agent");
            asm volatile("s_waitcnt vmcnt(0)" ::: "memory");
        }
    }
    __syncthreads();
}
constexpr int NWAVES = 8, NTHREADS = 512;
constexpr int BATCH = 8, SEQ = 4096, DM = 1024, NTOK = BATCH * SEQ, DEPTH = 4;
constexpr int DIN = 8208, NPROJ = 8192;
constexpr int NEXP = 32, DEXP = 512, LISTCAP = 32768, MOE_MAXT = 288;
constexpr float LN_EPS = 1e-5f, DN_ALPHA = 1.6817928305074292f;
constexpr size_t MiB = 1u << 20;
constexpr size_t WS_CTL = 0, CTL_ZERO_BYTES = 1 * MiB;
constexpr size_t WS_ADA = 1 * MiB;
constexpr size_t WS_ABWT = 2 * MiB;
constexpr size_t WS_RWT = 2 * MiB + 256 * 1024;
constexpr size_t WS_TOKINFO = 3 * MiB;
constexpr size_t WS_LIST = 4 * MiB;
constexpr size_t WS_SSQ = 8 * MiB;
constexpr size_t WS_PRM = 16 * MiB;
constexpr int PO_BGATES = 0, PO_WALPHA = 8192, PO_BALPHA = 40960, PO_LQ1 = 43008, PO_LK1 = 43264, PO_LQ2 = 43520, PO_LK2 = 43776, PO_DIFFG = 44032, PO_GLAG = 44544,
              PO_LN1G = 45568, PO_LN1B = 49664, PO_BRG = 53760, PO_BRE = 53776, PO_LN2G = 53904, PO_LN2B = 58000, PO_END = 62096;
constexpr size_t WS_GDEC = 18 * MiB;
constexpr size_t WS_WIN = 32 * MiB;
constexpr size_t WS_WBA = 96 * MiB, WS_WBB = 104 * MiB, WS_WOUT = 112 * MiB;
constexpr size_t WS_W1 = 120 * MiB;
constexpr size_t WS_WD = 376 * MiB;
constexpr size_t WS_U = 504 * MiB;
constexpr size_t WS_QB = 568 * MiB, WS_KB = 632 * MiB, WS_VB = 696 * MiB;
constexpr size_t WS_GQ = 760 * MiB, WS_GK = 792 * MiB;
constexpr size_t WS_GV = 824 * MiB, WS_SG = 888 * MiB;
constexpr size_t WS_GT = 952 * MiB;
constexpr size_t WS_LA = 1080 * MiB;
constexpr size_t WS_END = 1144 * MiB;
constexpr size_t WS_OB = WS_U;
constexpr size_t WS_OP = WS_GQ;
constexpr size_t WS_OA2 = WS_QB, WS_OB2 = WS_KB;
constexpr size_t WS_TMP = WS_VB, WS_MIX = WS_GQ;
constexpr size_t WS_H = WS_QB;
constexpr size_t WS_YB = WS_QB + 72 * MiB;
constexpr int CW_ATQ = 32768;
constexpr int CW_TMO = 0, CW_CODE = 1, CW_BAR = 4096, CW_CNT = 8192;
constexpr int RING_OFF = 0, RING_BYTES = 147456;
constexpr int LDSCTL_OFF = RING_BYTES, MISC_OFF = LDSCTL_OFF + 320;
constexpr int TAB_CNT = RING_BYTES + 512, TAB_BASE = RING_BYTES + 640, TAB_IDX = RING_BYTES + 1024, IDX_UNITS = 8;
constexpr int LDS_BYTES = 163840;
static_assert(TAB_IDX + IDX_UNITS * 256 * 4 <= LDS_BYTES, "LDS map");
struct Frame {
    LAS unsigned char* lds;
    gu32* ctl;
    int tid, lane, wave, vcu, G;
    float* out; unsigned char* ws; const float* prm;
    float* xst; bf16* Ubuf; float* LAbuf; int dry;
};
enum { I_X = 0, I_C, I_WADA, I_BADA, I_WIN, I_BGATES, I_WALPHA, I_BALPHA, I_LQ1, I_LK1, I_LQ2, I_LK2, I_DIFFG, I_GLAG, I_WBA, I_WBB, I_WOUT, I_LN1G, I_LN1B,
       I_WRG, I_BRG, I_WRE, I_BRE, I_WGE, I_WUE, I_WDE, I_LN2G, I_LN2B };
__device__ __forceinline__ float dpp_add(float v, const int ctrl_sel) {
    const int x = __float_as_int(v); int y;
    if (ctrl_sel == 0) y = __builtin_amdgcn_update_dpp(x, x, 0xB1, 0xF, 0xF, false);
    else if (ctrl_sel == 1) y = __builtin_amdgcn_update_dpp(x, x, 0x4E, 0xF, 0xF, false);
    else if (ctrl_sel == 2) y = __builtin_amdgcn_update_dpp(x, x, 0x141, 0xF, 0xF, false);
    else y = __builtin_amdgcn_update_dpp(x, x, 0x140, 0xF, 0xF, false);
    return v + __int_as_float(y);
}
__device__ __forceinline__ float wave_sum(float v) {
    v = dpp_add(v, 0); v = dpp_add(v, 1); v = dpp_add(v, 2); v = dpp_add(v, 3);
    { auto rr = __builtin_amdgcn_permlane16_swap(__float_as_uint(v), __float_as_uint(v), false, false); v = __uint_as_float(rr[0]) + __uint_as_float(rr[1]); }
    { auto rr = __builtin_amdgcn_permlane32_swap(__float_as_uint(v), __float_as_uint(v), false, false); v = __uint_as_float(rr[0]) + __uint_as_float(rr[1]); }
    return v;
}
__device__ __forceinline__ float siluf_(float x) { return x * __builtin_amdgcn_rcpf(1.0f + __expf(-x)); }
__device__ __forceinline__ float bflo(unsigned w) { return __uint_as_float(w << 16); }
__device__ __forceinline__ float bfhi(unsigned w) { return __uint_as_float(w & 0xffff0000u); }

__device__ __forceinline__ void p0_ada(Frame& F, const float* c, const float* wada, const float* bada) {
    LAS float* COND = (LAS float*)(F.lds);
    LAS float* PART = (LAS float*)(F.lds + 32768);
    float* ADA = (float*)(F.ws + WS_ADA);
    for (int i = F.tid; i < 8192; i += NTHREADS) COND[i] = siluf_(c[i]);
    __syncthreads();
    for (int cg = (int)blockIdx.x; cg < 256; cg += F.G) {
        const int l = cg >> 6, j0 = (cg & 63) * 96;
        const int col4 = F.lane % 24, ksub = F.lane / 24;
        f32x4 acc[8];
#pragma unroll
        for (int b = 0; b < 8; ++b) acc[b] = (f32x4){0.f, 0.f, 0.f, 0.f};
        if (ksub < 2) {
            const float* wp = wada + ((size_t)l * 1024 + (size_t)(F.wave * 128 + ksub)) * 6144 + j0 + 4 * col4;
#pragma unroll 8
            for (int kk = 0; kk < 64; ++kk) {
                const f32x4 wv = *(const GAS f32x4*)(wp + (size_t)kk * 2 * 6144); const int k = F.wave * 128 + 2 * kk + ksub;
#pragma unroll
                for (int b = 0; b < 8; ++b) acc[b] += wv * COND[b * 1024 + k];
            }
#pragma unroll
            for (int b = 0; b < 8; ++b) *(LAS f32x4*)(PART + ((F.wave * 2 + ksub) * 8 + b) * 96 + 4 * col4) = acc[b];
        }
        __syncthreads();
        for (int idx = F.tid; idx < 768; idx += NTHREADS) { const int b = idx / 96, col = idx % 96; float s = 0.f;
#pragma unroll
            for (int p = 0; p < 16; ++p) s += PART[(p * 8 + b) * 96 + col];
            ADA[((size_t)l * 8 + b) * 6144 + j0 + col] = s + bada[l * 6144 + j0 + col]; }
        __syncthreads();
    }
}
struct RmIdent { __device__ __forceinline__ int operator()(int n) const { return n; } };
struct RmWin { __device__ __forceinline__ int operator()(int n) const { return n < 6144 ? n : (n < 6160 ? -1 : n - 16); } };
struct RmGateUp { int up; __device__ __forceinline__ int operator()(int n) const { return (n >> 7) * 256 + up * 128 + (n & 127); } };
template <class RowMap>
__device__ __forceinline__ void p0_transpose_item(const float* W, int K, int N, bf16* WT, const RowMap rm, LAS float* scr, int kb, int nb, int lane) {
    const int k0 = 64 * kb, n0 = 32 * nb; const int nl = n0 + (lane & 31);
#pragma unroll 8
    for (int i = 0; i < 32; ++i) { const int kk = 2 * i + (lane >> 5); scr[kk * 33 + (lane & 31)] = (nl < N) ? W[(size_t)(k0 + kk) * N + nl] : 0.f; }
    LDS_WAIT(); asm volatile("" ::: "memory");
    const int c = lane & 7;
#pragma unroll
    for (int j = 0; j < 4; ++j) { const int nn = (lane >> 3) + 8 * j, n = n0 + nn; const LAS float* s = scr + (8 * c) * 33 + nn;
        v4u o; o.x = pk2(s[0 * 33], s[1 * 33]); o.y = pk2(s[2 * 33], s[3 * 33]); o.z = pk2(s[4 * 33], s[5 * 33]); o.w = pk2(s[6 * 33], s[7 * 33]);
        const int r = (n < N) ? rm(n) : -1;
        if (r >= 0) *(GAS v4u*)(WT + (size_t)r * K + k0 + 8 * c) = o; }
    LDS_WAIT(); asm volatile("" ::: "memory");
}
struct SmallPrm { const float *bgates, *walpha, *balpha, *lq1, *lk1, *lq2, *lk2, *diffg, *glag, *ln1g, *ln1b, *brg, *bre, *ln2g, *ln2b; };
__device__ __forceinline__ void p0_copy(float* dst, const float* src, int n, int gt, int NGT) { for (int i = gt; i < n; i += NGT) dst[i] = src[i]; }
__device__ __forceinline__ void p0_weights(Frame& F, const float* win, const float* wba, const float* wbb, const float* wout, const float* wge, const float* wue, const float* wde, const float* wrg, const float* wre, const SmallPrm sp) {
    LAS float* scr = (LAS float*)(F.lds + RING_OFF + F.wave * 16384);
    const int gw = F.vcu * NWAVES + F.wave, NGW = F.G * NWAVES;
    constexpr int I_IN = 4 * 16 * 257, I_SQ = 12 * 16 * 32, I_E = 128 * 16 * 16, I_D = 128 * 8 * 32;
    constexpr int NITEMS = I_IN + I_SQ + 2 * I_E + I_D;
    for (int it = gw; it < NITEMS; it += NGW) {
        int r = it;
        if (r < I_IN) { const int l = r / 4112, q = r % 4112;
            p0_transpose_item(win + (size_t)l * 1024 * DIN, 1024, DIN, (bf16*)(F.ws + WS_WIN) + (size_t)l * NPROJ * 1024, RmWin{}, scr, q / 257, q % 257, F.lane); continue; }
        r -= I_IN;
        if (r < I_SQ) { const int mat = r / 512, q = r % 512, which = mat >> 2, l = mat & 3;
            const float* W = (which == 0 ? wba : (which == 1 ? wbb : wout)) + (size_t)l * 1024 * 1024;
            bf16* WT = (bf16*)(F.ws + (which == 0 ? WS_WBA : (which == 1 ? WS_WBB : WS_WOUT))) + (size_t)l * 1024 * 1024;
            p0_transpose_item(W, 1024, 1024, WT, RmIdent{}, scr, q / 32, q % 32, F.lane); continue; }
        r -= I_SQ;
        if (r < 2 * I_E) { const int up = r >= I_E ? 1 : 0; if (up) r -= I_E; const int me = r / 256, q = r % 256;
            p0_transpose_item((up ? wue : wge) + (size_t)me * 1024 * 512, 1024, 512, (bf16*)(F.ws + WS_W1) + (size_t)me * 1024 * 1024, RmGateUp{up}, scr, q / 16, q % 16, F.lane); continue; }
        r -= 2 * I_E;
        { const int me = r / 256, q = r % 256;
          p0_transpose_item(wde + (size_t)me * 512 * 1024, 512, 1024, (bf16*)(F.ws + WS_WD) + (size_t)me * 1024 * 512, RmIdent{}, scr, q / 32, q % 32, F.lane); }
    }
    const int gt = F.vcu * NTHREADS + F.tid, NGT = F.G * NTHREADS;
    float* ABWT = (float*)(F.ws + WS_ABWT); float* RWT = (float*)(F.ws + WS_RWT);
    { float* P = (float*)(F.ws + WS_PRM);
      p0_copy(P + PO_BGATES, sp.bgates, 8192, gt, NGT); p0_copy(P + PO_WALPHA, sp.walpha, 32768, gt, NGT); p0_copy(P + PO_BALPHA, sp.balpha, 2048, gt, NGT);
      p0_copy(P + PO_LQ1, sp.lq1, 256, gt, NGT); p0_copy(P + PO_LK1, sp.lk1, 256, gt, NGT); p0_copy(P + PO_LQ2, sp.lq2, 256, gt, NGT); p0_copy(P + PO_LK2, sp.lk2, 256, gt, NGT);
      p0_copy(P + PO_DIFFG, sp.diffg, 512, gt, NGT); p0_copy(P + PO_GLAG, sp.glag, 1024, gt, NGT); p0_copy(P + PO_LN1G, sp.ln1g, 4096, gt, NGT); p0_copy(P + PO_LN1B, sp.ln1b, 4096, gt, NGT);
      p0_copy(P + PO_BRG, sp.brg, 16, gt, NGT); p0_copy(P + PO_BRE, sp.bre, 128, gt, NGT); p0_copy(P + PO_LN2G, sp.ln2g, 4096, gt, NGT); p0_copy(P + PO_LN2B, sp.ln2b, 4096, gt, NGT); }
    for (int i = gt; i < 4 * 16 * 1024; i += NGT) { const int l = i >> 14, r = (i >> 10) & 15, k = i & 1023; ABWT[i] = win[((size_t)l * 1024 + k) * DIN + 6144 + r]; }
    for (int i = gt; i < 4 * 36 * 1024; i += NGT) { const int l = i / 36864, c = (i / 1024) % 36, k = i & 1023;
        RWT[i] = (c < 4) ? wrg[((size_t)l * 1024 + k) * 4 + c] : wre[((size_t)l * 1024 + k) * 32 + (c - 4)]; }
}

typedef f32x4 Row4[4];
__device__ __forceinline__ void row_load(Row4& v, const float* p, int lane) { const GAS f32x4* q = (const GAS f32x4*)p + lane;
#pragma unroll
    for (int j = 0; j < 4; ++j) v[j] = q[64 * j]; }
__device__ __forceinline__ void row_store(const Row4& v, float* p, int lane) { GAS f32x4* q = (GAS f32x4*)p + lane;
#pragma unroll
    for (int j = 0; j < 4; ++j) q[64 * j] = v[j]; }
__device__ __forceinline__ void row_standardize(Row4& v) {
    float s = 0.f;
#pragma unroll
    for (int j = 0; j < 4; ++j) s += (v[j].x + v[j].y) + (v[j].z + v[j].w);
    const float mean = wave_sum(s) * (1.f / DM); float s2 = 0.f;
#pragma unroll
    for (int j = 0; j < 4; ++j) { v[j] = v[j] - mean; s2 += (v[j].x * v[j].x + v[j].y * v[j].y) + (v[j].z * v[j].z + v[j].w * v[j].w); }
    const float rstd = 1.f / sqrtf(wave_sum(s2) * (1.f / DM) + LN_EPS);
#pragma unroll
    for (int j = 0; j < 4; ++j) v[j] = v[j] * rstd;
}
__device__ __forceinline__ void row_affine(Row4& v, const float* g, const float* b, bool one_plus, int lane) {
    asm volatile("" : "+s"(g), "+s"(b));
#pragma unroll
    for (int j = 0; j < 4; ++j) { f32x4 gv = *((const GAS f32x4*)g + lane + 64 * j); const f32x4 bv = *((const GAS f32x4*)b + lane + 64 * j); if (one_plus) gv = gv + 1.0f; v[j] = v[j] * gv + bv; }
}
__device__ __forceinline__ void row_store_bf16(const Row4& v, bf16* p, int lane) { GAS unsigned long long* o8 = (GAS unsigned long long*)p + lane;
#pragma unroll
    for (int j = 0; j < 4; ++j) o8[64 * j] = (unsigned long long)pk2(v[j].x, v[j].y) | ((unsigned long long)pk2(v[j].z, v[j].w) << 32); }
__device__ __forceinline__ int idx16(int L) { return ((L >> 5) & 1) + 2 * ((L >> 4) & 1) + 4 * ((L >> 3) & 1) + 8 * ((L >> 2) & 1) + 16 * ((L >> 1) & 1) + 32 * (L & 1); }
__device__ __forceinline__ int idx4(int L) { return ((L >> 5) & 1) + 2 * ((L >> 4) & 1) + 4 * ((L >> 3) & 1) + 8 * ((L >> 2) & 1); }
template <int NC>
__device__ __forceinline__ float rows4_proj(const Row4 (&u)[4], const float* wT, int lane) {
    float p[4 * NC]; f32x4 wa[4], wb[4];
    asm volatile("" : "+s"(wT));
    const GAS f32x4* wp = (const GAS f32x4*)wT + lane;
#define R4_LDW(DD_, CC_) do { _Pragma("unroll") for (int j = 0; j < 4; ++j) DD_[j] = wp[(CC_) * 256 + 64 * j]; } while (0)
#define R4_DOT(WW_, CC_) do { _Pragma("unroll") for (int r = 0; r < 4; ++r) { pg8::f32x2 s_ = (pg8::f32x2){0.f, 0.f}; _Pragma("unroll") for (int j = 0; j < 4; ++j) { \
        s_ = __builtin_elementwise_fma((pg8::f32x2){u[r][j].x, u[r][j].y}, (pg8::f32x2){WW_[j].x, WW_[j].y}, s_); s_ = __builtin_elementwise_fma((pg8::f32x2){u[r][j].z, u[r][j].w}, (pg8::f32x2){WW_[j].z, WW_[j].w}, s_); } \
        p[r * NC + (CC_)] = s_.x + s_.y; } } while (0)
    R4_LDW(wa, 0);
#pragma unroll
    for (int c = 0; c < NC; c += 2) {
        R4_LDW(wb, c + 1); __builtin_amdgcn_sched_barrier(0);
        R4_DOT(wa, c);
        if (c + 2 < NC) R4_LDW(wa, c + 2);
        __builtin_amdgcn_sched_barrier(0);
        R4_DOT(wb, c + 1);
        __builtin_amdgcn_sched_barrier(0);
    }
#undef R4_LDW
#undef R4_DOT
    int V = 4 * NC;
#pragma unroll
    for (int M = 32; M >= 1; M >>= 1) {
        if (V > 1) { const bool bit = (lane & M) != 0;
#pragma unroll
            for (int i = 0; i < 32; ++i) if (i < V / 2) { const float a = p[2 * i], b = p[2 * i + 1]; const float send = bit ? a : b; const float recv = __shfl_xor(send, M); p[i] = (bit ? b : a) + recv; }
            V >>= 1; }
        else p[0] += __shfl_xor(p[0], M);
    }
    return p[0];
}
constexpr int WAL_OFF = 16384, BAL_OFF = 16384 + 32768;
__device__ __forceinline__ void load_walpha(Frame& F, int l) {
    const float* walpha_all = F.prm + PO_WALPHA; const float* balpha_all = F.prm + PO_BALPHA;
    LAS float* WAL = (LAS float*)(F.lds + RING_OFF + WAL_OFF); LAS float* BAL = (LAS float*)(F.lds + RING_OFF + BAL_OFF);
    for (int i = F.tid; i < 8192; i += NTHREADS) WAL[i] = walpha_all[(size_t)l * 8192 + i];
    if (F.tid < 512) BAL[F.tid] = balpha_all[l * 512 + F.tid];
    __syncthreads();
}
__device__ __forceinline__ void rows4_mod1(Frame& F, Row4 (&x)[4], int m0, int l, LAS float* scr, const float* pf) {
    const int b = m0 >> 12; const float* ada = (const float*)(F.ws + WS_ADA) + ((size_t)l * 8 + b) * 6144;
#pragma unroll
    for (int r = 0; r < 4; ++r) { row_standardize(x[r]); row_affine(x[r], ada + 1024, ada, true, F.lane); row_store_bf16(x[r], F.Ubuf + (size_t)(m0 + r) * 1024, F.lane); __builtin_amdgcn_sched_barrier(0); }
    if (F.dry == 3) { if (pf) {
#pragma unroll
        for (int r = 0; r < 4; ++r) row_load(x[r], pf + (size_t)r * 1024, F.lane); } return; }
    const float abv = rows4_proj<16>(x, (const float*)(F.ws + WS_ABWT) + (size_t)l * 16 * 1024, F.lane);
    __builtin_amdgcn_sched_barrier(0);
    if (pf) {
#pragma unroll
        for (int r = 0; r < 4; ++r) row_load(x[r], pf + (size_t)r * 1024, F.lane); }
    __builtin_amdgcn_sched_barrier(0);
    scr[idx16(F.lane)] = abv;
    if (F.dry == 2) return;
    LDS_WAIT(); asm volatile("" ::: "memory");
    const LAS float* WAL = (const LAS float*)(F.lds + RING_OFF + WAL_OFF); const LAS float* BAL = (const LAS float*)(F.lds + RING_OFF + BAL_OFF); float* LA = F.LAbuf;
    asm volatile("" : "+s"(WAL), "+s"(BAL));
    float z[4][8];
#pragma unroll
    for (int i = 0; i < 8; ++i) { const float bb = BAL[F.lane + 64 * i];
#pragma unroll
        for (int r = 0; r < 4; ++r) z[r][i] = bb; }
#pragma unroll
    for (int rr = 0; rr < 16; ++rr) { float a[4];
#pragma unroll
        for (int r = 0; r < 4; ++r) a[r] = scr[r * 16 + rr];
#pragma unroll
        for (int i = 0; i < 8; ++i) { const float w_ = WAL[rr * 512 + F.lane + 64 * i];
#pragma unroll
            for (int r = 0; r < 4; ++r) z[r][i] += a[r] * w_; }
        __builtin_amdgcn_sched_barrier(0); }
#pragma unroll
    for (int r = 0; r < 4; ++r) {
#pragma unroll
        for (int i = 0; i < 8; ++i) { const float zz = z[r][i]; const float ls = fminf(zz, 0.f) - __logf(1.0f + __expf(-fabsf(zz)));
            LA[(size_t)(m0 + r) * 512 + F.lane + 64 * i] = __expf(ls * (1.0f / 16.0f)); }
        __builtin_amdgcn_sched_barrier(0); }
    LDS_WAIT(); asm volatile("" ::: "memory");
}
__device__ __forceinline__ void phase_r0(Frame& F, const float* xin) {
    LAS float* scr = (LAS float*)(F.lds + RING_OFF) + F.wave * 256;
    load_walpha(F, 0);
    const int gstep = F.G * NWAVES; int gi = F.vcu * NWAVES + F.wave; Row4 x[4];
    if (gi < NTOK / 4) {
#pragma unroll
        for (int r = 0; r < 4; ++r) row_load(x[r], xin + (size_t)(4 * gi + r) * 1024, F.lane); }
    for (; gi < NTOK / 4; gi += gstep) { const int m0 = 4 * gi;
#pragma unroll
        for (int r = 0; r < 4; ++r) row_store(x[r], F.xst + (size_t)(m0 + r) * 1024, F.lane);
        __builtin_amdgcn_sched_barrier(0);
        rows4_mod1(F, x, m0, 0, scr, (gi + gstep < NTOK / 4) ? xin + (size_t)(4 * (gi + gstep)) * 1024 : nullptr); }
}
__device__ __forceinline__ void phase_r1(Frame& F, int l) {
    LAS float* scr = (LAS float*)(F.lds + RING_OFF) + F.wave * 256;
    const float* g1 = F.prm + PO_LN1G + l * 1024; const float* b1 = F.prm + PO_LN1B + l * 1024; const float* RWT = (const float*)(F.ws + WS_RWT) + (size_t)l * 36 * 1024;
    const float* brg = F.prm + PO_BRG + l * 4; const float* bre = F.prm + PO_BRE + l * 32;
    LAS unsigned* LCNT = (LAS unsigned*)(F.lds + RING_OFF + 8192); LAS unsigned* BASEW = (LAS unsigned*)(F.lds + RING_OFF + 8320); LAS unsigned* TOKBUF = (LAS unsigned*)(F.lds + RING_OFF + 8448);
    if (F.tid < 32) LCNT[F.tid] = 0u; for (int i = F.tid; i < 256; i += NTHREADS) TOKBUF[i * 8] = 0xffffffffu;
    __syncthreads();
    int giter = 0;
    gu32* cnt = F.ctl + CW_CNT + l * 32 * 64 + (F.dry ? 16384 : 0); int* LIST = (int*)(F.ws + (F.dry ? WS_SSQ : WS_LIST)); unsigned* TI = (unsigned*)(F.ws + (F.dry ? WS_SSQ + 4 * MiB : WS_TOKINFO));
    const int gstep = F.G * NWAVES; int gi = F.vcu * NWAVES + F.wave; Row4 x[4];
    if (gi < NTOK / 4) {
#pragma unroll
        for (int r = 0; r < 4; ++r) row_load(x[r], F.out + (size_t)(4 * gi + r) * 1024, F.lane); }
    for (; gi < NTOK / 4; gi += gstep, ++giter) { const int m0 = 4 * gi, b = m0 >> 12;
        const float* ada = (const float*)(F.ws + WS_ADA) + ((size_t)l * 8 + b) * 6144;
#pragma unroll
        for (int r = 0; r < 4; ++r) { row_standardize(x[r]); row_affine(x[r], g1, b1, false, F.lane); if (F.dry < 3) row_store(x[r], F.xst + (size_t)(m0 + r) * 1024, F.lane);
            row_standardize(x[r]); row_affine(x[r], ada + 4 * 1024, ada + 3 * 1024, true, F.lane); if (F.dry < 3) row_store_bf16(x[r], F.Ubuf + (size_t)(m0 + r) * 1024, F.lane); __builtin_amdgcn_sched_barrier(0); }
        if (F.dry >= 2) { if (F.dry == 3) { float q_ = 0.f;
#pragma unroll
                for (int r = 0; r < 4; ++r) q_ += x[r][0].x; if (q_ == 123.456f) scr[0] = q_; }
            if (gi + gstep < NTOK / 4) {
#pragma unroll
                for (int r = 0; r < 4; ++r) row_load(x[r], F.out + (size_t)(4 * (gi + gstep) + r) * 1024, F.lane); }
            continue; }
        const float vg = rows4_proj<4>(x, RWT, F.lane);
        __builtin_amdgcn_sched_barrier(0);
        const float va = rows4_proj<16>(x, RWT + 4 * 1024, F.lane);
        __builtin_amdgcn_sched_barrier(0);
        const float vb = rows4_proj<16>(x, RWT + 20 * 1024, F.lane);
        __builtin_amdgcn_sched_barrier(0);
        if (gi + gstep < NTOK / 4) {
#pragma unroll
            for (int r = 0; r < 4; ++r) row_load(x[r], F.out + (size_t)(4 * (gi + gstep) + r) * 1024, F.lane); }
        __builtin_amdgcn_sched_barrier(0);
        if (F.dry == 4) { if (vg + va + vb == 123.456f) scr[0] = vg; continue; }
        { const int i4 = idx4(F.lane), i16 = idx16(F.lane); scr[(i4 >> 2) * 40 + (i4 & 3)] = vg; scr[(i16 >> 4) * 40 + 4 + (i16 & 15)] = va; scr[(i16 >> 4) * 40 + 20 + (i16 & 15)] = vb; }
        LDS_WAIT(); asm volatile("" ::: "memory");
        if (F.lane < 4) { const LAS float* s = scr + F.lane * 40; const int m = m0 + F.lane;
            float gl[4];
#pragma unroll
            for (int j = 0; j < 4; ++j) gl[j] = s[j] + brg[j];
            int gidx = 0; float gmax = gl[0];
#pragma unroll
            for (int j = 1; j < 4; ++j) if (gl[j] > gmax) { gmax = gl[j]; gidx = j; }
            float den = 0.f;
#pragma unroll
            for (int j = 0; j < 4; ++j) den += __expf(gl[j] - gmax);
            const float gw = 1.0f / den;
            float el[8];
#pragma unroll
            for (int j = 0; j < 8; ++j) el[j] = s[4 + gidx * 8 + j] + bre[gidx * 8 + j];
            int i0 = 0; float v0 = el[0];
#pragma unroll
            for (int j = 1; j < 8; ++j) if (el[j] > v0) { v0 = el[j]; i0 = j; }
            int i1 = -1; float v1 = -INFINITY;
#pragma unroll
            for (int j = 0; j < 8; ++j) if (j != i0 && el[j] > v1) { v1 = el[j]; i1 = j; }
            if (i1 < 0) i1 = (i0 + 1) & 7;
            const float ex = __expf(v1 - v0), inv = 1.0f / (1.0f + ex); const float w0 = inv * gw, w1 = ex * inv * gw;
            const int e0 = gidx * 8 + i0, e1 = gidx * 8 + i1;
            const unsigned lp0 = __hip_atomic_fetch_add(LCNT + e0, 1u, __ATOMIC_RELAXED, __HIP_MEMORY_SCOPE_WORKGROUP), lp1 = __hip_atomic_fetch_add(LCNT + e1, 1u, __ATOMIC_RELAXED, __HIP_MEMORY_SCOPE_WORKGROUP);
            const int slot = F.wave * 32 + (giter & 7) * 4 + F.lane;
            *(LAS v4u*)(TOKBUF + slot * 8) = (v4u){(unsigned)m, (unsigned)e0 | ((unsigned)e1 << 8), lp0, lp1}; TOKBUF[slot * 8 + 4] = __float_as_uint(w0); TOKBUF[slot * 8 + 5] = __float_as_uint(w1);
        }
        LDS_WAIT(); asm volatile("" ::: "memory");
    }
    __syncthreads();
    if (F.tid < 32) BASEW[F.tid] = __hip_atomic_fetch_add(cnt + F.tid * 64, LCNT[F.tid], RLX_AGENT);
    __syncthreads();
    if (F.tid < 256) { const v4u tk = *(const LAS v4u*)(TOKBUF + F.tid * 8);
        if (tk.x != 0xffffffffu) { const unsigned m = tk.x, e0 = tk.y & 255u, e1 = tk.y >> 8, p0 = BASEW[e0] + tk.z, p1 = BASEW[e1] + tk.w;
            LIST[(size_t)e0 * LISTCAP + p0] = (int)m; LIST[(size_t)e1 * LISTCAP + p1] = (int)m;
            *(GAS v4u*)(TI + (size_t)m * 8) = (v4u){e0, p0, e1, p1}; *(GAS v4u*)(TI + (size_t)m * 8 + 4) = (v4u){TOKBUF[F.tid * 8 + 4], TOKBUF[F.tid * 8 + 5], 0u, 0u}; } }
    __syncthreads();
}
__device__ __forceinline__ void moe_tables(Frame& F, int l) {
    LAS int* CNT = (LAS int*)(F.lds + TAB_CNT); LAS int* BASE = (LAS int*)(F.lds + TAB_BASE);
    if (F.tid < 32) CNT[F.tid] = (int)__hip_atomic_load(F.ctl + CW_CNT + (l * 32 + F.tid) * 64, RLX_AGENT);
    __syncthreads();
    if (F.tid == 0) { int a = 0; for (int e = 0; e < 32; ++e) { BASE[e] = a; a += (CNT[e] + 255) >> 8; } BASE[32] = a; }
    __syncthreads();
}
__device__ __forceinline__ void phase_r2(Frame& F, int l) {
    LAS float* scr = (LAS float*)(F.lds + RING_OFF) + F.wave * 256; const LAS int* BASE = (const LAS int*)(F.lds + TAB_BASE);
    if (l + 1 < DEPTH) load_walpha(F, l + 1);
    const float* g2 = F.prm + PO_LN2G + l * 1024; const float* b2 = F.prm + PO_LN2B + l * 1024; const unsigned* TI = (const unsigned*)(F.ws + WS_TOKINFO); const bf16* YB = (const bf16*)(F.ws + WS_YB);
    const int gstep = F.G * NWAVES;
    for (int gi = F.vcu * NWAVES + F.wave; gi < NTOK / 4; gi += gstep) { const int m0 = 4 * gi, b = m0 >> 12; Row4 x[4];
#pragma unroll
        for (int r = 0; r < 4; ++r) row_load(x[r], F.out + (size_t)(m0 + r) * 1024, F.lane);
        const float* gate = (const float*)(F.ws + WS_ADA) + ((size_t)l * 8 + b) * 6144 + 5 * 1024;
#pragma unroll
        for (int r = 0; r < 4; ++r) { const int m = m0 + r;
            const v4u ta = *(const GAS v4u*)(TI + (size_t)m * 8); const v4u tb = *(const GAS v4u*)(TI + (size_t)m * 8 + 4);
            const size_t r0 = (size_t)BASE[ta.x & 31] * 256 + ta.y, r1 = (size_t)BASE[ta.z & 31] * 256 + ta.w; const float w0 = __uint_as_float(tb.x), w1 = __uint_as_float(tb.y);
            const GAS unsigned long long* y0 = (const GAS unsigned long long*)(YB + r0 * 1024) + F.lane; const GAS unsigned long long* y1 = (const GAS unsigned long long*)(YB + r1 * 1024) + F.lane;
#pragma unroll
            for (int j = 0; j < 4; ++j) { const unsigned long long a = y0[64 * j], c = y1[64 * j]; const f32x4 gv = *((const GAS f32x4*)gate + F.lane + 64 * j);
                const f32x4 ya = (f32x4){bflo((unsigned)a), bfhi((unsigned)a), bflo((unsigned)(a >> 32)), bfhi((unsigned)(a >> 32))};
                const f32x4 yc = (f32x4){bflo((unsigned)c), bfhi((unsigned)c), bflo((unsigned)(c >> 32)), bfhi((unsigned)(c >> 32))};
                x[r][j] = x[r][j] * DN_ALPHA + gv * (ya * w0 + yc * w1); }
            row_standardize(x[r]); row_affine(x[r], g2, b2, false, F.lane); row_store(x[r], F.xst + (size_t)m * 1024, F.lane); __builtin_amdgcn_sched_barrier(0); }
        if (l + 1 < DEPTH) rows4_mod1(F, x, m0, l + 1, scr, nullptr);
    }
}
typedef short s16x8 __attribute__((ext_vector_type(8)));
#define MFMA16(a, b, c) __builtin_amdgcn_mfma_f32_16x16x32_bf16((a), (b), (c), 0, 0, 0)
struct GlaRegs { v4u rq[2], rk[2]; float rl[16]; unsigned long long vr; };
__device__ __forceinline__ void phase_gla(Frame& F, const int glav) {
    constexpr int QK0_OFF = 0, QK1_OFF = 16384, LAR_OFF = 32768, KLT_OFF = 65536, VT_OFF = 83968  , SBT_OFF = 93184, ATT_OFF = 101888, TOT_OFF = 111104, DEC_OFF = 113152;
    constexpr int QS = 272, TS = 144;
    LAS unsigned char* L = F.lds + RING_OFF;
    LAS float* TOT = (LAS float*)(L + TOT_OFF); LAS float* DEC = (LAS float*)(L + DEC_OFF);
    const int tid = F.tid, lane = F.lane, w = F.wave, k = tid & 127, tg = tid >> 7, fr = lane & 15, fq = lane >> 4;
    const bf16* GQ = (const bf16*)(F.ws + WS_GQ); const bf16* GK = (const bf16*)(F.ws + WS_GK); const bf16* GV = (const bf16*)(F.ws + WS_GV);
    const float* LA = (const float*)(F.ws + WS_LA); bf16* OB = (bf16*)(F.ws + WS_OB); float* SSQ = (float*)(F.ws + WS_SSQ);
    const int cr = tid >> 4, cc = tid & 15;
    const int qk_dst = cr * 256 + ((cc ^ (cr & 15)) << 4);
    const int kc = k >> 3, kb2 = (k & 7) * 2;
    for (int item = F.vcu; item < 256; item += F.G) {
        const int s = item & 7, hg = (item >> 3) & 3, b = item >> 5; const size_t row0 = (size_t)b * SEQ;
        const bf16* gq = GQ + (row0 + cr) * 512 + hg * 128 + cc * 8; const bf16* gk = GK + (row0 + cr) * 512 + hg * 128 + cc * 8; const float* la = LA + (row0 + tg * 16) * 512 + hg * 128 + k;
        const bf16* gv = GV + (row0 + (tid >> 3)) * 1024 + hg * 256 + s * 32 + (tid & 7) * 4;
        bf16* ob = OB + row0 * 1024 + hg * 256 + s * 32; float* ssq = SSQ + row0 * 64 + hg * 16 + s * 2;
        for (int i = tid; i < 8704 / 4; i += NTHREADS) ((LAS unsigned*)(L + SBT_OFF))[i] = 0u;
        f32x4 accS[2]; accS[0] = (f32x4){0.f, 0.f, 0.f, 0.f}; accS[1] = accS[0];
        GlaRegs RA, RB;
#define GLA_BAR() asm volatile("s_waitcnt lgkmcnt(0)\n\ts_barrier" ::: "memory")
#define GLA_LOAD(R_, c_) do { const size_t o_ = (size_t)(c_) * 64; R_.rq[0] = *(const GAS v4u*)(gq + o_ * 512); R_.rq[1] = *(const GAS v4u*)(gq + (o_ + 32) * 512); R_.rk[0] = *(const GAS v4u*)(gk + o_ * 512); R_.rk[1] = *(const GAS v4u*)(gk + (o_ + 32) * 512); \
        _Pragma("unroll") for (int i_ = 0; i_ < 16; ++i_) R_.rl[i_] = *(const GAS float*)(la + (o_ + i_) * 512); R_.vr = *(const GAS unsigned long long*)(gv + o_ * 1024); } while (0)
        GLA_LOAD(RA, 0); GLA_LOAD(RB, 1);
        __syncthreads();
        auto chunk = [&](const int c, GlaRegs& R) {
            *(LAS v4u*)(L + QK0_OFF + qk_dst) = R.rq[0]; *(LAS v4u*)(L + QK0_OFF + qk_dst + 8192) = R.rq[1]; *(LAS v4u*)(L + QK1_OFF + qk_dst) = R.rk[0]; *(LAS v4u*)(L + QK1_OFF + qk_dst + 8192) = R.rk[1];
            const int vto = VT_OFF + (c & 1) * 4608;
            { const int t = tid >> 3, w0 = (tid & 7) * 4;
#pragma unroll
              for (int i = 0; i < 4; ++i) *(LAS bf16*)(L + vto + (w0 + i) * TS + t * 2) = (bf16)((R.vr >> (16 * i)) & 0xffffu); }
            float cs[16]; { float run = 1.f;
#pragma unroll
                for (int i = 0; i < 16; ++i) { run *= R.rl[i]; cs[i] = run; }
                TOT[tg * 128 + k] = run; }
            if (c + 2 < 64 && !(glav & 8)) GLA_LOAD(R, c + 2);
            GLA_BAR();
            if (!(glav & 1)) { float off = 1.f, last = 1.f;
#pragma unroll
              for (int g = 0; g < 4; ++g) { const float tv = TOT[g * 128 + k]; if (g < tg) off *= tv; last *= tv; }
              unsigned klw[8]; float klp = 0.f;
#pragma unroll
              for (int i = 0; i < 16; ++i) { const float e1 = cs[i] * off, e2 = __builtin_amdgcn_rcpf(e1), e3 = last * e2;
                  const int eo = (tg * 16 + i) * 256 + ((kc ^ i) << 4) + kb2;
                  const float qf = __uint_as_float((unsigned)(*(const LAS bf16*)(L + QK0_OFF + eo)) << 16), kf = __uint_as_float((unsigned)(*(const LAS bf16*)(L + QK1_OFF + eo)) << 16);
                  const unsigned qk = pg8::cvt_pk_bf16_c(qf * e1, kf * e2);
                  *(LAS bf16*)(L + QK0_OFF + eo) = (bf16)(qk & 0xffffu); *(LAS bf16*)(L + QK1_OFF + eo) = (bf16)(qk >> 16);
                  if (i & 1) klw[i >> 1] = pg8::cvt_pk_bf16_c(klp, kf * e3); else klp = kf * e3; }
              *(LAS v4u*)(L + KLT_OFF + k * TS + tg * 32) = (v4u){klw[0], klw[1], klw[2], klw[3]}; *(LAS v4u*)(L + KLT_OFF + k * TS + tg * 32 + 16) = (v4u){klw[4], klw[5], klw[6], klw[7]};
              if (tg == 0) DEC[k] = last;
            }
            GLA_BAR();
            const int ti = w >> 1, wi = w & 1; f32x4 acco = (f32x4){0.f, 0.f, 0.f, 0.f};
            if (!(glav & 2)) { s16x8 aq[4];
#pragma unroll
              for (int kk = 0; kk < 4; ++kk) aq[kk] = *(const LAS s16x8*)(L + QK0_OFF + (ti * 16 + fr) * 256 + (((kk * 4 + fq) ^ fr) << 4));
#pragma unroll
              for (int s2 = 0; s2 < 2; ++s2) { const int si = wi * 2 + s2; f32x4 a4 = (f32x4){0.f, 0.f, 0.f, 0.f};
                  if (si <= ti) {
#pragma unroll
                      for (int kk = 0; kk < 4; ++kk) { const s16x8 bb = *(const LAS s16x8*)(L + QK1_OFF + (si * 16 + fr) * 256 + (((kk * 4 + fq) ^ fr) << 4)); a4 = MFMA16(aq[kk], bb, a4); } }
#pragma unroll
                  for (int r = 0; r < 4; ++r) { const int t = ti * 16 + fq * 4 + r, sc = si * 16 + fr; const float v = (sc <= t) ? a4[r] : 0.f; *(LAS bf16*)(L + ATT_OFF + t * TS + sc * 2) = (bf16)f2bf(v); } }
#pragma unroll
              for (int kk = 0; kk < 4; ++kk) { const s16x8 bb = *(const LAS s16x8*)(L + SBT_OFF + (wi * 16 + fr) * QS + (kk * 32 + 8 * fq) * 2); acco = MFMA16(aq[kk], bb, acco); }
            }
            GLA_BAR();
            if (!(glav & 4)) {
              s16x8 aat[2], bvo[2], akl[2], bv0[2], bv1[2];
#pragma unroll
              for (int kk = 0; kk < 2; ++kk) { aat[kk] = *(const LAS s16x8*)(L + ATT_OFF + (ti * 16 + fr) * TS + (kk * 32 + 8 * fq) * 2); bvo[kk] = *(const LAS s16x8*)(L + vto + (wi * 16 + fr) * TS + (kk * 32 + 8 * fq) * 2);
                  akl[kk] = *(const LAS s16x8*)(L + KLT_OFF + (w * 16 + fr) * TS + (kk * 32 + 8 * fq) * 2); bv0[kk] = *(const LAS s16x8*)(L + vto + fr * TS + (kk * 32 + 8 * fq) * 2); bv1[kk] = *(const LAS s16x8*)(L + vto + (16 + fr) * TS + (kk * 32 + 8 * fq) * 2); }
              const f32x4 dv = *(const LAS f32x4*)(DEC + w * 16 + fq * 4);
              acco = MFMA16(aat[0], bvo[0], acco); accS[0] = accS[0] * dv; accS[1] = accS[1] * dv;
              accS[0] = MFMA16(akl[0], bv0[0], accS[0]); accS[1] = MFMA16(akl[0], bv1[0], accS[1]);
              acco = MFMA16(aat[1], bvo[1], acco);
              accS[0] = MFMA16(akl[1], bv0[1], accS[0]); accS[1] = MFMA16(akl[1], bv1[1], accS[1]);
              { const unsigned o01 = pg8::cvt_pk_bf16_c(acco[0], acco[1]), o23 = pg8::cvt_pk_bf16_c(acco[2], acco[3]); bf16* obp = ob + (size_t)(c * 64 + ti * 16 + fq * 4) * 1024 + wi * 16 + fr;
                if (!(glav & 16)) { obp[0] = (bf16)(o01 & 0xffffu); obp[1024] = (bf16)(o01 >> 16); obp[2048] = (bf16)(o23 & 0xffffu); obp[3072] = (bf16)(o23 >> 16); } }
#pragma unroll
              for (int w2 = 0; w2 < 2; ++w2)
                  *(LAS unsigned long long*)(L + SBT_OFF + (w2 * 16 + fr) * QS + (w * 16 + fq * 4) * 2) = (unsigned long long)pg8::cvt_pk_bf16_c(accS[w2][0], accS[w2][1]) | ((unsigned long long)pg8::cvt_pk_bf16_c(accS[w2][2], accS[w2][3]) << 32);
#pragma unroll
              for (int r = 0; r < 4; ++r) { const int t = c * 64 + ti * 16 + fq * 4 + r;
                  float q = acco[r] * acco[r]; q = dpp_add(q, 0); q = dpp_add(q, 1); q = dpp_add(q, 2); q = dpp_add(q, 3);
                  if (fr == 0 && !(glav & 32)) ssq[(size_t)t * 64 + wi] = q; }
            }
        };
        for (int c = 0; c < 64; c += 2) { chunk(c, RA); chunk(c + 1, RB); }
#undef GLA_LOAD
#undef GLA_BAR
        __syncthreads();
    }
}
__device__ __forceinline__ size_t gla_fp16k(size_t rowg0, int hg, int p) { return ((rowg0 + (size_t)(p >> 4)) * 512 + hg * 128) * 2 + (size_t)(p & 15) * 16; }
__device__ __forceinline__ size_t gla_fp32k(size_t rowg0, int hg, int p) { return ((rowg0 + (size_t)(p >> 5)) * 1024 + hg * 256) * 2 + (size_t)(p & 31) * 16; }
__device__ __forceinline__ void phase_gla_a(Frame& F) {
    constexpr int QK0_OFF = 0, QK1_OFF = 16384, KLT_OFF = 32768, VT_OFF = 51200, ATT_OFF = 88064, TOT_OFF = 97280, DEC_OFF = 99328, TS = 144;
    LAS unsigned char* L = F.lds + RING_OFF;
    LAS float* TOT = (LAS float*)(L + TOT_OFF); LAS float* DEC = (LAS float*)(L + DEC_OFF);
    const int tid = F.tid, lane = F.lane, w = F.wave, k = tid & 127, tg = tid >> 7, fr = lane & 15, fq = lane >> 4;
    unsigned char* GQb = F.ws + WS_GQ; unsigned char* GKb = F.ws + WS_GK; unsigned char* GVb = F.ws + WS_GV; unsigned char* LAb = F.ws + WS_LA; float* DECG = (float*)(F.ws + WS_GDEC);
    const int cr = tid >> 4, cc = tid & 15, qk_dst = cr * 256 + ((cc ^ (cr & 15)) << 4), kc = k >> 3, kb2 = (k & 7) * 2;
    v4u rq[2], rk[2], rv[4]; float rl[16];
#define GLA_A_LOAD(u_) do { const int c_ = (u_) & 63, hg_ = ((u_) >> 6) & 3, b_ = (u_) >> 8; const size_t rg_ = (size_t)b_ * SEQ + (size_t)c_ * 64; \
        const GAS unsigned char* gq = (const GAS unsigned char*)GQb + ((rg_ + cr) * 512 + hg_ * 128 + cc * 8) * 2; const GAS unsigned char* gk = (const GAS unsigned char*)GKb + ((rg_ + cr) * 512 + hg_ * 128 + cc * 8) * 2; \
        rq[0] = *(const GAS v4u*)gq; rq[1] = *(const GAS v4u*)(gq + 32 * 1024); rk[0] = *(const GAS v4u*)gk; rk[1] = *(const GAS v4u*)(gk + 32 * 1024); \
        const GAS float* la = (const GAS float*)LAb + (rg_ + tg * 16) * 512 + hg_ * 128 + k; \
        _Pragma("unroll") for (int i = 0; i < 16; ++i) rl[i] = la[(size_t)i * 512]; \
        _Pragma("unroll") for (int i = 0; i < 4; ++i) { const int p = tid + 512 * i; rv[i] = *(const GAS v4u*)((const GAS unsigned char*)GVb + gla_fp32k(rg_, hg_, p)); } } while (0)
    __syncthreads();
    if (F.vcu < 2048) GLA_A_LOAD(F.vcu);
    for (int unit = F.vcu; unit < 2048; unit += F.G) {
        const int c = unit & 63, hg = (unit >> 6) & 3, b = unit >> 8; const size_t rowg0 = (size_t)b * SEQ + (size_t)c * 64;
        *(LAS v4u*)(L + QK0_OFF + qk_dst) = rq[0]; *(LAS v4u*)(L + QK0_OFF + qk_dst + 8192) = rq[1]; *(LAS v4u*)(L + QK1_OFF + qk_dst) = rk[0]; *(LAS v4u*)(L + QK1_OFF + qk_dst + 8192) = rk[1];
#pragma unroll
        for (int i = 0; i < 4; ++i) { const int p = tid + 512 * i, t = p >> 5, cp = p & 31; const int tsw = t ^ (8 * (cp & 7));
            const unsigned wd[4] = {rv[i].x, rv[i].y, rv[i].z, rv[i].w};
#pragma unroll
            for (int e = 0; e < 8; ++e) *(LAS bf16*)(L + VT_OFF + (8 * cp + e) * TS + tsw * 2) = (bf16)((wd[e >> 1] >> (16 * (e & 1))) & 0xffffu); }
        float cs[16]; { float run = 1.f;
#pragma unroll
            for (int i = 0; i < 16; ++i) { run *= rl[i]; cs[i] = run; }
            TOT[tg * 128 + k] = run; }
        if (unit + F.G < 2048) GLA_A_LOAD(unit + F.G);
        asm volatile("s_waitcnt lgkmcnt(0)\n\ts_barrier" ::: "memory");
        { float off = 1.f, last = 1.f;
#pragma unroll
          for (int g = 0; g < 4; ++g) { const float tv = TOT[g * 128 + k]; if (g < tg) off *= tv; last *= tv; }
          unsigned klw[8]; float klp = 0.f;
#pragma unroll
          for (int i = 0; i < 16; ++i) { const float e1 = cs[i] * off, e2 = __builtin_amdgcn_rcpf(e1), e3 = last * e2;
              const int eo = (tg * 16 + i) * 256 + ((kc ^ i) << 4) + kb2;
              const float qf = __uint_as_float((unsigned)(*(const LAS bf16*)(L + QK0_OFF + eo)) << 16), kf = __uint_as_float((unsigned)(*(const LAS bf16*)(L + QK1_OFF + eo)) << 16);
              const unsigned qk = pg8::cvt_pk_bf16_c(qf * e1, kf * e2);
              *(LAS bf16*)(L + QK0_OFF + eo) = (bf16)(qk & 0xffffu); *(LAS bf16*)(L + QK1_OFF + eo) = (bf16)(qk >> 16);
              if (i & 1) klw[i >> 1] = pg8::cvt_pk_bf16_c(klp, kf * e3); else klp = kf * e3; }
          *(LAS v4u*)(L + KLT_OFF + k * TS + tg * 32) = (v4u){klw[0], klw[1], klw[2], klw[3]}; *(LAS v4u*)(L + KLT_OFF + k * TS + tg * 32 + 16) = (v4u){klw[4], klw[5], klw[6], klw[7]};
          if (tg == 0) DEC[k] = last; }
        asm volatile("s_waitcnt lgkmcnt(0)\n\ts_barrier" ::: "memory");
        { const int ti = w >> 1, wi = w & 1; s16x8 aq[4];
#pragma unroll
          for (int kk = 0; kk < 4; ++kk) aq[kk] = *(const LAS s16x8*)(L + QK0_OFF + (ti * 16 + fr) * 256 + (((kk * 4 + fq) ^ fr) << 4));
#pragma unroll
          for (int s2 = 0; s2 < 2; ++s2) { const int si = wi * 2 + s2; f32x4 a4 = (f32x4){0.f, 0.f, 0.f, 0.f};
              if (si <= ti) {
#pragma unroll
                  for (int kk = 0; kk < 4; ++kk) { const s16x8 bb = *(const LAS s16x8*)(L + QK1_OFF + (si * 16 + fr) * 256 + (((kk * 4 + fq) ^ fr) << 4)); a4 = MFMA16(aq[kk], bb, a4); } }
#pragma unroll
              for (int r = 0; r < 4; ++r) { const int t = ti * 16 + fq * 4 + r, sc = si * 16 + fr; const float v = (sc <= t) ? a4[r] : 0.f; *(LAS bf16*)(L + ATT_OFF + t * TS + sc * 2) = (bf16)f2bf(v); } } }
#pragma unroll
        for (int i = 0; i < 2; ++i) { const int p = tid + 512 * i;
            const int l_ = p & 63, t = (p >> 8) * 16 + (l_ & 15), k0 = ((p >> 6) & 3) * 32 + 4 * (l_ >> 4);
            const unsigned long long lo = *(const LAS unsigned long long*)(L + QK0_OFF + t * 256 + (((k0 >> 3) ^ (t & 15)) << 4) + (k0 & 7) * 2);
            const unsigned long long hi = *(const LAS unsigned long long*)(L + QK0_OFF + t * 256 + ((((k0 + 16) >> 3) ^ (t & 15)) << 4) + (k0 & 7) * 2);
            *(GAS v4u*)((GAS unsigned char*)GQb + gla_fp16k(rowg0, hg, p)) = (v4u){(unsigned)lo, (unsigned)(lo >> 32), (unsigned)hi, (unsigned)(hi >> 32)}; }
#pragma unroll
        for (int i = 0; i < 2; ++i) { const int p = tid + 512 * i;
            const int l_ = p & 63, kk = (p >> 7) * 16 + (l_ & 15), t0 = ((p >> 6) & 1) * 32 + 8 * (l_ >> 4);
            *(GAS v4u*)((GAS unsigned char*)GKb + gla_fp16k(rowg0, hg, p)) = *(const LAS v4u*)(L + KLT_OFF + kk * TS + t0 * 2); }
#pragma unroll
        for (int i = 0; i < 4; ++i) { const int p = tid + 512 * i;
            const int l_ = p & 63, wv = (p >> 7) * 16 + (l_ & 15), t0 = (((p >> 6) & 1) * 32 + 8 * (l_ >> 4)) ^ (8 * ((wv >> 3) & 7));
            *(GAS v4u*)((GAS unsigned char*)GVb + gla_fp32k(rowg0, hg, p)) = *(const LAS v4u*)(L + VT_OFF + wv * TS + t0 * 2); }
        if (tid < 128) DECG[(size_t)unit * 128 + tid] = DEC[tid];
        asm volatile("s_waitcnt lgkmcnt(0)\n\ts_barrier" ::: "memory");
        { const int ti = w >> 1; s16x8 aat[2];
#pragma unroll
          for (int kk = 0; kk < 2; ++kk) aat[kk] = *(const LAS s16x8*)(L + ATT_OFF + (ti * 16 + fr) * TS + (kk * 32 + 8 * fq) * 2);
#pragma unroll
          for (int j = 0; j < 8; ++j) { const int wt = (w & 1) * 8 + j, wv = wt * 16 + fr; f32x4 a4 = (f32x4){0.f, 0.f, 0.f, 0.f};
#pragma unroll
              for (int kk = 0; kk < 2; ++kk) { const s16x8 bb = *(const LAS s16x8*)(L + VT_OFF + wv * TS + (((kk * 32 + 8 * fq) ^ (8 * ((wv >> 3) & 7))) * 2)); a4 = MFMA16(aat[kk], bb, a4); }
              const unsigned long long pk = (unsigned long long)pg8::cvt_pk_bf16_c(a4[0], a4[1]) | ((unsigned long long)pg8::cvt_pk_bf16_c(a4[2], a4[3]) << 32);
              *(GAS unsigned long long*)((GAS unsigned char*)LAb + ((rowg0 + (size_t)(ti * 16 + wt)) * 512 + hg * 128) * 4 + (size_t)lane * 8) = pk; } }
        asm volatile("s_waitcnt lgkmcnt(0)\n\ts_barrier" ::: "memory");
    }
#undef GLA_A_LOAD
    __syncthreads();
}
__device__ __forceinline__ void phase_gla_b(Frame& F) {
    constexpr int SLOT = 41984, O_QEF = 0, O_KLF = 16384, O_VTF = 32768, O_OIF = 36864, O_DEC = 40960;
    LAS unsigned char* L = F.lds + RING_OFF;
    const int lane = F.lane, w = F.wave, fr = lane & 15, fq = lane >> 4, ti = w >> 1, wi = w & 1;
    const GAS unsigned char* GQb = (const GAS unsigned char*)(F.ws + WS_GQ); const GAS unsigned char* GKb = (const GAS unsigned char*)(F.ws + WS_GK); const GAS unsigned char* GVb = (const GAS unsigned char*)(F.ws + WS_GV);
    const GAS unsigned char* LAb = (const GAS unsigned char*)(F.ws + WS_LA); const GAS unsigned char* DECb = (const GAS unsigned char*)(F.ws + WS_GDEC); bf16* OB = (bf16*)(F.ws + WS_OB); float* SSQ = (float*)(F.ws + WS_SSQ);
    for (int item = F.vcu; item < 256; item += F.G) {
        const int s = item & 7, hg = (item >> 3) & 3, b = item >> 5; const size_t row0 = (size_t)b * SEQ;
        bf16* ob = OB + row0 * 1024 + hg * 256 + s * 32; float* ssq = SSQ + row0 * 64 + hg * 16 + s * 2;
        f32x4 accS[8];
#pragma unroll
        for (int kt = 0; kt < 8; ++kt) accS[kt] = (f32x4){0.f, 0.f, 0.f, 0.f};
#define GLB_DMA(c_, slot_) do { const size_t rg_ = row0 + (size_t)(c_) * 64; _Pragma("unroll") for (int j_ = 0; j_ < 6; ++j_) { const int j = w + 8 * j_; if (j < 41) { const GAS unsigned char* src; \
            if (j < 16) src = GQb + gla_fp16k(rg_, hg, j * 64 + lane); else if (j < 32) src = GKb + gla_fp16k(rg_, hg, (j - 16) * 64 + lane); \
            else if (j < 36) src = GVb + gla_fp32k(rg_, hg, ((2 * s + ((j - 32) >> 1)) * 2 + ((j - 32) & 1)) * 64 + lane); \
            else if (j < 40) src = LAb + ((rg_ + (size_t)((j - 36) * 16 + 2 * s + (lane >> 5))) * 512 + hg * 128) * 4 + (size_t)(lane & 31) * 16; \
            else src = DECb + ((size_t)((b * 4 + hg) * 64 + (c_)) * 128) * 4 + (size_t)(lane & 31) * 16; \
            __builtin_amdgcn_global_load_lds((const GAS unsigned*)src, (LAS unsigned*)(L + (slot_) * SLOT + j * 1024), 16, 0, 0); } } } while (0)
        __syncthreads();
        GLB_DMA(0, 0); GLB_DMA(1, 1);
        int slot = 0;
        for (int c = 0; c < 64; ++c) {
            if (c == 0) asm volatile("s_waitcnt vmcnt(5) lgkmcnt(0)\n\ts_barrier" ::: "memory"); else asm volatile("s_waitcnt vmcnt(13) lgkmcnt(0)\n\ts_barrier" ::: "memory");
            { const int cn = (c + 2 < 64) ? c + 2 : 63; const int sn = (slot == 0) ? 2 : slot - 1; GLB_DMA(cn, sn); }
            const LAS unsigned char* S_ = L + slot * SLOT;
            v4u aq[4], bv[2];
#pragma unroll
            for (int s4 = 0; s4 < 4; ++s4) aq[s4] = *(const LAS v4u*)(S_ + O_QEF + ((ti * 4 + s4) * 64 + lane) * 16);
#pragma unroll
            for (int s2 = 0; s2 < 2; ++s2) bv[s2] = *(const LAS v4u*)(S_ + O_VTF + ((wi * 2 + s2) * 64 + lane) * 16);
            const unsigned long long oi = *(const LAS unsigned long long*)(S_ + O_OIF + ti * 1024 + wi * 512 + lane * 8);
            f32x4 acco = (f32x4){0.f, 0.f, 0.f, 0.f};
#pragma unroll
            for (int s4 = 0; s4 < 4; ++s4) { const v4u bs = (v4u){pg8::cvt_pk_bf16_c(accS[2 * s4][0], accS[2 * s4][1]), pg8::cvt_pk_bf16_c(accS[2 * s4][2], accS[2 * s4][3]), pg8::cvt_pk_bf16_c(accS[2 * s4 + 1][0], accS[2 * s4 + 1][1]), pg8::cvt_pk_bf16_c(accS[2 * s4 + 1][2], accS[2 * s4 + 1][3])};
                acco = MFMA16(__builtin_bit_cast(s16x8, aq[s4]), __builtin_bit_cast(s16x8, bs), acco); }
            acco = acco + (f32x4){bflo((unsigned)oi), bfhi((unsigned)oi), bflo((unsigned)(oi >> 32)), bfhi((unsigned)(oi >> 32))};
            const s16x8 bv0 = __builtin_bit_cast(s16x8, bv[0]), bv1 = __builtin_bit_cast(s16x8, bv[1]);
#pragma unroll
            for (int kt = 0; kt < 8; ++kt) { const f32x4 dv = *(const LAS f32x4*)(S_ + O_DEC + (kt * 16 + 4 * fq) * 4);
                const s16x8 a0 = *(const LAS s16x8*)(S_ + O_KLF + ((kt * 2 + 0) * 64 + lane) * 16), a1 = *(const LAS s16x8*)(S_ + O_KLF + ((kt * 2 + 1) * 64 + lane) * 16);
                accS[kt] = accS[kt] * dv; accS[kt] = MFMA16(a0, bv0, accS[kt]); accS[kt] = MFMA16(a1, bv1, accS[kt]); }
            { const unsigned o01 = pg8::cvt_pk_bf16_c(acco[0], acco[1]), o23 = pg8::cvt_pk_bf16_c(acco[2], acco[3]); bf16* obp = ob + (size_t)(c * 64 + ti * 16 + fq * 4) * 1024 + wi * 16 + fr;
              obp[0] = (bf16)(o01 & 0xffffu); obp[1024] = (bf16)(o01 >> 16); obp[2048] = (bf16)(o23 & 0xffffu); obp[3072] = (bf16)(o23 >> 16); }
#pragma unroll
            for (int r = 0; r < 4; ++r) { const int t = c * 64 + ti * 16 + fq * 4 + r;
                float q = acco[r] * acco[r]; q = dpp_add(q, 0); q = dpp_add(q, 1); q = dpp_add(q, 2); q = dpp_add(q, 3);
                if (fr == 0) ssq[(size_t)t * 64 + wi] = q; }
            slot = (slot == 2) ? 0 : slot + 1;
        }
#undef GLB_DMA
        asm volatile("s_waitcnt vmcnt(0) lgkmcnt(0)\n\ts_barrier" ::: "memory");
    }
}
__device__ __forceinline__ void unpack8(const v4u w, float* d) { d[0] = bflo(w.x); d[1] = bfhi(w.x); d[2] = bflo(w.y); d[3] = bfhi(w.y); d[4] = bflo(w.z); d[5] = bfhi(w.z); d[6] = bflo(w.w); d[7] = bfhi(w.w); }
__device__ __forceinline__ v4u pack8(const float* d) { v4u o; o.x = pk2(d[0], d[1]); o.y = pk2(d[2], d[3]); o.z = pk2(d[4], d[5]); o.w = pk2(d[6], d[7]); return o; }
__device__ __forceinline__ void phase_post(Frame& F, int l) {
    const float* lq1 = F.prm + PO_LQ1; const float* lk1 = F.prm + PO_LK1; const float* lq2 = F.prm + PO_LQ2; const float* lk2 = F.prm + PO_LK2; const float* diffg = F.prm + PO_DIFFG; const float* glag = F.prm + PO_GLAG;
    const int lane = F.lane;
    const float lam_init = 0.8f - 0.6f * expf(-0.3f * (float)l);
    const float d1 = lq1[l * 64 + lane] * lk1[l * 64 + lane], d2 = lq2[l * 64 + lane] * lk2[l * 64 + lane];
    const float lam = expf(wave_sum(d1)) - expf(wave_sum(d2)) + lam_init, osc = 1.0f - lam_init;
    float dgr[16], ggr[16];
#pragma unroll
    for (int i = 0; i < 16; ++i) { dgr[i] = diffg[l * 128 + 16 * (lane & 7) + i] * osc; ggr[i] = glag[l * 256 + 16 * (lane & 15) + i]; }
    const bf16* OP = (const bf16*)(F.ws + WS_OP); const bf16* OB = (const bf16*)(F.ws + WS_OB); const bf16* SG = (const bf16*)(F.ws + WS_SG); const float* SSQ = (const float*)(F.ws + WS_SSQ);
    bf16* OA2 = (bf16*)(F.ws + WS_OA2); bf16* OB2 = (bf16*)(F.ws + WS_OB2);
    for (int m = F.vcu * NWAVES + F.wave; m < NTOK; m += F.G * NWAVES) {
        float o0[16], o1[16], d[16];
        { const GAS v4u* p0 = (const GAS v4u*)(OP + (size_t)m * 2048 + 16 * lane); const GAS v4u* p1 = (const GAS v4u*)(OP + (size_t)m * 2048 + 1024 + 16 * lane);
          unpack8(p0[0], o0); unpack8(p0[1], o0 + 8); unpack8(p1[0], o1); unpack8(p1[1], o1 + 8); }
        float ss = 0.f;
#pragma unroll
        for (int i = 0; i < 16; ++i) { d[i] = o0[i] - lam * o1[i]; ss += d[i] * d[i]; }
        ss += __shfl_xor(ss, 1); ss += __shfl_xor(ss, 2); ss += __shfl_xor(ss, 4);
        { const float r = 1.0f / sqrtf(ss * (1.0f / 128.0f) + LN_EPS);
#pragma unroll
          for (int i = 0; i < 16; ++i) d[i] = d[i] * r * dgr[i];
          GAS v4u* q = (GAS v4u*)(OA2 + (size_t)m * 1024 + 16 * lane); q[0] = pack8(d); q[1] = pack8(d + 8); }
        { const GAS v4u* p0 = (const GAS v4u*)(OB + (size_t)m * 1024 + 16 * lane); const GAS v4u* p1 = (const GAS v4u*)(SG + (size_t)m * 1024 + 16 * lane);
          unpack8(p0[0], o0); unpack8(p0[1], o0 + 8); unpack8(p1[0], o1); unpack8(p1[1], o1 + 8); }
        { const GAS f32x4* sp = (const GAS f32x4*)(SSQ + (size_t)m * 64 + (lane >> 4) * 16); float sq = 0.f;
#pragma unroll
          for (int j = 0; j < 4; ++j) { const f32x4 v = sp[j]; sq += v.x; sq += v.y; sq += v.z; sq += v.w; }
          const float r = 1.0f / sqrtf(sq * (1.0f / 256.0f) + LN_EPS);
#pragma unroll
          for (int i = 0; i < 16; ++i) d[i] = o0[i] * r * ggr[i] * o1[i];
          GAS v4u* q = (GAS v4u*)(OB2 + (size_t)m * 1024 + 16 * lane); q[0] = pack8(d); q[1] = pack8(d + 8); }
    }
}
struct MoeOrder {
    const LAS int* BASE; int total4, G, c;
    __device__ __forceinline__ bool next(int i, pg8::Unit& u) const {
        const int Lx = i * G + c; if (Lx >= total4) return false;
        const int rt = Lx >> 2, pn = Lx & 3; int e = 0;
        for (int j = 1; j < 32; ++j) if (BASE[j] <= rt) e = j;
        e = __builtin_amdgcn_readfirstlane(e);
        u.pm = rt; u.pn = pn; u.pb = e * 4 + pn; return true;
    }
};

#ifndef PHMASK
#define PHMASK 0xFFFF
#endif
#ifndef REPMASK
#define REPMASK 0
#endif
#define REP(bit) for (int rep_ = 0; rep_ < ((REPMASK & (bit)) ? 2 : 1); ++rep_)
struct Args { const float* in[28]; float* out; unsigned char* ws; };
__global__ void __launch_bounds__(NTHREADS, 2) mk_fwd(Args args) {
    extern __shared__ __attribute__((aligned(16))) unsigned char lds[];
    Frame F;
    F.lds = (LAS unsigned char*)lds;
    F.tid = threadIdx.x; F.lane = F.tid & 63; F.wave = __builtin_amdgcn_readfirstlane(F.tid >> 6);
    F.G = gridDim.x; { const int bx = blockIdx.x; F.vcu = (F.G % 8 == 0) ? (bx % 8) * (F.G / 8) + bx / 8 : bx; }
    F.out = args.out; F.ws = args.ws; F.ctl = (gu32*)(args.ws + WS_CTL); F.prm = (const float*)(args.ws + WS_PRM);
    unsigned char* ws = args.ws;
    for (int u = F.tid; u < (LDS_BYTES - LDSCTL_OFF) / 4; u += NTHREADS) ((LAS unsigned*)(F.lds + LDSCTL_OFF))[u] = 0u;
    __syncthreads();
    volatile LAS unsigned* MISC = (volatile LAS unsigned*)(F.lds + MISC_OFF);
    XcdBarrier bar = xcd_barrier_post((unsigned*)(F.ctl + CW_BAR), MISC + 8);
    if ((REPMASK & 16384) && threadIdx.x == 0) MISC[21] = (unsigned)rt();
#ifndef BARSEL
#define BARSEL 0xFFF
#endif
#ifndef PSEL
#define PSEL 0
#endif
#ifndef DRYLVL
#define DRYLVL 1
#endif
#ifndef GLAV
#define GLAV 0
#endif
#ifndef GLA_TWO_PHASE
#define GLA_TWO_PHASE 1
#endif
#define GRID_BAR(id_) do { const unsigned long long tb0_ = (REPMASK & (8192 | 16384)) ? rt() : 0ull; \
        if ((REPMASK & 16384) && ((PSEL >> (id_)) & 1) && threadIdx.x == 0) MISC[20] += (unsigned)tb0_ - MISC[21];     \
        GAS unsigned char* bw_ = (GAS unsigned char*)args.ws; asm volatile("" : "+s"(bw_)); unsigned bx_ = bar.x; asm volatile("" : "+s"(bx_)); XcdBarrier b_ = bar; b_.x = bx_; b_.bar = (unsigned*)(bw_ + WS_CTL) + CW_BAR; xcd_barrier(b_); if (REPMASK & 4096) xcd_barrier(b_); \
        if ((REPMASK & 8192) && ((BARSEL >> (id_)) & 1) && threadIdx.x == 0) MISC[20] += (unsigned)(rt() - tb0_); if ((REPMASK & 16384) && threadIdx.x == 0) MISC[21] = (unsigned)rt(); } while (0)
#define PHASE_ENTER() do { int t_ = threadIdx.x; asm volatile("" : "+v"(t_)); F.tid = t_; F.lane = t_ & 63; F.wave = __builtin_amdgcn_readfirstlane(t_ >> 6); \
        GAS unsigned char* w_ = (GAS unsigned char*)args.ws; GAS float* o_ = (GAS float*)args.out; asm volatile("" : "+s"(w_), "+s"(o_));   \
        F.ws = (unsigned char*)w_; F.out = (float*)o_; ws = (unsigned char*)w_; F.ctl = (gu32*)(w_ + WS_CTL); F.prm = (const float*)(w_ + WS_PRM); F.xst = (float*)o_; F.Ubuf = (bf16*)(w_ + WS_U); F.LAbuf = (float*)(w_ + WS_LA); F.dry = 0; } while (0)
    typedef pg8::bf16_t pb;
    REP(1) if (PHMASK & 1) { PHASE_ENTER(); p0_ada(F, args.in[I_C], args.in[I_WADA], args.in[I_BADA]);
        __syncthreads();
        p0_weights(F, args.in[I_WIN], args.in[I_WBA], args.in[I_WBB], args.in[I_WOUT], args.in[I_WGE], args.in[I_WUE], args.in[I_WDE], args.in[I_WRG], args.in[I_WRE],
                   SmallPrm{args.in[I_BGATES], args.in[I_WALPHA], args.in[I_BALPHA], args.in[I_LQ1], args.in[I_LK1], args.in[I_LQ2], args.in[I_LK2], args.in[I_DIFFG], args.in[I_GLAG], args.in[I_LN1G], args.in[I_LN1B], args.in[I_BRG], args.in[I_BRE], args.in[I_LN2G], args.in[I_LN2B]}); __syncthreads(); }
    GRID_BAR(0);
    REP(2) if (PHMASK & 2) { PHASE_ENTER(); phase_r0(F, args.in[I_X]); }
    GRID_BAR(1);
    for (int l = 0; l < DEPTH; ++l) {
        REP(4) if (PHMASK & 4) { PHASE_ENTER(); pg8::Gemm g{(const pb*)(ws + WS_U), (const pb*)(ws + WS_WIN) + (size_t)l * NPROJ * 1024, NTOK, NPROJ, 1024}; pg8::StaticOrder S; S.init(NTOK, NPROJ, F.G, (int)blockIdx.x);
          pg8::EpiProj E{(pb*)(ws + WS_QB), (pb*)(ws + WS_KB), (pb*)(ws + WS_VB), (pb*)(ws + WS_GQ), (pb*)(ws + WS_GK), (pb*)(ws + WS_GV), (pb*)(ws + WS_SG), (pb*)(ws + WS_GT), F.prm + PO_BGATES + l * 2048};
          pg8::gemm_phase<pg8::EpiProj, pg8::StaticOrder, true, false>(F.lds + RING_OFF, g, S, E, nullptr); }
        GRID_BAR(2);
#if GLA_TWO_PHASE
        if (PHMASK & 8) { PHASE_ENTER(); phase_gla_a(F); }
        GRID_BAR(12);
        if (PHMASK & 8) { PHASE_ENTER(); phase_gla_b(F); }
#else
        REP(8) if (PHMASK & 8) { PHASE_ENTER(); phase_gla(F, ((REPMASK & 8) && rep_ == 0) ? GLAV : 0); }
#endif
        GRID_BAR(3);
        REP(16) if (PHMASK & 16) { PHASE_ENTER(); const attn_body::AttnTensors AT{(const attn_body::bf16*)(ws + WS_QB), (const attn_body::bf16*)(ws + WS_KB), (const attn_body::bf16*)(ws + WS_VB), (attn_body::bf16*)(ws + WS_OP)};
          attn_body::attn_phase<8>((char*)lds + RING_OFF, AT, (unsigned*)(F.ctl + CW_ATQ + (l * 2 + ((REPMASK & 16) ? rep_ : 0)) * 64), MISC + 16); }
        GRID_BAR(4);
        REP(32) if (PHMASK & 32) { PHASE_ENTER(); phase_post(F, l); }
        GRID_BAR(5);
        REP(64) if (PHMASK & 64) { PHASE_ENTER(); pg8::PairOrder S; S.S.init(NTOK, 1024, F.G, (int)blockIdx.x);
          static_assert(WS_OB2 == WS_OA2 + (size_t)NTOK * 1024 * 2 && WS_WBB == WS_WBA + 16 * 256 * 1024 * 2, "stacked A / B views of the two branch GEMMs");
          pg8::Gemm g{(const pb*)(ws + WS_OA2), (const pb*)(ws + WS_WBA) + (size_t)l * 1024 * 1024, 2 * NTOK, 1024, 1024};
          pg8::EpiGatePair E{(pb*)(ws + WS_TMP), (long)((WS_MIX - WS_TMP) / 2), (const pb*)(ws + WS_GT)};
          pg8::gemm_phase<pg8::EpiGatePair, pg8::PairOrder, true, false>(F.lds + RING_OFF, g, S, E, nullptr); }
        GRID_BAR(6);
        if (PHMASK & 128) { PHASE_ENTER(); pg8::Gemm g{(const pb*)(ws + WS_MIX), (const pb*)(ws + WS_WOUT) + (size_t)l * 1024 * 1024, NTOK, 1024, 1024}; pg8::StaticOrder S; S.init(NTOK, 1024, F.G, (int)blockIdx.x);
          REP(128) { pg8::EpiResid E{F.out, ((REPMASK & 128) && rep_ == 0) ? (float*)(ws + WS_QB) : F.out, (const float*)(ws + WS_ADA) + (size_t)l * 8 * 6144 + 2 * 1024, 6144, DN_ALPHA};
          pg8::gemm_phase<pg8::EpiResid, pg8::StaticOrder, true, false>(F.lds + RING_OFF, g, S, E, nullptr); } }
        GRID_BAR(7);
        REP(256) if (PHMASK & 256) { PHASE_ENTER(); if ((REPMASK & 256) && rep_ == 0) { F.dry = DRYLVL; F.xst = (float*)(ws + WS_QB); F.Ubuf = (bf16*)(ws + WS_VB); } phase_r1(F, l); }
        GRID_BAR(8);
        if (PHMASK & 512) { PHASE_ENTER(); moe_tables(F, l); }
        if (PHMASK & 512) { const LAS int* BASE = (const LAS int*)(F.lds + TAB_BASE); const LAS int* CNT = (const LAS int*)(F.lds + TAB_CNT); LAS int* IDX = (LAS int*)(F.lds + TAB_IDX);
          const int total4 = __builtin_amdgcn_readfirstlane(BASE[32]) * 4; const int* LIST = (const int*)(ws + WS_LIST);
          MoeOrder S{BASE, total4, F.G, (int)blockIdx.x};
          for (int ui = 0; ui < IDX_UNITS; ++ui) { pg8::Unit u; if (!S.next(ui, u)) break; const int e = u.pb >> 2;
              if (F.tid < 256) { const int pos = (u.pm - BASE[e]) * 256 + F.tid; IDX[ui * 256 + F.tid] = (pos < CNT[e]) ? LIST[(size_t)e * LISTCAP + pos] : 0; } }
          __syncthreads();
          REP(512) { pg8::Gemm g{(const pb*)(ws + WS_U), (const pb*)(ws + WS_W1) + (size_t)l * 32 * 1024 * 1024, MOE_MAXT * 256, 1024, 1024};
            pg8::EpiSwiGLU E{(pb*)(ws + WS_H)};
            pg8::gemm_phase<pg8::EpiSwiGLU, MoeOrder, true, true>(F.lds + RING_OFF, g, S, E, IDX); }
          GRID_BAR(9);
          PHASE_ENTER();
          REP(2048) { pg8::Gemm g{(const pb*)(ws + WS_H), (const pb*)(ws + WS_WD) + (size_t)l * 32 * 1024 * 512, MOE_MAXT * 256, 1024, 512};
            pg8::EpiGate<2> E{(pb*)(ws + WS_YB), 1024, nullptr, nullptr, 0, 0};
            pg8::gemm_phase<pg8::EpiGate<2>, MoeOrder, true, false>(F.lds + RING_OFF, g, S, E, nullptr); }
        }
        GRID_BAR(10);
        REP(1024) if (PHMASK & 1024) { PHASE_ENTER(); if ((REPMASK & 1024) && rep_ == 0) { F.dry = DRYLVL; F.xst = (float*)(ws + WS_GT); F.Ubuf = (bf16*)(ws + WS_SG); F.LAbuf = (float*)(ws + WS_GV); } phase_r2(F, l); }
        if (l + 1 < DEPTH) GRID_BAR(11);
    }
    if ((REPMASK & 16384) && ((PSEL >> 11) & 1) && threadIdx.x == 0) MISC[20] += (unsigned)rt() - MISC[21];
    if ((REPMASK & (8192 | 16384)) && blockIdx.x == 0 && threadIdx.x == 0) { const unsigned tw_ = MISC[20]; const unsigned long long ts_ = rt(); while ((unsigned)(rt() - ts_) < tw_) __builtin_amdgcn_s_sleep(8); }
}

extern "C" void kernel_launch(void* const* d_in, const int* in_sizes, int n_in, void* d_out, int out_size, void* d_ws, size_t ws_size, hipStream_t stream) {
    static int grid = 0;
    if (grid == 0) {
        if (n_in != 28 || in_sizes[0] != NTOK * DM || out_size != NTOK * DM || ws_size < WS_END) { fprintf(stderr, "kernel_launch: unexpected shapes (n_in %d, in0 %d, out %d, ws %zu < %zu); nothing launched\n", n_in, n_in > 0 ? in_sizes[0] : -1, out_size, ws_size, (size_t)WS_END); grid = -1; return; }
        int dev = 0, cus = 0, per_cu = 0;
        if (hipGetDevice(&dev) != hipSuccess || hipDeviceGetAttribute(&cus, hipDeviceAttributeMultiprocessorCount, dev) != hipSuccess) { fprintf(stderr, "kernel_launch: device query failed\n"); grid = -1; return; }
        if (hipFuncSetAttribute((const void*)mk_fwd, hipFuncAttributeMaxDynamicSharedMemorySize, LDS_BYTES) != hipSuccess) { fprintf(stderr, "kernel_launch: hipFuncSetAttribute failed\n"); grid = -1; return; }
        if (hipOccupancyMaxActiveBlocksPerMultiprocessor(&per_cu, (const void*)mk_fwd, NTHREADS, LDS_BYTES) != hipSuccess || per_cu < 1) { fprintf(stderr, "kernel_launch: occupancy query says %d\n", per_cu); }
        (void)hipGetLastError();
        grid = cus;
    }
    if (grid < 0) return;
    if (hipMemsetAsync((char*)d_ws + WS_CTL, 0, CTL_ZERO_BYTES, stream) != hipSuccess) { fprintf(stderr, "kernel_launch: memset failed\n"); return; }
    Args a{};
    for (int i = 0; i < 28; ++i) a.in[i] = (const float*)d_in[i];
    a.out = (float*)d_out; a.ws = (unsigned char*)d_ws;
    hipLaunchKernelGGL(mk_fwd, dim3(grid), dim3(NTHREADS), LDS_BYTES, stream, a);
    const hipError_t le = hipPeekAtLastError();
    if (le != hipSuccess) fprintf(stderr, "kernel_launch: launch failed: %s\n", hipGetErrorName(le));
}
```

```cpp
#include <hip/hip_runtime.h>
#include <hip/hip_bf16.h>
#include <cstdio>
#include <cstdint>
#include <cmath>
namespace pg8 {
#define PG8_LAS __attribute__((address_space(3)))
typedef unsigned short bf16_t;
typedef short bf16x8 __attribute__((ext_vector_type(8)));
typedef float f32x4 __attribute__((ext_vector_type(4)));
typedef float f32x2 __attribute__((ext_vector_type(2)));
typedef unsigned u32x4 __attribute__((ext_vector_type(4)));
typedef unsigned u32x2 __attribute__((ext_vector_type(2)));
constexpr int BM = 256, BK = 64, HALF = 128, HTB = HALF * BK * 2  , STAGE_BYTES = 8 * HTB, NXCD = 8, WGM = 8;

__host__ __device__ __forceinline__ int lds_byte(int r, int c) { const int st = (r >> 4) * 2 + (c >> 5), rr = r & 15, cc = c & 31, ob = rr * 64 + cc * 2; return st * 1024 + (ob ^ (((ob >> 9) & 1) << 5)); }
__host__ __device__ __forceinline__ void stage_rc(int b, int& R, int& C) { const int st = b / 1024, sb = b % 1024, swz = sb ^ (((sb >> 9) & 1) << 5); R = (st >> 1) * 16 + swz / 64; C = (st & 1) * 32 + (swz % 64) / 2; }
__host__ __device__ __forceinline__ int perm32(int rho) { const int n = rho >> 4, i = rho & 15; return 8 * (i >> 2) + 4 * n + (i & 3); }

struct Unit { int pm, pn, pb; };
struct Gemm { const bf16_t* A; const bf16_t* Bt; int M, N, K; };

struct StaticOrder {
    int nM, nN, nwg, G, c;
    __host__ __device__ __forceinline__ void init(int M, int N, int G_, int c_) { nM = M / BM; nN = N / BM; nwg = nM * nN; G = G_; c = c_; }
    __host__ __device__ __forceinline__ bool next(int i, Unit& u) const {
        const long L = (long)i * G + c; if (L >= nwg) return false;
        int wgid = (int)L; { const int q = nwg / NXCD, r = nwg % NXCD, xcd = wgid % NXCD, off = wgid / NXCD; wgid = (xcd < r ? xcd * (q + 1) : r * (q + 1) + (xcd - r) * q) + off; }
        const int nig = WGM * nN, gid = wgid / nig, fm = gid * WGM, gsz = (nM - fm) < WGM ? (nM - fm) : WGM;
        u.pm = fm + ((wgid % nig) % gsz); u.pn = (wgid % nig) / gsz; u.pb = u.pn; return true;
    }
};

__device__ __forceinline__ unsigned cvt_pk_bf16(float lo, float hi) { unsigned r; asm volatile("v_cvt_pk_bf16_f32 %0, %1, %2" : "=v"(r) : "v"(lo), "v"(hi)); return r; }
typedef __bf16 bf16x2_c __attribute__((ext_vector_type(2)));
__device__ __forceinline__ unsigned cvt_pk_bf16_c(float lo, float hi) { const f32x2 v = {lo, hi}; const bf16x2_c b = __builtin_convertvector(v, bf16x2_c); return __builtin_bit_cast(unsigned, b); }
__device__ __forceinline__ float bf_lo(unsigned w) { return __uint_as_float(w << 16); }
__device__ __forceinline__ float bf_hi(unsigned w) { return __uint_as_float(w & 0xffff0000u); }
__device__ __forceinline__ float sigmoidf_(float x) { return __builtin_amdgcn_rcpf(1.0f + __expf(-x)); }

template <class Epi, class Sched, bool ALIGN_EPI, bool GATHER>
__device__ __forceinline__ void gemm_phase(PG8_LAS unsigned char* lds, const Gemm g, const Sched& S, const Epi& E, const PG8_LAS int* idxtab) {
    int tid_ = threadIdx.x; asm volatile("" : "+v"(tid_));
    const int tid = tid_, wid = __builtin_amdgcn_readfirstlane(tid >> 6), lane = tid & 63, wr = wid >> 2, wc = wid & 3, fr = lane & 15, fq = lane >> 4;
    const int K = g.K, nt = K / BK;
    unsigned voffA[2], voffB[2];
#pragma unroll
    for (int i = 0; i < 2; ++i) { int R, C; stage_rc(tid * 16 + i * 8192, R, C); const int Rb = Epi::PERM ? ((R & ~31) + perm32(R & 31)) : R;
        voffA[i] = (unsigned)(R * K + C) * 2u; voffB[i] = (unsigned)(Rb * K + C) * 2u; }
    const size_t kstep = (size_t)(BK * 2);
    const size_t hstep = (size_t)HALF * K * 2;
    const size_t tstep = 2 * hstep;
    const unsigned ldsw = (unsigned)wid * 1024u;
    const int aoff = lds_byte(wr * 64 + fr, fq * 8), boff = lds_byte(wc * 32 + fr, fq * 8);
    unsigned offAc[2][2];
    int nui = 0;
#define PG8_SA(b, h) (((b) * 2 + (h)) * HTB)
#define PG8_SB(b, h) ((4 + (b) * 2 + (h)) * HTB)
#define PG8_STAGE(bufoff, gbase, voff) do { _Pragma("unroll") for (int _i = 0; _i < 2; ++_i) \
        __builtin_amdgcn_global_load_lds((const unsigned*)((const char*)(gbase) + (voff)[_i]), (PG8_LAS unsigned*)(lds + (bufoff) + ldsw + _i * 8192), 16, 0, 0); } while (0)
#define PG8_GOFF(uix, h, i, tt) ({ int _R, _C; stage_rc((tt) * 16 + (i) * 8192, _R, _C); (unsigned)idxtab[(uix) * 256 + (h) * HALF + _R] * (unsigned)(K * 2) + (unsigned)_C * 2u; })
#define PG8_STAGE_A(bufoff, kb, h, nx) do { if constexpr (GATHER) { unsigned _o[2] = {offAc[h][0], offAc[h][1]}; \
        if (nx) { int _t = tid; asm volatile("" : "+v"(_t)); _o[0] = PG8_GOFF(nui, h, 0, _t); _o[1] = PG8_GOFF(nui, h, 1, _t); } \
        _Pragma("unroll") for (int _i = 0; _i < 2; ++_i) \
        __builtin_amdgcn_global_load_lds((const unsigned*)((const char*)g.A + (size_t)(kb) + _o[_i]), (PG8_LAS unsigned*)(lds + (bufoff) + ldsw + _i * 8192), 16, 0, 0); } \
        else { const char* _b = ((nx) ? nA : cA) + (size_t)(kb) + (size_t)(h) * hstep; PG8_STAGE(bufoff, _b, voffA); } } while (0)
#define PG8_GIDX(dst, uix) do { if constexpr (GATHER) { int _t = tid; asm volatile("" : "+v"(_t)); _Pragma("unroll") for (int _h = 0; _h < 2; ++_h) _Pragma("unroll") for (int _i = 0; _i < 2; ++_i) \
        dst[_h][_i] = PG8_GOFF(uix, _h, _i, _t); } } while (0)
#define PG8_LDA(dst, b, h) do { _Pragma("unroll") for (int m = 0; m < 4; ++m) _Pragma("unroll") for (int k = 0; k < 2; ++k) dst[m][k] = *(const PG8_LAS bf16x8*)(lds + PG8_SA(b, h) + aoff + m * 2048 + k * 1024); } while (0)
#define PG8_LDB(dst, b, h) do { _Pragma("unroll") for (int n = 0; n < 2; ++n) _Pragma("unroll") for (int k = 0; k < 2; ++k) dst[n][k] = *(const PG8_LAS bf16x8*)(lds + PG8_SB(b, h) + boff + n * 2048 + k * 1024); } while (0)
#define PG8_MMA(ai, bj, At, Bt) do { __builtin_amdgcn_s_setprio(1); _Pragma("unroll") for (int m = 0; m < 4; ++m) _Pragma("unroll") for (int n = 0; n < 2; ++n) _Pragma("unroll") for (int k = 0; k < 2; ++k) \
        acc[ai][bj][m][n] = __builtin_amdgcn_mfma_f32_16x16x32_bf16(Bt[n][k], At[m][k], acc[ai][bj][m][n], 0, 0, 0); __builtin_amdgcn_s_setprio(0); } while (0)
#define PG8_WAIT_V(n) asm volatile("s_waitcnt vmcnt(" #n ")" ::: "memory")
#define PG8_WAIT_L(n) asm volatile("s_waitcnt lgkmcnt(" #n ")" ::: "memory")
#define PG8_BAR __builtin_amdgcn_s_barrier()
#define PG8_SCHED __builtin_amdgcn_sched_barrier(0)
    Unit cur, nxt; int ui = 0;
    if (!S.next(0, cur)) return;
    f32x4 acc[2][2][4][2];
#pragma unroll
    for (int a = 0; a < 2; ++a)
#pragma unroll
        for (int b = 0; b < 2; ++b)
#pragma unroll
            for (int m = 0; m < 4; ++m)
#pragma unroll
                for (int n = 0; n < 2; ++n) acc[a][b][m][n] = (f32x4){0.f, 0.f, 0.f, 0.f};
    bf16x8 At[4][2], B0[2][2], B1[2][2];
    const char* cA = (const char*)g.A + (size_t)cur.pm * tstep; const char* cB = (const char*)g.Bt + (size_t)cur.pb * tstep;
    const char* nA = cA;
    PG8_GIDX(offAc, 0);
    PG8_STAGE(PG8_SB(0, 0), cB, voffB); PG8_STAGE(PG8_SB(0, 1), cB + hstep, voffB); PG8_STAGE_A(PG8_SA(0, 0), 0, 0, false); PG8_STAGE_A(PG8_SA(0, 1), 0, 1, false);
    if (wr == 1) PG8_BAR;
    PG8_WAIT_V(2); PG8_BAR;
    PG8_STAGE(PG8_SB(1, 0), cB + kstep, voffB); PG8_STAGE_A(PG8_SA(1, 0), kstep, 0, false); PG8_STAGE(PG8_SB(1, 1), cB + hstep + kstep, voffB);
    PG8_WAIT_V(6); PG8_BAR;
    for (;;) {
        const bool has_next = S.next(ui + 1, nxt);
        nA = has_next ? (const char*)g.A + (size_t)nxt.pm * tstep : cA; const char* nB = has_next ? (const char*)g.Bt + (size_t)nxt.pb * tstep : cB;
        nui = has_next ? ui + 1 : ui;
        for (int t = 0; t < nt; t += 2) {
            const bool last = (t == nt - 2);
            const size_t kb1 = (size_t)(t + 1) * kstep;
            const size_t kb2 = last ? (size_t)0 : (size_t)(t + 2) * kstep, kb3 = kb2 + kstep;
            const char* b2 = last ? nB : cB + (size_t)(t + 2) * kstep; const char* b3 = b2 + kstep;
            PG8_LDB(B0, 0, 0); PG8_LDB(B1, 0, 1); PG8_SCHED; PG8_LDA(At, 0, 0); PG8_STAGE_A(PG8_SA(1, 1), kb1, 1, false);
            PG8_WAIT_V(8); PG8_WAIT_L(0); PG8_BAR; PG8_MMA(0, 0, At, B0); PG8_MMA(0, 1, At, B1); PG8_BAR; PG8_SCHED;
            PG8_LDA(At, 0, 1); PG8_STAGE(PG8_SB(0, 0), b2, voffB); PG8_STAGE(PG8_SB(0, 1), b2 + hstep, voffB); PG8_STAGE_A(PG8_SA(0, 0), kb2, 0, last);
            PG8_WAIT_V(8); PG8_WAIT_L(0); PG8_BAR; PG8_MMA(1, 0, At, B0); PG8_MMA(1, 1, At, B1); PG8_BAR; PG8_SCHED;
            PG8_LDB(B0, 1, 0); PG8_LDB(B1, 1, 1); PG8_SCHED; PG8_LDA(At, 1, 0); PG8_STAGE_A(PG8_SA(0, 1), kb2, 1, last);
            PG8_WAIT_V(8); PG8_WAIT_L(0); PG8_BAR; PG8_MMA(0, 0, At, B0); PG8_MMA(0, 1, At, B1); PG8_BAR; PG8_SCHED;
            PG8_LDA(At, 1, 1); PG8_STAGE(PG8_SB(1, 0), b3, voffB); PG8_STAGE(PG8_SB(1, 1), b3 + hstep, voffB); PG8_STAGE_A(PG8_SA(1, 0), kb3, 0, last);
            PG8_WAIT_V(8); PG8_WAIT_L(0); PG8_BAR; PG8_MMA(1, 0, At, B0); PG8_MMA(1, 1, At, B1); PG8_BAR; PG8_SCHED;
        }
        if constexpr (ALIGN_EPI) { if (wr == 0) PG8_BAR; }
        E(acc, cur, wr, wc, fr, fq);
        if (!has_next) break;
#pragma unroll
        for (int a = 0; a < 2; ++a)
#pragma unroll
            for (int b = 0; b < 2; ++b)
#pragma unroll
                for (int m = 0; m < 4; ++m)
#pragma unroll
                    for (int n = 0; n < 2; ++n) acc[a][b][m][n] = (f32x4){0.f, 0.f, 0.f, 0.f};
        cur = nxt; cA = nA; cB = nB; ++ui;
        PG8_GIDX(offAc, ui);
        if constexpr (ALIGN_EPI) { if (wr == 1) PG8_BAR; }
    }
    PG8_WAIT_V(0);
    if constexpr (!ALIGN_EPI) { if (wr == 0) PG8_BAR; }
    PG8_BAR;
#undef PG8_SA
#undef PG8_SB
#undef PG8_STAGE
#undef PG8_STAGE_A
#undef PG8_GIDX
#undef PG8_GOFF
#undef PG8_LDA
#undef PG8_LDB
#undef PG8_MMA
#undef PG8_WAIT_V
#undef PG8_WAIT_L
#undef PG8_BAR
#undef PG8_SCHED
}
}
namespace pg8 {
constexpr float ATT_C2 = 0.125f * 1.4426950408889634f;
constexpr float GLA_QS = 0.08838834764831845f;
struct EpiProj {
    static constexpr bool PERM = true;
    bf16_t *Qb, *Kb, *Vb, *GQ, *GK, *GV, *SG, *GT; const float* bgates;
    __device__ __forceinline__ void operator()(const f32x4 (&acc)[2][2][4][2], const Unit& u, int wr, int wc, int fr, int fq) const {
        asm volatile("" : "+v"(fr), "+v"(fq));
        const int pn = u.pn; bf16_t* base; int ldc = 1024, ct; int act = 0; float sc = 1.f;
        if (pn < 4) { base = Qb; ct = pn; sc = ATT_C2; }
        else if (pn < 8) { base = Kb; ct = pn - 4; }
        else if (pn < 12) { base = Vb; ct = pn - 8; }
        else if (pn < 14) { base = GQ; ldc = 512; ct = pn - 12; sc = GLA_QS; }
        else if (pn < 16) { base = GK; ldc = 512; ct = pn - 14; }
        else if (pn < 20) { base = GV; ct = pn - 16; }
        else if (pn < 24) { base = SG; ct = pn - 20; act = 1; }
        else { base = GT; ldc = 2048; ct = pn - 24; act = 2; }
        const int row0 = u.pm * BM + wr * 64 + fr, col0 = ct * BM + wc * 32 + 8 * fq;
        f32x4 bv[2][2];
#pragma unroll
        for (int bj = 0; bj < 2; ++bj)
#pragma unroll
            for (int n = 0; n < 2; ++n) bv[bj][n] = (act == 2) ? *(const f32x4*)(bgates + col0 + bj * HALF + 4 * n) : (f32x4){0.f, 0.f, 0.f, 0.f};
#pragma unroll
        for (int ai = 0; ai < 2; ++ai)
#pragma unroll
            for (int m = 0; m < 4; ++m) { bf16_t* rowp = base + (size_t)(row0 + ai * HALF + m * 16) * ldc + col0;
#pragma unroll
                for (int bj = 0; bj < 2; ++bj) { f32x4 v0 = acc[ai][bj][m][0] * sc + bv[bj][0], v1 = acc[ai][bj][m][1] * sc + bv[bj][1];
                    if (act != 0) {
#pragma unroll
                        for (int e = 0; e < 4; ++e) { const float s0 = sigmoidf_(v0[e]), s1 = sigmoidf_(v1[e]); v0[e] = (act == 1) ? v0[e] * s0 : s0; v1[e] = (act == 1) ? v1[e] * s1 : s1; } }
                    u32x4 w; w.x = cvt_pk_bf16(v0[0], v0[1]); w.y = cvt_pk_bf16(v0[2], v0[3]); w.z = cvt_pk_bf16(v1[0], v1[1]); w.w = cvt_pk_bf16(v1[2], v1[3]);
                    *(u32x4*)(rowp + bj * HALF) = w; } }
    }
};
template <int MODE> struct EpiGate {
    static constexpr bool PERM = true;
    bf16_t* O; int ldo; const bf16_t* T; const bf16_t* gate; int ldg, gcol0;
    __device__ __forceinline__ void operator()(const f32x4 (&acc)[2][2][4][2], const Unit& u, int wr, int wc, int fr, int fq) const {
        asm volatile("" : "+v"(fr), "+v"(fq));
        const int row0 = u.pm * BM + wr * 64 + fr, col0 = u.pn * BM + wc * 32 + 8 * fq;
#pragma unroll
        for (int ai = 0; ai < 2; ++ai)
#pragma unroll
            for (int m = 0; m < 4; ++m) { const size_t row = (size_t)(row0 + ai * HALF + m * 16);
#pragma unroll
                for (int bj = 0; bj < 2; ++bj) { f32x4 v0 = acc[ai][bj][m][0], v1 = acc[ai][bj][m][1]; const int col = col0 + bj * HALF;
                    if (MODE != 2) { const u32x4 gw = *(const u32x4*)(gate + row * ldg + gcol0 + col);
                        v0 = v0 * (f32x4){bf_lo(gw.x), bf_hi(gw.x), bf_lo(gw.y), bf_hi(gw.y)}; v1 = v1 * (f32x4){bf_lo(gw.z), bf_hi(gw.z), bf_lo(gw.w), bf_hi(gw.w)}; }
                    if (MODE == 1) { const u32x4 tw = *(const u32x4*)(T + row * ldo + col);
                        v0 = v0 + (f32x4){bf_lo(tw.x), bf_hi(tw.x), bf_lo(tw.y), bf_hi(tw.y)}; v1 = v1 + (f32x4){bf_lo(tw.z), bf_hi(tw.z), bf_lo(tw.w), bf_hi(tw.w)}; }
                    u32x4 w; w.x = cvt_pk_bf16(v0[0], v0[1]); w.y = cvt_pk_bf16(v0[2], v0[3]); w.z = cvt_pk_bf16(v1[0], v1[1]); w.w = cvt_pk_bf16(v1[2], v1[3]);
                    *(u32x4*)(O + row * ldo + col) = w; }
                asm volatile("" ::: "memory"); }
    }
};
struct EpiGatePair {
    static constexpr bool PERM = true;
    bf16_t* TMP; long mix_delta; const bf16_t* gate;
    __device__ __forceinline__ void operator()(const f32x4 (&acc)[2][2][4][2], const Unit& u, int wr, int wc, int fr, int fq) const {
        asm volatile("" : "+v"(fr), "+v"(fq));
        const int kind = u.pm >= 128 ? 1 : 0; const int row0 = (u.pm - 128 * kind) * BM + wr * 64 + fr, col0 = u.pn * BM + wc * 32 + 8 * fq;
#pragma unroll
        for (int ai = 0; ai < 2; ++ai)
#pragma unroll
            for (int m = 0; m < 4; ++m) { const size_t row = (size_t)(row0 + ai * HALF + m * 16);
#pragma unroll
                for (int bj = 0; bj < 2; ++bj) { f32x4 v0 = acc[ai][bj][m][0], v1 = acc[ai][bj][m][1]; const int col = col0 + bj * HALF;
                    { const u32x4 gw = *(const u32x4*)(gate + row * 2048 + kind * 1024 + col);
                      v0 = v0 * (f32x4){bf_lo(gw.x), bf_hi(gw.x), bf_lo(gw.y), bf_hi(gw.y)}; v1 = v1 * (f32x4){bf_lo(gw.z), bf_hi(gw.z), bf_lo(gw.w), bf_hi(gw.w)}; }
                    if (kind) { const u32x4 tw = *(const u32x4*)(TMP + row * 1024 + col);
                        v0 = v0 + (f32x4){bf_lo(tw.x), bf_hi(tw.x), bf_lo(tw.y), bf_hi(tw.y)}; v1 = v1 + (f32x4){bf_lo(tw.z), bf_hi(tw.z), bf_lo(tw.w), bf_hi(tw.w)}; }
                    u32x4 w; w.x = cvt_pk_bf16(v0[0], v0[1]); w.y = cvt_pk_bf16(v0[2], v0[3]); w.z = cvt_pk_bf16(v1[0], v1[1]); w.w = cvt_pk_bf16(v1[2], v1[3]);
                    *(u32x4*)(TMP + (long)kind * mix_delta + row * 1024 + col) = w; }
                asm volatile("" ::: "memory"); }
    }
};
struct PairOrder {
    StaticOrder S;
    __device__ __forceinline__ bool next(int i, Unit& u) const { if (!S.next(i >> 1, u)) return false; const int kind = i & 1; u.pm += 128 * kind; u.pb = u.pn + 16 * kind; return true; }
};
struct EpiResid {
    static constexpr bool PERM = false;
    const float* X; float* Xo; const float* gvec; int gstride; float alpha;
    __device__ __forceinline__ void operator()(const f32x4 (&acc)[2][2][4][2], const Unit& u, int wr, int wc, int fr, int fq) const {
        asm volatile("" : "+v"(fr), "+v"(fq));
        const int row0 = u.pm * BM + wr * 64 + fr, col0 = u.pn * BM + wc * 32 + 4 * fq; const float* gv = gvec + (size_t)(u.pm >> 4) * gstride;
        f32x4 g4[2][2];
#pragma unroll
        for (int bj = 0; bj < 2; ++bj)
#pragma unroll
            for (int n = 0; n < 2; ++n) g4[bj][n] = *(const f32x4*)(gv + col0 + bj * HALF + n * 16);
#pragma unroll
        for (int ai = 0; ai < 2; ++ai)
#pragma unroll
            for (int m = 0; m < 4; ++m) { const size_t ro = (size_t)(row0 + ai * HALF + m * 16) * 1024 + col0;
#pragma unroll
                for (int bj = 0; bj < 2; ++bj)
#pragma unroll
                    for (int n = 0; n < 2; ++n) { const size_t o = ro + bj * HALF + n * 16; const f32x4 xv = *(const f32x4*)(X + o); *(f32x4*)(Xo + o) = xv * alpha + g4[bj][n] * acc[ai][bj][m][n]; }
                asm volatile("" ::: "memory"); }
    }
};
struct EpiSwiGLU {
    static constexpr bool PERM = true;
    bf16_t* H;
    __device__ __forceinline__ void operator()(const f32x4 (&acc)[2][2][4][2], const Unit& u, int wr, int wc, int fr, int fq) const {
        asm volatile("" : "+v"(fr), "+v"(fq));
        const int row0 = u.pm * BM + wr * 64 + fr, col0 = u.pn * HALF + wc * 32 + 8 * fq;
#pragma unroll
        for (int ai = 0; ai < 2; ++ai)
#pragma unroll
            for (int m = 0; m < 4; ++m) { f32x4 h0, h1;
#pragma unroll
                for (int e = 0; e < 4; ++e) { const float g0 = acc[ai][0][m][0][e], g1 = acc[ai][0][m][1][e]; h0[e] = g0 * sigmoidf_(g0) * acc[ai][1][m][0][e]; h1[e] = g1 * sigmoidf_(g1) * acc[ai][1][m][1][e]; }
                u32x4 w; w.x = cvt_pk_bf16(h0[0], h0[1]); w.y = cvt_pk_bf16(h0[2], h0[3]); w.z = cvt_pk_bf16(h1[0], h1[1]); w.w = cvt_pk_bf16(h1[2], h1[3]);
                *(u32x4*)(H + (size_t)(row0 + ai * HALF + m * 16) * 512 + col0) = w; }
    }
};
}
#include <hip/hip_bf16.h>
#include <cmath>
namespace attn_body {
using bf16=__hip_bfloat16;
using bf16x8=__attribute__((ext_vector_type(8)))short;
using s16x4=__attribute__((ext_vector_type(4)))short;
using f32x16=__attribute__((ext_vector_type(16)))float;
using u32x4=__attribute__((ext_vector_type(4)))unsigned;
constexpr int BATCH=8,NHEAD=16,SEQ=4096,D=64,DM=NHEAD*D,OPITCH=2048;
constexpr int NW=8,QBLK=32,QB=QBLK*NW,KVBLK=64,NQB=SEQ/QB;
constexpr int ATTN_PITCH=DM, ATTN_UNIT_ROWS=QB;
__device__ __forceinline__ int crow(int r,int hi){return (r&3)+8*(r>>2)+4*hi;}
#define SBAR() __builtin_amdgcn_sched_barrier(0)
__device__ __forceinline__ void cmask(f32x16&p0,f32x16&p1,int jb,int qrel,int hi){
  const float NEG=-INFINITY; int kb=64*jb+4*hi;
  #pragma unroll
  for(int r=0;r<16;++r){int kv=kb+(r&3)+8*(r>>2); if(kv>qrel)p0[r]=NEG; if(kv+32>qrel)p1[r]=NEG;}
}

constexpr int NSLOT=3, SLOTB=8192;
constexpr int LDS_K=0, LDS_V=NSLOT*SLOTB, LDS_WS=3*NSLOT*SLOTB, LDS_OST=LDS_WS+NW*64*4, LDS_BYTES=LDS_OST+NW*4096;
constexpr float C2=0.125f*1.4426950408889634f;
__device__ __forceinline__ void glds16s(const void*sbase,unsigned voff,unsigned lds_dst){unsigned keep;
  asm volatile("s_mov_b32 %0, m0\n\ts_mov_b32 m0, %2\n\ts_nop 0\n\tglobal_load_lds_dwordx4 %1, %3\n\ts_mov_b32 m0, %0":"=&s"(keep):"v"(voff),"s"(lds_dst),"s"(sbase):"memory");}
__device__ __forceinline__ void glds16(const void*gsrc,unsigned lds_dst){unsigned keep;
  asm volatile("s_mov_b32 %0, m0\n\ts_mov_b32 m0, %2\n\ts_nop 0\n\tglobal_load_lds_dwordx4 %1, off\n\ts_mov_b32 m0, %0":"=&s"(keep):"v"(gsrc),"s"(lds_dst):"memory");}
__device__ __forceinline__ float max3f(float a,float b,float c){float r;asm("v_max3_f32 %0, %1, %2, %3":"=v"(r):"v"(a),"v"(b),"v"(c));return r;}
__device__ __forceinline__ float max2f(float a,float b){float r;asm("v_max_f32_e32 %0, %1, %2":"=v"(r):"v"(a),"v"(b));return r;}
__device__ __forceinline__ float fadd_s(float a,float b){float r;asm("v_add_f32_e32 %0, %1, %2":"=v"(r):"v"(a),"v"(b));return r;}
__device__ __forceinline__ float fsub_s(float a,float b){float r;asm("v_sub_f32_e32 %0, %1, %2":"=v"(r):"v"(a),"v"(b));return r;}
typedef float f32x2_t __attribute__((ext_vector_type(2))); typedef __bf16 bf16x2_t __attribute__((ext_vector_type(2)));
__device__ __forceinline__ unsigned cvtpk_s(float lo,float hi){f32x2_t v={lo,hi};bf16x2_t b=__builtin_convertvector(v,bf16x2_t);return __builtin_bit_cast(unsigned,b);}
#define WAIT_BAR(N) asm volatile("s_waitcnt vmcnt(" #N ") lgkmcnt(0)\n\ts_barrier":::"memory")

__device__ __forceinline__ void qkt(f32x16&p0,f32x16&p1,const char*Kslot,const bf16x8*qr,const f32x16&c0,const f32x16&c1,int r32,int hi){
  const char*kb=Kslot+hi*1024+r32*16;
  #pragma unroll
  for(int d0=0;d0<4;++d0){
    const bf16x8 b0=*reinterpret_cast<const bf16x8*>(kb+d0*2048);
    const bf16x8 b1=*reinterpret_cast<const bf16x8*>(kb+d0*2048+512);
    if(d0==0){p0=__builtin_amdgcn_mfma_f32_32x32x16_bf16(b0,qr[0],c0,0,0,0);p1=__builtin_amdgcn_mfma_f32_32x32x16_bf16(b1,qr[0],c1,0,0,0);}
    else{p0=__builtin_amdgcn_mfma_f32_32x32x16_bf16(b0,qr[d0],p0,0,0,0);p1=__builtin_amdgcn_mfma_f32_32x32x16_bf16(b1,qr[d0],p1,0,0,0);}}
}
typedef __attribute__((address_space(3))) const char* lds_cptr;
typedef short v4i16_t __attribute__((ext_vector_type(4)));
__device__ __forceinline__ void kload8(bf16x8*kf,lds_cptr kp){
  kf[0]=*(const __attribute__((address_space(3))) bf16x8*)(kp);      kf[1]=*(const __attribute__((address_space(3))) bf16x8*)(kp+512);
  kf[2]=*(const __attribute__((address_space(3))) bf16x8*)(kp+2048); kf[3]=*(const __attribute__((address_space(3))) bf16x8*)(kp+2560);
  kf[4]=*(const __attribute__((address_space(3))) bf16x8*)(kp+4096); kf[5]=*(const __attribute__((address_space(3))) bf16x8*)(kp+4608);
  kf[6]=*(const __attribute__((address_space(3))) bf16x8*)(kp+6144); kf[7]=*(const __attribute__((address_space(3))) bf16x8*)(kp+6656);
}
__device__ __forceinline__ void kload2(bf16x8*kf,lds_cptr kp,int j){ kf[2*j]=*(const __attribute__((address_space(3))) bf16x8*)(kp+j*2048); kf[2*j+1]=*(const __attribute__((address_space(3))) bf16x8*)(kp+j*2048+512); }
__device__ __forceinline__ s16x4 vtr(lds_cptr p){ return __builtin_bit_cast(s16x4,__builtin_amdgcn_ds_read_tr16_b64_v4i16((__attribute__((address_space(3))) v4i16_t*)p)); }
__device__ __forceinline__ float rowmax(const f32x16&p0,const f32x16&p1){
  float a=max3f(p0[0],p0[1],p1[0]),b=max3f(p0[2],p0[3],p1[1]);a=max3f(a,p1[2],p1[3]);
  #pragma unroll
  for(int r=4;r<16;r+=4){a=max3f(a,p0[r],p0[r+1]);b=max3f(b,p0[r+2],p0[r+3]);a=max3f(a,p1[r],p1[r+1]);b=max3f(b,p1[r+2],p1[r+3]);}
  const float m=max2f(a,b);
  auto rr=__builtin_amdgcn_permlane32_swap(__float_as_uint(m),__float_as_uint(m),false,false);
  return max2f(__uint_as_float(rr[0]),__uint_as_float(rr[1]));
}
__device__ __forceinline__ void pv(f32x16*o,int vb,bf16x8 pa0,bf16x8 pa1,bf16x8 pa2,bf16x8 pa3){
  #pragma unroll
  for(int d0=0;d0<4;++d0){s16x4 lo[4],hi[4];
    #pragma unroll
    for(int ks=0;ks<4;++ks){
      asm volatile("ds_read_b64_tr_b16 %0,%1 offset:%c2":"=&v"(lo[ks]):"v"(vb),"i"(d0*4096+ks*1024):"memory");
      asm volatile("ds_read_b64_tr_b16 %0,%1 offset:%c2":"=&v"(hi[ks]):"v"(vb),"i"(d0*4096+ks*1024+512):"memory");}
    asm volatile("s_waitcnt lgkmcnt(0)":::"memory");SBAR();
    #define PK(k) (bf16x8){lo[k][0],lo[k][1],lo[k][2],lo[k][3],hi[k][0],hi[k][1],hi[k][2],hi[k][3]}
    o[d0]=__builtin_amdgcn_mfma_f32_32x32x16_bf16(pa0,PK(0),o[d0],0,0,0);
    o[d0]=__builtin_amdgcn_mfma_f32_32x32x16_bf16(pa1,PK(1),o[d0],0,0,0);
    o[d0]=__builtin_amdgcn_mfma_f32_32x32x16_bf16(pa2,PK(2),o[d0],0,0,0);
    o[d0]=__builtin_amdgcn_mfma_f32_32x32x16_bf16(pa3,PK(3),o[d0],0,0,0);
    #undef PK
  }
}

#ifndef ATTN_STORE16
#define ATTN_STORE16(p,v) (*(u32x4*)(p)=(v))
#endif
template<int THRL> __device__ __forceinline__ void attn_unit(int b,int hq,int hv,int ocol,int qb,int nfar,float sl2,const bf16*Q,const bf16*__restrict__ K,const bf16*__restrict__ V,bf16*O,char*shm){
  int tid_=threadIdx.x; asm volatile("":"+v"(tid_));
  const int tid=tid_,lane=tid&63,r32=lane&31,hi=lane>>5; const int wid=__builtin_amdgcn_readfirstlane(tid>>6);
  const long rowbase=(long)b*SEQ; const int q0=qb*QB;
  const bf16*Qw=Q+(rowbase+q0+wid*QBLK)*DM+hq*D;
  const int NTf=(q0+QB)/KVBLK, NT=(NTf<4+nfar)?NTf:4+nfar, t0=NTf-NT, q0c=q0-64*t0;
  const bf16*Kh=K+(rowbase+64*t0)*DM+hq*D,*Vh=V+(rowbase+64*t0)*DM+hv*D;
  const unsigned lds0=(unsigned)(uintptr_t)shm;
  float*wsf=(float*)(shm+LDS_WS)+wid*64;
  const unsigned kvoff=(unsigned)(lane*DM+wid*8)*2u;
  const unsigned vvoff=(unsigned)((16*(wid&3)+(lane>>2))*DM+(wid>>2)*32+(lane&3)*8)*2u;
  const unsigned kdst=lds0+LDS_K+wid*1024, vdst=lds0+LDS_V+wid*1024;
  #define DMA_K(t,slot) glds16s(Kh+(long)(t)*KVBLK*DM,kvoff,(unsigned)__builtin_amdgcn_readfirstlane(kdst+(slot)))
  #define DMA_V(t,slot) do{ glds16s(Vh+(long)(t)*KVBLK*DM,vvoff,(unsigned)__builtin_amdgcn_readfirstlane(vdst+2*(slot))); glds16s(Vh+(long)(t)*KVBLK*DM+64,vvoff,(unsigned)__builtin_amdgcn_readfirstlane(vdst+2*(slot)+8192)); }while(0)
  const int vb0=(int)(lds0+LDS_V)+((lane>>4)&1)*32+(lane&3)*8+(4*hi+((lane&15)>>2))*64;
  const char*Kbase=shm+LDS_K; bf16x8 kf[8];
  const lds_cptr shm3=(lds_cptr)shm; const lds_cptr kp0=shm3+LDS_K+hi*1024+r32*16; const lds_cptr vp0=shm3+LDS_V+((lane>>4)&1)*32+(lane&3)*8+(4*hi+((lane&15)>>2))*64;
  DMA_K(0,0);DMA_V(0,0);DMA_K(1,SLOTB);
  bf16x8 qr[4];
  #pragma unroll
  for(int d0=0;d0<4;++d0)qr[d0]=*reinterpret_cast<const bf16x8*>(&Qw[(long)r32*DM+d0*16+hi*8]);
  float mhat=0.f,l_reg=0.f;f32x16 o[4];o[0]=f32x16{};o[1]=f32x16{};o[2]=f32x16{};o[3]=f32x16{};
  #define CINIT0(C0_,t_) do{ const float bt_=sl2*(float)(64*(t_)-q0c+4*hi)-mhat; _Pragma("unroll") for(int r=0;r<16;++r){C0_[r]=__builtin_fmaf(sl2,(float)((r&3)+8*(r>>2)),bt_);} }while(0)
  #define CINIT1(C1_,t_) do{ const float bt_=sl2*(float)(64*(t_)-q0c+4*hi)-mhat; _Pragma("unroll") for(int r=0;r<16;++r){C1_[r]=__builtin_fmaf(sl2,(float)((r&3)+8*(r>>2)+32),bt_);} }while(0)
  #define CINIT(C0_,C1_,t_) do{ CINIT0(C0_,t_); CINIT1(C1_,t_); }while(0)
  const int qrel=wid*QBLK+r32;
  #define CMASK(P0,P1,t) do{int jb_=(t)-(NT-4); if(jb_>=0)cmask(P0,P1,jb_,qrel,hi);}while(0)
  bool resc=false;
  #define START(P0,P1) do{ const float rm=rowmax(P0,P1); resc=false; \
    { const float dl=rm; mhat=fadd_s(mhat,dl); \
      _Pragma("unroll") for(int r=0;r<16;++r){P0[r]=fsub_s(P0[r],dl);P1[r]=fsub_s(P1[r],dl);} } \
    _Pragma("unroll") for(int r=0;r<16;++r)P0[r]=__builtin_amdgcn_exp2f(P0[r]); }while(0)
  #define RESC() do{ if(resc){ asm volatile("s_waitcnt lgkmcnt(0)":::"memory"); \
      _Pragma("unroll") for(int d_=0;d_<4;++d_) _Pragma("unroll") for(int r=0;r<16;++r)o[d_][r]*=wsf[crow(r,hi)]; } }while(0)
  f32x16 pA0,pA1,pB0,pB1;
  int sl_prev=0,sl_cur=0,sl_next=SLOTB;
  #define ROT() do{sl_prev=sl_cur;sl_cur=sl_next;sl_next=(sl_next==(NSLOT-1)*SLOTB)?0:sl_next+SLOTB;}while(0)
  DMA_K(2,2*SLOTB);
  WAIT_BAR(4);
  { f32x16 c0_,c1_; CINIT(c0_,c1_,0); qkt(pA0,pA1,Kbase,qr,c0_,c1_,r32,hi); } asm volatile("s_nop 15\n\ts_nop 7":"+v"(pA0),"+v"(pA1));CMASK(pA0,pA1,0);
  START(pA0,pA1);
  _Pragma("unroll") for(int r=0;r<16;++r)pA1[r]=__builtin_amdgcn_exp2f(pA1[r]);
  WAIT_BAR(0);
  DMA_K(3,0);DMA_V(1,SLOTB);
  ROT();
  kload8(kf,kp0+sl_cur);
  WAIT_BAR(3);
  s16x4 vlo[8],vhi[8]; u32x4 pw0,pw1,pw2,pw3;
  #define PKW(P,B) cvtpk_s(P[B],P[B+1])
  #define PAF(k) __builtin_bit_cast(bf16x8,pw##k)
  #define VFR(i) (bf16x8){vlo[i][0],vlo[i][1],vlo[i][2],vlo[i][3],vhi[i][0],vhi[i][1],vhi[i][2],vhi[i][3]}
  #define PIN(x) asm volatile("":"+v"(x))
  #define MX3(a,b,c) __builtin_fmaxf(__builtin_fmaxf((a),(b)),(c))
  #define GAPA(MF,A0,A1,A2,A3,W0,W1,PW) do{ MF; sacc+=A0; sacc+=A1; sacc+=A2; sacc+=A3; PIN(sacc); W0; W1; PIN(PW); SBAR(); }while(0)
  #define EX(v) __builtin_amdgcn_exp2f(v)
  #define GAPB(MF,X,B) do{ MF; X[B]=EX(X[B]); X[B+1]=EX(X[B+1]); PIN(X); SBAR(); }while(0)
  #define VRD2(sl,fr) do{ vlo[sl]=vtr(vp_+(((fr)>>2)*4096+((fr)&3)*1024)); vhi[sl]=vtr(vp_+(((fr)>>2)*4096+((fr)&3)*1024+512)); SBAR(); }while(0)
  #define VRD(i) do{ vlo[i]=vtr(vp_+(((i)>>2)*4096+((i)&3)*1024)); vhi[i]=vtr(vp_+(((i)>>2)*4096+((i)&3)*1024+512)); }while(0)
  #define KRD(G,j) do{ if(G){ kload2(kf,kp0+sl_next,j); SBAR(); } }while(0)
  #define STEP(C0,C1,P0,P1,t,GK,GV,GL) do{ CINIT0(C0,t); SBAR(); \
    const lds_cptr vp_=vp0+2*sl_prev; \
    VRD(0); SBAR(); float sacc=(P0[0]+P0[1]); \
    GAPA(C0=__builtin_amdgcn_mfma_f32_32x32x16_bf16(kf[0],qr[0],C0,0,0,0), P0[2],P0[3],P0[4],P0[5],     pw0[0]=PKW(P0,0), pw0[1]=PKW(P0,2), pw0); \
    CINIT1(C1,t); VRD(4); SBAR(); GAPA(C1=__builtin_amdgcn_mfma_f32_32x32x16_bf16(kf[1],qr[0],C1,0,0,0), P0[6],P0[7],P0[8],P0[9],     pw0[2]=PKW(P0,4), pw0[3]=PKW(P0,6), pw0); \
    VRD(1); SBAR(); GAPA(C0=__builtin_amdgcn_mfma_f32_32x32x16_bf16(kf[2],qr[1],C0,0,0,0),   P0[10],P0[11],P0[12],P0[13], pw1[0]=PKW(P0,8), pw1[1]=PKW(P0,10), pw1); \
    VRD(5); SBAR(); GAPA(C1=__builtin_amdgcn_mfma_f32_32x32x16_bf16(kf[3],qr[1],C1,0,0,0),   P0[14],P0[15],P1[0],P1[1],   pw1[2]=PKW(P0,12),pw1[3]=PKW(P0,14), pw1); \
    VRD(2); SBAR(); GAPA(C0=__builtin_amdgcn_mfma_f32_32x32x16_bf16(kf[4],qr[2],C0,0,0,0),   P1[2],P1[3],P1[4],P1[5],     pw2[0]=PKW(P1,0), pw2[1]=PKW(P1,2), pw2); \
    VRD(6); SBAR(); GAPA(C1=__builtin_amdgcn_mfma_f32_32x32x16_bf16(kf[5],qr[2],C1,0,0,0),   P1[6],P1[7],P1[8],P1[9],     pw2[2]=PKW(P1,4), pw2[3]=PKW(P1,6), pw2); \
    VRD(3); SBAR(); GAPA(C0=__builtin_amdgcn_mfma_f32_32x32x16_bf16(kf[6],qr[3],C0,0,0,0),   P1[10],P1[11],P1[12],P1[13], pw3[0]=PKW(P1,8), pw3[1]=PKW(P1,10), pw3); \
    VRD(7); SBAR(); GAPA(C1=__builtin_amdgcn_mfma_f32_32x32x16_bf16(kf[7],qr[3],C1,0,0,0),   P1[14],P1[15],0.f,0.f,       pw3[2]=PKW(P1,12),pw3[3]=PKW(P1,14), pw3); \
    l_reg+=sacc; \
    if(GK){DMA_K((t)+3,sl_cur);} if(GV){DMA_V((t)+1,sl_next);} \
    CMASK(C0,C1,t); \
    { float a=MX3(C0[0],C0[1],C1[0]),b=MX3(C0[2],C0[3],C1[1]); a=MX3(a,C1[2],C1[3]); \
      _Pragma("unroll") for(int r=4;r<16;r+=4){a=MX3(a,C0[r],C0[r+1]);b=MX3(b,C0[r+2],C0[r+3]);a=MX3(a,C1[r],C1[r+1]);b=MX3(b,C1[r+2],C1[r+3]);} \
      float rm=__builtin_fmaxf(a,b); { auto rr=__builtin_amdgcn_permlane32_swap(__float_as_uint(rm),__float_as_uint(rm),false,false); rm=__builtin_fmaxf(__uint_as_float(rr[0]),__uint_as_float(rr[1])); } \
      resc=false; \
      if(__builtin_expect(__any(rm>(float)THRL),0)){ const float dl=__builtin_fmaxf(rm,0.f); mhat+=dl; \
        _Pragma("unroll") for(int r=0;r<16;++r){C0[r]-=dl;C1[r]-=dl;} \
        const float f=__builtin_amdgcn_exp2f(-dl); l_reg*=f; if(hi==0)wsf[r32]=f; resc=true; } } \
    SBAR(); \
    GAPB(o[0]=__builtin_amdgcn_mfma_f32_32x32x16_bf16(PAF(0),VFR(0),o[0],0,0,0), C0,0);  VRD2(0,8); \
    GAPB(o[1]=__builtin_amdgcn_mfma_f32_32x32x16_bf16(PAF(0),VFR(4),o[1],0,0,0), C0,2);  VRD2(4,12); \
    KRD(GL,0); GAPB(o[0]=__builtin_amdgcn_mfma_f32_32x32x16_bf16(PAF(1),VFR(1),o[0],0,0,0), C0,4);  VRD2(1,9); \
    KRD(GL,1); GAPB(o[1]=__builtin_amdgcn_mfma_f32_32x32x16_bf16(PAF(1),VFR(5),o[1],0,0,0), C0,6);  VRD2(5,13); \
    KRD(GL,2); GAPB(o[0]=__builtin_amdgcn_mfma_f32_32x32x16_bf16(PAF(2),VFR(2),o[0],0,0,0), C0,8);  VRD2(2,10); \
    KRD(GL,3); GAPB(o[1]=__builtin_amdgcn_mfma_f32_32x32x16_bf16(PAF(2),VFR(6),o[1],0,0,0), C0,10); VRD2(6,14); \
    GAPB(o[0]=__builtin_amdgcn_mfma_f32_32x32x16_bf16(PAF(3),VFR(3),o[0],0,0,0), C0,12); VRD2(3,11); \
    GAPB(o[1]=__builtin_amdgcn_mfma_f32_32x32x16_bf16(PAF(3),VFR(7),o[1],0,0,0), C0,14); VRD2(7,15); \
    GAPB(o[2]=__builtin_amdgcn_mfma_f32_32x32x16_bf16(PAF(0),VFR(0),o[2],0,0,0), C1,0); \
    GAPB(o[3]=__builtin_amdgcn_mfma_f32_32x32x16_bf16(PAF(0),VFR(4),o[3],0,0,0), C1,2); \
    GAPB(o[2]=__builtin_amdgcn_mfma_f32_32x32x16_bf16(PAF(1),VFR(1),o[2],0,0,0), C1,4); \
    GAPB(o[3]=__builtin_amdgcn_mfma_f32_32x32x16_bf16(PAF(1),VFR(5),o[3],0,0,0), C1,6); \
    GAPB(o[2]=__builtin_amdgcn_mfma_f32_32x32x16_bf16(PAF(2),VFR(2),o[2],0,0,0), C1,8); \
    GAPB(o[3]=__builtin_amdgcn_mfma_f32_32x32x16_bf16(PAF(2),VFR(6),o[3],0,0,0), C1,10); \
    GAPB(o[2]=__builtin_amdgcn_mfma_f32_32x32x16_bf16(PAF(3),VFR(3),o[2],0,0,0), C1,12); \
    GAPB(o[3]=__builtin_amdgcn_mfma_f32_32x32x16_bf16(PAF(3),VFR(7),o[3],0,0,0), C1,14); \
    }while(0)
  int t=1;
  #undef CMASK
  #define CMASK(P0,P1,t) do{}while(0)
  for(;t+5<NT;t+=2){
    STEP(pB0,pB1,pA0,pA1,t,true,true,true);     WAIT_BAR(3); RESC(); ROT();
    STEP(pA0,pA1,pB0,pB1,t+1,true,true,true);   WAIT_BAR(3); RESC(); ROT();
  }
  #undef CMASK
  #define CMASK(P0,P1,t) do{int jb_=(t)-(NT-4); if(jb_>=0)cmask(P0,P1,jb_,qrel,hi);}while(0)
  #define ENDW(tt) do{ if((tt)+3<NT){WAIT_BAR(3);} else if((tt)+2<NT){WAIT_BAR(2);} else {WAIT_BAR(0);} }while(0)
  for(;t+1<NT;t+=2){
    STEP(pB0,pB1,pA0,pA1,t,(t+3<NT),(t+1<NT),(t+1<NT));       ENDW(t);   RESC(); ROT();
    STEP(pA0,pA1,pB0,pB1,t+1,(t+4<NT),(t+2<NT),(t+2<NT));     ENDW(t+1); RESC(); ROT();
  }
  STEP(pB0,pB1,pA0,pA1,NT-1,false,false,false); RESC();
  { float sacc=pB0[0]+pB0[1]; _Pragma("unroll") for(int r=2;r<16;++r)sacc+=pB0[r]; _Pragma("unroll") for(int r=0;r<16;++r)sacc+=pB1[r]; l_reg+=sacc;
    pw0=(u32x4){PKW(pB0,0),PKW(pB0,2),PKW(pB0,4),PKW(pB0,6)};pw1=(u32x4){PKW(pB0,8),PKW(pB0,10),PKW(pB0,12),PKW(pB0,14)};pw2=(u32x4){PKW(pB1,0),PKW(pB1,2),PKW(pB1,4),PKW(pB1,6)};pw3=(u32x4){PKW(pB1,8),PKW(pB1,10),PKW(pB1,12),PKW(pB1,14)};
    SBAR(); pv(o,vb0+2*sl_cur,PAF(0),PAF(1),PAF(2),PAF(3)); }
  #undef PKW
  #undef PAF
  #undef VFR
  #undef PIN
  #undef MX3
  #undef GAPA
  #undef GAPB
  #undef EX
  #undef VRD
  #undef VRD2
  #undef KRD
  #undef STEP
  #undef ENDW
  {auto rr=__builtin_amdgcn_permlane32_swap(__float_as_uint(l_reg),__float_as_uint(l_reg),false,false);l_reg=__uint_as_float(rr[0])+__uint_as_float(rr[1]);}
  if(hi==0)wsf[32+r32]=l_reg;asm volatile("s_waitcnt lgkmcnt(0)":::"memory");
  float rli[16];
  #pragma unroll
  for(int r=0;r<16;++r)rli[r]=__builtin_amdgcn_rcpf(wsf[32+crow(r,hi)]);
  bf16*Ow=O+(rowbase+q0+wid*QBLK)*OPITCH+ocol;
  { bf16*stg=(bf16*)(shm+LDS_OST)+wid*2048;
    int ln2_=lane; asm volatile("":"+v"(ln2_));
    #pragma unroll
    for(int hf=0;hf<2;++hf){
      #pragma unroll
      for(int r=0;r<16;++r){const int orow=crow(r,hi);
        #pragma unroll
        for(int d0=0;d0<2;++d0)stg[orow*64+d0*32+r32]=__float2bfloat16(o[2*hf+d0][r]*rli[r]);}
      asm volatile("s_waitcnt lgkmcnt(0)":::"memory");
      #pragma unroll
      for(int i=0;i<4;++i){const int row=i*8+(ln2_>>3),ch=ln2_&7; const u32x4 v=*(const u32x4*)(stg+row*64+ch*8); ATTN_STORE16(Ow+(long)row*OPITCH+hf*64+ch*8,v);}
      asm volatile("s_waitcnt lgkmcnt(0)":::"memory"); } }
  asm volatile("s_waitcnt lgkmcnt(0)\n\ts_barrier":::"memory");
  #undef DMA_K
  #undef DMA_V
  #undef CMASK
  #undef CINIT
  #undef CINIT0
  #undef CINIT1
  #undef START
  #undef RESC
  #undef ROT
}
constexpr int ATTN_LDS_BYTES=LDS_BYTES;
struct AttnTensors { const bf16* Q; const bf16* K; const bf16* V; bf16* O; };
template<int THRL=8> __device__ __forceinline__ void attn_phase(char*lds,const AttnTensors&T,unsigned*qw,volatile __attribute__((address_space(3))) unsigned*qs){
  for(;;){
    if(threadIdx.x==0) qs[0]=__hip_atomic_fetch_add(qw,2u,__ATOMIC_RELAXED,__HIP_MEMORY_SCOPE_AGENT);
    __syncthreads();
    const int idx0=__builtin_amdgcn_readfirstlane((int)qs[0]);
    __syncthreads();
    if(idx0>=2048)break;
    for(int idx=idx0;idx<idx0+2;++idx){
      const int c=idx&1,b=(idx>>1)&7,h=7-((idx>>4)&7),qb=15-(idx>>7);
      const float sl2=__uint_as_float(__builtin_amdgcn_readfirstlane(__float_as_uint(__builtin_amdgcn_exp2f(-(float)(h+1))*1.4426950408889634f)));
      const int nfar=(h==0)?6:(h==1)?10:(h==2)?20:(h==3)?38:64;
      attn_unit<THRL>(b,2*h+c,2*h,c*1024+h*128,qb,nfar,sl2,T.Q,T.K,T.V,T.O,lds);
    }
  }
}
#undef SBAR
#undef WAIT_BAR
}
#define GAS __attribute__((address_space(1)))
#define LAS __attribute__((address_space(3)))
typedef unsigned short bf16;
typedef unsigned v4u __attribute__((ext_vector_type(4)));
typedef float f32x4 __attribute__((ext_vector_type(4)));
typedef short bf16x8 __attribute__((ext_vector_type(8)));
typedef GAS unsigned gu32;
typedef GAS unsigned long long gu64;
#define RLX_AGENT __ATOMIC_RELAXED, __HIP_MEMORY_SCOPE_AGENT
#define LDS_WAIT() asm volatile("s_waitcnt lgkmcnt(0)" ::: "memory")
#define VM_WAIT() asm volatile("s_waitcnt vmcnt(0)" ::: "memory")
__device__ __forceinline__ unsigned long long rt() { return __builtin_amdgcn_s_memrealtime(); }
__device__ __forceinline__ unsigned f2bf(float f) { unsigned u = __builtin_bit_cast(unsigned, f); return (u + 0x7fffu + ((u >> 16) & 1u)) >> 16; }
__device__ __forceinline__ unsigned pk2(float lo, float hi) { return f2bf(lo) | (f2bf(hi) << 16); }

#define XB_TMO      128
#define XB_XCNT(j)  (256  + 64 * (j))
#define XB_XSUB(j)  (1280 + 64 * (j))
#define XB_XGEN(j)  (2304 + 64 * (j))
#define XB_TOP      3328
#define XB_TOPGEN   3392
#define XCD_BAR_WORDS 3456
#define XB_SPIN_CAP (1u << 18)

__device__ __forceinline__ unsigned xb_ld(unsigned* p)              { return __hip_atomic_load(p, __ATOMIC_RELAXED, __HIP_MEMORY_SCOPE_AGENT); }
__device__ __forceinline__ unsigned xb_add(unsigned* p, unsigned v) { return __hip_atomic_fetch_add(p, v, __ATOMIC_RELAXED, __HIP_MEMORY_SCOPE_AGENT); }
__device__ __forceinline__ unsigned xb_xcc_id() { return (unsigned)__builtin_amdgcn_s_getreg((3 << 11) | 20) & 0xFu; }
#define XB_SPIN(cond, bar) do { unsigned _sp = 0; while (cond) { __builtin_amdgcn_s_sleep(1); \
    if ((++_sp & 255u) == 0u) { if (xb_ld(&(bar)[XB_TMO])) break; if (_sp > XB_SPIN_CAP) { atomicAdd(&(bar)[XB_TMO], 1u); break; } } } } while (0)

struct XcdBarrier {
    unsigned* bar; unsigned x;
    volatile LAS unsigned* st;
};

__device__ __forceinline__ XcdBarrier xcd_barrier_post(unsigned* bar, volatile LAS unsigned* st) {
    XcdBarrier b; b.bar = bar; b.x = xb_xcc_id(); b.st = st;
    if (threadIdx.x == 0) (void)xb_add(&bar[XB_XCNT(b.x)], 1u);
    return b;
}
__device__ __forceinline__ void xcd_barrier_complete(unsigned* bar, unsigned x, unsigned& nloc, unsigned& nx) {
    const unsigned G = gridDim.x * gridDim.y * gridDim.z;
    unsigned sum, cnt, mine, sp = 0u;
    for (;;) {
        sum = 0u; cnt = 0u; mine = 0u;
#pragma unroll
        for (unsigned j = 0; j < 16; ++j) { const unsigned c = xb_ld(&bar[XB_XCNT(j)]); sum += c; cnt += (c > 0u) ? 1u : 0u; mine = (j == x) ? c : mine; }
        if (sum == G) break;
        __builtin_amdgcn_s_sleep(1);
        if ((++sp & 255u) == 0u) { if (xb_ld(&bar[XB_TMO])) break; if (sp > XB_SPIN_CAP) { atomicAdd(&bar[XB_TMO], 1u); break; } }
    }
    nloc = mine > 0u ? mine : 1u; nx = cnt > 0u ? cnt : 1u;
}

__device__ __forceinline__ void xcd_barrier(const XcdBarrier& b) {
    asm volatile("s_waitcnt vmcnt(0)" ::: "memory");
    __syncthreads();
    if (threadIdx.x == 0) {
        unsigned* bar = b.bar;
        __builtin_amdgcn_s_waitcnt(0);
        unsigned nloc = b.st[0], nx = b.st[1];
        if (nloc == 0u) { xcd_barrier_complete(bar, b.x, nloc, nx); b.st[0] = nloc; b.st[1] = nx; }
        const unsigned old = xb_add(&bar[XB_XSUB(b.x)], 1u);
        const unsigned gen = old / nloc;
        if (old + 1u == (gen + 1u) * nloc) {
            __builtin_amdgcn_fence(__ATOMIC_RELEASE, "agent");
            asm volatile("s_waitcnt vmcnt(0)" ::: "memory");
            const unsigned og = xb_add(&bar[XB_TOP], 1u);
            const unsigned tg = og / nx;
            if (og + 1u == (tg + 1u) * nx) xb_add(&bar[XB_TOPGEN], 1u);
            else XB_SPIN(xb_ld(&bar[XB_TOPGEN]) == tg, bar);
            __builtin_amdgcn_fence(__ATOMIC_ACQUIRE, "agent");
            xb_add(&bar[XB_XGEN(b.x)], 1u);
            asm volatile("s_waitcnt vmcnt(0)" ::: "memory");
        } else {
            XB_SPIN(xb_ld(&bar[XB_XGEN(b.x)]) == gen, bar);
            __builtin_amdgcn_fence(__ATOMIC_ACQUIRE, "agent");
            asm volatile("s_waitcnt vmcnt(0)" ::: "memory");
        }
    }
    __syncthreads();
}
constexpr int NWAVES = 8, NTHREADS = 512;
constexpr int BATCH = 8, SEQ = 4096, DM = 1024, NTOK = BATCH * SEQ, DEPTH = 4;
constexpr int DIN = 8208, NPROJ = 8192;
constexpr int NEXP = 32, DEXP = 512, LISTCAP = 32768, MOE_MAXT = 288;
constexpr float LN_EPS = 1e-5f, DN_ALPHA = 1.6817928305074292f;
constexpr size_t MiB = 1u << 20;
constexpr size_t WS_CTL = 0, CTL_ZERO_BYTES = 1 * MiB;
constexpr size_t WS_ADA = 1 * MiB;
constexpr size_t WS_ABWT = 2 * MiB;
constexpr size_t WS_RWT = 2 * MiB + 256 * 1024;
constexpr size_t WS_TOKINFO = 3 * MiB;
constexpr size_t WS_LIST = 4 * MiB;
constexpr size_t WS_SSQ = 8 * MiB;
constexpr size_t WS_PRM = 16 * MiB;
constexpr int PO_BGATES = 0, PO_WALPHA = 8192, PO_BALPHA = 40960, PO_LQ1 = 43008, PO_LK1 = 43264, PO_LQ2 = 43520, PO_LK2 = 43776, PO_DIFFG = 44032, PO_GLAG = 44544,
              PO_LN1G = 45568, PO_LN1B = 49664, PO_BRG = 53760, PO_BRE = 53776, PO_LN2G = 53904, PO_LN2B = 58000, PO_END = 62096;
constexpr size_t WS_GDEC = 18 * MiB;
constexpr size_t WS_WIN = 32 * MiB;
constexpr size_t WS_WBA = 96 * MiB, WS_WBB = 104 * MiB, WS_WOUT = 112 * MiB;
constexpr size_t WS_W1 = 120 * MiB;
constexpr size_t WS_WD = 376 * MiB;
constexpr size_t WS_U = 504 * MiB;
constexpr size_t WS_QB = 568 * MiB, WS_KB = 632 * MiB, WS_VB = 696 * MiB;
constexpr size_t WS_GQ = 760 * MiB, WS_GK = 792 * MiB;
constexpr size_t WS_GV = 824 * MiB, WS_SG = 888 * MiB;
constexpr size_t WS_GT = 952 * MiB;
constexpr size_t WS_LA = 1080 * MiB;
constexpr size_t WS_END = 1144 * MiB;
constexpr size_t WS_OB = WS_U;
constexpr size_t WS_OP = WS_GQ;
constexpr size_t WS_OA2 = WS_QB, WS_OB2 = WS_KB;
constexpr size_t WS_TMP = WS_VB, WS_MIX = WS_GQ;
constexpr size_t WS_H = WS_QB;
constexpr size_t WS_YB = WS_QB + 72 * MiB;
constexpr int CW_ATQ = 32768;
constexpr int CW_TMO = 0, CW_CODE = 1, CW_BAR = 4096, CW_CNT = 8192;
constexpr int RING_OFF = 0, RING_BYTES = 147456;
constexpr int LDSCTL_OFF = RING_BYTES, MISC_OFF = LDSCTL_OFF + 320;
constexpr int TAB_CNT = RING_BYTES + 512, TAB_BASE = RING_BYTES + 640, TAB_IDX = RING_BYTES + 1024, IDX_UNITS = 8;
constexpr int LDS_BYTES = 163840;
static_assert(TAB_IDX + IDX_UNITS * 256 * 4 <= LDS_BYTES, "LDS map");
struct Frame {
    LAS unsigned char* lds;
    gu32* ctl;
    int tid, lane, wave, vcu, G;
    float* out; unsigned char* ws; const float* prm;
    float* xst; bf16* Ubuf; float* LAbuf; int dry;
};
enum { I_X = 0, I_C, I_WADA, I_BADA, I_WIN, I_BGATES, I_WALPHA, I_BALPHA, I_LQ1, I_LK1, I_LQ2, I_LK2, I_DIFFG, I_GLAG, I_WBA, I_WBB, I_WOUT, I_LN1G, I_LN1B,
       I_WRG, I_BRG, I_WRE, I_BRE, I_WGE, I_WUE, I_WDE, I_LN2G, I_LN2B };
__device__ __forceinline__ float dpp_add(float v, const int ctrl_sel) {
    const int x = __float_as_int(v); int y;
    if (ctrl_sel == 0) y = __builtin_amdgcn_update_dpp(x, x, 0xB1, 0xF, 0xF, false);
    else if (ctrl_sel == 1) y = __builtin_amdgcn_update_dpp(x, x, 0x4E, 0xF, 0xF, false);
    else if (ctrl_sel == 2) y = __builtin_amdgcn_update_dpp(x, x, 0x141, 0xF, 0xF, false);
    else y = __builtin_amdgcn_update_dpp(x, x, 0x140, 0xF, 0xF, false);
    return v + __int_as_float(y);
}
__device__ __forceinline__ float wave_sum(float v) {
    v = dpp_add(v, 0); v = dpp_add(v, 1); v = dpp_add(v, 2); v = dpp_add(v, 3);
    { auto rr = __builtin_amdgcn_permlane16_swap(__float_as_uint(v), __float_as_uint(v), false, false); v = __uint_as_float(rr[0]) + __uint_as_float(rr[1]); }
    { auto rr = __builtin_amdgcn_permlane32_swap(__float_as_uint(v), __float_as_uint(v), false, false); v = __uint_as_float(rr[0]) + __uint_as_float(rr[1]); }
    return v;
}
__device__ __forceinline__ float siluf_(float x) { return x * __builtin_amdgcn_rcpf(1.0f + __expf(-x)); }
__device__ __forceinline__ float bflo(unsigned w) { return __uint_as_float(w << 16); }
__device__ __forceinline__ float bfhi(unsigned w) { return __uint_as_float(w & 0xffff0000u); }

__device__ __forceinline__ void p0_ada(Frame& F, const float* c, const float* wada, const float* bada) {
    LAS float* COND = (LAS float*)(F.lds);
    LAS float* PART = (LAS float*)(F.lds + 32768);
    float* ADA = (float*)(F.ws + WS_ADA);
    for (int i = F.tid; i < 8192; i += NTHREADS) COND[i] = siluf_(c[i]);
    __syncthreads();
    for (int cg = (int)blockIdx.x; cg < 256; cg += F.G) {
        const int l = cg >> 6, j0 = (cg & 63) * 96;
        const int col4 = F.lane % 24, ksub = F.lane / 24;
        f32x4 acc[8];
#pragma unroll
        for (int b = 0; b < 8; ++b) acc[b] = (f32x4){0.f, 0.f, 0.f, 0.f};
        if (ksub < 2) {
            const float* wp = wada + ((size_t)l * 1024 + (size_t)(F.wave * 128 + ksub)) * 6144 + j0 + 4 * col4;
#pragma unroll 8
            for (int kk = 0; kk < 64; ++kk) {
                const f32x4 wv = *(const GAS f32x4*)(wp + (size_t)kk * 2 * 6144); const int k = F.wave * 128 + 2 * kk + ksub;
#pragma unroll
                for (int b = 0; b < 8; ++b) acc[b] += wv * COND[b * 1024 + k];
            }
#pragma unroll
            for (int b = 0; b < 8; ++b) *(LAS f32x4*)(PART + ((F.wave * 2 + ksub) * 8 + b) * 96 + 4 * col4) = acc[b];
        }
        __syncthreads();
        for (int idx = F.tid; idx < 768; idx += NTHREADS) { const int b = idx / 96, col = idx % 96; float s = 0.f;
#pragma unroll
            for (int p = 0; p < 16; ++p) s += PART[(p * 8 + b) * 96 + col];
            ADA[((size_t)l * 8 + b) * 6144 + j0 + col] = s + bada[l * 6144 + j0 + col]; }
        __syncthreads();
    }
}
struct RmIdent { __device__ __forceinline__ int operator()(int n) const { return n; } };
struct RmWin { __device__ __forceinline__ int operator()(int n) const { return n < 6144 ? n : (n < 6160 ? -1 : n - 16); } };
struct RmGateUp { int up; __device__ __forceinline__ int operator()(int n) const { return (n >> 7) * 256 + up * 128 + (n & 127); } };
template <class RowMap>
__device__ __forceinline__ void p0_transpose_item(const float* W, int K, int N, bf16* WT, const RowMap rm, LAS float* scr, int kb, int nb, int lane) {
    const int k0 = 64 * kb, n0 = 32 * nb; const int nl = n0 + (lane & 31);
#pragma unroll 8
    for (int i = 0; i < 32; ++i) { const int kk = 2 * i + (lane >> 5); scr[kk * 33 + (lane & 31)] = (nl < N) ? W[(size_t)(k0 + kk) * N + nl] : 0.f; }
    LDS_WAIT(); asm volatile("" ::: "memory");
    const int c = lane & 7;
#pragma unroll
    for (int j = 0; j < 4; ++j) { const int nn = (lane >> 3) + 8 * j, n = n0 + nn; const LAS float* s = scr + (8 * c) * 33 + nn;
        v4u o; o.x = pk2(s[0 * 33], s[1 * 33]); o.y = pk2(s[2 * 33], s[3 * 33]); o.z = pk2(s[4 * 33], s[5 * 33]); o.w = pk2(s[6 * 33], s[7 * 33]);
        const int r = (n < N) ? rm(n) : -1;
        if (r >= 0) *(GAS v4u*)(WT + (size_t)r * K + k0 + 8 * c) = o; }
    LDS_WAIT(); asm volatile("" ::: "memory");
}
struct SmallPrm { const float *bgates, *walpha, *balpha, *lq1, *lk1, *lq2, *lk2, *diffg, *glag, *ln1g, *ln1b, *brg, *bre, *ln2g, *ln2b; };
__device__ __forceinline__ void p0_copy(float* dst, const float* src, int n, int gt, int NGT) { for (int i = gt; i < n; i += NGT) dst[i] = src[i]; }
__device__ __forceinline__ void p0_weights(Frame& F, const float* win, const float* wba, const float* wbb, const float* wout, const float* wge, const float* wue, const float* wde, const float* wrg, const float* wre, const SmallPrm sp) {
    LAS float* scr = (LAS float*)(F.lds + RING_OFF + F.wave * 16384);
    const int gw = F.vcu * NWAVES + F.wave, NGW = F.G * NWAVES;
    constexpr int I_IN = 4 * 16 * 257, I_SQ = 12 * 16 * 32, I_E = 128 * 16 * 16, I_D = 128 * 8 * 32;
    constexpr int NITEMS = I_IN + I_SQ + 2 * I_E + I_D;
    for (int it = gw; it < NITEMS; it += NGW) {
        int r = it;
        if (r < I_IN) { const int l = r / 4112, q = r % 4112;
            p0_transpose_item(win + (size_t)l * 1024 * DIN, 1024, DIN, (bf16*)(F.ws + WS_WIN) + (size_t)l * NPROJ * 1024, RmWin{}, scr, q / 257, q % 257, F.lane); continue; }
        r -= I_IN;
        if (r < I_SQ) { const int mat = r / 512, q = r % 512, which = mat >> 2, l = mat & 3;
            const float* W = (which == 0 ? wba : (which == 1 ? wbb : wout)) + (size_t)l * 1024 * 1024;
            bf16* WT = (bf16*)(F.ws + (which == 0 ? WS_WBA : (which == 1 ? WS_WBB : WS_WOUT))) + (size_t)l * 1024 * 1024;
            p0_transpose_item(W, 1024, 1024, WT, RmIdent{}, scr, q / 32, q % 32, F.lane); continue; }
        r -= I_SQ;
        if (r < 2 * I_E) { const int up = r >= I_E ? 1 : 0; if (up) r -= I_E; const int me = r / 256, q = r % 256;
            p0_transpose_item((up ? wue : wge) + (size_t)me * 1024 * 512, 1024, 512, (bf16*)(F.ws + WS_W1) + (size_t)me * 1024 * 1024, RmGateUp{up}, scr, q / 16, q % 16, F.lane); continue; }
        r -= 2 * I_E;
        { const int me = r / 256, q = r % 256;
          p0_transpose_item(wde + (size_t)me * 512 * 1024, 512, 1024, (bf16*)(F.ws + WS_WD) + (size_t)me * 1024 * 512, RmIdent{}, scr, q / 32, q % 32, F.lane); }
    }
    const int gt = F.vcu * NTHREADS + F.tid, NGT = F.G * NTHREADS;
    float* ABWT = (float*)(F.ws + WS_ABWT); float* RWT = (float*)(F.ws + WS_RWT);
    { float* P = (float*)(F.ws + WS_PRM);
      p0_copy(P + PO_BGATES, sp.bgates, 8192, gt, NGT); p0_copy(P + PO_WALPHA, sp.walpha, 32768, gt, NGT); p0_copy(P + PO_BALPHA, sp.balpha, 2048, gt, NGT);
      p0_copy(P + PO_LQ1, sp.lq1, 256, gt, NGT); p0_copy(P + PO_LK1, sp.lk1, 256, gt, NGT); p0_copy(P + PO_LQ2, sp.lq2, 256, gt, NGT); p0_copy(P + PO_LK2, sp.lk2, 256, gt, NGT);
      p0_copy(P + PO_DIFFG, sp.diffg, 512, gt, NGT); p0_copy(P + PO_GLAG, sp.glag, 1024, gt, NGT); p0_copy(P + PO_LN1G, sp.ln1g, 4096, gt, NGT); p0_copy(P + PO_LN1B, sp.ln1b, 4096, gt, NGT);
      p0_copy(P + PO_BRG, sp.brg, 16, gt, NGT); p0_copy(P + PO_BRE, sp.bre, 128, gt, NGT); p0_copy(P + PO_LN2G, sp.ln2g, 4096, gt, NGT); p0_copy(P + PO_LN2B, sp.ln2b, 4096, gt, NGT); }
    for (int i = gt; i < 4 * 16 * 1024; i += NGT) { const int l = i >> 14, r = (i >> 10) & 15, k = i & 1023; ABWT[i] = win[((size_t)l * 1024 + k) * DIN + 6144 + r]; }
    for (int i = gt; i < 4 * 36 * 1024; i += NGT) { const int l = i / 36864, c = (i / 1024) % 36, k = i & 1023;
        RWT[i] = (c < 4) ? wrg[((size_t)l * 1024 + k) * 4 + c] : wre[((size_t)l * 1024 + k) * 32 + (c - 4)]; }
}

typedef f32x4 Row4[4];
__device__ __forceinline__ void row_load(Row4& v, const float* p, int lane) { const GAS f32x4* q = (const GAS f32x4*)p + lane;
#pragma unroll
    for (int j = 0; j < 4; ++j) v[j] = q[64 * j]; }
__device__ __forceinline__ void row_store(const Row4& v, float* p, int lane) { GAS f32x4* q = (GAS f32x4*)p + lane;
#pragma unroll
    for (int j = 0; j < 4; ++j) q[64 * j] = v[j]; }
__device__ __forceinline__ void row_standardize(Row4& v) {
    float s = 0.f;
#pragma unroll
    for (int j = 0; j < 4; ++j) s += (v[j].x + v[j].y) + (v[j].z + v[j].w);
    const float mean = wave_sum(s) * (1.f / DM); float s2 = 0.f;
#pragma unroll
    for (int j = 0; j < 4; ++j) { v[j] = v[j] - mean; s2 += (v[j].x * v[j].x + v[j].y * v[j].y) + (v[j].z * v[j].z + v[j].w * v[j].w); }
    const float rstd = 1.f / sqrtf(wave_sum(s2) * (1.f / DM) + LN_EPS);
#pragma unroll
    for (int j = 0; j < 4; ++j) v[j] = v[j] * rstd;
}
__device__ __forceinline__ void row_affine(Row4& v, const float* g, const float* b, bool one_plus, int lane) {
    asm volatile("" : "+s"(g), "+s"(b));
#pragma unroll
    for (int j = 0; j < 4; ++j) { f32x4 gv = *((const GAS f32x4*)g + lane + 64 * j); const f32x4 bv = *((const GAS f32x4*)b + lane + 64 * j); if (one_plus) gv = gv + 1.0f; v[j] = v[j] * gv + bv; }
}
__device__ __forceinline__ void row_store_bf16(const Row4& v, bf16* p, int lane) { GAS unsigned long long* o8 = (GAS unsigned long long*)p + lane;
#pragma unroll
    for (int j = 0; j < 4; ++j) o8[64 * j] = (unsigned long long)pk2(v[j].x, v[j].y) | ((unsigned long long)pk2(v[j].z, v[j].w) << 32); }
__device__ __forceinline__ int idx16(int L) { return ((L >> 5) & 1) + 2 * ((L >> 4) & 1) + 4 * ((L >> 3) & 1) + 8 * ((L >> 2) & 1) + 16 * ((L >> 1) & 1) + 32 * (L & 1); }
__device__ __forceinline__ int idx4(int L) { return ((L >> 5) & 1) + 2 * ((L >> 4) & 1) + 4 * ((L >> 3) & 1) + 8 * ((L >> 2) & 1); }
template <int NC>
__device__ __forceinline__ float rows4_proj(const Row4 (&u)[4], const float* wT, int lane) {
    float p[4 * NC]; f32x4 wa[4], wb[4];
    asm volatile("" : "+s"(wT));
    const GAS f32x4* wp = (const GAS f32x4*)wT + lane;
#define R4_LDW(DD_, CC_) do { _Pragma("unroll") for (int j = 0; j < 4; ++j) DD_[j] = wp[(CC_) * 256 + 64 * j]; } while (0)
#define R4_DOT(WW_, CC_) do { _Pragma("unroll") for (int r = 0; r < 4; ++r) { pg8::f32x2 s_ = (pg8::f32x2){0.f, 0.f}; _Pragma("unroll") for (int j = 0; j < 4; ++j) { \
        s_ = __builtin_elementwise_fma((pg8::f32x2){u[r][j].x, u[r][j].y}, (pg8::f32x2){WW_[j].x, WW_[j].y}, s_); s_ = __builtin_elementwise_fma((pg8::f32x2){u[r][j].z, u[r][j].w}, (pg8::f32x2){WW_[j].z, WW_[j].w}, s_); } \
        p[r * NC + (CC_)] = s_.x + s_.y; } } while (0)
    R4_LDW(wa, 0);
#pragma unroll
    for (int c = 0; c < NC; c += 2) {
        R4_LDW(wb, c + 1); __builtin_amdgcn_sched_barrier(0);
        R4_DOT(wa, c);
        if (c + 2 < NC) R4_LDW(wa, c + 2);
        __builtin_amdgcn_sched_barrier(0);
        R4_DOT(wb, c + 1);
        __builtin_amdgcn_sched_barrier(0);
    }
#undef R4_LDW
#undef R4_DOT
    int V = 4 * NC;
#pragma unroll
    for (int M = 32; M >= 1; M >>= 1) {
        if (V > 1) { const bool bit = (lane & M) != 0;
#pragma unroll
            for (int i = 0; i < 32; ++i) if (i < V / 2) { const float a = p[2 * i], b = p[2 * i + 1]; const float send = bit ? a : b; const float recv = __shfl_xor(send, M); p[i] = (bit ? b : a) + recv; }
            V >>= 1; }
        else p[0] += __shfl_xor(p[0], M);
    }
    return p[0];
}
constexpr int WAL_OFF = 16384, BAL_OFF = 16384 + 32768;
__device__ __forceinline__ void load_walpha(Frame& F, int l) {
    const float* walpha_all = F.prm + PO_WALPHA; const float* balpha_all = F.prm + PO_BALPHA;
    LAS float* WAL = (LAS float*)(F.lds + RING_OFF + WAL_OFF); LAS float* BAL = (LAS float*)(F.lds + RING_OFF + BAL_OFF);
    for (int i = F.tid; i < 8192; i += NTHREADS) WAL[i] = walpha_all[(size_t)l * 8192 + i];
    if (F.tid < 512) BAL[F.tid] = balpha_all[l * 512 + F.tid];
    __syncthreads();
}
__device__ __forceinline__ void rows4_mod1(Frame& F, Row4 (&x)[4], int m0, int l, LAS float* scr, const float* pf) {
    const int b = m0 >> 12; const float* ada = (const float*)(F.ws + WS_ADA) + ((size_t)l * 8 + b) * 6144;
#pragma unroll
    for (int r = 0; r < 4; ++r) { row_standardize(x[r]); row_affine(x[r], ada + 1024, ada, true, F.lane); row_store_bf16(x[r], F.Ubuf + (size_t)(m0 + r) * 1024, F.lane); __builtin_amdgcn_sched_barrier(0); }
    if (F.dry == 3) { if (pf) {
#pragma unroll
        for (int r = 0; r < 4; ++r) row_load(x[r], pf + (size_t)r * 1024, F.lane); } return; }
    const float abv = rows4_proj<16>(x, (const float*)(F.ws + WS_ABWT) + (size_t)l * 16 * 1024, F.lane);
    __builtin_amdgcn_sched_barrier(0);
    if (pf) {
#pragma unroll
        for (int r = 0; r < 4; ++r) row_load(x[r], pf + (size_t)r * 1024, F.lane); }
    __builtin_amdgcn_sched_barrier(0);
    scr[idx16(F.lane)] = abv;
    if (F.dry == 2) return;
    LDS_WAIT(); asm volatile("" ::: "memory");
    const LAS float* WAL = (const LAS float*)(F.lds + RING_OFF + WAL_OFF); const LAS float* BAL = (const LAS float*)(F.lds + RING_OFF + BAL_OFF); float* LA = F.LAbuf;
    asm volatile("" : "+s"(WAL), "+s"(BAL));
    float z[4][8];
#pragma unroll
    for (int i = 0; i < 8; ++i) { const float bb = BAL[F.lane + 64 * i];
#pragma unroll
        for (int r = 0; r < 4; ++r) z[r][i] = bb; }
#pragma unroll
    for (int rr = 0; rr < 16; ++rr) { float a[4];
#pragma unroll
        for (int r = 0; r < 4; ++r) a[r] = scr[r * 16 + rr];
#pragma unroll
        for (int i = 0; i < 8; ++i) { const float w_ = WAL[rr * 512 + F.lane + 64 * i];
#pragma unroll
            for (int r = 0; r < 4; ++r) z[r][i] += a[r] * w_; }
        __builtin_amdgcn_sched_barrier(0); }
#pragma unroll
    for (int r = 0; r < 4; ++r) {
#pragma unroll
        for (int i = 0; i < 8; ++i) { const float zz = z[r][i]; const float ls = fminf(zz, 0.f) - __logf(1.0f + __expf(-fabsf(zz)));
            LA[(size_t)(m0 + r) * 512 + F.lane + 64 * i] = __expf(ls * (1.0f / 16.0f)); }
        __builtin_amdgcn_sched_barrier(0); }
    LDS_WAIT(); asm volatile("" ::: "memory");
}
__device__ __forceinline__ void phase_r0(Frame& F, const float* xin) {
    LAS float* scr = (LAS float*)(F.lds + RING_OFF) + F.wave * 256;
    load_walpha(F, 0);
    const int gstep = F.G * NWAVES; int gi = F.vcu * NWAVES + F.wave; Row4 x[4];
    if (gi < NTOK / 4) {
#pragma unroll
        for (int r = 0; r < 4; ++r) row_load(x[r], xin + (size_t)(4 * gi + r) * 1024, F.lane); }
    for (; gi < NTOK / 4; gi += gstep) { const int m0 = 4 * gi;
#pragma unroll
        for (int r = 0; r < 4; ++r) row_store(x[r], F.xst + (size_t)(m0 + r) * 1024, F.lane);
        __builtin_amdgcn_sched_barrier(0);
        rows4_mod1(F, x, m0, 0, scr, (gi + gstep < NTOK / 4) ? xin + (size_t)(4 * (gi + gstep)) * 1024 : nullptr); }
}
__device__ __forceinline__ void phase_r1(Frame& F, int l) {
    LAS float* scr = (LAS float*)(F.lds + RING_OFF) + F.wave * 256;
    const float* g1 = F.prm + PO_LN1G + l * 1024; const float* b1 = F.prm + PO_LN1B + l * 1024; const float* RWT = (const float*)(F.ws + WS_RWT) + (size_t)l * 36 * 1024;
    const float* brg = F.prm + PO_BRG + l * 4; const float* bre = F.prm + PO_BRE + l * 32;
    LAS unsigned* LCNT = (LAS unsigned*)(F.lds + RING_OFF + 8192); LAS unsigned* BASEW = (LAS unsigned*)(F.lds + RING_OFF + 8320); LAS unsigned* TOKBUF = (LAS unsigned*)(F.lds + RING_OFF + 8448);
    if (F.tid < 32) LCNT[F.tid] = 0u; for (int i = F.tid; i < 256; i += NTHREADS) TOKBUF[i * 8] = 0xffffffffu;
    __syncthreads();
    int giter = 0;
    gu32* cnt = F.ctl + CW_CNT + l * 32 * 64 + (F.dry ? 16384 : 0); int* LIST = (int*)(F.ws + (F.dry ? WS_SSQ : WS_LIST)); unsigned* TI = (unsigned*)(F.ws + (F.dry ? WS_SSQ + 4 * MiB : WS_TOKINFO));
    const int gstep = F.G * NWAVES; int gi = F.vcu * NWAVES + F.wave; Row4 x[4];
    if (gi < NTOK / 4) {
#pragma unroll
        for (int r = 0; r < 4; ++r) row_load(x[r], F.out + (size_t)(4 * gi + r) * 1024, F.lane); }
    for (; gi < NTOK / 4; gi += gstep, ++giter) { const int m0 = 4 * gi, b = m0 >> 12;
        const float* ada = (const float*)(F.ws + WS_ADA) + ((size_t)l * 8 + b) * 6144;
#pragma unroll
        for (int r = 0; r < 4; ++r) { row_standardize(x[r]); row_affine(x[r], g1, b1, false, F.lane); if (F.dry < 3) row_store(x[r], F.xst + (size_t)(m0 + r) * 1024, F.lane);
            row_standardize(x[r]); row_affine(x[r], ada + 4 * 1024, ada + 3 * 1024, true, F.lane); if (F.dry < 3) row_store_bf16(x[r], F.Ubuf + (size_t)(m0 + r) * 1024, F.lane); __builtin_amdgcn_sched_barrier(0); }
        if (F.dry >= 2) { if (F.dry == 3) { float q_ = 0.f;
#pragma unroll
                for (int r = 0; r < 4; ++r) q_ += x[r][0].x; if (q_ == 123.456f) scr[0] = q_; }
            if (gi + gstep < NTOK / 4) {
#pragma unroll
                for (int r = 0; r < 4; ++r) row_load(x[r], F.out + (size_t)(4 * (gi + gstep) + r) * 1024, F.lane); }
            continue; }
        const float vg = rows4_proj<4>(x, RWT, F.lane);
        __builtin_amdgcn_sched_barrier(0);
        const float va = rows4_proj<16>(x, RWT + 4 * 1024, F.lane);
        __builtin_amdgcn_sched_barrier(0);
        const float vb = rows4_proj<16>(x, RWT + 20 * 1024, F.lane);
        __builtin_amdgcn_sched_barrier(0);
        if (gi + gstep < NTOK / 4) {
#pragma unroll
            for (int r = 0; r < 4; ++r) row_load(x[r], F.out + (size_t)(4 * (gi + gstep) + r) * 1024, F.lane); }
        __builtin_amdgcn_sched_barrier(0);
        if (F.dry == 4) { if (vg + va + vb == 123.456f) scr[0] = vg; continue; }
        { const int i4 = idx4(F.lane), i16 = idx16(F.lane); scr[(i4 >> 2) * 40 + (i4 & 3)] = vg; scr[(i16 >> 4) * 40 + 4 + (i16 & 15)] = va; scr[(i16 >> 4) * 40 + 20 + (i16 & 15)] = vb; }
        LDS_WAIT(); asm volatile("" ::: "memory");
        if (F.lane < 4) { const LAS float* s = scr + F.lane * 40; const int m = m0 + F.lane;
            float gl[4];
#pragma unroll
            for (int j = 0; j < 4; ++j) gl[j] = s[j] + brg[j];
            int gidx = 0; float gmax = gl[0];
#pragma unroll
            for (int j = 1; j < 4; ++j) if (gl[j] > gmax) { gmax = gl[j]; gidx = j; }
            float den = 0.f;
#pragma unroll
            for (int j = 0; j < 4; ++j) den += __expf(gl[j] - gmax);
            const float gw = 1.0f / den;
            float el[8];
#pragma unroll
            for (int j = 0; j < 8; ++j) el[j] = s[4 + gidx * 8 + j] + bre[gidx * 8 + j];
            int i0 = 0; float v0 = el[0];
#pragma unroll
            for (int j = 1; j < 8; ++j) if (el[j] > v0) { v0 = el[j]; i0 = j; }
            int i1 = -1; float v1 = -INFINITY;
#pragma unroll
            for (int j = 0; j < 8; ++j) if (j != i0 && el[j] > v1) { v1 = el[j]; i1 = j; }
            if (i1 < 0) i1 = (i0 + 1) & 7;
            const float ex = __expf(v1 - v0), inv = 1.0f / (1.0f + ex); const float w0 = inv * gw, w1 = ex * inv * gw;
            const int e0 = gidx * 8 + i0, e1 = gidx * 8 + i1;
            const unsigned lp0 = __hip_atomic_fetch_add(LCNT + e0, 1u, __ATOMIC_RELAXED, __HIP_MEMORY_SCOPE_WORKGROUP), lp1 = __hip_atomic_fetch_add(LCNT + e1, 1u, __ATOMIC_RELAXED, __HIP_MEMORY_SCOPE_WORKGROUP);
            const int slot = F.wave * 32 + (giter & 7) * 4 + F.lane;
            *(LAS v4u*)(TOKBUF + slot * 8) = (v4u){(unsigned)m, (unsigned)e0 | ((unsigned)e1 << 8), lp0, lp1}; TOKBUF[slot * 8 + 4] = __float_as_uint(w0); TOKBUF[slot * 8 + 5] = __float_as_uint(w1);
        }
        LDS_WAIT(); asm volatile("" ::: "memory");
    }
    __syncthreads();
    if (F.tid < 32) BASEW[F.tid] = __hip_atomic_fetch_add(cnt + F.tid * 64, LCNT[F.tid], RLX_AGENT);
    __syncthreads();
    if (F.tid < 256) { const v4u tk = *(const LAS v4u*)(TOKBUF + F.tid * 8);
        if (tk.x != 0xffffffffu) { const unsigned m = tk.x, e0 = tk.y & 255u, e1 = tk.y >> 8, p0 = BASEW[e0] + tk.z, p1 = BASEW[e1] + tk.w;
            LIST[(size_t)e0 * LISTCAP + p0] = (int)m; LIST[(size_t)e1 * LISTCAP + p1] = (int)m;
            *(GAS v4u*)(TI + (size_t)m * 8) = (v4u){e0, p0, e1, p1}; *(GAS v4u*)(TI + (size_t)m * 8 + 4) = (v4u){TOKBUF[F.tid * 8 + 4], TOKBUF[F.tid * 8 + 5], 0u, 0u}; } }
    __syncthreads();
}
__device__ __forceinline__ void moe_tables(Frame& F, int l) {
    LAS int* CNT = (LAS int*)(F.lds + TAB_CNT); LAS int* BASE = (LAS int*)(F.lds + TAB_BASE);
    if (F.tid < 32) CNT[F.tid] = (int)__hip_atomic_load(F.ctl + CW_CNT + (l * 32 + F.tid) * 64, RLX_AGENT);
    __syncthreads();
    if (F.tid == 0) { int a = 0; for (int e = 0; e < 32; ++e) { BASE[e] = a; a += (CNT[e] + 255) >> 8; } BASE[32] = a; }
    __syncthreads();
}
__device__ __forceinline__ void phase_r2(Frame& F, int l) {
    LAS float* scr = (LAS float*)(F.lds + RING_OFF) + F.wave * 256; const LAS int* BASE = (const LAS int*)(F.lds + TAB_BASE);
    if (l + 1 < DEPTH) load_walpha(F, l + 1);
    const float* g2 = F.prm + PO_LN2G + l * 1024; const float* b2 = F.prm + PO_LN2B + l * 1024; const unsigned* TI = (const unsigned*)(F.ws + WS_TOKINFO); const bf16* YB = (const bf16*)(F.ws + WS_YB);
    const int gstep = F.G * NWAVES;
    for (int gi = F.vcu * NWAVES + F.wave; gi < NTOK / 4; gi += gstep) { const int m0 = 4 * gi, b = m0 >> 12; Row4 x[4];
#pragma unroll
        for (int r = 0; r < 4; ++r) row_load(x[r], F.out + (size_t)(m0 + r) * 1024, F.lane);
        const float* gate = (const float*)(F.ws + WS_ADA) + ((size_t)l * 8 + b) * 6144 + 5 * 1024;
#pragma unroll
        for (int r = 0; r < 4; ++r) { const int m = m0 + r;
            const v4u ta = *(const GAS v4u*)(TI + (size_t)m * 8); const v4u tb = *(const GAS v4u*)(TI + (size_t)m * 8 + 4);
            const size_t r0 = (size_t)BASE[ta.x & 31] * 256 + ta.y, r1 = (size_t)BASE[ta.z & 31] * 256 + ta.w; const float w0 = __uint_as_float(tb.x), w1 = __uint_as_float(tb.y);
            const GAS unsigned long long* y0 = (const GAS unsigned long long*)(YB + r0 * 1024) + F.lane; const GAS unsigned long long* y1 = (const GAS unsigned long long*)(YB + r1 * 1024) + F.lane;
#pragma unroll
            for (int j = 0; j < 4; ++j) { const unsigned long long a = y0[64 * j], c = y1[64 * j]; const f32x4 gv = *((const GAS f32x4*)gate + F.lane + 64 * j);
                const f32x4 ya = (f32x4){bflo((unsigned)a), bfhi((unsigned)a), bflo((unsigned)(a >> 32)), bfhi((unsigned)(a >> 32))};
                const f32x4 yc = (f32x4){bflo((unsigned)c), bfhi((unsigned)c), bflo((unsigned)(c >> 32)), bfhi((unsigned)(c >> 32))};
                x[r][j] = x[r][j] * DN_ALPHA + gv * (ya * w0 + yc * w1); }
            row_standardize(x[r]); row_affine(x[r], g2, b2, false, F.lane); row_store(x[r], F.xst + (size_t)m * 1024, F.lane); __builtin_amdgcn_sched_barrier(0); }
        if (l + 1 < DEPTH) rows4_mod1(F, x, m0, l + 1, scr, nullptr);
    }
}
typedef short s16x8 __attribute__((ext_vector_type(8)));
#define MFMA16(a, b, c) __builtin_amdgcn_mfma_f32_16x16x32_bf16((a), (b), (c), 0, 0, 0)
struct GlaRegs { v4u rq[2], rk[2]; float rl[16]; unsigned long long vr; };
__device__ __forceinline__ void phase_gla(Frame& F, const int glav) {
    constexpr int QK0_OFF = 0, QK1_OFF = 16384, LAR_OFF = 32768, KLT_OFF = 65536, VT_OFF = 83968  , SBT_OFF = 93184, ATT_OFF = 101888, TOT_OFF = 111104, DEC_OFF = 113152;
    constexpr int QS = 272, TS = 144;
    LAS unsigned char* L = F.lds + RING_OFF;
    LAS float* TOT = (LAS float*)(L + TOT_OFF); LAS float* DEC = (LAS float*)(L + DEC_OFF);
    const int tid = F.tid, lane = F.lane, w = F.wave, k = tid & 127, tg = tid >> 7, fr = lane & 15, fq = lane >> 4;
    const bf16* GQ = (const bf16*)(F.ws + WS_GQ); const bf16* GK = (const bf16*)(F.ws + WS_GK); const bf16* GV = (const bf16*)(F.ws + WS_GV);
    const float* LA = (const float*)(F.ws + WS_LA); bf16* OB = (bf16*)(F.ws + WS_OB); float* SSQ = (float*)(F.ws + WS_SSQ);
    const int cr = tid >> 4, cc = tid & 15;
    const int qk_dst = cr * 256 + ((cc ^ (cr & 15)) << 4);
    const int kc = k >> 3, kb2 = (k & 7) * 2;
    for (int item = F.vcu; item < 256; item += F.G) {
        const int s = item & 7, hg = (item >> 3) & 3, b = item >> 5; const size_t row0 = (size_t)b * SEQ;
        const bf16* gq = GQ + (row0 + cr) * 512 + hg * 128 + cc * 8; const bf16* gk = GK + (row0 + cr) * 512 + hg * 128 + cc * 8; const float* la = LA + (row0 + tg * 16) * 512 + hg * 128 + k;
        const bf16* gv = GV + (row0 + (tid >> 3)) * 1024 + hg * 256 + s * 32 + (tid & 7) * 4;
        bf16* ob = OB + row0 * 1024 + hg * 256 + s * 32; float* ssq = SSQ + row0 * 64 + hg * 16 + s * 2;
        for (int i = tid; i < 8704 / 4; i += NTHREADS) ((LAS unsigned*)(L + SBT_OFF))[i] = 0u;
        f32x4 accS[2]; accS[0] = (f32x4){0.f, 0.f, 0.f, 0.f}; accS[1] = accS[0];
        GlaRegs RA, RB;
#define GLA_BAR() asm volatile("s_waitcnt lgkmcnt(0)\n\ts_barrier" ::: "memory")
#define GLA_LOAD(R_, c_) do { const size_t o_ = (size_t)(c_) * 64; R_.rq[0] = *(const GAS v4u*)(gq + o_ * 512); R_.rq[1] = *(const GAS v4u*)(gq + (o_ + 32) * 512); R_.rk[0] = *(const GAS v4u*)(gk + o_ * 512); R_.rk[1] = *(const GAS v4u*)(gk + (o_ + 32) * 512); \
        _Pragma("unroll") for (int i_ = 0; i_ < 16; ++i_) R_.rl[i_] = *(const GAS float*)(la + (o_ + i_) * 512); R_.vr = *(const GAS unsigned long long*)(gv + o_ * 1024); } while (0)
        GLA_LOAD(RA, 0); GLA_LOAD(RB, 1);
        __syncthreads();
        auto chunk = [&](const int c, GlaRegs& R) {
            *(LAS v4u*)(L + QK0_OFF + qk_dst) = R.rq[0]; *(LAS v4u*)(L + QK0_OFF + qk_dst + 8192) = R.rq[1]; *(LAS v4u*)(L + QK1_OFF + qk_dst) = R.rk[0]; *(LAS v4u*)(L + QK1_OFF + qk_dst + 8192) = R.rk[1];
            const int vto = VT_OFF + (c & 1) * 4608;
            { const int t = tid >> 3, w0 = (tid & 7) * 4;
#pragma unroll
              for (int i = 0; i < 4; ++i) *(LAS bf16*)(L + vto + (w0 + i) * TS + t * 2) = (bf16)((R.vr >> (16 * i)) & 0xffffu); }
            float cs[16]; { float run = 1.f;
#pragma unroll
                for (int i = 0; i < 16; ++i) { run *= R.rl[i]; cs[i] = run; }
                TOT[tg * 128 + k] = run; }
            if (c + 2 < 64 && !(glav & 8)) GLA_LOAD(R, c + 2);
            GLA_BAR();
            if (!(glav & 1)) { float off = 1.f, last = 1.f;
#pragma unroll
              for (int g = 0; g < 4; ++g) { const float tv = TOT[g * 128 + k]; if (g < tg) off *= tv; last *= tv; }
              unsigned klw[8]; float klp = 0.f;
#pragma unroll
              for (int i = 0; i < 16; ++i) { const float e1 = cs[i] * off, e2 = __builtin_amdgcn_rcpf(e1), e3 = last * e2;
                  const int eo = (tg * 16 + i) * 256 + ((kc ^ i) << 4) + kb2;
                  const float qf = __uint_as_float((unsigned)(*(const LAS bf16*)(L + QK0_OFF + eo)) << 16), kf = __uint_as_float((unsigned)(*(const LAS bf16*)(L + QK1_OFF + eo)) << 16);
                  const unsigned qk = pg8::cvt_pk_bf16_c(qf * e1, kf * e2);
                  *(LAS bf16*)(L + QK0_OFF + eo) = (bf16)(qk & 0xffffu); *(LAS bf16*)(L + QK1_OFF + eo) = (bf16)(qk >> 16);
                  if (i & 1) klw[i >> 1] = pg8::cvt_pk_bf16_c(klp, kf * e3); else klp = kf * e3; }
              *(LAS v4u*)(L + KLT_OFF + k * TS + tg * 32) = (v4u){klw[0], klw[1], klw[2], klw[3]}; *(LAS v4u*)(L + KLT_OFF + k * TS + tg * 32 + 16) = (v4u){klw[4], klw[5], klw[6], klw[7]};
              if (tg == 0) DEC[k] = last;
            }
            GLA_BAR();
            const int ti = w >> 1, wi = w & 1; f32x4 acco = (f32x4){0.f, 0.f, 0.f, 0.f};
            if (!(glav & 2)) { s16x8 aq[4];
#pragma unroll
              for (int kk = 0; kk < 4; ++kk) aq[kk] = *(const LAS s16x8*)(L + QK0_OFF + (ti * 16 + fr) * 256 + (((kk * 4 + fq) ^ fr) << 4));
#pragma unroll
              for (int s2 = 0; s2 < 2; ++s2) { const int si = wi * 2 + s2; f32x4 a4 = (f32x4){0.f, 0.f, 0.f, 0.f};
                  if (si <= ti) {
#pragma unroll
                      for (int kk = 0; kk < 4; ++kk) { const s16x8 bb = *(const LAS s16x8*)(L + QK1_OFF + (si * 16 + fr) * 256 + (((kk * 4 + fq) ^ fr) << 4)); a4 = MFMA16(aq[kk], bb, a4); } }
#pragma unroll
                  for (int r = 0; r < 4; ++r) { const int t = ti * 16 + fq * 4 + r, sc = si * 16 + fr; const float v = (sc <= t) ? a4[r] : 0.f; *(LAS bf16*)(L + ATT_OFF + t * TS + sc * 2) = (bf16)f2bf(v); } }
#pragma unroll
              for (int kk = 0; kk < 4; ++kk) { const s16x8 bb = *(const LAS s16x8*)(L + SBT_OFF + (wi * 16 + fr) * QS + (kk * 32 + 8 * fq) * 2); acco = MFMA16(aq[kk], bb, acco); }
            }
            GLA_BAR();
            if (!(glav & 4)) {
              s16x8 aat[2], bvo[2], akl[2], bv0[2], bv1[2];
#pragma unroll
              for (int kk = 0; kk < 2; ++kk) { aat[kk] = *(const LAS s16x8*)(L + ATT_OFF + (ti * 16 + fr) * TS + (kk * 32 + 8 * fq) * 2); bvo[kk] = *(const LAS s16x8*)(L + vto + (wi * 16 + fr) * TS + (kk * 32 + 8 * fq) * 2);
                  akl[kk] = *(const LAS s16x8*)(L + KLT_OFF + (w * 16 + fr) * TS + (kk * 32 + 8 * fq) * 2); bv0[kk] = *(const LAS s16x8*)(L + vto + fr * TS + (kk * 32 + 8 * fq) * 2); bv1[kk] = *(const LAS s16x8*)(L + vto + (16 + fr) * TS + (kk * 32 + 8 * fq) * 2); }
              const f32x4 dv = *(const LAS f32x4*)(DEC + w * 16 + fq * 4);
              acco = MFMA16(aat[0], bvo[0], acco); accS[0] = accS[0] * dv; accS[1] = accS[1] * dv;
              accS[0] = MFMA16(akl[0], bv0[0], accS[0]); accS[1] = MFMA16(akl[0], bv1[0], accS[1]);
              acco = MFMA16(aat[1], bvo[1], acco);
              accS[0] = MFMA16(akl[1], bv0[1], accS[0]); accS[1] = MFMA16(akl[1], bv1[1], accS[1]);
              { const unsigned o01 = pg8::cvt_pk_bf16_c(acco[0], acco[1]), o23 = pg8::cvt_pk_bf16_c(acco[2], acco[3]); bf16* obp = ob + (size_t)(c * 64 + ti * 16 + fq * 4) * 1024 + wi * 16 + fr;
                if (!(glav & 16)) { obp[0] = (bf16)(o01 & 0xffffu); obp[1024] = (bf16)(o01 >> 16); obp[2048] = (bf16)(o23 & 0xffffu); obp[3072] = (bf16)(o23 >> 16); } }
#pragma unroll
              for (int w2 = 0; w2 < 2; ++w2)
                  *(LAS unsigned long long*)(L + SBT_OFF + (w2 * 16 + fr) * QS + (w * 16 + fq * 4) * 2) = (unsigned long long)pg8::cvt_pk_bf16_c(accS[w2][0], accS[w2][1]) | ((unsigned long long)pg8::cvt_pk_bf16_c(accS[w2][2], accS[w2][3]) << 32);
#pragma unroll
              for (int r = 0; r < 4; ++r) { const int t = c * 64 + ti * 16 + fq * 4 + r;
                  float q = acco[r] * acco[r]; q = dpp_add(q, 0); q = dpp_add(q, 1); q = dpp_add(q, 2); q = dpp_add(q, 3);
                  if (fr == 0 && !(glav & 32)) ssq[(size_t)t * 64 + wi] = q; }
            }
        };
        for (int c = 0; c < 64; c += 2) { chunk(c, RA); chunk(c + 1, RB); }
#undef GLA_LOAD
#undef GLA_BAR
        __syncthreads();
    }
}
__device__ __forceinline__ size_t gla_fp16k(size_t rowg0, int hg, int p) { return ((rowg0 + (size_t)(p >> 4)) * 512 + hg * 128) * 2 + (size_t)(p & 15) * 16; }
__device__ __forceinline__ size_t gla_fp32k(size_t rowg0, int hg, int p) { return ((rowg0 + (size_t)(p >> 5)) * 1024 + hg * 256) * 2 + (size_t)(p & 31) * 16; }
__device__ __forceinline__ void phase_gla_a(Frame& F) {
    constexpr int QK0_OFF = 0, QK1_OFF = 16384, KLT_OFF = 32768, VT_OFF = 51200, ATT_OFF = 88064, TOT_OFF = 97280, DEC_OFF = 99328, TS = 144;
    LAS unsigned char* L = F.lds + RING_OFF;
    LAS float* TOT = (LAS float*)(L + TOT_OFF); LAS float* DEC = (LAS float*)(L + DEC_OFF);
    const int tid = F.tid, lane = F.lane, w = F.wave, k = tid & 127, tg = tid >> 7, fr = lane & 15, fq = lane >> 4;
    unsigned char* GQb = F.ws + WS_GQ; unsigned char* GKb = F.ws + WS_GK; unsigned char* GVb = F.ws + WS_GV; unsigned char* LAb = F.ws + WS_LA; float* DECG = (float*)(F.ws + WS_GDEC);
    const int cr = tid >> 4, cc = tid & 15, qk_dst = cr * 256 + ((cc ^ (cr & 15)) << 4), kc = k >> 3, kb2 = (k & 7) * 2;
    v4u rq[2], rk[2], rv[4]; float rl[16];
#define GLA_A_LOAD(u_) do { const int c_ = (u_) & 63, hg_ = ((u_) >> 6) & 3, b_ = (u_) >> 8; const size_t rg_ = (size_t)b_ * SEQ + (size_t)c_ * 64; \
        const GAS unsigned char* gq = (const GAS unsigned char*)GQb + ((rg_ + cr) * 512 + hg_ * 128 + cc * 8) * 2; const GAS unsigned char* gk = (const GAS unsigned char*)GKb + ((rg_ + cr) * 512 + hg_ * 128 + cc * 8) * 2; \
        rq[0] = *(const GAS v4u*)gq; rq[1] = *(const GAS v4u*)(gq + 32 * 1024); rk[0] = *(const GAS v4u*)gk; rk[1] = *(const GAS v4u*)(gk + 32 * 1024); \
        const GAS float* la = (const GAS float*)LAb + (rg_ + tg * 16) * 512 + hg_ * 128 + k; \
        _Pragma("unroll") for (int i = 0; i < 16; ++i) rl[i] = la[(size_t)i * 512]; \
        _Pragma("unroll") for (int i = 0; i < 4; ++i) { const int p = tid + 512 * i; rv[i] = *(const GAS v4u*)((const GAS unsigned char*)GVb + gla_fp32k(rg_, hg_, p)); } } while (0)
    __syncthreads();
    if (F.vcu < 2048) GLA_A_LOAD(F.vcu);
    for (int unit = F.vcu; unit < 2048; unit += F.G) {
        const int c = unit & 63, hg = (unit >> 6) & 3, b = unit >> 8; const size_t rowg0 = (size_t)b * SEQ + (size_t)c * 64;
        *(LAS v4u*)(L + QK0_OFF + qk_dst) = rq[0]; *(LAS v4u*)(L + QK0_OFF + qk_dst + 8192) = rq[1]; *(LAS v4u*)(L + QK1_OFF + qk_dst) = rk[0]; *(LAS v4u*)(L + QK1_OFF + qk_dst + 8192) = rk[1];
#pragma unroll
        for (int i = 0; i < 4; ++i) { const int p = tid + 512 * i, t = p >> 5, cp = p & 31; const int tsw = t ^ (8 * (cp & 7));
            const unsigned wd[4] = {rv[i].x, rv[i].y, rv[i].z, rv[i].w};
#pragma unroll
            for (int e = 0; e < 8; ++e) *(LAS bf16*)(L + VT_OFF + (8 * cp + e) * TS + tsw * 2) = (bf16)((wd[e >> 1] >> (16 * (e & 1))) & 0xffffu); }
        float cs[16]; { float run = 1.f;
#pragma unroll
            for (int i = 0; i < 16; ++i) { run *= rl[i]; cs[i] = run; }
            TOT[tg * 128 + k] = run; }
        if (unit + F.G < 2048) GLA_A_LOAD(unit + F.G);
        asm volatile("s_waitcnt lgkmcnt(0)\n\ts_barrier" ::: "memory");
        { float off = 1.f, last = 1.f;
#pragma unroll
          for (int g = 0; g < 4; ++g) { const float tv = TOT[g * 128 + k]; if (g < tg) off *= tv; last *= tv; }
          unsigned klw[8]; float klp = 0.f;
#pragma unroll
          for (int i = 0; i < 16; ++i) { const float e1 = cs[i] * off, e2 = __builtin_amdgcn_rcpf(e1), e3 = last * e2;
              const int eo = (tg * 16 + i) * 256 + ((kc ^ i) << 4) + kb2;
              const float qf = __uint_as_float((unsigned)(*(const LAS bf16*)(L + QK0_OFF + eo)) << 16), kf = __uint_as_float((unsigned)(*(const LAS bf16*)(L + QK1_OFF + eo)) << 16);
              const unsigned qk = pg8::cvt_pk_bf16_c(qf * e1, kf * e2);
              *(LAS bf16*)(L + QK0_OFF + eo) = (bf16)(qk & 0xffffu); *(LAS bf16*)(L + QK1_OFF + eo) = (bf16)(qk >> 16);
              if (i & 1) klw[i >> 1] = pg8::cvt_pk_bf16_c(klp, kf * e3); else klp = kf * e3; }
          *(LAS v4u*)(L + KLT_OFF + k * TS + tg * 32) = (v4u){klw[0], klw[1], klw[2], klw[3]}; *(LAS v4u*)(L + KLT_OFF + k * TS + tg * 32 + 16) = (v4u){klw[4], klw[5], klw[6], klw[7]};
          if (tg == 0) DEC[k] = last; }
        asm volatile("s_waitcnt lgkmcnt(0)\n\ts_barrier" ::: "memory");
        { const int ti = w >> 1, wi = w & 1; s16x8 aq[4];
#pragma unroll
          for (int kk = 0; kk < 4; ++kk) aq[kk] = *(const LAS s16x8*)(L + QK0_OFF + (ti * 16 + fr) * 256 + (((kk * 4 + fq) ^ fr) << 4));
#pragma unroll
          for (int s2 = 0; s2 < 2; ++s2) { const int si = wi * 2 + s2; f32x4 a4 = (f32x4){0.f, 0.f, 0.f, 0.f};
              if (si <= ti) {
#pragma unroll
                  for (int kk = 0; kk < 4; ++kk) { const s16x8 bb = *(const LAS s16x8*)(L + QK1_OFF + (si * 16 + fr) * 256 + (((kk * 4 + fq) ^ fr) << 4)); a4 = MFMA16(aq[kk], bb, a4); } }
#pragma unroll
              for (int r = 0; r < 4; ++r) { const int t = ti * 16 + fq * 4 + r, sc = si * 16 + fr; const float v = (sc <= t) ? a4[r] : 0.f; *(LAS bf16*)(L + ATT_OFF + t * TS + sc * 2) = (bf16)f2bf(v); } } }
#pragma unroll
        for (int i = 0; i < 2; ++i) { const int p = tid + 512 * i;
            const int l_ = p & 63, t = (p >> 8) * 16 + (l_ & 15), k0 = ((p >> 6) & 3) * 32 + 4 * (l_ >> 4);
            const unsigned long long lo = *(const LAS unsigned long long*)(L + QK0_OFF + t * 256 + (((k0 >> 3) ^ (t & 15)) << 4) + (k0 & 7) * 2);
            const unsigned long long hi = *(const LAS unsigned long long*)(L + QK0_OFF + t * 256 + ((((k0 + 16) >> 3) ^ (t & 15)) << 4) + (k0 & 7) * 2);
            *(GAS v4u*)((GAS unsigned char*)GQb + gla_fp16k(rowg0, hg, p)) = (v4u){(unsigned)lo, (unsigned)(lo >> 32), (unsigned)hi, (unsigned)(hi >> 32)}; }
#pragma unroll
        for (int i = 0; i < 2; ++i) { const int p = tid + 512 * i;
            const int l_ = p & 63, kk = (p >> 7) * 16 + (l_ & 15), t0 = ((p >> 6) & 1) * 32 + 8 * (l_ >> 4);
            *(GAS v4u*)((GAS unsigned char*)GKb + gla_fp16k(rowg0, hg, p)) = *(const LAS v4u*)(L + KLT_OFF + kk * TS + t0 * 2); }
#pragma unroll
        for (int i = 0; i < 4; ++i) { const int p = tid + 512 * i;
            const int l_ = p & 63, wv = (p >> 7) * 16 + (l_ & 15), t0 = (((p >> 6) & 1) * 32 + 8 * (l_ >> 4)) ^ (8 * ((wv >> 3) & 7));
            *(GAS v4u*)((GAS unsigned char*)GVb + gla_fp32k(rowg0, hg, p)) = *(const LAS v4u*)(L + VT_OFF + wv * TS + t0 * 2); }
        if (tid < 128) DECG[(size_t)unit * 128 + tid] = DEC[tid];
        asm volatile("s_waitcnt lgkmcnt(0)\n\ts_barrier" ::: "memory");
        { const int ti = w >> 1; s16x8 aat[2];
#pragma unroll
          for (int kk = 0; kk < 2; ++kk) aat[kk] = *(const LAS s16x8*)(L + ATT_OFF + (ti * 16 + fr) * TS + (kk * 32 + 8 * fq) * 2);
#pragma unroll
          for (int j = 0; j < 8; ++j) { const int wt = (w & 1) * 8 + j, wv = wt * 16 + fr; f32x4 a4 = (f32x4){0.f, 0.f, 0.f, 0.f};
#pragma unroll
              for (int kk = 0; kk < 2; ++kk) { const s16x8 bb = *(const LAS s16x8*)(L + VT_OFF + wv * TS + (((kk * 32 + 8 * fq) ^ (8 * ((wv >> 3) & 7))) * 2)); a4 = MFMA16(aat[kk], bb, a4); }
              const unsigned long long pk = (unsigned long long)pg8::cvt_pk_bf16_c(a4[0], a4[1]) | ((unsigned long long)pg8::cvt_pk_bf16_c(a4[2], a4[3]) << 32);
              *(GAS unsigned long long*)((GAS unsigned char*)LAb + ((rowg0 + (size_t)(ti * 16 + wt)) * 512 + hg * 128) * 4 + (size_t)lane * 8) = pk; } }
        asm volatile("s_waitcnt lgkmcnt(0)\n\ts_barrier" ::: "memory");
    }
#undef GLA_A_LOAD
    __syncthreads();
}
__device__ __forceinline__ void phase_gla_b(Frame& F, const int gbv) {
    constexpr int SLOT = 37888, O_QEF = 0, O_KLF = 16384, O_VTF = 32768, O_DEC = 36864, PART_OFF = 3 * SLOT;
    static_assert(PART_OFF + 32768 <= RING_BYTES, "GB LDS map");
    LAS unsigned char* L = F.lds + RING_OFF;
    const int lane = F.lane, w = F.wave, fr = lane & 15, fq = lane >> 4, kq = w >> 1, wi = w & 1;
    const GAS unsigned char* GQb = (const GAS unsigned char*)(F.ws + WS_GQ); const GAS unsigned char* GKb = (const GAS unsigned char*)(F.ws + WS_GK); const GAS unsigned char* GVb = (const GAS unsigned char*)(F.ws + WS_GV);
    const GAS unsigned char* LAb = (const GAS unsigned char*)(F.ws + WS_LA); const GAS unsigned char* DECb = (const GAS unsigned char*)(F.ws + WS_GDEC); bf16* OB = (bf16*)(F.ws + WS_OB); float* SSQ = (float*)(F.ws + WS_SSQ);
    for (int item = F.vcu; item < 256; item += F.G) {
        const int s = item & 7, hg = (item >> 3) & 3, b = item >> 5, wt = 2 * s + wi; const size_t row0 = (size_t)b * SEQ;
        bf16* ob = OB + row0 * 1024 + hg * 256 + s * 32; float* ssq = SSQ + row0 * 64 + hg * 16 + s * 2;
        f32x4 accS[2]; accS[0] = (f32x4){0.f, 0.f, 0.f, 0.f}; accS[1] = accS[0];
        const GAS unsigned char* pbase[5]; unsigned pstride[5];
#pragma unroll
        for (int i = 0; i < 5; ++i) { const int j = (w + 8 * i < 37) ? w + 8 * i : 36;
            if (j < 16) { pbase[i] = GQb + gla_fp16k(row0, hg, j * 64 + lane); pstride[i] = 64u * 1024u; }
            else if (j < 32) { pbase[i] = GKb + gla_fp16k(row0, hg, (j - 16) * 64 + lane); pstride[i] = 64u * 1024u; }
            else if (j < 36) { pbase[i] = GVb + gla_fp32k(row0, hg, ((2 * s + ((j - 32) >> 1)) * 2 + ((j - 32) & 1)) * 64 + lane); pstride[i] = 64u * 2048u; }
            else { pbase[i] = DECb + ((size_t)((b * 4 + hg) * 64) * 128) * 4 + (size_t)(lane & 31) * 16; pstride[i] = 512u; } }
#define GLB_DMA(c_, slot_) do { _Pragma("unroll") for (int i_ = 0; i_ < 5; ++i_) \
            __builtin_amdgcn_global_load_lds((const GAS unsigned*)(pbase[i_] + (size_t)(c_) * pstride[i_]), (LAS unsigned*)(L + (slot_) * SLOT + ((w + 8 * i_ < 37) ? w + 8 * i_ : 36) * 1024), 16, 0, 0); } while (0)
        const GAS unsigned char* oib = LAb + ((row0 + (size_t)(kq * 16 + wt)) * 512 + hg * 128) * 4 + (size_t)lane * 8;
        __syncthreads();
        GLB_DMA(0, 0); GLB_DMA(1, 1);
        int slot = 0;
        for (int c = 0; c < 64; ++c) {
            if (c == 0) asm volatile("s_waitcnt vmcnt(5) lgkmcnt(0)\n\ts_barrier" ::: "memory"); else asm volatile("s_waitcnt vmcnt(13) lgkmcnt(0)\n\ts_barrier" ::: "memory");
            unsigned long long oic; { const GAS unsigned char* oip = oib + (size_t)c * (64 * 2048); asm volatile("global_load_dwordx2 %0, %1, off" : "=v"(oic) : "v"(oip) : "memory"); }
            if (!(gbv & 1)) { const int cn = (c + 2 < 64) ? c + 2 : 63; const int sn = (slot == 0) ? 2 : slot - 1; GLB_DMA(cn, sn); }
            if (gbv & 2) { slot = (slot == 2) ? 0 : slot + 1; asm volatile("s_barrier" ::: "memory"); continue; }
            const LAS unsigned char* S_ = L + slot * SLOT;
            s16x8 aqs[4], akl[2][2], bv[2]; f32x4 dv[2];
#pragma unroll
            for (int ti = 0; ti < 4; ++ti) aqs[ti] = *(const LAS s16x8*)(S_ + O_QEF + ((ti * 4 + kq) * 64 + lane) * 16);
#pragma unroll
            for (int e = 0; e < 2; ++e) { akl[e][0] = *(const LAS s16x8*)(S_ + O_KLF + (((2 * kq + e) * 2 + 0) * 64 + lane) * 16); akl[e][1] = *(const LAS s16x8*)(S_ + O_KLF + (((2 * kq + e) * 2 + 1) * 64 + lane) * 16);
                dv[e] = *(const LAS f32x4*)(S_ + O_DEC + ((2 * kq + e) * 16 + 4 * fq) * 4); bv[e] = *(const LAS s16x8*)(S_ + O_VTF + ((wi * 2 + e) * 64 + lane) * 16); }
            { const v4u bsw = (v4u){pg8::cvt_pk_bf16_c(accS[0][0], accS[0][1]), pg8::cvt_pk_bf16_c(accS[0][2], accS[0][3]), pg8::cvt_pk_bf16_c(accS[1][0], accS[1][1]), pg8::cvt_pk_bf16_c(accS[1][2], accS[1][3])};
              const s16x8 bs = __builtin_bit_cast(s16x8, bsw);
#pragma unroll
              for (int ti = 0; ti < 4; ++ti) { const f32x4 pt = MFMA16(aqs[ti], bs, ((f32x4){0.f, 0.f, 0.f, 0.f})); *(LAS f32x4*)(L + PART_OFF + (((ti * 2 + wi) * 4 + kq) * 64 + lane) * 16) = pt; } }
#pragma unroll
            for (int e = 0; e < 2; ++e) { accS[e] = accS[e] * dv[e]; accS[e] = MFMA16(akl[e][0], bv[0], accS[e]); accS[e] = MFMA16(akl[e][1], bv[1], accS[e]); }
            asm volatile("s_waitcnt lgkmcnt(0)\n\ts_barrier" ::: "memory");
            asm volatile("s_waitcnt vmcnt(5)" : "+v"(oic) :: "memory");
            f32x4 acco = (f32x4){bflo((unsigned)oic), bfhi((unsigned)oic), bflo((unsigned)(oic >> 32)), bfhi((unsigned)(oic >> 32))};
#pragma unroll
            for (int q2 = 0; q2 < 4; ++q2) acco = acco + *(const LAS f32x4*)(L + PART_OFF + (((kq * 2 + wi) * 4 + q2) * 64 + lane) * 16);
            { const unsigned o01 = pg8::cvt_pk_bf16_c(acco[0], acco[1]), o23 = pg8::cvt_pk_bf16_c(acco[2], acco[3]); bf16* obp = ob + (size_t)(c * 64 + kq * 16 + fq * 4) * 1024 + wi * 16 + fr;
              obp[0] = (bf16)(o01 & 0xffffu); obp[1024] = (bf16)(o01 >> 16); obp[2048] = (bf16)(o23 & 0xffffu); obp[3072] = (bf16)(o23 >> 16); }
#pragma unroll
            for (int r = 0; r < 4; ++r) { const int t = c * 64 + kq * 16 + fq * 4 + r;
                float q = acco[r] * acco[r]; q = dpp_add(q, 0); q = dpp_add(q, 1); q = dpp_add(q, 2); q = dpp_add(q, 3);
                if (fr == 0) ssq[(size_t)t * 64 + wi] = q; }
            slot = (slot == 2) ? 0 : slot + 1;
        }
#undef GLB_DMA
        asm volatile("s_waitcnt vmcnt(0) lgkmcnt(0)\n\ts_barrier" ::: "memory");
    }
}
__device__ __forceinline__ void unpack8(const v4u w, float* d) { d[0] = bflo(w.x); d[1] = bfhi(w.x); d[2] = bflo(w.y); d[3] = bfhi(w.y); d[4] = bflo(w.z); d[5] = bfhi(w.z); d[6] = bflo(w.w); d[7] = bfhi(w.w); }
__device__ __forceinline__ v4u pack8(const float* d) { v4u o; o.x = pk2(d[0], d[1]); o.y = pk2(d[2], d[3]); o.z = pk2(d[4], d[5]); o.w = pk2(d[6], d[7]); return o; }
__device__ __forceinline__ void phase_post(Frame& F, int l) {
    const float* lq1 = F.prm + PO_LQ1; const float* lk1 = F.prm + PO_LK1; const float* lq2 = F.prm + PO_LQ2; const float* lk2 = F.prm + PO_LK2; const float* diffg = F.prm + PO_DIFFG; const float* glag = F.prm + PO_GLAG;
    const int lane = F.lane;
    const float lam_init = 0.8f - 0.6f * expf(-0.3f * (float)l);
    const float d1 = lq1[l * 64 + lane] * lk1[l * 64 + lane], d2 = lq2[l * 64 + lane] * lk2[l * 64 + lane];
    const float lam = expf(wave_sum(d1)) - expf(wave_sum(d2)) + lam_init, osc = 1.0f - lam_init;
    float dgr[16], ggr[16];
#pragma unroll
    for (int i = 0; i < 16; ++i) { dgr[i] = diffg[l * 128 + 16 * (lane & 7) + i] * osc; ggr[i] = glag[l * 256 + 16 * (lane & 15) + i]; }
    const bf16* OP = (const bf16*)(F.ws + WS_OP); const bf16* OB = (const bf16*)(F.ws + WS_OB); const bf16* SG = (const bf16*)(F.ws + WS_SG); const float* SSQ = (const float*)(F.ws + WS_SSQ);
    bf16* OA2 = (bf16*)(F.ws + WS_OA2); bf16* OB2 = (bf16*)(F.ws + WS_OB2);
    for (int m = F.vcu * NWAVES + F.wave; m < NTOK; m += F.G * NWAVES) {
        float o0[16], o1[16], d[16];
        { const GAS v4u* p0 = (const GAS v4u*)(OP + (size_t)m * 2048 + 16 * lane); const GAS v4u* p1 = (const GAS v4u*)(OP + (size_t)m * 2048 + 1024 + 16 * lane);
          unpack8(p0[0], o0); unpack8(p0[1], o0 + 8); unpack8(p1[0], o1); unpack8(p1[1], o1 + 8); }
        float ss = 0.f;
#pragma unroll
        for (int i = 0; i < 16; ++i) { d[i] = o0[i] - lam * o1[i]; ss += d[i] * d[i]; }
        ss += __shfl_xor(ss, 1); ss += __shfl_xor(ss, 2); ss += __shfl_xor(ss, 4);
        { const float r = 1.0f / sqrtf(ss * (1.0f / 128.0f) + LN_EPS);
#pragma unroll
          for (int i = 0; i < 16; ++i) d[i] = d[i] * r * dgr[i];
          GAS v4u* q = (GAS v4u*)(OA2 + (size_t)m * 1024 + 16 * lane); q[0] = pack8(d); q[1] = pack8(d + 8); }
        { const GAS v4u* p0 = (const GAS v4u*)(OB + (size_t)m * 1024 + 16 * lane); const GAS v4u* p1 = (const GAS v4u*)(SG + (size_t)m * 1024 + 16 * lane);
          unpack8(p0[0], o0); unpack8(p0[1], o0 + 8); unpack8(p1[0], o1); unpack8(p1[1], o1 + 8); }
        { const GAS f32x4* sp = (const GAS f32x4*)(SSQ + (size_t)m * 64 + (lane >> 4) * 16); float sq = 0.f;
#pragma unroll
          for (int j = 0; j < 4; ++j) { const f32x4 v = sp[j]; sq += v.x; sq += v.y; sq += v.z; sq += v.w; }
          const float r = 1.0f / sqrtf(sq * (1.0f / 256.0f) + LN_EPS);
#pragma unroll
          for (int i = 0; i < 16; ++i) d[i] = o0[i] * r * ggr[i] * o1[i];
          GAS v4u* q = (GAS v4u*)(OB2 + (size_t)m * 1024 + 16 * lane); q[0] = pack8(d); q[1] = pack8(d + 8); }
    }
}
struct MoeOrder {
    const LAS int* BASE; int total4, G, c;
    __device__ __forceinline__ bool next(int i, pg8::Unit& u) const {
        const int Lx = i * G + c; if (Lx >= total4) return false;
        const int rt = Lx >> 2, pn = Lx & 3; int e = 0;
        for (int j = 1; j < 32; ++j) if (BASE[j] <= rt) e = j;
        e = __builtin_amdgcn_readfirstlane(e);
        u.pm = rt; u.pn = pn; u.pb = e * 4 + pn; return true;
    }
};

#ifndef PHMASK
#define PHMASK 0xFFFF
#endif
#ifndef REPMASK
#define REPMASK 0
#endif
#define REP(bit) for (int rep_ = 0; rep_ < ((REPMASK & (bit)) ? 2 : 1); ++rep_)
struct Args { const float* in[28]; float* out; unsigned char* ws; };
__global__ void __launch_bounds__(NTHREADS, 2) mk_fwd(Args args) {
    extern __shared__ __attribute__((aligned(16))) unsigned char lds[];
    Frame F;
    F.lds = (LAS unsigned char*)lds;
    F.tid = threadIdx.x; F.lane = F.tid & 63; F.wave = __builtin_amdgcn_readfirstlane(F.tid >> 6);
    F.G = gridDim.x; { const int bx = blockIdx.x; F.vcu = (F.G % 8 == 0) ? (bx % 8) * (F.G / 8) + bx / 8 : bx; }
    F.out = args.out; F.ws = args.ws; F.ctl = (gu32*)(args.ws + WS_CTL); F.prm = (const float*)(args.ws + WS_PRM);
    unsigned char* ws = args.ws;
    for (int u = F.tid; u < (LDS_BYTES - LDSCTL_OFF) / 4; u += NTHREADS) ((LAS unsigned*)(F.lds + LDSCTL_OFF))[u] = 0u;
    __syncthreads();
    volatile LAS unsigned* MISC = (volatile LAS unsigned*)(F.lds + MISC_OFF);
    XcdBarrier bar = xcd_barrier_post((unsigned*)(F.ctl + CW_BAR), MISC + 8);
    if ((REPMASK & 16384) && threadIdx.x == 0) MISC[21] = (unsigned)rt();
#ifndef BARSEL
#define BARSEL 0xFFF
#endif
#ifndef PSEL
#define PSEL 0
#endif
#ifndef DRYLVL
#define DRYLVL 1
#endif
#ifndef GLAV
#define GLAV 0
#endif
#ifndef GLA_TWO_PHASE
#define GLA_TWO_PHASE 1
#endif
#define GRID_BAR(id_) do { const unsigned long long tb0_ = (REPMASK & (8192 | 16384)) ? rt() : 0ull; \
        if ((REPMASK & 16384) && ((PSEL >> (id_)) & 1) && threadIdx.x == 0) MISC[20] += (unsigned)tb0_ - MISC[21];     \
        GAS unsigned char* bw_ = (GAS unsigned char*)args.ws; asm volatile("" : "+s"(bw_)); unsigned bx_ = bar.x; asm volatile("" : "+s"(bx_)); XcdBarrier b_ = bar; b_.x = bx_; b_.bar = (unsigned*)(bw_ + WS_CTL) + CW_BAR; xcd_barrier(b_); if (REPMASK & 4096) xcd_barrier(b_); \
        if ((REPMASK & 8192) && ((BARSEL >> (id_)) & 1) && threadIdx.x == 0) MISC[20] += (unsigned)(rt() - tb0_); if ((REPMASK & 16384) && threadIdx.x == 0) MISC[21] = (unsigned)rt(); } while (0)
#define PHASE_ENTER() do { int t_ = threadIdx.x; asm volatile("" : "+v"(t_)); F.tid = t_; F.lane = t_ & 63; F.wave = __builtin_amdgcn_readfirstlane(t_ >> 6); \
        GAS unsigned char* w_ = (GAS unsigned char*)args.ws; GAS float* o_ = (GAS float*)args.out; asm volatile("" : "+s"(w_), "+s"(o_));   \
        F.ws = (unsigned char*)w_; F.out = (float*)o_; ws = (unsigned char*)w_; F.ctl = (gu32*)(w_ + WS_CTL); F.prm = (const float*)(w_ + WS_PRM); F.xst = (float*)o_; F.Ubuf = (bf16*)(w_ + WS_U); F.LAbuf = (float*)(w_ + WS_LA); F.dry = 0; } while (0)
    typedef pg8::bf16_t pb;
    REP(1) if (PHMASK & 1) { PHASE_ENTER(); p0_ada(F, args.in[I_C], args.in[I_WADA], args.in[I_BADA]);
        __syncthreads();
        p0_weights(F, args.in[I_WIN], args.in[I_WBA], args.in[I_WBB], args.in[I_WOUT], args.in[I_WGE], args.in[I_WUE], args.in[I_WDE], args.in[I_WRG], args.in[I_WRE],
                   SmallPrm{args.in[I_BGATES], args.in[I_WALPHA], args.in[I_BALPHA], args.in[I_LQ1], args.in[I_LK1], args.in[I_LQ2], args.in[I_LK2], args.in[I_DIFFG], args.in[I_GLAG], args.in[I_LN1G], args.in[I_LN1B], args.in[I_BRG], args.in[I_BRE], args.in[I_LN2G], args.in[I_LN2B]}); __syncthreads(); }
    GRID_BAR(0);
    REP(2) if (PHMASK & 2) { PHASE_ENTER(); phase_r0(F, args.in[I_X]); }
    GRID_BAR(1);
    for (int l = 0; l < DEPTH; ++l) {
        REP(4) if (PHMASK & 4) { PHASE_ENTER(); pg8::Gemm g{(const pb*)(ws + WS_U), (const pb*)(ws + WS_WIN) + (size_t)l * NPROJ * 1024, NTOK, NPROJ, 1024}; pg8::StaticOrder S; S.init(NTOK, NPROJ, F.G, (int)blockIdx.x);
          pg8::EpiProj E{(pb*)(ws + WS_QB), (pb*)(ws + WS_KB), (pb*)(ws + WS_VB), (pb*)(ws + WS_GQ), (pb*)(ws + WS_GK), (pb*)(ws + WS_GV), (pb*)(ws + WS_SG), (pb*)(ws + WS_GT), F.prm + PO_BGATES + l * 2048};
          pg8::gemm_phase<pg8::EpiProj, pg8::StaticOrder, true, false>(F.lds + RING_OFF, g, S, E, nullptr); }
        GRID_BAR(2);
#if GLA_TWO_PHASE
        if (PHMASK & 8) { PHASE_ENTER(); phase_gla_a(F); }
        GRID_BAR(12);
        REP(8) if (PHMASK & 8) { PHASE_ENTER(); phase_gla_b(F, ((REPMASK & 8) && rep_ == 0) ? GLAV : 0); }
#else
        REP(8) if (PHMASK & 8) { PHASE_ENTER(); phase_gla(F, ((REPMASK & 8) && rep_ == 0) ? GLAV : 0); }
#endif
        GRID_BAR(3);
        REP(16) if (PHMASK & 16) { PHASE_ENTER(); const attn_body::AttnTensors AT{(const attn_body::bf16*)(ws + WS_QB), (const attn_body::bf16*)(ws + WS_KB), (const attn_body::bf16*)(ws + WS_VB), (attn_body::bf16*)(ws + WS_OP)};
          attn_body::attn_phase<8>((char*)lds + RING_OFF, AT, (unsigned*)(F.ctl + CW_ATQ + (l * 2 + ((REPMASK & 16) ? rep_ : 0)) * 64), MISC + 16); }
        GRID_BAR(4);
        REP(32) if (PHMASK & 32) { PHASE_ENTER(); phase_post(F, l); }
        GRID_BAR(5);
        REP(64) if (PHMASK & 64) { PHASE_ENTER(); pg8::PairOrder S; S.S.init(NTOK, 1024, F.G, (int)blockIdx.x);
          static_assert(WS_OB2 == WS_OA2 + (size_t)NTOK * 1024 * 2 && WS_WBB == WS_WBA + 16 * 256 * 1024 * 2, "stacked A / B views of the two branch GEMMs");
          pg8::Gemm g{(const pb*)(ws + WS_OA2), (const pb*)(ws + WS_WBA) + (size_t)l * 1024 * 1024, 2 * NTOK, 1024, 1024};
          pg8::EpiGatePair E{(pb*)(ws + WS_TMP), (long)((WS_MIX - WS_TMP) / 2), (const pb*)(ws + WS_GT)};
          pg8::gemm_phase<pg8::EpiGatePair, pg8::PairOrder, true, false>(F.lds + RING_OFF, g, S, E, nullptr); }
        GRID_BAR(6);
        if (PHMASK & 128) { PHASE_ENTER(); pg8::Gemm g{(const pb*)(ws + WS_MIX), (const pb*)(ws + WS_WOUT) + (size_t)l * 1024 * 1024, NTOK, 1024, 1024}; pg8::StaticOrder S; S.init(NTOK, 1024, F.G, (int)blockIdx.x);
          REP(128) { pg8::EpiResid E{F.out, ((REPMASK & 128) && rep_ == 0) ? (float*)(ws + WS_QB) : F.out, (const float*)(ws + WS_ADA) + (size_t)l * 8 * 6144 + 2 * 1024, 6144, DN_ALPHA};
          pg8::gemm_phase<pg8::EpiResid, pg8::StaticOrder, true, false>(F.lds + RING_OFF, g, S, E, nullptr); } }
        GRID_BAR(7);
        REP(256) if (PHMASK & 256) { PHASE_ENTER(); if ((REPMASK & 256) && rep_ == 0) { F.dry = DRYLVL; F.xst = (float*)(ws + WS_QB); F.Ubuf = (bf16*)(ws + WS_VB); } phase_r1(F, l); }
        GRID_BAR(8);
        if (PHMASK & 512) { PHASE_ENTER(); moe_tables(F, l); }
        if (PHMASK & 512) { const LAS int* BASE = (const LAS int*)(F.lds + TAB_BASE); const LAS int* CNT = (const LAS int*)(F.lds + TAB_CNT); LAS int* IDX = (LAS int*)(F.lds + TAB_IDX);
          const int total4 = __builtin_amdgcn_readfirstlane(BASE[32]) * 4; const int* LIST = (const int*)(ws + WS_LIST);
          MoeOrder S{BASE, total4, F.G, (int)blockIdx.x};
          for (int ui = 0; ui < IDX_UNITS; ++ui) { pg8::Unit u; if (!S.next(ui, u)) break; const int e = u.pb >> 2;
              if (F.tid < 256) { const int pos = (u.pm - BASE[e]) * 256 + F.tid; IDX[ui * 256 + F.tid] = (pos < CNT[e]) ? LIST[(size_t)e * LISTCAP + pos] : 0; } }
          __syncthreads();
          REP(512) { pg8::Gemm g{(const pb*)(ws + WS_U), (const pb*)(ws + WS_W1) + (size_t)l * 32 * 1024 * 1024, MOE_MAXT * 256, 1024, 1024};
            pg8::EpiSwiGLU E{(pb*)(ws + WS_H)};
            pg8::gemm_phase<pg8::EpiSwiGLU, MoeOrder, true, true>(F.lds + RING_OFF, g, S, E, IDX); }
          GRID_BAR(9);
          PHASE_ENTER();
          REP(2048) { pg8::Gemm g{(const pb*)(ws + WS_H), (const pb*)(ws + WS_WD) + (size_t)l * 32 * 1024 * 512, MOE_MAXT * 256, 1024, 512};
            pg8::EpiGate<2> E{(pb*)(ws + WS_YB), 1024, nullptr, nullptr, 0, 0};
            pg8::gemm_phase<pg8::EpiGate<2>, MoeOrder, true, false>(F.lds + RING_OFF, g, S, E, nullptr); }
        }
        GRID_BAR(10);
        REP(1024) if (PHMASK & 1024) { PHASE_ENTER(); if ((REPMASK & 1024) && rep_ == 0) { F.dry = DRYLVL; F.xst = (float*)(ws + WS_GT); F.Ubuf = (bf16*)(ws + WS_SG); F.LAbuf = (float*)(ws + WS_GV); } phase_r2(F, l); }
        if (l + 1 < DEPTH) GRID_BAR(11);
    }
    if ((REPMASK & 16384) && ((PSEL >> 11) & 1) && threadIdx.x == 0) MISC[20] += (unsigned)rt() - MISC[21];
    if ((REPMASK & (8192 | 16384)) && blockIdx.x == 0 && threadIdx.x == 0) { const unsigned tw_ = MISC[20]; const unsigned long long ts_ = rt(); while ((unsigned)(rt() - ts_) < tw_) __builtin_amdgcn_s_sleep(8); }
}

extern "C" void kernel_launch(void* const* d_in, const int* in_sizes, int n_in, void* d_out, int out_size, void* d_ws, size_t ws_size, hipStream_t stream) {
    static int grid = 0;
    if (grid == 0) {
        if (n_in != 28 || in_sizes[0] != NTOK * DM || out_size != NTOK * DM || ws_size < WS_END) { fprintf(stderr, "kernel_launch: unexpected shapes (n_in %d, in0 %d, out %d, ws %zu < %zu); nothing launched\n", n_in, n_in > 0 ? in_sizes[0] : -1, out_size, ws_size, (size_t)WS_END); grid = -1; return; }
        int dev = 0, cus = 0, per_cu = 0;
        if (hipGetDevice(&dev) != hipSuccess || hipDeviceGetAttribute(&cus, hipDeviceAttributeMultiprocessorCount, dev) != hipSuccess) { fprintf(stderr, "kernel_launch: device query failed\n"); grid = -1; return; }
        if (hipFuncSetAttribute((const void*)mk_fwd, hipFuncAttributeMaxDynamicSharedMemorySize, LDS_BYTES) != hipSuccess) { fprintf(stderr, "kernel_launch: hipFuncSetAttribute failed\n"); grid = -1; return; }
        if (hipOccupancyMaxActiveBlocksPerMultiprocessor(&per_cu, (const void*)mk_fwd, NTHREADS, LDS_BYTES) != hipSuccess || per_cu < 1) { fprintf(stderr, "kernel_launch: occupancy query says %d\n", per_cu); }
        (void)hipGetLastError();
        grid = cus;
    }
    if (grid < 0) return;
    if (hipMemsetAsync((char*)d_ws + WS_CTL, 0, CTL_ZERO_BYTES, stream) != hipSuccess) { fprintf(stderr, "kernel_launch: memset failed\n"); return; }
    Args a{};
    for (int i = 0; i < 28; ++i) a.in[i] = (const float*)d_in[i];
    a.out = (float*)d_out; a.ws = (unsigned char*)d_ws;
    hipLaunchKernelGGL(mk_fwd, dim3(grid), dim3(NTHREADS), LDS_BYTES, stream, a);
    const hipError_t le = hipPeekAtLastError();
    if (le != hipSuccess) fprintf(stderr, "kernel_launch: launch failed: %s\n", hipGetErrorName(le));
}
```

```cpp
#include <hip/hip_runtime.h>
#include <hip/hip_bf16.h>
#include <cstdio>
#include <cstdint>
#include <cmath>
namespace pg8 {
#define PG8_LAS __attribute__((address_space(3)))
typedef unsigned short bf16_t;
typedef short bf16x8 __attribute__((ext_vector_type(8)));
typedef float f32x4 __attribute__((ext_vector_type(4)));
typedef float f32x2 __attribute__((ext_vector_type(2)));
typedef unsigned u32x4 __attribute__((ext_vector_type(4)));
typedef unsigned u32x2 __attribute__((ext_vector_type(2)));
constexpr int BM = 256, BK = 64, HALF = 128, HTB = HALF * BK * 2  , STAGE_BYTES = 8 * HTB, NXCD = 8, WGM = 8;

__host__ __device__ __forceinline__ int lds_byte(int r, int c) { const int st = (r >> 4) * 2 + (c >> 5), rr = r & 15, cc = c & 31, ob = rr * 64 + cc * 2; return st * 1024 + (ob ^ (((ob >> 9) & 1) << 5)); }
__host__ __device__ __forceinline__ void stage_rc(int b, int& R, int& C) { const int st = b / 1024, sb = b % 1024, swz = sb ^ (((sb >> 9) & 1) << 5); R = (st >> 1) * 16 + swz / 64; C = (st & 1) * 32 + (swz % 64) / 2; }
__host__ __device__ __forceinline__ int perm32(int rho) { const int n = rho >> 4, i = rho & 15; return 8 * (i >> 2) + 4 * n + (i & 3); }

struct Unit { int pm, pn, pb; };
struct Gemm { const bf16_t* A; const bf16_t* Bt; int M, N, K; };

struct StaticOrder {
    int nM, nN, nwg, G, c;
    __host__ __device__ __forceinline__ void init(int M, int N, int G_, int c_) { nM = M / BM; nN = N / BM; nwg = nM * nN; G = G_; c = c_; }
    __host__ __device__ __forceinline__ bool next(int i, Unit& u) const {
        const long L = (long)i * G + c; if (L >= nwg) return false;
        int wgid = (int)L; { const int q = nwg / NXCD, r = nwg % NXCD, xcd = wgid % NXCD, off = wgid / NXCD; wgid = (xcd < r ? xcd * (q + 1) : r * (q + 1) + (xcd - r) * q) + off; }
        const int nig = WGM * nN, gid = wgid / nig, fm = gid * WGM, gsz = (nM - fm) < WGM ? (nM - fm) : WGM;
        u.pm = fm + ((wgid % nig) % gsz); u.pn = (wgid % nig) / gsz; u.pb = u.pn; return true;
    }
};

__device__ __forceinline__ unsigned cvt_pk_bf16(float lo, float hi) { unsigned r; asm volatile("v_cvt_pk_bf16_f32 %0, %1, %2" : "=v"(r) : "v"(lo), "v"(hi)); return r; }
typedef __bf16 bf16x2_c __attribute__((ext_vector_type(2)));
__device__ __forceinline__ unsigned cvt_pk_bf16_c(float lo, float hi) { const f32x2 v = {lo, hi}; const bf16x2_c b = __builtin_convertvector(v, bf16x2_c); return __builtin_bit_cast(unsigned, b); }
__device__ __forceinline__ float bf_lo(unsigned w) { return __uint_as_float(w << 16); }
__device__ __forceinline__ float bf_hi(unsigned w) { return __uint_as_float(w & 0xffff0000u); }
__device__ __forceinline__ float sigmoidf_(float x) { return __builtin_amdgcn_rcpf(1.0f + __expf(-x)); }

template <class Epi, class Sched, bool ALIGN_EPI, bool GATHER>
__device__ __forceinline__ void gemm_phase(PG8_LAS unsigned char* lds, const Gemm g, const Sched& S, const Epi& E, const PG8_LAS int* idxtab) {
    int tid_ = threadIdx.x; asm volatile("" : "+v"(tid_));
    const int tid = tid_, wid = __builtin_amdgcn_readfirstlane(tid >> 6), lane = tid & 63, wr = wid >> 2, wc = wid & 3, fr = lane & 15, fq = lane >> 4;
    const int K = g.K, nt = K / BK;
    unsigned voffA[2], voffB[2];
#pragma unroll
    for (int i = 0; i < 2; ++i) { int R, C; stage_rc(tid * 16 + i * 8192, R, C); const int Rb = Epi::PERM ? ((R & ~31) + perm32(R & 31)) : R;
        voffA[i] = (unsigned)(R * K + C) * 2u; voffB[i] = (unsigned)(Rb * K + C) * 2u; }
    const size_t kstep = (size_t)(BK * 2);
    const size_t hstep = (size_t)HALF * K * 2;
    const size_t tstep = 2 * hstep;
    const unsigned ldsw = (unsigned)wid * 1024u;
    const int aoff = lds_byte(wr * 64 + fr, fq * 8), boff = lds_byte(wc * 32 + fr, fq * 8);
    unsigned offAc[2][2];
    int nui = 0;
#define PG8_SA(b, h) (((b) * 2 + (h)) * HTB)
#define PG8_SB(b, h) ((4 + (b) * 2 + (h)) * HTB)
#define PG8_STAGE(bufoff, gbase, voff) do { _Pragma("unroll") for (int _i = 0; _i < 2; ++_i) \
        __builtin_amdgcn_global_load_lds((const unsigned*)((const char*)(gbase) + (voff)[_i]), (PG8_LAS unsigned*)(lds + (bufoff) + ldsw + _i * 8192), 16, 0, 0); } while (0)
#define PG8_GOFF(uix, h, i, tt) ({ int _R, _C; stage_rc((tt) * 16 + (i) * 8192, _R, _C); (unsigned)idxtab[(uix) * 256 + (h) * HALF + _R] * (unsigned)(K * 2) + (unsigned)_C * 2u; })
#define PG8_STAGE_A(bufoff, kb, h, nx) do { if constexpr (GATHER) { unsigned _o[2] = {offAc[h][0], offAc[h][1]}; \
        if (nx) { int _t = tid; asm volatile("" : "+v"(_t)); _o[0] = PG8_GOFF(nui, h, 0, _t); _o[1] = PG8_GOFF(nui, h, 1, _t); } \
        _Pragma("unroll") for (int _i = 0; _i < 2; ++_i) \
        __builtin_amdgcn_global_load_lds((const unsigned*)((const char*)g.A + (size_t)(kb) + _o[_i]), (PG8_LAS unsigned*)(lds + (bufoff) + ldsw + _i * 8192), 16, 0, 0); } \
        else { const char* _b = ((nx) ? nA : cA) + (size_t)(kb) + (size_t)(h) * hstep; PG8_STAGE(bufoff, _b, voffA); } } while (0)
#define PG8_GIDX(dst, uix) do { if constexpr (GATHER) { int _t = tid; asm volatile("" : "+v"(_t)); _Pragma("unroll") for (int _h = 0; _h < 2; ++_h) _Pragma("unroll") for (int _i = 0; _i < 2; ++_i) \
        dst[_h][_i] = PG8_GOFF(uix, _h, _i, _t); } } while (0)
#define PG8_LDA(dst, b, h) do { _Pragma("unroll") for (int m = 0; m < 4; ++m) _Pragma("unroll") for (int k = 0; k < 2; ++k) dst[m][k] = *(const PG8_LAS bf16x8*)(lds + PG8_SA(b, h) + aoff + m * 2048 + k * 1024); } while (0)
#define PG8_LDB(dst, b, h) do { _Pragma("unroll") for (int n = 0; n < 2; ++n) _Pragma("unroll") for (int k = 0; k < 2; ++k) dst[n][k] = *(const PG8_LAS bf16x8*)(lds + PG8_SB(b, h) + boff + n * 2048 + k * 1024); } while (0)
#define PG8_MMA(ai, bj, At, Bt) do { __builtin_amdgcn_s_setprio(1); _Pragma("unroll") for (int m = 0; m < 4; ++m) _Pragma("unroll") for (int n = 0; n < 2; ++n) _Pragma("unroll") for (int k = 0; k < 2; ++k) \
        acc[ai][bj][m][n] = __builtin_amdgcn_mfma_f32_16x16x32_bf16(Bt[n][k], At[m][k], acc[ai][bj][m][n], 0, 0, 0); __builtin_amdgcn_s_setprio(0); } while (0)
#define PG8_WAIT_V(n) asm volatile("s_waitcnt vmcnt(" #n ")" ::: "memory")
#define PG8_WAIT_L(n) asm volatile("s_waitcnt lgkmcnt(" #n ")" ::: "memory")
#define PG8_BAR __builtin_amdgcn_s_barrier()
#define PG8_SCHED __builtin_amdgcn_sched_barrier(0)
    Unit cur, nxt; int ui = 0;
    if (!S.next(0, cur)) return;
    f32x4 acc[2][2][4][2];
#pragma unroll
    for (int a = 0; a < 2; ++a)
#pragma unroll
        for (int b = 0; b < 2; ++b)
#pragma unroll
            for (int m = 0; m < 4; ++m)
#pragma unroll
                for (int n = 0; n < 2; ++n) acc[a][b][m][n] = (f32x4){0.f, 0.f, 0.f, 0.f};
    bf16x8 At[4][2], B0[2][2], B1[2][2];
    const char* cA = (const char*)g.A + (size_t)cur.pm * tstep; const char* cB = (const char*)g.Bt + (size_t)cur.pb * tstep;
    const char* nA = cA;
    PG8_GIDX(offAc, 0);
    PG8_STAGE(PG8_SB(0, 0), cB, voffB); PG8_STAGE(PG8_SB(0, 1), cB + hstep, voffB); PG8_STAGE_A(PG8_SA(0, 0), 0, 0, false); PG8_STAGE_A(PG8_SA(0, 1), 0, 1, false);
    if (wr == 1) PG8_BAR;
    PG8_WAIT_V(2); PG8_BAR;
    PG8_STAGE(PG8_SB(1, 0), cB + kstep, voffB); PG8_STAGE_A(PG8_SA(1, 0), kstep, 0, false); PG8_STAGE(PG8_SB(1, 1), cB + hstep + kstep, voffB);
    PG8_WAIT_V(6); PG8_BAR;
    for (;;) {
        const bool has_next = S.next(ui + 1, nxt);
        nA = has_next ? (const char*)g.A + (size_t)nxt.pm * tstep : cA; const char* nB = has_next ? (const char*)g.Bt + (size_t)nxt.pb * tstep : cB;
        nui = has_next ? ui + 1 : ui;
        for (int t = 0; t < nt; t += 2) {
            const bool last = (t == nt - 2);
            const size_t kb1 = (size_t)(t + 1) * kstep;
            const size_t kb2 = last ? (size_t)0 : (size_t)(t + 2) * kstep, kb3 = kb2 + kstep;
            const char* b2 = last ? nB : cB + (size_t)(t + 2) * kstep; const char* b3 = b2 + kstep;
            PG8_LDB(B0, 0, 0); PG8_LDB(B1, 0, 1); PG8_SCHED; PG8_LDA(At, 0, 0); PG8_STAGE_A(PG8_SA(1, 1), kb1, 1, false);
            PG8_WAIT_V(8); PG8_WAIT_L(0); PG8_BAR; PG8_MMA(0, 0, At, B0); PG8_MMA(0, 1, At, B1); PG8_BAR; PG8_SCHED;
            PG8_LDA(At, 0, 1); PG8_STAGE(PG8_SB(0, 0), b2, voffB); PG8_STAGE(PG8_SB(0, 1), b2 + hstep, voffB); PG8_STAGE_A(PG8_SA(0, 0), kb2, 0, last);
            PG8_WAIT_V(8); PG8_WAIT_L(0); PG8_BAR; PG8_MMA(1, 0, At, B0); PG8_MMA(1, 1, At, B1); PG8_BAR; PG8_SCHED;
            PG8_LDB(B0, 1, 0); PG8_LDB(B1, 1, 1); PG8_SCHED; PG8_LDA(At, 1, 0); PG8_STAGE_A(PG8_SA(0, 1), kb2, 1, last);
            PG8_WAIT_V(8); PG8_WAIT_L(0); PG8_BAR; PG8_MMA(0, 0, At, B0); PG8_MMA(0, 1, At, B1); PG8_BAR; PG8_SCHED;
            PG8_LDA(At, 1, 1); PG8_STAGE(PG8_SB(1, 0), b3, voffB); PG8_STAGE(PG8_SB(1, 1), b3 + hstep, voffB); PG8_STAGE_A(PG8_SA(1, 0), kb3, 0, last);
            PG8_WAIT_V(8); PG8_WAIT_L(0); PG8_BAR; PG8_MMA(1, 0, At, B0); PG8_MMA(1, 1, At, B1); PG8_BAR; PG8_SCHED;
        }
        if constexpr (ALIGN_EPI) { if (wr == 0) PG8_BAR; }
        E(acc, cur, wr, wc, fr, fq);
        if (!has_next) break;
#pragma unroll
        for (int a = 0; a < 2; ++a)
#pragma unroll
            for (int b = 0; b < 2; ++b)
#pragma unroll
                for (int m = 0; m < 4; ++m)
#pragma unroll
                    for (int n = 0; n < 2; ++n) acc[a][b][m][n] = (f32x4){0.f, 0.f, 0.f, 0.f};
        cur = nxt; cA = nA; cB = nB; ++ui;
        PG8_GIDX(offAc, ui);
        if constexpr (ALIGN_EPI) { if (wr == 1) PG8_BAR; }
    }
    PG8_WAIT_V(0);
    if constexpr (!ALIGN_EPI) { if (wr == 0) PG8_BAR; }
    PG8_BAR;
#undef PG8_SA
#undef PG8_SB
#undef PG8_STAGE
#undef PG8_STAGE_A
#undef PG8_GIDX
#undef PG8_GOFF
#undef PG8_LDA
#undef PG8_LDB
#undef PG8_MMA
#undef PG8_WAIT_V
#undef PG8_WAIT_L
#undef PG8_BAR
#undef PG8_SCHED
}
}
namespace pg8 {
constexpr float ATT_C2 = 0.125f * 1.4426950408889634f;
constexpr float GLA_QS = 0.08838834764831845f;
struct EpiProj {
    static constexpr bool PERM = true;
    bf16_t *Qb, *Kb, *Vb, *GQ, *GK, *GV, *SG, *GT; const float* bgates;
    __device__ __forceinline__ void operator()(const f32x4 (&acc)[2][2][4][2], const Unit& u, int wr, int wc, int fr, int fq) const {
        asm volatile("" : "+v"(fr), "+v"(fq));
        const int pn = u.pn; bf16_t* base; int ldc = 1024, ct; int act = 0; float sc = 1.f;
        if (pn < 4) { base = Qb; ct = pn; sc = ATT_C2; }
        else if (pn < 8) { base = Kb; ct = pn - 4; }
        else if (pn < 12) { base = Vb; ct = pn - 8; }
        else if (pn < 14) { base = GQ; ldc = 512; ct = pn - 12; sc = GLA_QS; }
        else if (pn < 16) { base = GK; ldc = 512; ct = pn - 14; }
        else if (pn < 20) { base = GV; ct = pn - 16; }
        else if (pn < 24) { base = SG; ct = pn - 20; act = 1; }
        else { base = GT; ldc = 2048; ct = pn - 24; act = 2; }
        const int row0 = u.pm * BM + wr * 64 + fr, col0 = ct * BM + wc * 32 + 8 * fq;
        f32x4 bv[2][2];
#pragma unroll
        for (int bj = 0; bj < 2; ++bj)
#pragma unroll
            for (int n = 0; n < 2; ++n) bv[bj][n] = (act == 2) ? *(const f32x4*)(bgates + col0 + bj * HALF + 4 * n) : (f32x4){0.f, 0.f, 0.f, 0.f};
#pragma unroll
        for (int ai = 0; ai < 2; ++ai)
#pragma unroll
            for (int m = 0; m < 4; ++m) { bf16_t* rowp = base + (size_t)(row0 + ai * HALF + m * 16) * ldc + col0;
#pragma unroll
                for (int bj = 0; bj < 2; ++bj) { f32x4 v0 = acc[ai][bj][m][0] * sc + bv[bj][0], v1 = acc[ai][bj][m][1] * sc + bv[bj][1];
                    if (act != 0) {
#pragma unroll
                        for (int e = 0; e < 4; ++e) { const float s0 = sigmoidf_(v0[e]), s1 = sigmoidf_(v1[e]); v0[e] = (act == 1) ? v0[e] * s0 : s0; v1[e] = (act == 1) ? v1[e] * s1 : s1; } }
                    u32x4 w; w.x = cvt_pk_bf16(v0[0], v0[1]); w.y = cvt_pk_bf16(v0[2], v0[3]); w.z = cvt_pk_bf16(v1[0], v1[1]); w.w = cvt_pk_bf16(v1[2], v1[3]);
                    *(u32x4*)(rowp + bj * HALF) = w; } }
    }
};
template <int MODE> struct EpiGate {
    static constexpr bool PERM = true;
    bf16_t* O; int ldo; const bf16_t* T; const bf16_t* gate; int ldg, gcol0;
    __device__ __forceinline__ void operator()(const f32x4 (&acc)[2][2][4][2], const Unit& u, int wr, int wc, int fr, int fq) const {
        asm volatile("" : "+v"(fr), "+v"(fq));
        const int row0 = u.pm * BM + wr * 64 + fr, col0 = u.pn * BM + wc * 32 + 8 * fq;
#pragma unroll
        for (int ai = 0; ai < 2; ++ai)
#pragma unroll
            for (int m = 0; m < 4; ++m) { const size_t row = (size_t)(row0 + ai * HALF + m * 16);
#pragma unroll
                for (int bj = 0; bj < 2; ++bj) { f32x4 v0 = acc[ai][bj][m][0], v1 = acc[ai][bj][m][1]; const int col = col0 + bj * HALF;
                    if (MODE != 2) { const u32x4 gw = *(const u32x4*)(gate + row * ldg + gcol0 + col);
                        v0 = v0 * (f32x4){bf_lo(gw.x), bf_hi(gw.x), bf_lo(gw.y), bf_hi(gw.y)}; v1 = v1 * (f32x4){bf_lo(gw.z), bf_hi(gw.z), bf_lo(gw.w), bf_hi(gw.w)}; }
                    if (MODE == 1) { const u32x4 tw = *(const u32x4*)(T + row * ldo + col);
                        v0 = v0 + (f32x4){bf_lo(tw.x), bf_hi(tw.x), bf_lo(tw.y), bf_hi(tw.y)}; v1 = v1 + (f32x4){bf_lo(tw.z), bf_hi(tw.z), bf_lo(tw.w), bf_hi(tw.w)}; }
                    u32x4 w; w.x = cvt_pk_bf16(v0[0], v0[1]); w.y = cvt_pk_bf16(v0[2], v0[3]); w.z = cvt_pk_bf16(v1[0], v1[1]); w.w = cvt_pk_bf16(v1[2], v1[3]);
                    *(u32x4*)(O + row * ldo + col) = w; }
                asm volatile("" ::: "memory"); }
    }
};
struct EpiGatePair {
    static constexpr bool PERM = true;
    bf16_t* TMP; long mix_delta; const bf16_t* gate;
    __device__ __forceinline__ void operator()(const f32x4 (&acc)[2][2][4][2], const Unit& u, int wr, int wc, int fr, int fq) const {
        asm volatile("" : "+v"(fr), "+v"(fq));
        const int kind = u.pm >= 128 ? 1 : 0; const int row0 = (u.pm - 128 * kind) * BM + wr * 64 + fr, col0 = u.pn * BM + wc * 32 + 8 * fq;
#pragma unroll
        for (int ai = 0; ai < 2; ++ai)
#pragma unroll
            for (int m = 0; m < 4; ++m) { const size_t row = (size_t)(row0 + ai * HALF + m * 16);
#pragma unroll
                for (int bj = 0; bj < 2; ++bj) { f32x4 v0 = acc[ai][bj][m][0], v1 = acc[ai][bj][m][1]; const int col = col0 + bj * HALF;
                    { const u32x4 gw = *(const u32x4*)(gate + row * 2048 + kind * 1024 + col);
                      v0 = v0 * (f32x4){bf_lo(gw.x), bf_hi(gw.x), bf_lo(gw.y), bf_hi(gw.y)}; v1 = v1 * (f32x4){bf_lo(gw.z), bf_hi(gw.z), bf_lo(gw.w), bf_hi(gw.w)}; }
                    if (kind) { const u32x4 tw = *(const u32x4*)(TMP + row * 1024 + col);
                        v0 = v0 + (f32x4){bf_lo(tw.x), bf_hi(tw.x), bf_lo(tw.y), bf_hi(tw.y)}; v1 = v1 + (f32x4){bf_lo(tw.z), bf_hi(tw.z), bf_lo(tw.w), bf_hi(tw.w)}; }
                    u32x4 w; w.x = cvt_pk_bf16(v0[0], v0[1]); w.y = cvt_pk_bf16(v0[2], v0[3]); w.z = cvt_pk_bf16(v1[0], v1[1]); w.w = cvt_pk_bf16(v1[2], v1[3]);
                    *(u32x4*)(TMP + (long)kind * mix_delta + row * 1024 + col) = w; }
                asm volatile("" ::: "memory"); }
    }
};
struct PairOrder {
    StaticOrder S;
    __device__ __forceinline__ bool next(int i, Unit& u) const { if (!S.next(i >> 1, u)) return false; const int kind = i & 1; u.pm += 128 * kind; u.pb = u.pn + 16 * kind; return true; }
};
struct EpiResid {
    static constexpr bool PERM = false;
    const float* X; float* Xo; const float* gvec; int gstride; float alpha;
    __device__ __forceinline__ void operator()(const f32x4 (&acc)[2][2][4][2], const Unit& u, int wr, int wc, int fr, int fq) const {
        asm volatile("" : "+v"(fr), "+v"(fq));
        const int row0 = u.pm * BM + wr * 64 + fr, col0 = u.pn * BM + wc * 32 + 4 * fq; const float* gv = gvec + (size_t)(u.pm >> 4) * gstride;
        f32x4 g4[2][2];
#pragma unroll
        for (int bj = 0; bj < 2; ++bj)
#pragma unroll
            for (int n = 0; n < 2; ++n) g4[bj][n] = *(const f32x4*)(gv + col0 + bj * HALF + n * 16);
#pragma unroll
        for (int ai = 0; ai < 2; ++ai)
#pragma unroll
            for (int m = 0; m < 4; ++m) { const size_t ro = (size_t)(row0 + ai * HALF + m * 16) * 1024 + col0;
#pragma unroll
                for (int bj = 0; bj < 2; ++bj)
#pragma unroll
                    for (int n = 0; n < 2; ++n) { const size_t o = ro + bj * HALF + n * 16; const f32x4 xv = *(const f32x4*)(X + o); *(f32x4*)(Xo + o) = xv * alpha + g4[bj][n] * acc[ai][bj][m][n]; }
                asm volatile("" ::: "memory"); }
    }
};
struct EpiSwiGLU {
    static constexpr bool PERM = true;
    bf16_t* H;
    __device__ __forceinline__ void operator()(const f32x4 (&acc)[2][2][4][2], const Unit& u, int wr, int wc, int fr, int fq) const {
        asm volatile("" : "+v"(fr), "+v"(fq));
        const int row0 = u.pm * BM + wr * 64 + fr, col0 = u.pn * HALF + wc * 32 + 8 * fq;
#pragma unroll
        for (int ai = 0; ai < 2; ++ai)
#pragma unroll
            for (int m = 0; m < 4; ++m) { f32x4 h0, h1;
#pragma unroll
                for (int e = 0; e < 4; ++e) { const float g0 = acc[ai][0][m][0][e], g1 = acc[ai][0][m][1][e]; h0[e] = g0 * sigmoidf_(g0) * acc[ai][1][m][0][e]; h1[e] = g1 * sigmoidf_(g1) * acc[ai][1][m][1][e]; }
                u32x4 w; w.x = cvt_pk_bf16(h0[0], h0[1]); w.y = cvt_pk_bf16(h0[2], h0[3]); w.z = cvt_pk_bf16(h1[0], h1[1]); w.w = cvt_pk_bf16(h1[2], h1[3]);
                *(u32x4*)(H + (size_t)(row0 + ai * HALF + m * 16) * 512 + col0) = w; }
    }
};
}
#include <hip/hip_bf16.h>
#include <cmath>
namespace attn_body {
using bf16=__hip_bfloat16;
using bf16x8=__attribute__((ext_vector_type(8)))short;
using s16x4=__attribute__((ext_vector_type(4)))short;
using f32x16=__attribute__((ext_vector_type(16)))float;
using u32x4=__attribute__((ext_vector_type(4)))unsigned;
constexpr int BATCH=8,NHEAD=16,SEQ=4096,D=64,DM=NHEAD*D,OPITCH=2048;
constexpr int NW=8,QBLK=32,QB=QBLK*NW,KVBLK=64,NQB=SEQ/QB;
constexpr int ATTN_PITCH=DM, ATTN_UNIT_ROWS=QB;
__device__ __forceinline__ int crow(int r,int hi){return (r&3)+8*(r>>2)+4*hi;}
#define SBAR() __builtin_amdgcn_sched_barrier(0)
__device__ __forceinline__ void cmask(f32x16&p0,f32x16&p1,int jb,int qrel,int hi){
  const float NEG=-INFINITY; int kb=64*jb+4*hi;
  #pragma unroll
  for(int r=0;r<16;++r){int kv=kb+(r&3)+8*(r>>2); if(kv>qrel)p0[r]=NEG; if(kv+32>qrel)p1[r]=NEG;}
}

constexpr int NSLOT=3, SLOTB=8192;
constexpr int LDS_K=0, LDS_V=NSLOT*SLOTB, LDS_WS=3*NSLOT*SLOTB, LDS_OST=LDS_WS+NW*64*4, LDS_BYTES=LDS_OST+NW*4096;
constexpr float C2=0.125f*1.4426950408889634f;
__device__ __forceinline__ void glds16s(const void*sbase,unsigned voff,unsigned lds_dst){unsigned keep;
  asm volatile("s_mov_b32 %0, m0\n\ts_mov_b32 m0, %2\n\ts_nop 0\n\tglobal_load_lds_dwordx4 %1, %3\n\ts_mov_b32 m0, %0":"=&s"(keep):"v"(voff),"s"(lds_dst),"s"(sbase):"memory");}
__device__ __forceinline__ void glds16(const void*gsrc,unsigned lds_dst){unsigned keep;
  asm volatile("s_mov_b32 %0, m0\n\ts_mov_b32 m0, %2\n\ts_nop 0\n\tglobal_load_lds_dwordx4 %1, off\n\ts_mov_b32 m0, %0":"=&s"(keep):"v"(gsrc),"s"(lds_dst):"memory");}
__device__ __forceinline__ float max3f(float a,float b,float c){float r;asm("v_max3_f32 %0, %1, %2, %3":"=v"(r):"v"(a),"v"(b),"v"(c));return r;}
__device__ __forceinline__ float max2f(float a,float b){float r;asm("v_max_f32_e32 %0, %1, %2":"=v"(r):"v"(a),"v"(b));return r;}
__device__ __forceinline__ float fadd_s(float a,float b){float r;asm("v_add_f32_e32 %0, %1, %2":"=v"(r):"v"(a),"v"(b));return r;}
__device__ __forceinline__ float fsub_s(float a,float b){float r;asm("v_sub_f32_e32 %0, %1, %2":"=v"(r):"v"(a),"v"(b));return r;}
typedef float f32x2_t __attribute__((ext_vector_type(2))); typedef __bf16 bf16x2_t __attribute__((ext_vector_type(2)));
__device__ __forceinline__ unsigned cvtpk_s(float lo,float hi){f32x2_t v={lo,hi};bf16x2_t b=__builtin_convertvector(v,bf16x2_t);return __builtin_bit_cast(unsigned,b);}
#define WAIT_BAR(N) asm volatile("s_waitcnt vmcnt(" #N ") lgkmcnt(0)\n\ts_barrier":::"memory")

__device__ __forceinline__ void qkt(f32x16&p0,f32x16&p1,const char*Kslot,const bf16x8*qr,const f32x16&c0,const f32x16&c1,int r32,int hi){
  const char*kb=Kslot+hi*1024+r32*16;
  #pragma unroll
  for(int d0=0;d0<4;++d0){
    const bf16x8 b0=*reinterpret_cast<const bf16x8*>(kb+d0*2048);
    const bf16x8 b1=*reinterpret_cast<const bf16x8*>(kb+d0*2048+512);
    if(d0==0){p0=__builtin_amdgcn_mfma_f32_32x32x16_bf16(b0,qr[0],c0,0,0,0);p1=__builtin_amdgcn_mfma_f32_32x32x16_bf16(b1,qr[0],c1,0,0,0);}
    else{p0=__builtin_amdgcn_mfma_f32_32x32x16_bf16(b0,qr[d0],p0,0,0,0);p1=__builtin_amdgcn_mfma_f32_32x32x16_bf16(b1,qr[d0],p1,0,0,0);}}
}
typedef __attribute__((address_space(3))) const char* lds_cptr;
typedef short v4i16_t __attribute__((ext_vector_type(4)));
__device__ __forceinline__ void kload8(bf16x8*kf,lds_cptr kp){
  kf[0]=*(const __attribute__((address_space(3))) bf16x8*)(kp);      kf[1]=*(const __attribute__((address_space(3))) bf16x8*)(kp+512);
  kf[2]=*(const __attribute__((address_space(3))) bf16x8*)(kp+2048); kf[3]=*(const __attribute__((address_space(3))) bf16x8*)(kp+2560);
  kf[4]=*(const __attribute__((address_space(3))) bf16x8*)(kp+4096); kf[5]=*(const __attribute__((address_space(3))) bf16x8*)(kp+4608);
  kf[6]=*(const __attribute__((address_space(3))) bf16x8*)(kp+6144); kf[7]=*(const __attribute__((address_space(3))) bf16x8*)(kp+6656);
}
__device__ __forceinline__ void kload2(bf16x8*kf,lds_cptr kp,int j){ kf[2*j]=*(const __attribute__((address_space(3))) bf16x8*)(kp+j*2048); kf[2*j+1]=*(const __attribute__((address_space(3))) bf16x8*)(kp+j*2048+512); }
__device__ __forceinline__ s16x4 vtr(lds_cptr p){ return __builtin_bit_cast(s16x4,__builtin_amdgcn_ds_read_tr16_b64_v4i16((__attribute__((address_space(3))) v4i16_t*)p)); }
__device__ __forceinline__ float rowmax(const f32x16&p0,const f32x16&p1){
  float a=max3f(p0[0],p0[1],p1[0]),b=max3f(p0[2],p0[3],p1[1]);a=max3f(a,p1[2],p1[3]);
  #pragma unroll
  for(int r=4;r<16;r+=4){a=max3f(a,p0[r],p0[r+1]);b=max3f(b,p0[r+2],p0[r+3]);a=max3f(a,p1[r],p1[r+1]);b=max3f(b,p1[r+2],p1[r+3]);}
  const float m=max2f(a,b);
  auto rr=__builtin_amdgcn_permlane32_swap(__float_as_uint(m),__float_as_uint(m),false,false);
  return max2f(__uint_as_float(rr[0]),__uint_as_float(rr[1]));
}
__device__ __forceinline__ void pv(f32x16*o,int vb,bf16x8 pa0,bf16x8 pa1,bf16x8 pa2,bf16x8 pa3){
  #pragma unroll
  for(int d0=0;d0<4;++d0){s16x4 lo[4],hi[4];
    #pragma unroll
    for(int ks=0;ks<4;++ks){
      asm volatile("ds_read_b64_tr_b16 %0,%1 offset:%c2":"=&v"(lo[ks]):"v"(vb),"i"(d0*4096+ks*1024):"memory");
      asm volatile("ds_read_b64_tr_b16 %0,%1 offset:%c2":"=&v"(hi[ks]):"v"(vb),"i"(d0*4096+ks*1024+512):"memory");}
    asm volatile("s_waitcnt lgkmcnt(0)":::"memory");SBAR();
    #define PK(k) (bf16x8){lo[k][0],lo[k][1],lo[k][2],lo[k][3],hi[k][0],hi[k][1],hi[k][2],hi[k][3]}
    o[d0]=__builtin_amdgcn_mfma_f32_32x32x16_bf16(pa0,PK(0),o[d0],0,0,0);
    o[d0]=__builtin_amdgcn_mfma_f32_32x32x16_bf16(pa1,PK(1),o[d0],0,0,0);
    o[d0]=__builtin_amdgcn_mfma_f32_32x32x16_bf16(pa2,PK(2),o[d0],0,0,0);
    o[d0]=__builtin_amdgcn_mfma_f32_32x32x16_bf16(pa3,PK(3),o[d0],0,0,0);
    #undef PK
  }
}

#ifndef ATTN_STORE16
#define ATTN_STORE16(p,v) (*(u32x4*)(p)=(v))
#endif
template<int THRL> __device__ __forceinline__ void attn_unit(int b,int hq,int hv,int ocol,int qb,int nfar,float sl2,const bf16*Q,const bf16*__restrict__ K,const bf16*__restrict__ V,bf16*O,char*shm){
  int tid_=threadIdx.x; asm volatile("":"+v"(tid_));
  const int tid=tid_,lane=tid&63,r32=lane&31,hi=lane>>5; const int wid=__builtin_amdgcn_readfirstlane(tid>>6);
  const long rowbase=(long)b*SEQ; const int q0=qb*QB;
  const bf16*Qw=Q+(rowbase+q0+wid*QBLK)*DM+hq*D;
  const int NTf=(q0+QB)/KVBLK, NT=(NTf<4+nfar)?NTf:4+nfar, t0=NTf-NT, q0c=q0-64*t0;
  const bf16*Kh=K+(rowbase+64*t0)*DM+hq*D,*Vh=V+(rowbase+64*t0)*DM+hv*D;
  const unsigned lds0=(unsigned)(uintptr_t)shm;
  float*wsf=(float*)(shm+LDS_WS)+wid*64;
  const unsigned kvoff=(unsigned)(lane*DM+wid*8)*2u;
  const unsigned vvoff=(unsigned)((16*(wid&3)+(lane>>2))*DM+(wid>>2)*32+(lane&3)*8)*2u;
  const unsigned kdst=lds0+LDS_K+wid*1024, vdst=lds0+LDS_V+wid*1024;
  #define DMA_K(t,slot) glds16s(Kh+(long)(t)*KVBLK*DM,kvoff,(unsigned)__builtin_amdgcn_readfirstlane(kdst+(slot)))
  #define DMA_V(t,slot) do{ glds16s(Vh+(long)(t)*KVBLK*DM,vvoff,(unsigned)__builtin_amdgcn_readfirstlane(vdst+2*(slot))); glds16s(Vh+(long)(t)*KVBLK*DM+64,vvoff,(unsigned)__builtin_amdgcn_readfirstlane(vdst+2*(slot)+8192)); }while(0)
  const int vb0=(int)(lds0+LDS_V)+((lane>>4)&1)*32+(lane&3)*8+(4*hi+((lane&15)>>2))*64;
  const char*Kbase=shm+LDS_K; bf16x8 kf[8];
  const lds_cptr shm3=(lds_cptr)shm; const lds_cptr kp0=shm3+LDS_K+hi*1024+r32*16; const lds_cptr vp0=shm3+LDS_V+((lane>>4)&1)*32+(lane&3)*8+(4*hi+((lane&15)>>2))*64;
  DMA_K(0,0);DMA_V(0,0);DMA_K(1,SLOTB);
  bf16x8 qr[4];
  #pragma unroll
  for(int d0=0;d0<4;++d0)qr[d0]=*reinterpret_cast<const bf16x8*>(&Qw[(long)r32*DM+d0*16+hi*8]);
  float mhat=0.f,l_reg=0.f;f32x16 o[4];o[0]=f32x16{};o[1]=f32x16{};o[2]=f32x16{};o[3]=f32x16{};
  #define CINIT0(C0_,t_) do{ const float bt_=sl2*(float)(64*(t_)-q0c+4*hi)-mhat; _Pragma("unroll") for(int r=0;r<16;++r){C0_[r]=__builtin_fmaf(sl2,(float)((r&3)+8*(r>>2)),bt_);} }while(0)
  #define CINIT1(C1_,t_) do{ const float bt_=sl2*(float)(64*(t_)-q0c+4*hi)-mhat; _Pragma("unroll") for(int r=0;r<16;++r){C1_[r]=__builtin_fmaf(sl2,(float)((r&3)+8*(r>>2)+32),bt_);} }while(0)
  #define CINIT(C0_,C1_,t_) do{ CINIT0(C0_,t_); CINIT1(C1_,t_); }while(0)
  const int qrel=wid*QBLK+r32;
  #define CMASK(P0,P1,t) do{int jb_=(t)-(NT-4); if(jb_>=0)cmask(P0,P1,jb_,qrel,hi);}while(0)
  bool resc=false;
  #define START(P0,P1) do{ const float rm=rowmax(P0,P1); resc=false; \
    { const float dl=rm; mhat=fadd_s(mhat,dl); \
      _Pragma("unroll") for(int r=0;r<16;++r){P0[r]=fsub_s(P0[r],dl);P1[r]=fsub_s(P1[r],dl);} } \
    _Pragma("unroll") for(int r=0;r<16;++r)P0[r]=__builtin_amdgcn_exp2f(P0[r]); }while(0)
  #define RESC() do{ if(resc){ asm volatile("s_waitcnt lgkmcnt(0)":::"memory"); \
      _Pragma("unroll") for(int d_=0;d_<4;++d_) _Pragma("unroll") for(int r=0;r<16;++r)o[d_][r]*=wsf[crow(r,hi)]; } }while(0)
  f32x16 pA0,pA1,pB0,pB1;
  int sl_prev=0,sl_cur=0,sl_next=SLOTB;
  #define ROT() do{sl_prev=sl_cur;sl_cur=sl_next;sl_next=(sl_next==(NSLOT-1)*SLOTB)?0:sl_next+SLOTB;}while(0)
  DMA_K(2,2*SLOTB);
  WAIT_BAR(4);
  { f32x16 c0_,c1_; CINIT(c0_,c1_,0); qkt(pA0,pA1,Kbase,qr,c0_,c1_,r32,hi); } asm volatile("s_nop 15\n\ts_nop 7":"+v"(pA0),"+v"(pA1));CMASK(pA0,pA1,0);
  START(pA0,pA1);
  _Pragma("unroll") for(int r=0;r<16;++r)pA1[r]=__builtin_amdgcn_exp2f(pA1[r]);
  WAIT_BAR(0);
  DMA_K(3,0);DMA_V(1,SLOTB);
  ROT();
  kload8(kf,kp0+sl_cur);
  WAIT_BAR(3);
  s16x4 vlo[8],vhi[8]; u32x4 pw0,pw1,pw2,pw3;
  #define PKW(P,B) cvtpk_s(P[B],P[B+1])
  #define PAF(k) __builtin_bit_cast(bf16x8,pw##k)
  #define VFR(i) (bf16x8){vlo[i][0],vlo[i][1],vlo[i][2],vlo[i][3],vhi[i][0],vhi[i][1],vhi[i][2],vhi[i][3]}
  #define PIN(x) asm volatile("":"+v"(x))
  #define MX3(a,b,c) __builtin_fmaxf(__builtin_fmaxf((a),(b)),(c))
  #define GAPA(MF,A0,A1,A2,A3,W0,W1,PW) do{ MF; sacc+=A0; sacc+=A1; sacc+=A2; sacc+=A3; PIN(sacc); W0; W1; PIN(PW); SBAR(); }while(0)
  #define EX(v) __builtin_amdgcn_exp2f(v)
  #define GAPB(MF,X,B) do{ MF; X[B]=EX(X[B]); X[B+1]=EX(X[B+1]); PIN(X); SBAR(); }while(0)
  #define VRD2(sl,fr) do{ vlo[sl]=vtr(vp_+(((fr)>>2)*4096+((fr)&3)*1024)); vhi[sl]=vtr(vp_+(((fr)>>2)*4096+((fr)&3)*1024+512)); SBAR(); }while(0)
  #define VRD(i) do{ vlo[i]=vtr(vp_+(((i)>>2)*4096+((i)&3)*1024)); vhi[i]=vtr(vp_+(((i)>>2)*4096+((i)&3)*1024+512)); }while(0)
  #define KRD(G,j) do{ if(G){ kload2(kf,kp0+sl_next,j); SBAR(); } }while(0)
  #define STEP(C0,C1,P0,P1,t,GK,GV,GL) do{ CINIT0(C0,t); SBAR(); \
    const lds_cptr vp_=vp0+2*sl_prev; \
    VRD(0); SBAR(); float sacc=(P0[0]+P0[1]); \
    GAPA(C0=__builtin_amdgcn_mfma_f32_32x32x16_bf16(kf[0],qr[0],C0,0,0,0), P0[2],P0[3],P0[4],P0[5],     pw0[0]=PKW(P0,0), pw0[1]=PKW(P0,2), pw0); \
    CINIT1(C1,t); VRD(4); SBAR(); GAPA(C1=__builtin_amdgcn_mfma_f32_32x32x16_bf16(kf[1],qr[0],C1,0,0,0), P0[6],P0[7],P0[8],P0[9],     pw0[2]=PKW(P0,4), pw0[3]=PKW(P0,6), pw0); \
    VRD(1); SBAR(); GAPA(C0=__builtin_amdgcn_mfma_f32_32x32x16_bf16(kf[2],qr[1],C0,0,0,0),   P0[10],P0[11],P0[12],P0[13], pw1[0]=PKW(P0,8), pw1[1]=PKW(P0,10), pw1); \
    VRD(5); SBAR(); GAPA(C1=__builtin_amdgcn_mfma_f32_32x32x16_bf16(kf[3],qr[1],C1,0,0,0),   P0[14],P0[15],P1[0],P1[1],   pw1[2]=PKW(P0,12),pw1[3]=PKW(P0,14), pw1); \
    VRD(2); SBAR(); GAPA(C0=__builtin_amdgcn_mfma_f32_32x32x16_bf16(kf[4],qr[2],C0,0,0,0),   P1[2],P1[3],P1[4],P1[5],     pw2[0]=PKW(P1,0), pw2[1]=PKW(P1,2), pw2); \
    VRD(6); SBAR(); GAPA(C1=__builtin_amdgcn_mfma_f32_32x32x16_bf16(kf[5],qr[2],C1,0,0,0),   P1[6],P1[7],P1[8],P1[9],     pw2[2]=PKW(P1,4), pw2[3]=PKW(P1,6), pw2); \
    VRD(3); SBAR(); GAPA(C0=__builtin_amdgcn_mfma_f32_32x32x16_bf16(kf[6],qr[3],C0,0,0,0),   P1[10],P1[11],P1[12],P1[13], pw3[0]=PKW(P1,8), pw3[1]=PKW(P1,10), pw3); \
    VRD(7); SBAR(); GAPA(C1=__builtin_amdgcn_mfma_f32_32x32x16_bf16(kf[7],qr[3],C1,0,0,0),   P1[14],P1[15],0.f,0.f,       pw3[2]=PKW(P1,12),pw3[3]=PKW(P1,14), pw3); \
    l_reg+=sacc; \
    if(GK){DMA_K((t)+3,sl_cur);} if(GV){DMA_V((t)+1,sl_next);} \
    CMASK(C0,C1,t); \
    { float a=MX3(C0[0],C0[1],C1[0]),b=MX3(C0[2],C0[3],C1[1]); a=MX3(a,C1[2],C1[3]); \
      _Pragma("unroll") for(int r=4;r<16;r+=4){a=MX3(a,C0[r],C0[r+1]);b=MX3(b,C0[r+2],C0[r+3]);a=MX3(a,C1[r],C1[r+1]);b=MX3(b,C1[r+2],C1[r+3]);} \
      float rm=__builtin_fmaxf(a,b); { auto rr=__builtin_amdgcn_permlane32_swap(__float_as_uint(rm),__float_as_uint(rm),false,false); rm=__builtin_fmaxf(__uint_as_float(rr[0]),__uint_as_float(rr[1])); } \
      resc=false; \
      if(__builtin_expect(__any(rm>(float)THRL),0)){ const float dl=__builtin_fmaxf(rm,0.f); mhat+=dl; \
        _Pragma("unroll") for(int r=0;r<16;++r){C0[r]-=dl;C1[r]-=dl;} \
        const float f=__builtin_amdgcn_exp2f(-dl); l_reg*=f; if(hi==0)wsf[r32]=f; resc=true; } } \
    SBAR(); \
    GAPB(o[0]=__builtin_amdgcn_mfma_f32_32x32x16_bf16(PAF(0),VFR(0),o[0],0,0,0), C0,0);  VRD2(0,8); \
    GAPB(o[1]=__builtin_amdgcn_mfma_f32_32x32x16_bf16(PAF(0),VFR(4),o[1],0,0,0), C0,2);  VRD2(4,12); \
    KRD(GL,0); GAPB(o[0]=__builtin_amdgcn_mfma_f32_32x32x16_bf16(PAF(1),VFR(1),o[0],0,0,0), C0,4);  VRD2(1,9); \
    KRD(GL,1); GAPB(o[1]=__builtin_amdgcn_mfma_f32_32x32x16_bf16(PAF(1),VFR(5),o[1],0,0,0), C0,6);  VRD2(5,13); \
    KRD(GL,2); GAPB(o[0]=__builtin_amdgcn_mfma_f32_32x32x16_bf16(PAF(2),VFR(2),o[0],0,0,0), C0,8);  VRD2(2,10); \
    KRD(GL,3); GAPB(o[1]=__builtin_amdgcn_mfma_f32_32x32x16_bf16(PAF(2),VFR(6),o[1],0,0,0), C0,10); VRD2(6,14); \
    GAPB(o[0]=__builtin_amdgcn_mfma_f32_32x32x16_bf16(PAF(3),VFR(3),o[0],0,0,0), C0,12); VRD2(3,11); \
    GAPB(o[1]=__builtin_amdgcn_mfma_f32_32x32x16_bf16(PAF(3),VFR(7),o[1],0,0,0), C0,14); VRD2(7,15); \
    GAPB(o[2]=__builtin_amdgcn_mfma_f32_32x32x16_bf16(PAF(0),VFR(0),o[2],0,0,0), C1,0); \
    GAPB(o[3]=__builtin_amdgcn_mfma_f32_32x32x16_bf16(PAF(0),VFR(4),o[3],0,0,0), C1,2); \
    GAPB(o[2]=__builtin_amdgcn_mfma_f32_32x32x16_bf16(PAF(1),VFR(1),o[2],0,0,0), C1,4); \
    GAPB(o[3]=__builtin_amdgcn_mfma_f32_32x32x16_bf16(PAF(1),VFR(5),o[3],0,0,0), C1,6); \
    GAPB(o[2]=__builtin_amdgcn_mfma_f32_32x32x16_bf16(PAF(2),VFR(2),o[2],0,0,0), C1,8); \
    GAPB(o[3]=__builtin_amdgcn_mfma_f32_32x32x16_bf16(PAF(2),VFR(6),o[3],0,0,0), C1,10); \
    GAPB(o[2]=__builtin_amdgcn_mfma_f32_32x32x16_bf16(PAF(3),VFR(3),o[2],0,0,0), C1,12); \
    GAPB(o[3]=__builtin_amdgcn_mfma_f32_32x32x16_bf16(PAF(3),VFR(7),o[3],0,0,0), C1,14); \
    }while(0)
  int t=1;
  #undef CMASK
  #define CMASK(P0,P1,t) do{}while(0)
  for(;t+5<NT;t+=2){
    STEP(pB0,pB1,pA0,pA1,t,true,true,true);     WAIT_BAR(3); RESC(); ROT();
    STEP(pA0,pA1,pB0,pB1,t+1,true,true,true);   WAIT_BAR(3); RESC(); ROT();
  }
  #undef CMASK
  #define CMASK(P0,P1,t) do{int jb_=(t)-(NT-4); if(jb_>=0)cmask(P0,P1,jb_,qrel,hi);}while(0)
  #define ENDW(tt) do{ if((tt)+3<NT){WAIT_BAR(3);} else if((tt)+2<NT){WAIT_BAR(2);} else {WAIT_BAR(0);} }while(0)
  for(;t+1<NT;t+=2){
    STEP(pB0,pB1,pA0,pA1,t,(t+3<NT),(t+1<NT),(t+1<NT));       ENDW(t);   RESC(); ROT();
    STEP(pA0,pA1,pB0,pB1,t+1,(t+4<NT),(t+2<NT),(t+2<NT));     ENDW(t+1); RESC(); ROT();
  }
  STEP(pB0,pB1,pA0,pA1,NT-1,false,false,false); RESC();
  { float sacc=pB0[0]+pB0[1]; _Pragma("unroll") for(int r=2;r<16;++r)sacc+=pB0[r]; _Pragma("unroll") for(int r=0;r<16;++r)sacc+=pB1[r]; l_reg+=sacc;
    pw0=(u32x4){PKW(pB0,0),PKW(pB0,2),PKW(pB0,4),PKW(pB0,6)};pw1=(u32x4){PKW(pB0,8),PKW(pB0,10),PKW(pB0,12),PKW(pB0,14)};pw2=(u32x4){PKW(pB1,0),PKW(pB1,2),PKW(pB1,4),PKW(pB1,6)};pw3=(u32x4){PKW(pB1,8),PKW(pB1,10),PKW(pB1,12),PKW(pB1,14)};
    SBAR(); pv(o,vb0+2*sl_cur,PAF(0),PAF(1),PAF(2),PAF(3)); }
  #undef PKW
  #undef PAF
  #undef VFR
  #undef PIN
  #undef MX3
  #undef GAPA
  #undef GAPB
  #undef EX
  #undef VRD
  #undef VRD2
  #undef KRD
  #undef STEP
  #undef ENDW
  {auto rr=__builtin_amdgcn_permlane32_swap(__float_as_uint(l_reg),__float_as_uint(l_reg),false,false);l_reg=__uint_as_float(rr[0])+__uint_as_float(rr[1]);}
  if(hi==0)wsf[32+r32]=l_reg;asm volatile("s_waitcnt lgkmcnt(0)":::"memory");
  float rli[16];
  #pragma unroll
  for(int r=0;r<16;++r)rli[r]=__builtin_amdgcn_rcpf(wsf[32+crow(r,hi)]);
  bf16*Ow=O+(rowbase+q0+wid*QBLK)*OPITCH+ocol;
  { bf16*stg=(bf16*)(shm+LDS_OST)+wid*2048;
    int ln2_=lane; asm volatile("":"+v"(ln2_));
    #pragma unroll
    for(int hf=0;hf<2;++hf){
      #pragma unroll
      for(int r=0;r<16;++r){const int orow=crow(r,hi);
        #pragma unroll
        for(int d0=0;d0<2;++d0)stg[orow*64+d0*32+r32]=__float2bfloat16(o[2*hf+d0][r]*rli[r]);}
      asm volatile("s_waitcnt lgkmcnt(0)":::"memory");
      #pragma unroll
      for(int i=0;i<4;++i){const int row=i*8+(ln2_>>3),ch=ln2_&7; const u32x4 v=*(const u32x4*)(stg+row*64+ch*8); ATTN_STORE16(Ow+(long)row*OPITCH+hf*64+ch*8,v);}
      asm volatile("s_waitcnt lgkmcnt(0)":::"memory"); } }
  asm volatile("s_waitcnt lgkmcnt(0)\n\ts_barrier":::"memory");
  #undef DMA_K
  #undef DMA_V
  #undef CMASK
  #undef CINIT
  #undef CINIT0
  #undef CINIT1
  #undef START
  #undef RESC
  #undef ROT
}
constexpr int ATTN_LDS_BYTES=LDS_BYTES;
struct AttnTensors { const bf16* Q; const bf16* K; const bf16* V; bf16* O; };
template<int THRL=8> __device__ __forceinline__ void attn_phase(char*lds,const AttnTensors&T,unsigned*qw,volatile __attribute__((address_space(3))) unsigned*qs){
  for(;;){
    if(threadIdx.x==0) qs[0]=__hip_atomic_fetch_add(qw,2u,__ATOMIC_RELAXED,__HIP_MEMORY_SCOPE_AGENT);
    __syncthreads();
    const int idx0=__builtin_amdgcn_readfirstlane((int)qs[0]);
    __syncthreads();
    if(idx0>=2048)break;
    for(int idx=idx0;idx<idx0+2;++idx){
      const int c=idx&1,b=(idx>>1)&7,h=7-((idx>>4)&7),qb=15-(idx>>7);
      const float sl2=__uint_as_float(__builtin_amdgcn_readfirstlane(__float_as_uint(__builtin_amdgcn_exp2f(-(float)(h+1))*1.4426950408889634f)));
      const int nfar=(h==0)?6:(h==1)?10:(h==2)?20:(h==3)?38:64;
      attn_unit<THRL>(b,2*h+c,2*h,c*1024+h*128,qb,nfar,sl2,T.Q,T.K,T.V,T.O,lds);
    }
  }
}
#undef SBAR
#undef WAIT_BAR
}
#define GAS __attribute__((address_space(1)))
#define LAS __attribute__((address_space(3)))
typedef unsigned short bf16;
typedef unsigned v4u __attribute__((ext_vector_type(4)));
typedef float f32x4 __attribute__((ext_vector_type(4)));
typedef short bf16x8 __attribute__((ext_vector_type(8)));
typedef GAS unsigned gu32;
typedef GAS unsigned long long gu64;
#define RLX_AGENT __ATOMIC_RELAXED, __HIP_MEMORY_SCOPE_AGENT
#define LDS_WAIT() asm volatile("s_waitcnt lgkmcnt(0)" ::: "memory")
#define VM_WAIT() asm volatile("s_waitcnt vmcnt(0)" ::: "memory")
__device__ __forceinline__ unsigned long long rt() { return __builtin_amdgcn_s_memrealtime(); }
__device__ __forceinline__ unsigned f2bf(float f) { unsigned u = __builtin_bit_cast(unsigned, f); return (u + 0x7fffu + ((u >> 16) & 1u)) >> 16; }
__device__ __forceinline__ unsigned pk2(float lo, float hi) { return f2bf(lo) | (f2bf(hi) << 16); }

#define XB_TMO      128
#define XB_XCNT(j)  (256  + 64 * (j))
#define XB_XSUB(j)  (1280 + 64 * (j))
#define XB_XGEN(j)  (2304 + 64 * (j))
#define XB_TOP      3328
#define XB_TOPGEN   3392
#define XCD_BAR_WORDS 3456
#define XB_SPIN_CAP (1u << 18)

__device__ __forceinline__ unsigned xb_ld(unsigned* p)              { return __hip_atomic_load(p, __ATOMIC_RELAXED, __HIP_MEMORY_SCOPE_AGENT); }
__device__ __forceinline__ unsigned xb_add(unsigned* p, unsigned v) { return __hip_atomic_fetch_add(p, v, __ATOMIC_RELAXED, __HIP_MEMORY_SCOPE_AGENT); }
__device__ __forceinline__ unsigned xb_xcc_id() { return (unsigned)__builtin_amdgcn_s_getreg((3 << 11) | 20) & 0xFu; }
#define XB_SPIN(cond, bar) do { unsigned _sp = 0; while (cond) { __builtin_amdgcn_s_sleep(1); \
    if ((++_sp & 255u) == 0u) { if (xb_ld(&(bar)[XB_TMO])) break; if (_sp > XB_SPIN_CAP) { atomicAdd(&(bar)[XB_TMO], 1u); break; } } } } while (0)

struct XcdBarrier {
    unsigned* bar; unsigned x;
    volatile LAS unsigned* st;
};

__device__ __forceinline__ XcdBarrier xcd_barrier_post(unsigned* bar, volatile LAS unsigned* st) {
    XcdBarrier b; b.bar = bar; b.x = xb_xcc_id(); b.st = st;
    if (threadIdx.x == 0) (void)xb_add(&bar[XB_XCNT(b.x)], 1u);
    return b;
}
__device__ __forceinline__ void xcd_barrier_complete(unsigned* bar, unsigned x, unsigned& nloc, unsigned& nx) {
    const unsigned G = gridDim.x * gridDim.y * gridDim.z;
    unsigned sum, cnt, mine, sp = 0u;
    for (;;) {
        sum = 0u; cnt = 0u; mine = 0u;
#pragma unroll
        for (unsigned j = 0; j < 16; ++j) { const unsigned c = xb_ld(&bar[XB_XCNT(j)]); sum += c; cnt += (c > 0u) ? 1u : 0u; mine = (j == x) ? c : mine; }
        if (sum == G) break;
        __builtin_amdgcn_s_sleep(1);
        if ((++sp & 255u) == 0u) { if (xb_ld(&bar[XB_TMO])) break; if (sp > XB_SPIN_CAP) { atomicAdd(&bar[XB_TMO], 1u); break; } }
    }
    nloc = mine > 0u ? mine : 1u; nx = cnt > 0u ? cnt : 1u;
}

__device__ __forceinline__ void xcd_barrier(const XcdBarrier& b) {
    asm volatile("s_waitcnt vmcnt(0)" ::: "memory");
    __syncthreads();
    if (threadIdx.x == 0) {
        unsigned* bar = b.bar;
        __builtin_amdgcn_s_waitcnt(0);
        unsigned nloc = b.st[0], nx = b.st[1];
        if (nloc == 0u) { xcd_barrier_complete(bar, b.x, nloc, nx); b.st[0] = nloc; b.st[1] = nx; }
        const unsigned old = xb_add(&bar[XB_XSUB(b.x)], 1u);
        const unsigned gen = old / nloc;
        if (old + 1u == (gen + 1u) * nloc) {
            __builtin_amdgcn_fence(__ATOMIC_RELEASE, "agent");
            asm volatile("s_waitcnt vmcnt(0)" ::: "memory");
            const unsigned og = xb_add(&bar[XB_TOP], 1u);
            const unsigned tg = og / nx;
            if (og + 1u == (tg + 1u) * nx) xb_add(&bar[XB_TOPGEN], 1u);
            else XB_SPIN(xb_ld(&bar[XB_TOPGEN]) == tg, bar);
            __builtin_amdgcn_fence(__ATOMIC_ACQUIRE, "agent");
            xb_add(&bar[XB_XGEN(b.x)], 1u);
            asm volatile("s_waitcnt vmcnt(0)" ::: "memory");
        } else {
            XB_SPIN(xb_ld(&bar[XB_XGEN(b.x)]) == gen, bar);
            __builtin_amdgcn_fence(__ATOMIC_ACQUIRE, "agent");
            asm volatile("s_waitcnt vmcnt(0)" ::: "memory");
        }
    }
    __syncthreads();
}
constexpr int NWAVES = 8, NTHREADS = 512;
constexpr int BATCH = 8, SEQ = 4096, DM = 1024, NTOK = BATCH * SEQ, DEPTH = 4;
constexpr int DIN = 8208, NPROJ = 8192;
constexpr int NEXP = 32, DEXP = 512, LISTCAP = 32768, MOE_MAXT = 288;
constexpr float LN_EPS = 1e-5f, DN_ALPHA = 1.6817928305074292f;
constexpr size_t MiB = 1u << 20;
constexpr size_t WS_CTL = 0, CTL_ZERO_BYTES = 1 * MiB;
constexpr size_t WS_ADA = 1 * MiB;
constexpr size_t WS_ABWT = 2 * MiB;
constexpr size_t WS_RWT = 2 * MiB + 256 * 1024;
constexpr size_t WS_TOKINFO = 3 * MiB;
constexpr size_t WS_LIST = 4 * MiB;
constexpr size_t WS_SSQ = 8 * MiB;
constexpr size_t WS_PRM = 16 * MiB;
constexpr int PO_BGATES = 0, PO_WALPHA = 8192, PO_BALPHA = 40960, PO_LQ1 = 43008, PO_LK1 = 43264, PO_LQ2 = 43520, PO_LK2 = 43776, PO_DIFFG = 44032, PO_GLAG = 44544,
              PO_LN1G = 45568, PO_LN1B = 49664, PO_BRG = 53760, PO_BRE = 53776, PO_LN2G = 53904, PO_LN2B = 58000, PO_END = 62096;
constexpr size_t WS_GDEC = 18 * MiB;
constexpr size_t WS_WIN = 32 * MiB;
constexpr size_t WS_WBA = 96 * MiB, WS_WBB = 104 * MiB, WS_WOUT = 112 * MiB;
constexpr size_t WS_W1 = 120 * MiB;
constexpr size_t WS_WD = 376 * MiB;
constexpr size_t WS_U = 504 * MiB;
constexpr size_t WS_QB = 568 * MiB, WS_KB = 632 * MiB, WS_VB = 696 * MiB;
constexpr size_t WS_GQ = 760 * MiB, WS_GK = 792 * MiB;
constexpr size_t WS_GV = 824 * MiB, WS_SG = 888 * MiB;
constexpr size_t WS_GT = 952 * MiB;
constexpr size_t WS_LA = 1080 * MiB;
constexpr size_t WS_END = 1144 * MiB;
constexpr size_t WS_OB = WS_U;
constexpr size_t WS_OP = WS_GQ;
constexpr size_t WS_OA2 = WS_QB, WS_OB2 = WS_KB;
constexpr size_t WS_TMP = WS_VB, WS_MIX = WS_GQ;
constexpr size_t WS_H = WS_QB;
constexpr size_t WS_YB = WS_QB + 72 * MiB;
constexpr int CW_ATQ = 32768;
constexpr int CW_TMO = 0, CW_CODE = 1, CW_BAR = 4096, CW_CNT = 8192;
constexpr int RING_OFF = 0, RING_BYTES = 147456;
constexpr int LDSCTL_OFF = RING_BYTES, MISC_OFF = LDSCTL_OFF + 320;
constexpr int TAB_CNT = RING_BYTES + 512, TAB_BASE = RING_BYTES + 640, TAB_IDX = RING_BYTES + 1024, IDX_UNITS = 8;
constexpr int LDS_BYTES = 163840;
static_assert(TAB_IDX + IDX_UNITS * 256 * 4 <= LDS_BYTES, "LDS map");
struct Frame {
    LAS unsigned char* lds;
    gu32* ctl;
    int tid, lane, wave, vcu, G;
    float* out; unsigned char* ws; const float* prm;
    float* xst; bf16* Ubuf; float* LAbuf; int dry;
};
enum { I_X = 0, I_C, I_WADA, I_BADA, I_WIN, I_BGATES, I_WALPHA, I_BALPHA, I_LQ1, I_LK1, I_LQ2, I_LK2, I_DIFFG, I_GLAG, I_WBA, I_WBB, I_WOUT, I_LN1G, I_LN1B,
       I_WRG, I_BRG, I_WRE, I_BRE, I_WGE, I_WUE, I_WDE, I_LN2G, I_LN2B };
__device__ __forceinline__ float dpp_add(float v, const int ctrl_sel) {
    const int x = __float_as_int(v); int y;
    if (ctrl_sel == 0) y = __builtin_amdgcn_update_dpp(x, x, 0xB1, 0xF, 0xF, false);
    else if (ctrl_sel == 1) y = __builtin_amdgcn_update_dpp(x, x, 0x4E, 0xF, 0xF, false);
    else if (ctrl_sel == 2) y = __builtin_amdgcn_update_dpp(x, x, 0x141, 0xF, 0xF, false);
    else y = __builtin_amdgcn_update_dpp(x, x, 0x140, 0xF, 0xF, false);
    return v + __int_as_float(y);
}
__device__ __forceinline__ float wave_sum(float v) {
    v = dpp_add(v, 0); v = dpp_add(v, 1); v = dpp_add(v, 2); v = dpp_add(v, 3);
    { auto rr = __builtin_amdgcn_permlane16_swap(__float_as_uint(v), __float_as_uint(v), false, false); v = __uint_as_float(rr[0]) + __uint_as_float(rr[1]); }
    { auto rr = __builtin_amdgcn_permlane32_swap(__float_as_uint(v), __float_as_uint(v), false, false); v = __uint_as_float(rr[0]) + __uint_as_float(rr[1]); }
    return v;
}
__device__ __forceinline__ float siluf_(float x) { return x * __builtin_amdgcn_rcpf(1.0f + __expf(-x)); }
__device__ __forceinline__ float bflo(unsigned w) { return __uint_as_float(w << 16); }
__device__ __forceinline__ float bfhi(unsigned w) { return __uint_as_float(w & 0xffff0000u); }

__device__ __forceinline__ void p0_ada(Frame& F, const float* c, const float* wada, const float* bada) {
    LAS float* COND = (LAS float*)(F.lds);
    LAS float* PART = (LAS float*)(F.lds + 32768);
    float* ADA = (float*)(F.ws + WS_ADA);
    for (int i = F.tid; i < 8192; i += NTHREADS) COND[i] = siluf_(c[i]);
    __syncthreads();
    for (int cg = (int)blockIdx.x; cg < 256; cg += F.G) {
        const int l = cg >> 6, j0 = (cg & 63) * 96;
        const int col4 = F.lane % 24, ksub = F.lane / 24;
        f32x4 acc[8];
#pragma unroll
        for (int b = 0; b < 8; ++b) acc[b] = (f32x4){0.f, 0.f, 0.f, 0.f};
        if (ksub < 2) {
            const float* wp = wada + ((size_t)l * 1024 + (size_t)(F.wave * 128 + ksub)) * 6144 + j0 + 4 * col4;
#pragma unroll 8
            for (int kk = 0; kk < 64; ++kk) {
                const f32x4 wv = *(const GAS f32x4*)(wp + (size_t)kk * 2 * 6144); const int k = F.wave * 128 + 2 * kk + ksub;
#pragma unroll
                for (int b = 0; b < 8; ++b) acc[b] += wv * COND[b * 1024 + k];
            }
#pragma unroll
            for (int b = 0; b < 8; ++b) *(LAS f32x4*)(PART + ((F.wave * 2 + ksub) * 8 + b) * 96 + 4 * col4) = acc[b];
        }
        __syncthreads();
        for (int idx = F.tid; idx < 768; idx += NTHREADS) { const int b = idx / 96, col = idx % 96; float s = 0.f;
#pragma unroll
            for (int p = 0; p < 16; ++p) s += PART[(p * 8 + b) * 96 + col];
            ADA[((size_t)l * 8 + b) * 6144 + j0 + col] = s + bada[l * 6144 + j0 + col]; }
        __syncthreads();
    }
}
struct RmIdent { __device__ __forceinline__ int operator()(int n) const { return n; } };
struct RmWin { __device__ __forceinline__ int operator()(int n) const { return n < 6144 ? n : (n < 6160 ? -1 : n - 16); } };
struct RmGateUp { int up; __device__ __forceinline__ int operator()(int n) const { return (n >> 7) * 256 + up * 128 + (n & 127); } };
template <class RowMap>
__device__ __forceinline__ void p0_transpose_item(const float* W, int K, int N, bf16* WT, const RowMap rm, LAS float* scr, int kb, int nb, int lane) {
    const int k0 = 64 * kb, n0 = 32 * nb; const int n4 = (lane & 7) * 4; const bool nv = (n0 + n4 + 3 < N);
    f32x4 tv[8];
#pragma unroll
    for (int i = 0; i < 8; ++i) { const int kk = 8 * i + (lane >> 3); tv[i] = nv ? *(const GAS f32x4*)(W + (size_t)(k0 + kk) * N + n0 + n4) : (f32x4){0.f, 0.f, 0.f, 0.f}; }
#pragma unroll
    for (int i = 0; i < 8; ++i) { const int kk = 8 * i + (lane >> 3); LAS float* d = scr + kk * 33 + n4; d[0] = tv[i].x; d[1] = tv[i].y; d[2] = tv[i].z; d[3] = tv[i].w; }
    LDS_WAIT(); asm volatile("" ::: "memory");
    const int c = lane & 7;
#pragma unroll
    for (int j = 0; j < 4; ++j) { const int nn = (lane >> 3) + 8 * j, n = n0 + nn; const LAS float* s = scr + (8 * c) * 33 + nn;
        v4u o; o.x = pk2(s[0 * 33], s[1 * 33]); o.y = pk2(s[2 * 33], s[3 * 33]); o.z = pk2(s[4 * 33], s[5 * 33]); o.w = pk2(s[6 * 33], s[7 * 33]);
        const int r = (n < N) ? rm(n) : -1;
        if (r >= 0) *(GAS v4u*)(WT + (size_t)r * K + k0 + 8 * c) = o; }
    LDS_WAIT(); asm volatile("" ::: "memory");
}
struct SmallPrm { const float *bgates, *walpha, *balpha, *lq1, *lk1, *lq2, *lk2, *diffg, *glag, *ln1g, *ln1b, *brg, *bre, *ln2g, *ln2b; };
__device__ __forceinline__ void p0_copy(float* dst, const float* src, int n, int gt, int NGT) { for (int i = gt; i < n; i += NGT) dst[i] = src[i]; }
__device__ __forceinline__ void p0_weights(Frame& F, const float* win, const float* wba, const float* wbb, const float* wout, const float* wge, const float* wue, const float* wde, const float* wrg, const float* wre, const SmallPrm sp) {
    LAS float* scr = (LAS float*)(F.lds + RING_OFF + F.wave * 16384);
    const int gw = F.vcu * NWAVES + F.wave, NGW = F.G * NWAVES;
    constexpr int I_IN = 4 * 16 * 257, I_SQ = 12 * 16 * 32, I_E = 128 * 16 * 16, I_D = 128 * 8 * 32;
    constexpr int NITEMS = I_IN + I_SQ + 2 * I_E + I_D;
    for (int it = gw; it < NITEMS; it += NGW) {
        int r = it;
        if (r < I_IN) { const int l = r / 4112, q = r % 4112;
            p0_transpose_item(win + (size_t)l * 1024 * DIN, 1024, DIN, (bf16*)(F.ws + WS_WIN) + (size_t)l * NPROJ * 1024, RmWin{}, scr, q / 257, q % 257, F.lane); continue; }
        r -= I_IN;
        if (r < I_SQ) { const int mat = r / 512, q = r % 512, which = mat >> 2, l = mat & 3;
            const float* W = (which == 0 ? wba : (which == 1 ? wbb : wout)) + (size_t)l * 1024 * 1024;
            bf16* WT = (bf16*)(F.ws + (which == 0 ? WS_WBA : (which == 1 ? WS_WBB : WS_WOUT))) + (size_t)l * 1024 * 1024;
            p0_transpose_item(W, 1024, 1024, WT, RmIdent{}, scr, q / 32, q % 32, F.lane); continue; }
        r -= I_SQ;
        if (r < 2 * I_E) { const int up = r >= I_E ? 1 : 0; if (up) r -= I_E; const int me = r / 256, q = r % 256;
            p0_transpose_item((up ? wue : wge) + (size_t)me * 1024 * 512, 1024, 512, (bf16*)(F.ws + WS_W1) + (size_t)me * 1024 * 1024, RmGateUp{up}, scr, q / 16, q % 16, F.lane); continue; }
        r -= 2 * I_E;
        { const int me = r / 256, q = r % 256;
          p0_transpose_item(wde + (size_t)me * 512 * 1024, 512, 1024, (bf16*)(F.ws + WS_WD) + (size_t)me * 1024 * 512, RmIdent{}, scr, q / 32, q % 32, F.lane); }
    }
    const int gt = F.vcu * NTHREADS + F.tid, NGT = F.G * NTHREADS;
    float* ABWT = (float*)(F.ws + WS_ABWT); float* RWT = (float*)(F.ws + WS_RWT);
    { float* P = (float*)(F.ws + WS_PRM);
      p0_copy(P + PO_BGATES, sp.bgates, 8192, gt, NGT); p0_copy(P + PO_WALPHA, sp.walpha, 32768, gt, NGT); p0_copy(P + PO_BALPHA, sp.balpha, 2048, gt, NGT);
      p0_copy(P + PO_LQ1, sp.lq1, 256, gt, NGT); p0_copy(P + PO_LK1, sp.lk1, 256, gt, NGT); p0_copy(P + PO_LQ2, sp.lq2, 256, gt, NGT); p0_copy(P + PO_LK2, sp.lk2, 256, gt, NGT);
      p0_copy(P + PO_DIFFG, sp.diffg, 512, gt, NGT); p0_copy(P + PO_GLAG, sp.glag, 1024, gt, NGT); p0_copy(P + PO_LN1G, sp.ln1g, 4096, gt, NGT); p0_copy(P + PO_LN1B, sp.ln1b, 4096, gt, NGT);
      p0_copy(P + PO_BRG, sp.brg, 16, gt, NGT); p0_copy(P + PO_BRE, sp.bre, 128, gt, NGT); p0_copy(P + PO_LN2G, sp.ln2g, 4096, gt, NGT); p0_copy(P + PO_LN2B, sp.ln2b, 4096, gt, NGT); }
    for (int i = gt; i < 4 * 16 * 1024; i += NGT) { const int l = i >> 14, r = (i >> 10) & 15, k = i & 1023; ABWT[i] = win[((size_t)l * 1024 + k) * DIN + 6144 + r]; }
    for (int i = gt; i < 4 * 36 * 1024; i += NGT) { const int l = i / 36864, c = (i / 1024) % 36, k = i & 1023;
        RWT[i] = (c < 4) ? wrg[((size_t)l * 1024 + k) * 4 + c] : wre[((size_t)l * 1024 + k) * 32 + (c - 4)]; }
}

typedef f32x4 Row4[4];
__device__ __forceinline__ void row_load(Row4& v, const float* p, int lane) { const GAS f32x4* q = (const GAS f32x4*)p + lane;
#pragma unroll
    for (int j = 0; j < 4; ++j) v[j] = q[64 * j]; }
__device__ __forceinline__ void row_store(const Row4& v, float* p, int lane) { GAS f32x4* q = (GAS f32x4*)p + lane;
#pragma unroll
    for (int j = 0; j < 4; ++j) q[64 * j] = v[j]; }
__device__ __forceinline__ void row_standardize(Row4& v) {
    float s = 0.f;
#pragma unroll
    for (int j = 0; j < 4; ++j) s += (v[j].x + v[j].y) + (v[j].z + v[j].w);
    const float mean = wave_sum(s) * (1.f / DM); float s2 = 0.f;
#pragma unroll
    for (int j = 0; j < 4; ++j) { v[j] = v[j] - mean; s2 += (v[j].x * v[j].x + v[j].y * v[j].y) + (v[j].z * v[j].z + v[j].w * v[j].w); }
    const float rstd = 1.f / sqrtf(wave_sum(s2) * (1.f / DM) + LN_EPS);
#pragma unroll
    for (int j = 0; j < 4; ++j) v[j] = v[j] * rstd;
}
__device__ __forceinline__ void row_affine(Row4& v, const float* g, const float* b, bool one_plus, int lane) {
    asm volatile("" : "+s"(g), "+s"(b));
#pragma unroll
    for (int j = 0; j < 4; ++j) { f32x4 gv = *((const GAS f32x4*)g + lane + 64 * j); const f32x4 bv = *((const GAS f32x4*)b + lane + 64 * j); if (one_plus) gv = gv + 1.0f; v[j] = v[j] * gv + bv; }
}
__device__ __forceinline__ void row_store_bf16(const Row4& v, bf16* p, int lane) { GAS unsigned long long* o8 = (GAS unsigned long long*)p + lane;
#pragma unroll
    for (int j = 0; j < 4; ++j) o8[64 * j] = (unsigned long long)pk2(v[j].x, v[j].y) | ((unsigned long long)pk2(v[j].z, v[j].w) << 32); }
__device__ __forceinline__ int idx16(int L) { return ((L >> 5) & 1) + 2 * ((L >> 4) & 1) + 4 * ((L >> 3) & 1) + 8 * ((L >> 2) & 1) + 16 * ((L >> 1) & 1) + 32 * (L & 1); }
__device__ __forceinline__ int idx4(int L) { return ((L >> 5) & 1) + 2 * ((L >> 4) & 1) + 4 * ((L >> 3) & 1) + 8 * ((L >> 2) & 1); }
template <int NC, class WP>
__device__ __forceinline__ float rows4_proj(const Row4 (&u)[4], WP wT, int lane) {
    float p[4 * NC]; f32x4 wa[4], wb[4];
    asm volatile("" : "+s"(wT));
    const WP wp = wT + lane;
#define R4_LDW(DD_, CC_) do { _Pragma("unroll") for (int j = 0; j < 4; ++j) DD_[j] = wp[(CC_) * 256 + 64 * j]; } while (0)
#define R4_DOT(WW_, CC_) do { _Pragma("unroll") for (int r = 0; r < 4; ++r) { pg8::f32x2 s_ = (pg8::f32x2){0.f, 0.f}; _Pragma("unroll") for (int j = 0; j < 4; ++j) { \
        s_ = __builtin_elementwise_fma((pg8::f32x2){u[r][j].x, u[r][j].y}, (pg8::f32x2){WW_[j].x, WW_[j].y}, s_); s_ = __builtin_elementwise_fma((pg8::f32x2){u[r][j].z, u[r][j].w}, (pg8::f32x2){WW_[j].z, WW_[j].w}, s_); } \
        p[r * NC + (CC_)] = s_.x + s_.y; } } while (0)
    R4_LDW(wa, 0);
#pragma unroll
    for (int c = 0; c < NC; c += 2) {
        R4_LDW(wb, c + 1); __builtin_amdgcn_sched_barrier(0);
        R4_DOT(wa, c);
        if (c + 2 < NC) R4_LDW(wa, c + 2);
        __builtin_amdgcn_sched_barrier(0);
        R4_DOT(wb, c + 1);
        __builtin_amdgcn_sched_barrier(0);
    }
#undef R4_LDW
#undef R4_DOT
    int V = 4 * NC;
#pragma unroll
    for (int M = 32; M >= 1; M >>= 1) {
        if (V > 1) { const bool bit = (lane & M) != 0;
#pragma unroll
            for (int i = 0; i < 32; ++i) if (i < V / 2) { const float a = p[2 * i], b = p[2 * i + 1]; const float send = bit ? a : b; const float recv = __shfl_xor(send, M); p[i] = (bit ? b : a) + recv; }
            V >>= 1; }
        else p[0] += __shfl_xor(p[0], M);
    }
    return p[0];
}
constexpr int WAL_OFF = 16384, BAL_OFF = 16384 + 32768, ABL_OFF = 16384 + 32768 + 2048;
__device__ __forceinline__ void load_walpha(Frame& F, int l) {
    const float* walpha_all = F.prm + PO_WALPHA; const float* balpha_all = F.prm + PO_BALPHA;
    LAS float* WAL = (LAS float*)(F.lds + RING_OFF + WAL_OFF); LAS float* BAL = (LAS float*)(F.lds + RING_OFF + BAL_OFF);
    for (int i = F.tid; i < 8192; i += NTHREADS) WAL[i] = walpha_all[(size_t)l * 8192 + i];
    if (F.tid < 512) BAL[F.tid] = balpha_all[l * 512 + F.tid];
    { const GAS f32x4* src = (const GAS f32x4*)((const float*)(F.ws + WS_ABWT) + (size_t)l * 16 * 1024); LAS f32x4* dst = (LAS f32x4*)(F.lds + RING_OFF + ABL_OFF);
      for (int i = F.tid; i < 4096; i += NTHREADS) dst[i] = src[i]; }
    __syncthreads();
}
__device__ __forceinline__ void rows4_mod1(Frame& F, Row4 (&x)[4], int m0, int l, LAS float* scr, const float* pf) {
    const int b = m0 >> 12; const float* ada = (const float*)(F.ws + WS_ADA) + ((size_t)l * 8 + b) * 6144;
#pragma unroll
    for (int r = 0; r < 4; ++r) { row_standardize(x[r]); row_affine(x[r], ada + 1024, ada, true, F.lane); row_store_bf16(x[r], F.Ubuf + (size_t)(m0 + r) * 1024, F.lane); __builtin_amdgcn_sched_barrier(0); }
    if (F.dry == 3) { if (pf) {
#pragma unroll
        for (int r = 0; r < 4; ++r) row_load(x[r], pf + (size_t)r * 1024, F.lane); } return; }
    const float abv = rows4_proj<16>(x, (const LAS f32x4*)(F.lds + RING_OFF + ABL_OFF), F.lane);
    __builtin_amdgcn_sched_barrier(0);
    if (pf) {
#pragma unroll
        for (int r = 0; r < 4; ++r) row_load(x[r], pf + (size_t)r * 1024, F.lane); }
    __builtin_amdgcn_sched_barrier(0);
    scr[idx16(F.lane)] = abv;
    if (F.dry == 2) return;
    LDS_WAIT(); asm volatile("" ::: "memory");
    const LAS float* WAL = (const LAS float*)(F.lds + RING_OFF + WAL_OFF); const LAS float* BAL = (const LAS float*)(F.lds + RING_OFF + BAL_OFF); float* LA = F.LAbuf;
    asm volatile("" : "+s"(WAL), "+s"(BAL));
    float z[4][8];
#pragma unroll
    for (int i = 0; i < 8; ++i) { const float bb = BAL[F.lane + 64 * i];
#pragma unroll
        for (int r = 0; r < 4; ++r) z[r][i] = bb; }
#pragma unroll
    for (int rr = 0; rr < 16; ++rr) { float a[4];
#pragma unroll
        for (int r = 0; r < 4; ++r) a[r] = scr[r * 16 + rr];
#pragma unroll
        for (int i = 0; i < 8; ++i) { const float w_ = WAL[rr * 512 + F.lane + 64 * i];
#pragma unroll
            for (int r = 0; r < 4; ++r) z[r][i] += a[r] * w_; }
        __builtin_amdgcn_sched_barrier(0); }
#pragma unroll
    for (int r = 0; r < 4; ++r) {
#pragma unroll
        for (int i = 0; i < 8; ++i) { const float zz = z[r][i]; const float ls = fminf(zz, 0.f) - __logf(1.0f + __expf(-fabsf(zz)));
            LA[(size_t)(m0 + r) * 512 + F.lane + 64 * i] = __expf(ls * (1.0f / 16.0f)); }
        __builtin_amdgcn_sched_barrier(0); }
    LDS_WAIT(); asm volatile("" ::: "memory");
}
__device__ __forceinline__ void phase_r0(Frame& F, const float* xin) {
    LAS float* scr = (LAS float*)(F.lds + RING_OFF) + F.wave * 256;
    load_walpha(F, 0);
    const int gstep = F.G * NWAVES; int gi = F.vcu * NWAVES + F.wave; Row4 x[4];
    if (gi < NTOK / 4) {
#pragma unroll
        for (int r = 0; r < 4; ++r) row_load(x[r], xin + (size_t)(4 * gi + r) * 1024, F.lane); }
    for (; gi < NTOK / 4; gi += gstep) { const int m0 = 4 * gi;
#pragma unroll
        for (int r = 0; r < 4; ++r) row_store(x[r], F.xst + (size_t)(m0 + r) * 1024, F.lane);
        __builtin_amdgcn_sched_barrier(0);
        rows4_mod1(F, x, m0, 0, scr, (gi + gstep < NTOK / 4) ? xin + (size_t)(4 * (gi + gstep)) * 1024 : nullptr); }
}
__device__ __forceinline__ void phase_r1(Frame& F, int l) {
    LAS float* scr = (LAS float*)(F.lds + RING_OFF) + F.wave * 256;
    const float* g1 = F.prm + PO_LN1G + l * 1024; const float* b1 = F.prm + PO_LN1B + l * 1024; const float* RWT = (const float*)(F.ws + WS_RWT) + (size_t)l * 36 * 1024;
    const float* brg = F.prm + PO_BRG + l * 4; const float* bre = F.prm + PO_BRE + l * 32;
    LAS unsigned* LCNT = (LAS unsigned*)(F.lds + TAB_CNT); LAS unsigned* BASEW = (LAS unsigned*)(F.lds + TAB_BASE); LAS unsigned* TOKBUF = (LAS unsigned*)(F.lds + TAB_IDX);
    { const GAS f32x4* src = (const GAS f32x4*)(RWT + 4 * 1024); LAS f32x4* dst = (LAS f32x4*)(F.lds + RING_OFF + 8192);
      for (int i = F.tid; i < 8192; i += NTHREADS) dst[i] = src[i]; }
    const LAS f32x4* WRE = (const LAS f32x4*)(F.lds + RING_OFF + 8192);
    if (F.tid < 32) LCNT[F.tid] = 0u; for (int i = F.tid; i < 256; i += NTHREADS) TOKBUF[i * 8] = 0xffffffffu;
    __syncthreads();
    int giter = 0;
    gu32* cnt = F.ctl + CW_CNT + l * 32 * 64 + (F.dry ? 16384 : 0); int* LIST = (int*)(F.ws + (F.dry ? WS_SSQ : WS_LIST)); unsigned* TI = (unsigned*)(F.ws + (F.dry ? WS_SSQ + 4 * MiB : WS_TOKINFO));
    const int gstep = F.G * NWAVES; int gi = F.vcu * NWAVES + F.wave; Row4 x[4];
    if (gi < NTOK / 4) {
#pragma unroll
        for (int r = 0; r < 4; ++r) row_load(x[r], F.out + (size_t)(4 * gi + r) * 1024, F.lane); }
    for (; gi < NTOK / 4; gi += gstep, ++giter) { const int m0 = 4 * gi, b = m0 >> 12;
        const float* ada = (const float*)(F.ws + WS_ADA) + ((size_t)l * 8 + b) * 6144;
#pragma unroll
        for (int r = 0; r < 4; ++r) { row_standardize(x[r]); row_affine(x[r], g1, b1, false, F.lane); if (F.dry < 3) row_store(x[r], F.xst + (size_t)(m0 + r) * 1024, F.lane);
            row_standardize(x[r]); row_affine(x[r], ada + 4 * 1024, ada + 3 * 1024, true, F.lane); if (F.dry < 3) row_store_bf16(x[r], F.Ubuf + (size_t)(m0 + r) * 1024, F.lane); __builtin_amdgcn_sched_barrier(0); }
        if (F.dry >= 2) { if (F.dry == 3) { float q_ = 0.f;
#pragma unroll
                for (int r = 0; r < 4; ++r) q_ += x[r][0].x; if (q_ == 123.456f) scr[0] = q_; }
            if (gi + gstep < NTOK / 4) {
#pragma unroll
                for (int r = 0; r < 4; ++r) row_load(x[r], F.out + (size_t)(4 * (gi + gstep) + r) * 1024, F.lane); }
            continue; }
        const float vg = rows4_proj<4>(x, (const GAS f32x4*)RWT, F.lane);
        __builtin_amdgcn_sched_barrier(0);
        const float va = rows4_proj<16>(x, WRE, F.lane);
        __builtin_amdgcn_sched_barrier(0);
        const float vb = rows4_proj<16>(x, WRE + 16 * 256, F.lane);
        __builtin_amdgcn_sched_barrier(0);
        if (gi + gstep < NTOK / 4) {
#pragma unroll
            for (int r = 0; r < 4; ++r) row_load(x[r], F.out + (size_t)(4 * (gi + gstep) + r) * 1024, F.lane); }
        __builtin_amdgcn_sched_barrier(0);
        if (F.dry == 4) { if (vg + va + vb == 123.456f) scr[0] = vg; continue; }
        { const int i4 = idx4(F.lane), i16 = idx16(F.lane); scr[(i4 >> 2) * 40 + (i4 & 3)] = vg; scr[(i16 >> 4) * 40 + 4 + (i16 & 15)] = va; scr[(i16 >> 4) * 40 + 20 + (i16 & 15)] = vb; }
        LDS_WAIT(); asm volatile("" ::: "memory");
        if (F.lane < 4) { const LAS float* s = scr + F.lane * 40; const int m = m0 + F.lane;
            float gl[4];
#pragma unroll
            for (int j = 0; j < 4; ++j) gl[j] = s[j] + brg[j];
            int gidx = 0; float gmax = gl[0];
#pragma unroll
            for (int j = 1; j < 4; ++j) if (gl[j] > gmax) { gmax = gl[j]; gidx = j; }
            float den = 0.f;
#pragma unroll
            for (int j = 0; j < 4; ++j) den += __expf(gl[j] - gmax);
            const float gw = 1.0f / den;
            float el[8];
#pragma unroll
            for (int j = 0; j < 8; ++j) el[j] = s[4 + gidx * 8 + j] + bre[gidx * 8 + j];
            int i0 = 0; float v0 = el[0];
#pragma unroll
            for (int j = 1; j < 8; ++j) if (el[j] > v0) { v0 = el[j]; i0 = j; }
            int i1 = -1; float v1 = -INFINITY;
#pragma unroll
            for (int j = 0; j < 8; ++j) if (j != i0 && el[j] > v1) { v1 = el[j]; i1 = j; }
            if (i1 < 0) i1 = (i0 + 1) & 7;
            const float ex = __expf(v1 - v0), inv = 1.0f / (1.0f + ex); const float w0 = inv * gw, w1 = ex * inv * gw;
            const int e0 = gidx * 8 + i0, e1 = gidx * 8 + i1;
            const unsigned lp0 = __hip_atomic_fetch_add(LCNT + e0, 1u, __ATOMIC_RELAXED, __HIP_MEMORY_SCOPE_WORKGROUP), lp1 = __hip_atomic_fetch_add(LCNT + e1, 1u, __ATOMIC_RELAXED, __HIP_MEMORY_SCOPE_WORKGROUP);
            const int slot = F.wave * 32 + (giter & 7) * 4 + F.lane;
            *(LAS v4u*)(TOKBUF + slot * 8) = (v4u){(unsigned)m, (unsigned)e0 | ((unsigned)e1 << 8), lp0, lp1}; TOKBUF[slot * 8 + 4] = __float_as_uint(w0); TOKBUF[slot * 8 + 5] = __float_as_uint(w1);
        }
        LDS_WAIT(); asm volatile("" ::: "memory");
    }
    __syncthreads();
    if (F.tid < 32) BASEW[F.tid] = __hip_atomic_fetch_add(cnt + F.tid * 64, LCNT[F.tid], RLX_AGENT);
    __syncthreads();
    if (F.tid < 256) { const v4u tk = *(const LAS v4u*)(TOKBUF + F.tid * 8);
        if (tk.x != 0xffffffffu) { const unsigned m = tk.x, e0 = tk.y & 255u, e1 = tk.y >> 8, p0 = BASEW[e0] + tk.z, p1 = BASEW[e1] + tk.w;
            LIST[(size_t)e0 * LISTCAP + p0] = (int)m; LIST[(size_t)e1 * LISTCAP + p1] = (int)m;
            *(GAS v4u*)(TI + (size_t)m * 8) = (v4u){e0, p0, e1, p1}; *(GAS v4u*)(TI + (size_t)m * 8 + 4) = (v4u){TOKBUF[F.tid * 8 + 4], TOKBUF[F.tid * 8 + 5], 0u, 0u}; } }
    __syncthreads();
}
__device__ __forceinline__ void moe_tables(Frame& F, int l) {
    LAS int* CNT = (LAS int*)(F.lds + TAB_CNT); LAS int* BASE = (LAS int*)(F.lds + TAB_BASE);
    if (F.tid < 32) CNT[F.tid] = (int)__hip_atomic_load(F.ctl + CW_CNT + (l * 32 + F.tid) * 64, RLX_AGENT);
    __syncthreads();
    if (F.tid == 0) { int a = 0; for (int e = 0; e < 32; ++e) { BASE[e] = a; a += (CNT[e] + 255) >> 8; } BASE[32] = a; }
    __syncthreads();
}
__device__ __forceinline__ void phase_r2(Frame& F, int l) {
    LAS float* scr = (LAS float*)(F.lds + RING_OFF) + F.wave * 256; const LAS int* BASE = (const LAS int*)(F.lds + TAB_BASE);
    if (l + 1 < DEPTH) load_walpha(F, l + 1);
    const float* g2 = F.prm + PO_LN2G + l * 1024; const float* b2 = F.prm + PO_LN2B + l * 1024; const unsigned* TI = (const unsigned*)(F.ws + WS_TOKINFO); const bf16* YB = (const bf16*)(F.ws + WS_YB);
    const int gstep = F.G * NWAVES;
    for (int gi = F.vcu * NWAVES + F.wave; gi < NTOK / 4; gi += gstep) { const int m0 = 4 * gi, b = m0 >> 12; Row4 x[4];
#pragma unroll
        for (int r = 0; r < 4; ++r) row_load(x[r], F.out + (size_t)(m0 + r) * 1024, F.lane);
        const float* gate = (const float*)(F.ws + WS_ADA) + ((size_t)l * 8 + b) * 6144 + 5 * 1024;
        v4u ta[4]; float w0[4], w1[4];
#pragma unroll
        for (int r = 0; r < 4; ++r) { ta[r] = *(const GAS v4u*)(TI + (size_t)(m0 + r) * 8); const v4u tb = *(const GAS v4u*)(TI + (size_t)(m0 + r) * 8 + 4); w0[r] = __uint_as_float(tb.x); w1[r] = __uint_as_float(tb.y); }
        unsigned long long ya_[4][4], yc_[4][4];
#pragma unroll
        for (int r = 0; r < 4; ++r) { const size_t r0 = (size_t)BASE[ta[r].x & 31] * 256 + ta[r].y, r1 = (size_t)BASE[ta[r].z & 31] * 256 + ta[r].w;
            const GAS unsigned long long* y0 = (const GAS unsigned long long*)(YB + r0 * 1024) + F.lane; const GAS unsigned long long* y1 = (const GAS unsigned long long*)(YB + r1 * 1024) + F.lane;
#pragma unroll
            for (int j = 0; j < 4; ++j) { ya_[r][j] = y0[64 * j]; yc_[r][j] = y1[64 * j]; } }
        __builtin_amdgcn_sched_barrier(0);
#pragma unroll
        for (int r = 0; r < 4; ++r) { const int m = m0 + r;
#pragma unroll
            for (int j = 0; j < 4; ++j) { const unsigned long long a = ya_[r][j], c = yc_[r][j]; const f32x4 gv = *((const GAS f32x4*)gate + F.lane + 64 * j);
                const f32x4 ya = (f32x4){bflo((unsigned)a), bfhi((unsigned)a), bflo((unsigned)(a >> 32)), bfhi((unsigned)(a >> 32))};
                const f32x4 yc = (f32x4){bflo((unsigned)c), bfhi((unsigned)c), bflo((unsigned)(c >> 32)), bfhi((unsigned)(c >> 32))};
                x[r][j] = x[r][j] * DN_ALPHA + gv * (ya * w0[r] + yc * w1[r]); }
            row_standardize(x[r]); row_affine(x[r], g2, b2, false, F.lane); row_store(x[r], F.xst + (size_t)m * 1024, F.lane); __builtin_amdgcn_sched_barrier(0); }
        if (l + 1 < DEPTH) rows4_mod1(F, x, m0, l + 1, scr, nullptr);
    }
}
typedef short s16x8 __attribute__((ext_vector_type(8)));
#define MFMA16(a, b, c) __builtin_amdgcn_mfma_f32_16x16x32_bf16((a), (b), (c), 0, 0, 0)
struct GlaRegs { v4u rq[2], rk[2]; float rl[16]; unsigned long long vr; };
__device__ __forceinline__ void phase_gla(Frame& F, const int glav) {
    constexpr int QK0_OFF = 0, QK1_OFF = 16384, LAR_OFF = 32768, KLT_OFF = 65536, VT_OFF = 83968  , SBT_OFF = 93184, ATT_OFF = 101888, TOT_OFF = 111104, DEC_OFF = 113152;
    constexpr int QS = 272, TS = 144;
    LAS unsigned char* L = F.lds + RING_OFF;
    LAS float* TOT = (LAS float*)(L + TOT_OFF); LAS float* DEC = (LAS float*)(L + DEC_OFF);
    const int tid = F.tid, lane = F.lane, w = F.wave, k = tid & 127, tg = tid >> 7, fr = lane & 15, fq = lane >> 4;
    const bf16* GQ = (const bf16*)(F.ws + WS_GQ); const bf16* GK = (const bf16*)(F.ws + WS_GK); const bf16* GV = (const bf16*)(F.ws + WS_GV);
    const float* LA = (const float*)(F.ws + WS_LA); bf16* OB = (bf16*)(F.ws + WS_OB); float* SSQ = (float*)(F.ws + WS_SSQ);
    const int cr = tid >> 4, cc = tid & 15;
    const int qk_dst = cr * 256 + ((cc ^ (cr & 15)) << 4);
    const int kc = k >> 3, kb2 = (k & 7) * 2;
    for (int item = F.vcu; item < 256; item += F.G) {
        const int s = item & 7, hg = (item >> 3) & 3, b = item >> 5; const size_t row0 = (size_t)b * SEQ;
        const bf16* gq = GQ + (row0 + cr) * 512 + hg * 128 + cc * 8; const bf16* gk = GK + (row0 + cr) * 512 + hg * 128 + cc * 8; const float* la = LA + (row0 + tg * 16) * 512 + hg * 128 + k;
        const bf16* gv = GV + (row0 + (tid >> 3)) * 1024 + hg * 256 + s * 32 + (tid & 7) * 4;
        bf16* ob = OB + row0 * 1024 + hg * 256 + s * 32; float* ssq = SSQ + row0 * 64 + hg * 16 + s * 2;
        for (int i = tid; i < 8704 / 4; i += NTHREADS) ((LAS unsigned*)(L + SBT_OFF))[i] = 0u;
        f32x4 accS[2]; accS[0] = (f32x4){0.f, 0.f, 0.f, 0.f}; accS[1] = accS[0];
        GlaRegs RA, RB;
#define GLA_BAR() asm volatile("s_waitcnt lgkmcnt(0)\n\ts_barrier" ::: "memory")
#define GLA_LOAD(R_, c_) do { const size_t o_ = (size_t)(c_) * 64; R_.rq[0] = *(const GAS v4u*)(gq + o_ * 512); R_.rq[1] = *(const GAS v4u*)(gq + (o_ + 32) * 512); R_.rk[0] = *(const GAS v4u*)(gk + o_ * 512); R_.rk[1] = *(const GAS v4u*)(gk + (o_ + 32) * 512); \
        _Pragma("unroll") for (int i_ = 0; i_ < 16; ++i_) R_.rl[i_] = *(const GAS float*)(la + (o_ + i_) * 512); R_.vr = *(const GAS unsigned long long*)(gv + o_ * 1024); } while (0)
        GLA_LOAD(RA, 0); GLA_LOAD(RB, 1);
        __syncthreads();
        auto chunk = [&](const int c, GlaRegs& R) {
            *(LAS v4u*)(L + QK0_OFF + qk_dst) = R.rq[0]; *(LAS v4u*)(L + QK0_OFF + qk_dst + 8192) = R.rq[1]; *(LAS v4u*)(L + QK1_OFF + qk_dst) = R.rk[0]; *(LAS v4u*)(L + QK1_OFF + qk_dst + 8192) = R.rk[1];
            const int vto = VT_OFF + (c & 1) * 4608;
            { const int t = tid >> 3, w0 = (tid & 7) * 4;
#pragma unroll
              for (int i = 0; i < 4; ++i) *(LAS bf16*)(L + vto + (w0 + i) * TS + t * 2) = (bf16)((R.vr >> (16 * i)) & 0xffffu); }
            float cs[16]; { float run = 1.f;
#pragma unroll
                for (int i = 0; i < 16; ++i) { run *= R.rl[i]; cs[i] = run; }
                TOT[tg * 128 + k] = run; }
            if (c + 2 < 64 && !(glav & 8)) GLA_LOAD(R, c + 2);
            GLA_BAR();
            if (!(glav & 1)) { float off = 1.f, last = 1.f;
#pragma unroll
              for (int g = 0; g < 4; ++g) { const float tv = TOT[g * 128 + k]; if (g < tg) off *= tv; last *= tv; }
              unsigned klw[8]; float klp = 0.f;
#pragma unroll
              for (int i = 0; i < 16; ++i) { const float e1 = cs[i] * off, e2 = __builtin_amdgcn_rcpf(e1), e3 = last * e2;
                  const int eo = (tg * 16 + i) * 256 + ((kc ^ i) << 4) + kb2;
                  const float qf = __uint_as_float((unsigned)(*(const LAS bf16*)(L + QK0_OFF + eo)) << 16), kf = __uint_as_float((unsigned)(*(const LAS bf16*)(L + QK1_OFF + eo)) << 16);
                  const unsigned qk = pg8::cvt_pk_bf16_c(qf * e1, kf * e2);
                  *(LAS bf16*)(L + QK0_OFF + eo) = (bf16)(qk & 0xffffu); *(LAS bf16*)(L + QK1_OFF + eo) = (bf16)(qk >> 16);
                  if (i & 1) klw[i >> 1] = pg8::cvt_pk_bf16_c(klp, kf * e3); else klp = kf * e3; }
              *(LAS v4u*)(L + KLT_OFF + k * TS + tg * 32) = (v4u){klw[0], klw[1], klw[2], klw[3]}; *(LAS v4u*)(L + KLT_OFF + k * TS + tg * 32 + 16) = (v4u){klw[4], klw[5], klw[6], klw[7]};
              if (tg == 0) DEC[k] = last;
            }
            GLA_BAR();
            const int ti = w >> 1, wi = w & 1; f32x4 acco = (f32x4){0.f, 0.f, 0.f, 0.f};
            if (!(glav & 2)) { s16x8 aq[4];
#pragma unroll
              for (int kk = 0; kk < 4; ++kk) aq[kk] = *(const LAS s16x8*)(L + QK0_OFF + (ti * 16 + fr) * 256 + (((kk * 4 + fq) ^ fr) << 4));
#pragma unroll
              for (int s2 = 0; s2 < 2; ++s2) { const int si = wi * 2 + s2; f32x4 a4 = (f32x4){0.f, 0.f, 0.f, 0.f};
                  if (si <= ti) {
#pragma unroll
                      for (int kk = 0; kk < 4; ++kk) { const s16x8 bb = *(const LAS s16x8*)(L + QK1_OFF + (si * 16 + fr) * 256 + (((kk * 4 + fq) ^ fr) << 4)); a4 = MFMA16(aq[kk], bb, a4); } }
#pragma unroll
                  for (int r = 0; r < 4; ++r) { const int t = ti * 16 + fq * 4 + r, sc = si * 16 + fr; const float v = (sc <= t) ? a4[r] : 0.f; *(LAS bf16*)(L + ATT_OFF + t * TS + sc * 2) = (bf16)f2bf(v); } }
#pragma unroll
              for (int kk = 0; kk < 4; ++kk) { const s16x8 bb = *(const LAS s16x8*)(L + SBT_OFF + (wi * 16 + fr) * QS + (kk * 32 + 8 * fq) * 2); acco = MFMA16(aq[kk], bb, acco); }
            }
            GLA_BAR();
            if (!(glav & 4)) {
              s16x8 aat[2], bvo[2], akl[2], bv0[2], bv1[2];
#pragma unroll
              for (int kk = 0; kk < 2; ++kk) { aat[kk] = *(const LAS s16x8*)(L + ATT_OFF + (ti * 16 + fr) * TS + (kk * 32 + 8 * fq) * 2); bvo[kk] = *(const LAS s16x8*)(L + vto + (wi * 16 + fr) * TS + (kk * 32 + 8 * fq) * 2);
                  akl[kk] = *(const LAS s16x8*)(L + KLT_OFF + (w * 16 + fr) * TS + (kk * 32 + 8 * fq) * 2); bv0[kk] = *(const LAS s16x8*)(L + vto + fr * TS + (kk * 32 + 8 * fq) * 2); bv1[kk] = *(const LAS s16x8*)(L + vto + (16 + fr) * TS + (kk * 32 + 8 * fq) * 2); }
              const f32x4 dv = *(const LAS f32x4*)(DEC + w * 16 + fq * 4);
              acco = MFMA16(aat[0], bvo[0], acco); accS[0] = accS[0] * dv; accS[1] = accS[1] * dv;
              accS[0] = MFMA16(akl[0], bv0[0], accS[0]); accS[1] = MFMA16(akl[0], bv1[0], accS[1]);
              acco = MFMA16(aat[1], bvo[1], acco);
              accS[0] = MFMA16(akl[1], bv0[1], accS[0]); accS[1] = MFMA16(akl[1], bv1[1], accS[1]);
              { const unsigned o01 = pg8::cvt_pk_bf16_c(acco[0], acco[1]), o23 = pg8::cvt_pk_bf16_c(acco[2], acco[3]); bf16* obp = ob + (size_t)(c * 64 + ti * 16 + fq * 4) * 1024 + wi * 16 + fr;
                if (!(glav & 16)) { obp[0] = (bf16)(o01 & 0xffffu); obp[1024] = (bf16)(o01 >> 16); obp[2048] = (bf16)(o23 & 0xffffu); obp[3072] = (bf16)(o23 >> 16); } }
#pragma unroll
              for (int w2 = 0; w2 < 2; ++w2)
                  *(LAS unsigned long long*)(L + SBT_OFF + (w2 * 16 + fr) * QS + (w * 16 + fq * 4) * 2) = (unsigned long long)pg8::cvt_pk_bf16_c(accS[w2][0], accS[w2][1]) | ((unsigned long long)pg8::cvt_pk_bf16_c(accS[w2][2], accS[w2][3]) << 32);
#pragma unroll
              for (int r = 0; r < 4; ++r) { const int t = c * 64 + ti * 16 + fq * 4 + r;
                  float q = acco[r] * acco[r]; q = dpp_add(q, 0); q = dpp_add(q, 1); q = dpp_add(q, 2); q = dpp_add(q, 3);
                  if (fr == 0 && !(glav & 32)) ssq[(size_t)t * 64 + wi] = q; }
            }
        };
        for (int c = 0; c < 64; c += 2) { chunk(c, RA); chunk(c + 1, RB); }
#undef GLA_LOAD
#undef GLA_BAR
        __syncthreads();
    }
}
__device__ __forceinline__ size_t gla_fp16k(size_t rowg0, int hg, int p) { return ((rowg0 + (size_t)(p >> 4)) * 512 + hg * 128) * 2 + (size_t)(p & 15) * 16; }
__device__ __forceinline__ size_t gla_fp32k(size_t rowg0, int hg, int p) { return ((rowg0 + (size_t)(p >> 5)) * 1024 + hg * 256) * 2 + (size_t)(p & 31) * 16; }
__device__ __forceinline__ void phase_gla_a(Frame& F) {
    constexpr int QK0_OFF = 0, QK1_OFF = 16384, KLT_OFF = 32768, VT_OFF = 51200, ATT_OFF = 88064, TOT_OFF = 97280, DEC_OFF = 99328, TS = 144;
    LAS unsigned char* L = F.lds + RING_OFF;
    LAS float* TOT = (LAS float*)(L + TOT_OFF); LAS float* DEC = (LAS float*)(L + DEC_OFF);
    const int tid = F.tid, lane = F.lane, w = F.wave, k = tid & 127, tg = tid >> 7, fr = lane & 15, fq = lane >> 4;
    unsigned char* GQb = F.ws + WS_GQ; unsigned char* GKb = F.ws + WS_GK; unsigned char* GVb = F.ws + WS_GV; unsigned char* LAb = F.ws + WS_LA; float* DECG = (float*)(F.ws + WS_GDEC);
    const int cr = tid >> 4, cc = tid & 15, qk_dst = cr * 256 + ((cc ^ (cr & 15)) << 4), kc = k >> 3, kb2 = (k & 7) * 2;
    v4u rq[2], rk[2], rv[4]; float rl[16];
#define GLA_A_LOAD(u_) do { const int c_ = (u_) & 63, hg_ = ((u_) >> 6) & 3, b_ = (u_) >> 8; const size_t rg_ = (size_t)b_ * SEQ + (size_t)c_ * 64; \
        const GAS unsigned char* gq = (const GAS unsigned char*)GQb + ((rg_ + cr) * 512 + hg_ * 128 + cc * 8) * 2; const GAS unsigned char* gk = (const GAS unsigned char*)GKb + ((rg_ + cr) * 512 + hg_ * 128 + cc * 8) * 2; \
        rq[0] = *(const GAS v4u*)gq; rq[1] = *(const GAS v4u*)(gq + 32 * 1024); rk[0] = *(const GAS v4u*)gk; rk[1] = *(const GAS v4u*)(gk + 32 * 1024); \
        const GAS float* la = (const GAS float*)LAb + (rg_ + tg * 16) * 512 + hg_ * 128 + k; \
        _Pragma("unroll") for (int i = 0; i < 16; ++i) rl[i] = la[(size_t)i * 512]; \
        _Pragma("unroll") for (int i = 0; i < 4; ++i) { const int p = tid + 512 * i; rv[i] = *(const GAS v4u*)((const GAS unsigned char*)GVb + gla_fp32k(rg_, hg_, p)); } } while (0)
    __syncthreads();
    if (F.vcu < 2048) GLA_A_LOAD(F.vcu);
    for (int unit = F.vcu; unit < 2048; unit += F.G) {
        const int c = unit & 63, hg = (unit >> 6) & 3, b = unit >> 8; const size_t rowg0 = (size_t)b * SEQ + (size_t)c * 64;
        *(LAS v4u*)(L + QK0_OFF + qk_dst) = rq[0]; *(LAS v4u*)(L + QK0_OFF + qk_dst + 8192) = rq[1]; *(LAS v4u*)(L + QK1_OFF + qk_dst) = rk[0]; *(LAS v4u*)(L + QK1_OFF + qk_dst + 8192) = rk[1];
#pragma unroll
        for (int i = 0; i < 4; ++i) { const int p = tid + 512 * i, t = p >> 5, cp = p & 31; const int tsw = t ^ (8 * (cp & 7));
            const unsigned wd[4] = {rv[i].x, rv[i].y, rv[i].z, rv[i].w};
#pragma unroll
            for (int e = 0; e < 8; ++e) *(LAS bf16*)(L + VT_OFF + (8 * cp + e) * TS + tsw * 2) = (bf16)((wd[e >> 1] >> (16 * (e & 1))) & 0xffffu); }
        float cs[16]; { float run = 1.f;
#pragma unroll
            for (int i = 0; i < 16; ++i) { run *= rl[i]; cs[i] = run; }
            TOT[tg * 128 + k] = run; }
        if (unit + F.G < 2048) GLA_A_LOAD(unit + F.G);
        asm volatile("s_waitcnt lgkmcnt(0)\n\ts_barrier" ::: "memory");
        { float off = 1.f, last = 1.f;
#pragma unroll
          for (int g = 0; g < 4; ++g) { const float tv = TOT[g * 128 + k]; if (g < tg) off *= tv; last *= tv; }
          unsigned klw[8]; float klp = 0.f;
#pragma unroll
          for (int i = 0; i < 16; ++i) { const float e1 = cs[i] * off, e2 = __builtin_amdgcn_rcpf(e1), e3 = last * e2;
              const int eo = (tg * 16 + i) * 256 + ((kc ^ i) << 4) + kb2;
              const float qf = __uint_as_float((unsigned)(*(const LAS bf16*)(L + QK0_OFF + eo)) << 16), kf = __uint_as_float((unsigned)(*(const LAS bf16*)(L + QK1_OFF + eo)) << 16);
              const unsigned qk = pg8::cvt_pk_bf16_c(qf * e1, kf * e2);
              *(LAS bf16*)(L + QK0_OFF + eo) = (bf16)(qk & 0xffffu); *(LAS bf16*)(L + QK1_OFF + eo) = (bf16)(qk >> 16);
              if (i & 1) klw[i >> 1] = pg8::cvt_pk_bf16_c(klp, kf * e3); else klp = kf * e3; }
          *(LAS v4u*)(L + KLT_OFF + k * TS + tg * 32) = (v4u){klw[0], klw[1], klw[2], klw[3]}; *(LAS v4u*)(L + KLT_OFF + k * TS + tg * 32 + 16) = (v4u){klw[4], klw[5], klw[6], klw[7]};
          if (tg == 0) DEC[k] = last; }
        asm volatile("s_waitcnt lgkmcnt(0)\n\ts_barrier" ::: "memory");
        { const int ti = w >> 1, wi = w & 1; s16x8 aq[4];
#pragma unroll
          for (int kk = 0; kk < 4; ++kk) aq[kk] = *(const LAS s16x8*)(L + QK0_OFF + (ti * 16 + fr) * 256 + (((kk * 4 + fq) ^ fr) << 4));
#pragma unroll
          for (int s2 = 0; s2 < 2; ++s2) { const int si = wi * 2 + s2; f32x4 a4 = (f32x4){0.f, 0.f, 0.f, 0.f};
              if (si <= ti) {
#pragma unroll
                  for (int kk = 0; kk < 4; ++kk) { const s16x8 bb = *(const LAS s16x8*)(L + QK1_OFF + (si * 16 + fr) * 256 + (((kk * 4 + fq) ^ fr) << 4)); a4 = MFMA16(aq[kk], bb, a4); } }
#pragma unroll
              for (int r = 0; r < 4; ++r) { const int t = ti * 16 + fq * 4 + r, sc = si * 16 + fr; const float v = (sc <= t) ? a4[r] : 0.f; *(LAS bf16*)(L + ATT_OFF + t * TS + sc * 2) = (bf16)f2bf(v); } } }
#pragma unroll
        for (int i = 0; i < 2; ++i) { const int p = tid + 512 * i;
            const int l_ = p & 63, t = (p >> 8) * 16 + (l_ & 15), k0 = ((p >> 6) & 3) * 32 + 4 * (l_ >> 4);
            const unsigned long long lo = *(const LAS unsigned long long*)(L + QK0_OFF + t * 256 + (((k0 >> 3) ^ (t & 15)) << 4) + (k0 & 7) * 2);
            const unsigned long long hi = *(const LAS unsigned long long*)(L + QK0_OFF + t * 256 + ((((k0 + 16) >> 3) ^ (t & 15)) << 4) + (k0 & 7) * 2);
            *(GAS v4u*)((GAS unsigned char*)GQb + gla_fp16k(rowg0, hg, p)) = (v4u){(unsigned)lo, (unsigned)(lo >> 32), (unsigned)hi, (unsigned)(hi >> 32)}; }
#pragma unroll
        for (int i = 0; i < 2; ++i) { const int p = tid + 512 * i;
            const int l_ = p & 63, kk = (p >> 7) * 16 + (l_ & 15), t0 = ((p >> 6) & 1) * 32 + 8 * (l_ >> 4);
            *(GAS v4u*)((GAS unsigned char*)GKb + gla_fp16k(rowg0, hg, p)) = *(const LAS v4u*)(L + KLT_OFF + kk * TS + t0 * 2); }
#pragma unroll
        for (int i = 0; i < 4; ++i) { const int p = tid + 512 * i;
            const int l_ = p & 63, wv = (p >> 7) * 16 + (l_ & 15), t0 = (((p >> 6) & 1) * 32 + 8 * (l_ >> 4)) ^ (8 * ((wv >> 3) & 7));
            *(GAS v4u*)((GAS unsigned char*)GVb + gla_fp32k(rowg0, hg, p)) = *(const LAS v4u*)(L + VT_OFF + wv * TS + t0 * 2); }
        if (tid < 128) DECG[(size_t)unit * 128 + tid] = DEC[tid];
        asm volatile("s_waitcnt lgkmcnt(0)\n\ts_barrier" ::: "memory");
        { const int ti = w >> 1; s16x8 aat[2];
#pragma unroll
          for (int kk = 0; kk < 2; ++kk) aat[kk] = *(const LAS s16x8*)(L + ATT_OFF + (ti * 16 + fr) * TS + (kk * 32 + 8 * fq) * 2);
#pragma unroll
          for (int j = 0; j < 8; ++j) { const int wt = (w & 1) * 8 + j, wv = wt * 16 + fr; f32x4 a4 = (f32x4){0.f, 0.f, 0.f, 0.f};
#pragma unroll
              for (int kk = 0; kk < 2; ++kk) { const s16x8 bb = *(const LAS s16x8*)(L + VT_OFF + wv * TS + (((kk * 32 + 8 * fq) ^ (8 * ((wv >> 3) & 7))) * 2)); a4 = MFMA16(aat[kk], bb, a4); }
              const unsigned long long pk = (unsigned long long)pg8::cvt_pk_bf16_c(a4[0], a4[1]) | ((unsigned long long)pg8::cvt_pk_bf16_c(a4[2], a4[3]) << 32);
              *(GAS unsigned long long*)((GAS unsigned char*)LAb + ((rowg0 + (size_t)(ti * 16 + wt)) * 512 + hg * 128) * 4 + (size_t)lane * 8) = pk; } }
        asm volatile("s_waitcnt lgkmcnt(0)\n\ts_barrier" ::: "memory");
    }
#undef GLA_A_LOAD
    __syncthreads();
}
__device__ __forceinline__ void phase_gla_b(Frame& F, const int gbv) {
    constexpr int SLOT = 37888, O_QEF = 0, O_KLF = 16384, O_VTF = 32768, O_DEC = 36864, PART_OFF = 3 * SLOT;
    static_assert(PART_OFF + 32768 <= RING_BYTES, "GB LDS map");
    LAS unsigned char* L = F.lds + RING_OFF;
    const int lane = F.lane, w = F.wave, fr = lane & 15, fq = lane >> 4, kq = w >> 1, wi = w & 1;
    const GAS unsigned char* GQb = (const GAS unsigned char*)(F.ws + WS_GQ); const GAS unsigned char* GKb = (const GAS unsigned char*)(F.ws + WS_GK); const GAS unsigned char* GVb = (const GAS unsigned char*)(F.ws + WS_GV);
    const GAS unsigned char* LAb = (const GAS unsigned char*)(F.ws + WS_LA); const GAS unsigned char* DECb = (const GAS unsigned char*)(F.ws + WS_GDEC); bf16* OB = (bf16*)(F.ws + WS_OB); float* SSQ = (float*)(F.ws + WS_SSQ);
    for (int item = F.vcu; item < 256; item += F.G) {
        const int s = item & 7, hg = (item >> 3) & 3, b = item >> 5, wt = 2 * s + wi; const size_t row0 = (size_t)b * SEQ;
        bf16* ob = OB + row0 * 1024 + hg * 256 + s * 32; float* ssq = SSQ + row0 * 64 + hg * 16 + s * 2;
        f32x4 accS[2]; accS[0] = (f32x4){0.f, 0.f, 0.f, 0.f}; accS[1] = accS[0];
        const GAS unsigned char* pbase[5]; unsigned pstride[5];
#pragma unroll
        for (int i = 0; i < 5; ++i) { const int j = (w + 8 * i < 37) ? w + 8 * i : 36;
            if (j < 16) { pbase[i] = GQb + gla_fp16k(row0, hg, j * 64 + lane); pstride[i] = 64u * 1024u; }
            else if (j < 32) { pbase[i] = GKb + gla_fp16k(row0, hg, (j - 16) * 64 + lane); pstride[i] = 64u * 1024u; }
            else if (j < 36) { pbase[i] = GVb + gla_fp32k(row0, hg, ((2 * s + ((j - 32) >> 1)) * 2 + ((j - 32) & 1)) * 64 + lane); pstride[i] = 64u * 2048u; }
            else { pbase[i] = DECb + ((size_t)((b * 4 + hg) * 64) * 128) * 4 + (size_t)(lane & 31) * 16; pstride[i] = 512u; } }
#define GLB_DMA(c_, slot_) do { _Pragma("unroll") for (int i_ = 0; i_ < 5; ++i_) \
            __builtin_amdgcn_global_load_lds((const GAS unsigned*)(pbase[i_] + (size_t)(c_) * pstride[i_]), (LAS unsigned*)(L + (slot_) * SLOT + ((w + 8 * i_ < 37) ? w + 8 * i_ : 36) * 1024), 16, 0, 0); } while (0)
        const GAS unsigned char* oib = LAb + ((row0 + (size_t)(kq * 16 + wt)) * 512 + hg * 128) * 4 + (size_t)lane * 8;
        __syncthreads();
        GLB_DMA(0, 0); GLB_DMA(1, 1);
        int slot = 0;
        for (int c = 0; c < 64; ++c) {
            if (c == 0) asm volatile("s_waitcnt vmcnt(5) lgkmcnt(0)\n\ts_barrier" ::: "memory"); else asm volatile("s_waitcnt vmcnt(13) lgkmcnt(0)\n\ts_barrier" ::: "memory");
            unsigned long long oic; { const GAS unsigned char* oip = oib + (size_t)c * (64 * 2048); asm volatile("global_load_dwordx2 %0, %1, off" : "=v"(oic) : "v"(oip) : "memory"); }
            if (!(gbv & 1)) { const int cn = (c + 2 < 64) ? c + 2 : 63; const int sn = (slot == 0) ? 2 : slot - 1; GLB_DMA(cn, sn); }
            if (gbv & 2) { slot = (slot == 2) ? 0 : slot + 1; asm volatile("s_barrier" ::: "memory"); continue; }
            const LAS unsigned char* S_ = L + slot * SLOT;
            s16x8 aqs[4], akl[2][2], bv[2]; f32x4 dv[2];
#pragma unroll
            for (int ti = 0; ti < 4; ++ti) aqs[ti] = *(const LAS s16x8*)(S_ + O_QEF + ((ti * 4 + kq) * 64 + lane) * 16);
#pragma unroll
            for (int e = 0; e < 2; ++e) { akl[e][0] = *(const LAS s16x8*)(S_ + O_KLF + (((2 * kq + e) * 2 + 0) * 64 + lane) * 16); akl[e][1] = *(const LAS s16x8*)(S_ + O_KLF + (((2 * kq + e) * 2 + 1) * 64 + lane) * 16);
                dv[e] = *(const LAS f32x4*)(S_ + O_DEC + ((2 * kq + e) * 16 + 4 * fq) * 4); bv[e] = *(const LAS s16x8*)(S_ + O_VTF + ((wi * 2 + e) * 64 + lane) * 16); }
            { const v4u bsw = (v4u){pg8::cvt_pk_bf16_c(accS[0][0], accS[0][1]), pg8::cvt_pk_bf16_c(accS[0][2], accS[0][3]), pg8::cvt_pk_bf16_c(accS[1][0], accS[1][1]), pg8::cvt_pk_bf16_c(accS[1][2], accS[1][3])};
              const s16x8 bs = __builtin_bit_cast(s16x8, bsw);
#pragma unroll
              for (int ti = 0; ti < 4; ++ti) { const f32x4 pt = MFMA16(aqs[ti], bs, ((f32x4){0.f, 0.f, 0.f, 0.f})); *(LAS f32x4*)(L + PART_OFF + (((ti * 2 + wi) * 4 + kq) * 64 + lane) * 16) = pt; } }
#pragma unroll
            for (int e = 0; e < 2; ++e) { accS[e] = accS[e] * dv[e]; accS[e] = MFMA16(akl[e][0], bv[0], accS[e]); accS[e] = MFMA16(akl[e][1], bv[1], accS[e]); }
            asm volatile("s_waitcnt lgkmcnt(0)\n\ts_barrier" ::: "memory");
            asm volatile("s_waitcnt vmcnt(5)" : "+v"(oic) :: "memory");
            f32x4 acco = (f32x4){bflo((unsigned)oic), bfhi((unsigned)oic), bflo((unsigned)(oic >> 32)), bfhi((unsigned)(oic >> 32))};
#pragma unroll
            for (int q2 = 0; q2 < 4; ++q2) acco = acco + *(const LAS f32x4*)(L + PART_OFF + (((kq * 2 + wi) * 4 + q2) * 64 + lane) * 16);
            { const unsigned o01 = pg8::cvt_pk_bf16_c(acco[0], acco[1]), o23 = pg8::cvt_pk_bf16_c(acco[2], acco[3]); bf16* obp = ob + (size_t)(c * 64 + kq * 16 + fq * 4) * 1024 + wi * 16 + fr;
              obp[0] = (bf16)(o01 & 0xffffu); obp[1024] = (bf16)(o01 >> 16); obp[2048] = (bf16)(o23 & 0xffffu); obp[3072] = (bf16)(o23 >> 16); }
#pragma unroll
            for (int r = 0; r < 4; ++r) { const int t = c * 64 + kq * 16 + fq * 4 + r;
                float q = acco[r] * acco[r]; q = dpp_add(q, 0); q = dpp_add(q, 1); q = dpp_add(q, 2); q = dpp_add(q, 3);
                if (fr == 0) ssq[(size_t)t * 64 + wi] = q; }
            slot = (slot == 2) ? 0 : slot + 1;
        }
#undef GLB_DMA
        asm volatile("s_waitcnt vmcnt(0) lgkmcnt(0)\n\ts_barrier" ::: "memory");
    }
}
__device__ __forceinline__ void unpack8(const v4u w, float* d) { d[0] = bflo(w.x); d[1] = bfhi(w.x); d[2] = bflo(w.y); d[3] = bfhi(w.y); d[4] = bflo(w.z); d[5] = bfhi(w.z); d[6] = bflo(w.w); d[7] = bfhi(w.w); }
__device__ __forceinline__ v4u pack8(const float* d) { v4u o; o.x = pk2(d[0], d[1]); o.y = pk2(d[2], d[3]); o.z = pk2(d[4], d[5]); o.w = pk2(d[6], d[7]); return o; }
__device__ __forceinline__ void phase_post(Frame& F, int l) {
    const float* lq1 = F.prm + PO_LQ1; const float* lk1 = F.prm + PO_LK1; const float* lq2 = F.prm + PO_LQ2; const float* lk2 = F.prm + PO_LK2; const float* diffg = F.prm + PO_DIFFG; const float* glag = F.prm + PO_GLAG;
    const int lane = F.lane;
    const float lam_init = 0.8f - 0.6f * expf(-0.3f * (float)l);
    const float d1 = lq1[l * 64 + lane] * lk1[l * 64 + lane], d2 = lq2[l * 64 + lane] * lk2[l * 64 + lane];
    const float lam = expf(wave_sum(d1)) - expf(wave_sum(d2)) + lam_init, osc = 1.0f - lam_init;
    float dgr[16], ggr[16];
#pragma unroll
    for (int i = 0; i < 16; ++i) { dgr[i] = diffg[l * 128 + 16 * (lane & 7) + i] * osc; ggr[i] = glag[l * 256 + 16 * (lane & 15) + i]; }
    const bf16* OP = (const bf16*)(F.ws + WS_OP); const bf16* OB = (const bf16*)(F.ws + WS_OB); const bf16* SG = (const bf16*)(F.ws + WS_SG); const float* SSQ = (const float*)(F.ws + WS_SSQ);
    bf16* OA2 = (bf16*)(F.ws + WS_OA2); bf16* OB2 = (bf16*)(F.ws + WS_OB2);
    const int mstep = F.G * NWAVES;
    for (int m = F.vcu * NWAVES + F.wave; m < NTOK; m += 2 * mstep) {
        v4u rp0[2][2], rp1[2][2], rb[2][2], rs[2][2]; f32x4 rq[2][4];
#pragma unroll
        for (int u = 0; u < 2; ++u) { const int mm = (m + u * mstep < NTOK) ? m + u * mstep : m;
            const GAS v4u* p0 = (const GAS v4u*)(OP + (size_t)mm * 2048 + 16 * lane); const GAS v4u* p1 = (const GAS v4u*)(OP + (size_t)mm * 2048 + 1024 + 16 * lane);
            const GAS v4u* pb = (const GAS v4u*)(OB + (size_t)mm * 1024 + 16 * lane); const GAS v4u* ps = (const GAS v4u*)(SG + (size_t)mm * 1024 + 16 * lane);
            const GAS f32x4* sp = (const GAS f32x4*)(SSQ + (size_t)mm * 64 + (lane >> 4) * 16);
            rp0[u][0] = p0[0]; rp0[u][1] = p0[1]; rp1[u][0] = p1[0]; rp1[u][1] = p1[1]; rb[u][0] = pb[0]; rb[u][1] = pb[1]; rs[u][0] = ps[0]; rs[u][1] = ps[1];
#pragma unroll
            for (int j = 0; j < 4; ++j) rq[u][j] = sp[j]; }
#pragma unroll
        for (int u = 0; u < 2; ++u) { const int mm = m + u * mstep; if (mm >= NTOK) break;
            float o0[16], o1[16], d[16];
            unpack8(rp0[u][0], o0); unpack8(rp0[u][1], o0 + 8); unpack8(rp1[u][0], o1); unpack8(rp1[u][1], o1 + 8);
            float ss = 0.f;
#pragma unroll
            for (int i = 0; i < 16; ++i) { d[i] = o0[i] - lam * o1[i]; ss += d[i] * d[i]; }
            ss = dpp_add(ss, 0); ss = dpp_add(ss, 1); ss = dpp_add(ss, 2);
            { const float r = 1.0f / sqrtf(ss * (1.0f / 128.0f) + LN_EPS);
#pragma unroll
              for (int i = 0; i < 16; ++i) d[i] = d[i] * r * dgr[i];
              GAS v4u* q = (GAS v4u*)(OA2 + (size_t)mm * 1024 + 16 * lane); q[0] = pack8(d); q[1] = pack8(d + 8); }
            unpack8(rb[u][0], o0); unpack8(rb[u][1], o0 + 8); unpack8(rs[u][0], o1); unpack8(rs[u][1], o1 + 8);
            { float sq = 0.f;
#pragma unroll
              for (int j = 0; j < 4; ++j) { const f32x4 v = rq[u][j]; sq += v.x; sq += v.y; sq += v.z; sq += v.w; }
              const float r = 1.0f / sqrtf(sq * (1.0f / 256.0f) + LN_EPS);
#pragma unroll
              for (int i = 0; i < 16; ++i) d[i] = o0[i] * r * ggr[i] * o1[i];
              GAS v4u* q = (GAS v4u*)(OB2 + (size_t)mm * 1024 + 16 * lane); q[0] = pack8(d); q[1] = pack8(d + 8); } }
    }
}
struct MoeOrder {
    const LAS int* BASE; int total4, G, c;
    __device__ __forceinline__ bool next(int i, pg8::Unit& u) const {
        const int Lx = i * G + c; if (Lx >= total4) return false;
        const int rt = Lx >> 2, pn = Lx & 3; int e = 0;
        for (int j = 1; j < 32; ++j) if (BASE[j] <= rt) e = j;
        e = __builtin_amdgcn_readfirstlane(e);
        u.pm = rt; u.pn = pn; u.pb = e * 4 + pn; return true;
    }
};

#ifndef PHMASK
#define PHMASK 0xFFFF
#endif
#ifndef REPMASK
#define REPMASK 0
#endif
#define REP(bit) for (int rep_ = 0; rep_ < ((REPMASK & (bit)) ? 2 : 1); ++rep_)
struct Args { const float* in[28]; float* out; unsigned char* ws; };
__global__ void __launch_bounds__(NTHREADS, 2) mk_fwd(Args args) {
    extern __shared__ __attribute__((aligned(16))) unsigned char lds[];
    Frame F;
    F.lds = (LAS unsigned char*)lds;
    F.tid = threadIdx.x; F.lane = F.tid & 63; F.wave = __builtin_amdgcn_readfirstlane(F.tid >> 6);
    F.G = gridDim.x; { const int bx = blockIdx.x; F.vcu = (F.G % 8 == 0) ? (bx % 8) * (F.G / 8) + bx / 8 : bx; }
    F.out = args.out; F.ws = args.ws; F.ctl = (gu32*)(args.ws + WS_CTL); F.prm = (const float*)(args.ws + WS_PRM);
    unsigned char* ws = args.ws;
    for (int u = F.tid; u < (LDS_BYTES - LDSCTL_OFF) / 4; u += NTHREADS) ((LAS unsigned*)(F.lds + LDSCTL_OFF))[u] = 0u;
    __syncthreads();
    volatile LAS unsigned* MISC = (volatile LAS unsigned*)(F.lds + MISC_OFF);
    XcdBarrier bar = xcd_barrier_post((unsigned*)(F.ctl + CW_BAR), MISC + 8);
    if ((REPMASK & 16384) && threadIdx.x == 0) MISC[21] = (unsigned)rt();
#ifndef BARSEL
#define BARSEL 0xFFF
#endif
#ifndef PSEL
#define PSEL 0
#endif
#ifndef DRYLVL
#define DRYLVL 1
#endif
#ifndef GLAV
#define GLAV 0
#endif
#ifndef G5_PAIR
#define G5_PAIR 1
#endif
#ifndef GLA_TWO_PHASE
#define GLA_TWO_PHASE 1
#endif
#define GRID_BAR(id_) do { const unsigned long long tb0_ = (REPMASK & (8192 | 16384)) ? rt() : 0ull; \
        if ((REPMASK & 16384) && ((PSEL >> (id_)) & 1) && threadIdx.x == 0) MISC[20] += (unsigned)tb0_ - MISC[21];     \
        GAS unsigned char* bw_ = (GAS unsigned char*)args.ws; asm volatile("" : "+s"(bw_)); unsigned bx_ = bar.x; asm volatile("" : "+s"(bx_)); XcdBarrier b_ = bar; b_.x = bx_; b_.bar = (unsigned*)(bw_ + WS_CTL) + CW_BAR; xcd_barrier(b_); if (REPMASK & 4096) xcd_barrier(b_); \
        if ((REPMASK & 8192) && ((BARSEL >> (id_)) & 1) && threadIdx.x == 0) MISC[20] += (unsigned)(rt() - tb0_); if ((REPMASK & 16384) && threadIdx.x == 0) MISC[21] = (unsigned)rt(); } while (0)
#define PHASE_ENTER() do { int t_ = threadIdx.x; asm volatile("" : "+v"(t_)); F.tid = t_; F.lane = t_ & 63; F.wave = __builtin_amdgcn_readfirstlane(t_ >> 6); \
        GAS unsigned char* w_ = (GAS unsigned char*)args.ws; GAS float* o_ = (GAS float*)args.out; asm volatile("" : "+s"(w_), "+s"(o_));   \
        F.ws = (unsigned char*)w_; F.out = (float*)o_; ws = (unsigned char*)w_; F.ctl = (gu32*)(w_ + WS_CTL); F.prm = (const float*)(w_ + WS_PRM); F.xst = (float*)o_; F.Ubuf = (bf16*)(w_ + WS_U); F.LAbuf = (float*)(w_ + WS_LA); F.dry = 0; } while (0)
    typedef pg8::bf16_t pb;
    REP(1) if (PHMASK & 1) { PHASE_ENTER(); p0_ada(F, args.in[I_C], args.in[I_WADA], args.in[I_BADA]);
        __syncthreads();
        p0_weights(F, args.in[I_WIN], args.in[I_WBA], args.in[I_WBB], args.in[I_WOUT], args.in[I_WGE], args.in[I_WUE], args.in[I_WDE], args.in[I_WRG], args.in[I_WRE],
                   SmallPrm{args.in[I_BGATES], args.in[I_WALPHA], args.in[I_BALPHA], args.in[I_LQ1], args.in[I_LK1], args.in[I_LQ2], args.in[I_LK2], args.in[I_DIFFG], args.in[I_GLAG], args.in[I_LN1G], args.in[I_LN1B], args.in[I_BRG], args.in[I_BRE], args.in[I_LN2G], args.in[I_LN2B]}); __syncthreads(); }
    GRID_BAR(0);
    REP(2) if (PHMASK & 2) { PHASE_ENTER(); phase_r0(F, args.in[I_X]); }
    GRID_BAR(1);
    for (int l = 0; l < DEPTH; ++l) {
        REP(4) if (PHMASK & 4) { PHASE_ENTER(); pg8::Gemm g{(const pb*)(ws + WS_U), (const pb*)(ws + WS_WIN) + (size_t)l * NPROJ * 1024, NTOK, NPROJ, 1024}; pg8::StaticOrder S; S.init(NTOK, NPROJ, F.G, (int)blockIdx.x);
          pg8::EpiProj E{(pb*)(ws + WS_QB), (pb*)(ws + WS_KB), (pb*)(ws + WS_VB), (pb*)(ws + WS_GQ), (pb*)(ws + WS_GK), (pb*)(ws + WS_GV), (pb*)(ws + WS_SG), (pb*)(ws + WS_GT), F.prm + PO_BGATES + l * 2048};
          pg8::gemm_phase<pg8::EpiProj, pg8::StaticOrder, true, false>(F.lds + RING_OFF, g, S, E, nullptr); }
        GRID_BAR(2);
#if GLA_TWO_PHASE
        if (PHMASK & 8) { PHASE_ENTER(); phase_gla_a(F); }
        GRID_BAR(12);
        REP(8) if (PHMASK & 8) { PHASE_ENTER(); phase_gla_b(F, ((REPMASK & 8) && rep_ == 0) ? GLAV : 0); }
#else
        REP(8) if (PHMASK & 8) { PHASE_ENTER(); phase_gla(F, ((REPMASK & 8) && rep_ == 0) ? GLAV : 0); }
#endif
        GRID_BAR(3);
        REP(16) if (PHMASK & 16) { PHASE_ENTER(); const attn_body::AttnTensors AT{(const attn_body::bf16*)(ws + WS_QB), (const attn_body::bf16*)(ws + WS_KB), (const attn_body::bf16*)(ws + WS_VB), (attn_body::bf16*)(ws + WS_OP)};
          attn_body::attn_phase<20>((char*)lds + RING_OFF, AT, (unsigned*)(F.ctl + CW_ATQ + (l * 2 + ((REPMASK & 16) ? rep_ : 0)) * 64), MISC + 16); }
        GRID_BAR(4);
        REP(32) if (PHMASK & 32) { PHASE_ENTER(); phase_post(F, l); }
        GRID_BAR(5);
#if G5_PAIR
        REP(64) if (PHMASK & 64) { PHASE_ENTER(); pg8::PairOrder S; S.S.init(NTOK, 1024, F.G, (int)blockIdx.x);
          static_assert(WS_OB2 == WS_OA2 + (size_t)NTOK * 1024 * 2 && WS_WBB == WS_WBA + 16 * 256 * 1024 * 2, "stacked A / B views of the two branch GEMMs");
          pg8::Gemm g{(const pb*)(ws + WS_OA2), (const pb*)(ws + WS_WBA) + (size_t)l * 1024 * 1024, 2 * NTOK, 1024, 1024};
          pg8::EpiGatePair E{(pb*)(ws + WS_TMP), (long)((WS_MIX - WS_TMP) / 2), (const pb*)(ws + WS_GT)};
          pg8::gemm_phase<pg8::EpiGatePair, pg8::PairOrder, true, false>(F.lds + RING_OFF, g, S, E, nullptr); }
#else
        REP(64) if (PHMASK & 64) { PHASE_ENTER(); pg8::StaticOrder S; S.init(NTOK, 1024, F.G, (int)blockIdx.x);
          { pg8::Gemm g{(const pb*)(ws + WS_OA2), (const pb*)(ws + WS_WBA) + (size_t)l * 1024 * 1024, NTOK, 1024, 1024};
            pg8::EpiGate<0> E{(pb*)(ws + WS_TMP), 1024, nullptr, (const pb*)(ws + WS_GT), 2048, 0};
            pg8::gemm_phase<pg8::EpiGate<0>, pg8::StaticOrder, true, false>(F.lds + RING_OFF, g, S, E, nullptr); }
          { pg8::Gemm g{(const pb*)(ws + WS_OB2), (const pb*)(ws + WS_WBB) + (size_t)l * 1024 * 1024, NTOK, 1024, 1024};
            pg8::EpiGate<1> E{(pb*)(ws + WS_MIX), 1024, (const pb*)(ws + WS_TMP), (const pb*)(ws + WS_GT), 2048, 1024};
            pg8::gemm_phase<pg8::EpiGate<1>, pg8::StaticOrder, true, false>(F.lds + RING_OFF, g, S, E, nullptr); } }
#endif
        GRID_BAR(6);
        if (PHMASK & 128) { PHASE_ENTER(); pg8::Gemm g{(const pb*)(ws + WS_MIX), (const pb*)(ws + WS_WOUT) + (size_t)l * 1024 * 1024, NTOK, 1024, 1024}; pg8::StaticOrder S; S.init(NTOK, 1024, F.G, (int)blockIdx.x);
          REP(128) { pg8::EpiResid E{F.out, ((REPMASK & 128) && rep_ == 0) ? (float*)(ws + WS_QB) : F.out, (const float*)(ws + WS_ADA) + (size_t)l * 8 * 6144 + 2 * 1024, 6144, DN_ALPHA};
          pg8::gemm_phase<pg8::EpiResid, pg8::StaticOrder, true, false>(F.lds + RING_OFF, g, S, E, nullptr); } }
        GRID_BAR(7);
        REP(256) if (PHMASK & 256) { PHASE_ENTER(); if ((REPMASK & 256) && rep_ == 0) { F.dry = DRYLVL; F.xst = (float*)(ws + WS_QB); F.Ubuf = (bf16*)(ws + WS_VB); } phase_r1(F, l); }
        GRID_BAR(8);
        if (PHMASK & 512) { PHASE_ENTER(); moe_tables(F, l); }
        if (PHMASK & 512) { const LAS int* BASE = (const LAS int*)(F.lds + TAB_BASE); const LAS int* CNT = (const LAS int*)(F.lds + TAB_CNT); LAS int* IDX = (LAS int*)(F.lds + TAB_IDX);
          const int total4 = __builtin_amdgcn_readfirstlane(BASE[32]) * 4; const int* LIST = (const int*)(ws + WS_LIST);
          MoeOrder S{BASE, total4, F.G, (int)blockIdx.x};
          for (int ui = 0; ui < IDX_UNITS; ++ui) { pg8::Unit u; if (!S.next(ui, u)) break; const int e = u.pb >> 2;
              if (F.tid < 256) { const int pos = (u.pm - BASE[e]) * 256 + F.tid; IDX[ui * 256 + F.tid] = (pos < CNT[e]) ? LIST[(size_t)e * LISTCAP + pos] : 0; } }
          __syncthreads();
          REP(512) { pg8::Gemm g{(const pb*)(ws + WS_U), (const pb*)(ws + WS_W1) + (size_t)l * 32 * 1024 * 1024, MOE_MAXT * 256, 1024, 1024};
            pg8::EpiSwiGLU E{(pb*)(ws + WS_H)};
            pg8::gemm_phase<pg8::EpiSwiGLU, MoeOrder, true, true>(F.lds + RING_OFF, g, S, E, IDX); }
          GRID_BAR(9);
          PHASE_ENTER();
          REP(2048) { pg8::Gemm g{(const pb*)(ws + WS_H), (const pb*)(ws + WS_WD) + (size_t)l * 32 * 1024 * 512, MOE_MAXT * 256, 1024, 512};
            pg8::EpiGate<2> E{(pb*)(ws + WS_YB), 1024, nullptr, nullptr, 0, 0};
            pg8::gemm_phase<pg8::EpiGate<2>, MoeOrder, true, false>(F.lds + RING_OFF, g, S, E, nullptr); }
        }
        GRID_BAR(10);
        REP(1024) if (PHMASK & 1024) { PHASE_ENTER(); if ((REPMASK & 1024) && rep_ == 0) { F.dry = DRYLVL; F.xst = (float*)(ws + WS_GT); F.Ubuf = (bf16*)(ws + WS_SG); F.LAbuf = (float*)(ws + WS_GV); } phase_r2(F, l); }
        if (l + 1 < DEPTH) GRID_BAR(11);
    }
    if ((REPMASK & 16384) && ((PSEL >> 11) & 1) && threadIdx.x == 0) MISC[20] += (unsigned)rt() - MISC[21];
    if ((REPMASK & (8192 | 16384)) && blockIdx.x == 0 && threadIdx.x == 0) { const unsigned tw_ = MISC[20]; const unsigned long long ts_ = rt(); while ((unsigned)(rt() - ts_) < tw_) __builtin_amdgcn_s_sleep(8); }
}

extern "C" void kernel_launch(void* const* d_in, const int* in_sizes, int n_in, void* d_out, int out_size, void* d_ws, size_t ws_size, hipStream_t stream) {
    static int grid = 0;
    if (grid == 0) {
        if (n_in != 28 || in_sizes[0] != NTOK * DM || out_size != NTOK * DM || ws_size < WS_END) { fprintf(stderr, "kernel_launch: unexpected shapes (n_in %d, in0 %d, out %d, ws %zu < %zu); nothing launched\n", n_in, n_in > 0 ? in_sizes[0] : -1, out_size, ws_size, (size_t)WS_END); grid = -1; return; }
        int dev = 0, cus = 0, per_cu = 0;
        if (hipGetDevice(&dev) != hipSuccess || hipDeviceGetAttribute(&cus, hipDeviceAttributeMultiprocessorCount, dev) != hipSuccess) { fprintf(stderr, "kernel_launch: device query failed\n"); grid = -1; return; }
        if (hipFuncSetAttribute((const void*)mk_fwd, hipFuncAttributeMaxDynamicSharedMemorySize, LDS_BYTES) != hipSuccess) { fprintf(stderr, "kernel_launch: hipFuncSetAttribute failed\n"); grid = -1; return; }
        if (hipOccupancyMaxActiveBlocksPerMultiprocessor(&per_cu, (const void*)mk_fwd, NTHREADS, LDS_BYTES) != hipSuccess || per_cu < 1) { fprintf(stderr, "kernel_launch: occupancy query says %d\n", per_cu); }
        (void)hipGetLastError();
        grid = cus;
    }
    if (grid < 0) return;
    if (hipMemsetAsync((char*)d_ws + WS_CTL, 0, CTL_ZERO_BYTES, stream) != hipSuccess) { fprintf(stderr, "kernel_launch: memset failed\n"); return; }
    Args a{};
    for (int i = 0; i < 28; ++i) a.in[i] = (const float*)d_in[i];
    a.out = (float*)d_out; a.ws = (unsigned char*)d_ws;
    hipLaunchKernelGGL(mk_fwd, dim3(grid), dim3(NTHREADS), LDS_BYTES, stream, a);
    const hipError_t le = hipPeekAtLastError();
    if (le != hipSuccess) fprintf(stderr, "kernel_launch: launch failed: %s\n", hipGetErrorName(le));
}
```

```cpp
#include <hip/hip_runtime.h>
#include <hip/hip_bf16.h>
#include <cstdio>
#include <cstdint>
#include <cmath>
namespace pg8 {
#define PG8_LAS __attribute__((address_space(3)))
typedef unsigned short bf16_t;
typedef short bf16x8 __attribute__((ext_vector_type(8)));
typedef float f32x4 __attribute__((ext_vector_type(4)));
typedef float f32x2 __attribute__((ext_vector_type(2)));
typedef unsigned u32x4 __attribute__((ext_vector_type(4)));
typedef unsigned u32x2 __attribute__((ext_vector_type(2)));
constexpr int BM = 256, BK = 64, HALF = 128, HTB = HALF * BK * 2  , STAGE_BYTES = 8 * HTB, NXCD = 8, WGM = 8;

__host__ __device__ __forceinline__ int lds_byte(int r, int c) { const int st = (r >> 4) * 2 + (c >> 5), rr = r & 15, cc = c & 31, ob = rr * 64 + cc * 2; return st * 1024 + (ob ^ (((ob >> 9) & 1) << 5)); }
__host__ __device__ __forceinline__ void stage_rc(int b, int& R, int& C) { const int st = b / 1024, sb = b % 1024, swz = sb ^ (((sb >> 9) & 1) << 5); R = (st >> 1) * 16 + swz / 64; C = (st & 1) * 32 + (swz % 64) / 2; }
__host__ __device__ __forceinline__ int perm32(int rho) { const int n = rho >> 4, i = rho & 15; return 8 * (i >> 2) + 4 * n + (i & 3); }

struct Unit { int pm, pn, pb; };
struct Gemm { const bf16_t* A; const bf16_t* Bt; int M, N, K; };

struct StaticOrder {
    int nM, nN, nwg, G, c;
    __host__ __device__ __forceinline__ void init(int M, int N, int G_, int c_) { nM = M / BM; nN = N / BM; nwg = nM * nN; G = G_; c = c_; }
    __host__ __device__ __forceinline__ bool next(int i, Unit& u) const {
        const long L = (long)i * G + c; if (L >= nwg) return false;
        int wgid = (int)L; { const int q = nwg / NXCD, r = nwg % NXCD, xcd = wgid % NXCD, off = wgid / NXCD; wgid = (xcd < r ? xcd * (q + 1) : r * (q + 1) + (xcd - r) * q) + off; }
        const int nig = WGM * nN, gid = wgid / nig, fm = gid * WGM, gsz = (nM - fm) < WGM ? (nM - fm) : WGM;
        u.pm = fm + ((wgid % nig) % gsz); u.pn = (wgid % nig) / gsz; u.pb = u.pn; return true;
    }
};

__device__ __forceinline__ unsigned cvt_pk_bf16(float lo, float hi) { unsigned r; asm volatile("v_cvt_pk_bf16_f32 %0, %1, %2" : "=v"(r) : "v"(lo), "v"(hi)); return r; }
typedef __bf16 bf16x2_c __attribute__((ext_vector_type(2)));
__device__ __forceinline__ unsigned cvt_pk_bf16_c(float lo, float hi) { const f32x2 v = {lo, hi}; const bf16x2_c b = __builtin_convertvector(v, bf16x2_c); return __builtin_bit_cast(unsigned, b); }
__device__ __forceinline__ float bf_lo(unsigned w) { return __uint_as_float(w << 16); }
__device__ __forceinline__ float bf_hi(unsigned w) { return __uint_as_float(w & 0xffff0000u); }
__device__ __forceinline__ float sigmoidf_(float x) { return __builtin_amdgcn_rcpf(1.0f + __expf(-x)); }

template <class Epi, class Sched, bool ALIGN_EPI, bool GATHER>
__device__ __forceinline__ void gemm_phase(PG8_LAS unsigned char* lds, const Gemm g, const Sched& S, const Epi& E, const PG8_LAS int* idxtab) {
    int tid_ = threadIdx.x; asm volatile("" : "+v"(tid_));
    const int tid = tid_, wid = __builtin_amdgcn_readfirstlane(tid >> 6), lane = tid & 63, wr = wid >> 2, wc = wid & 3, fr = lane & 15, fq = lane >> 4;
    const int K = g.K, nt = K / BK;
    unsigned voffA[2], voffB[2];
#pragma unroll
    for (int i = 0; i < 2; ++i) { int R, C; stage_rc(tid * 16 + i * 8192, R, C); const int Rb = Epi::PERM ? ((R & ~31) + perm32(R & 31)) : R;
        voffA[i] = (unsigned)(R * K + C) * 2u; voffB[i] = (unsigned)(Rb * K + C) * 2u; }
    const size_t kstep = (size_t)(BK * 2);
    const size_t hstep = (size_t)HALF * K * 2;
    const size_t tstep = 2 * hstep;
    const unsigned ldsw = (unsigned)wid * 1024u;
    const int aoff = lds_byte(wr * 64 + fr, fq * 8), boff = lds_byte(wc * 32 + fr, fq * 8);
    unsigned offAc[2][2];
    int nui = 0;
#define PG8_SA(b, h) (((b) * 2 + (h)) * HTB)
#define PG8_SB(b, h) ((4 + (b) * 2 + (h)) * HTB)
#define PG8_STAGE(bufoff, gbase, voff) do { _Pragma("unroll") for (int _i = 0; _i < 2; ++_i) \
        __builtin_amdgcn_global_load_lds((const unsigned*)((const char*)(gbase) + (voff)[_i]), (PG8_LAS unsigned*)(lds + (bufoff) + ldsw + _i * 8192), 16, 0, 0); } while (0)
#define PG8_GOFF(uix, h, i, tt) ({ int _R, _C; stage_rc((tt) * 16 + (i) * 8192, _R, _C); (unsigned)idxtab[(uix) * 256 + (h) * HALF + _R] * (unsigned)(K * 2) + (unsigned)_C * 2u; })
#define PG8_STAGE_A(bufoff, kb, h, nx) do { if constexpr (GATHER) { unsigned _o[2] = {offAc[h][0], offAc[h][1]}; \
        if (nx) { int _t = tid; asm volatile("" : "+v"(_t)); _o[0] = PG8_GOFF(nui, h, 0, _t); _o[1] = PG8_GOFF(nui, h, 1, _t); } \
        _Pragma("unroll") for (int _i = 0; _i < 2; ++_i) \
        __builtin_amdgcn_global_load_lds((const unsigned*)((const char*)g.A + (size_t)(kb) + _o[_i]), (PG8_LAS unsigned*)(lds + (bufoff) + ldsw + _i * 8192), 16, 0, 0); } \
        else { const char* _b = ((nx) ? nA : cA) + (size_t)(kb) + (size_t)(h) * hstep; PG8_STAGE(bufoff, _b, voffA); } } while (0)
#define PG8_GIDX(dst, uix) do { if constexpr (GATHER) { int _t = tid; asm volatile("" : "+v"(_t)); _Pragma("unroll") for (int _h = 0; _h < 2; ++_h) _Pragma("unroll") for (int _i = 0; _i < 2; ++_i) \
        dst[_h][_i] = PG8_GOFF(uix, _h, _i, _t); } } while (0)
#define PG8_LDA(dst, b, h) do { _Pragma("unroll") for (int m = 0; m < 4; ++m) _Pragma("unroll") for (int k = 0; k < 2; ++k) dst[m][k] = *(const PG8_LAS bf16x8*)(lds + PG8_SA(b, h) + aoff + m * 2048 + k * 1024); } while (0)
#define PG8_LDB(dst, b, h) do { _Pragma("unroll") for (int n = 0; n < 2; ++n) _Pragma("unroll") for (int k = 0; k < 2; ++k) dst[n][k] = *(const PG8_LAS bf16x8*)(lds + PG8_SB(b, h) + boff + n * 2048 + k * 1024); } while (0)
#define PG8_MMA(ai, bj, At, Bt) do { __builtin_amdgcn_s_setprio(1); _Pragma("unroll") for (int m = 0; m < 4; ++m) _Pragma("unroll") for (int n = 0; n < 2; ++n) _Pragma("unroll") for (int k = 0; k < 2; ++k) \
        acc[ai][bj][m][n] = __builtin_amdgcn_mfma_f32_16x16x32_bf16(Bt[n][k], At[m][k], acc[ai][bj][m][n], 0, 0, 0); __builtin_amdgcn_s_setprio(0); } while (0)
#define PG8_WAIT_V(n) asm volatile("s_waitcnt vmcnt(" #n ")" ::: "memory")
#define PG8_WAIT_L(n) asm volatile("s_waitcnt lgkmcnt(" #n ")" ::: "memory")
#define PG8_BAR __builtin_amdgcn_s_barrier()
#define PG8_SCHED __builtin_amdgcn_sched_barrier(0)
    Unit cur, nxt; int ui = 0;
    if (!S.next(0, cur)) return;
    f32x4 acc[2][2][4][2];
#pragma unroll
    for (int a = 0; a < 2; ++a)
#pragma unroll
        for (int b = 0; b < 2; ++b)
#pragma unroll
            for (int m = 0; m < 4; ++m)
#pragma unroll
                for (int n = 0; n < 2; ++n) acc[a][b][m][n] = (f32x4){0.f, 0.f, 0.f, 0.f};
    bf16x8 At[4][2], B0[2][2], B1[2][2];
    const char* cA = (const char*)g.A + (size_t)cur.pm * tstep; const char* cB = (const char*)g.Bt + (size_t)cur.pb * tstep;
    const char* nA = cA;
    PG8_GIDX(offAc, 0);
    PG8_STAGE(PG8_SB(0, 0), cB, voffB); PG8_STAGE(PG8_SB(0, 1), cB + hstep, voffB); PG8_STAGE_A(PG8_SA(0, 0), 0, 0, false); PG8_STAGE_A(PG8_SA(0, 1), 0, 1, false);
    if (wr == 1) PG8_BAR;
    PG8_WAIT_V(2); PG8_BAR;
    PG8_STAGE(PG8_SB(1, 0), cB + kstep, voffB); PG8_STAGE_A(PG8_SA(1, 0), kstep, 0, false); PG8_STAGE(PG8_SB(1, 1), cB + hstep + kstep, voffB);
    PG8_WAIT_V(6); PG8_BAR;
    for (;;) {
        const bool has_next = S.next(ui + 1, nxt);
        nA = has_next ? (const char*)g.A + (size_t)nxt.pm * tstep : cA; const char* nB = has_next ? (const char*)g.Bt + (size_t)nxt.pb * tstep : cB;
        nui = has_next ? ui + 1 : ui;
        for (int t = 0; t < nt; t += 2) {
            const bool last = (t == nt - 2);
            const size_t kb1 = (size_t)(t + 1) * kstep;
            const size_t kb2 = last ? (size_t)0 : (size_t)(t + 2) * kstep, kb3 = kb2 + kstep;
            const char* b2 = last ? nB : cB + (size_t)(t + 2) * kstep; const char* b3 = b2 + kstep;
            PG8_LDB(B0, 0, 0); PG8_LDB(B1, 0, 1); PG8_SCHED; PG8_LDA(At, 0, 0); PG8_STAGE_A(PG8_SA(1, 1), kb1, 1, false);
            PG8_WAIT_V(8); PG8_WAIT_L(0); PG8_BAR; PG8_MMA(0, 0, At, B0); PG8_MMA(0, 1, At, B1); PG8_BAR; PG8_SCHED;
            PG8_LDA(At, 0, 1); PG8_STAGE(PG8_SB(0, 0), b2, voffB); PG8_STAGE(PG8_SB(0, 1), b2 + hstep, voffB); PG8_STAGE_A(PG8_SA(0, 0), kb2, 0, last);
            PG8_WAIT_V(8); PG8_WAIT_L(0); PG8_BAR; PG8_MMA(1, 0, At, B0); PG8_MMA(1, 1, At, B1); PG8_BAR; PG8_SCHED;
            PG8_LDB(B0, 1, 0); PG8_LDB(B1, 1, 1); PG8_SCHED; PG8_LDA(At, 1, 0); PG8_STAGE_A(PG8_SA(0, 1), kb2, 1, last);
            PG8_WAIT_V(8); PG8_WAIT_L(0); PG8_BAR; PG8_MMA(0, 0, At, B0); PG8_MMA(0, 1, At, B1); PG8_BAR; PG8_SCHED;
            PG8_LDA(At, 1, 1); PG8_STAGE(PG8_SB(1, 0), b3, voffB); PG8_STAGE(PG8_SB(1, 1), b3 + hstep, voffB); PG8_STAGE_A(PG8_SA(1, 0), kb3, 0, last);
            PG8_WAIT_V(8); PG8_WAIT_L(0); PG8_BAR; PG8_MMA(1, 0, At, B0); PG8_MMA(1, 1, At, B1); PG8_BAR; PG8_SCHED;
        }
        if constexpr (ALIGN_EPI) { if (wr == 0) PG8_BAR; }
        E(acc, cur, wr, wc, fr, fq);
        if (!has_next) break;
#pragma unroll
        for (int a = 0; a < 2; ++a)
#pragma unroll
            for (int b = 0; b < 2; ++b)
#pragma unroll
                for (int m = 0; m < 4; ++m)
#pragma unroll
                    for (int n = 0; n < 2; ++n) acc[a][b][m][n] = (f32x4){0.f, 0.f, 0.f, 0.f};
        cur = nxt; cA = nA; cB = nB; ++ui;
        PG8_GIDX(offAc, ui);
        if constexpr (ALIGN_EPI) { if (wr == 1) PG8_BAR; }
    }
    PG8_WAIT_V(0);
    if constexpr (!ALIGN_EPI) { if (wr == 0) PG8_BAR; }
    PG8_BAR;
#undef PG8_SA
#undef PG8_SB
#undef PG8_STAGE
#undef PG8_STAGE_A
#undef PG8_GIDX
#undef PG8_GOFF
#undef PG8_LDA
#undef PG8_LDB
#undef PG8_MMA
#undef PG8_WAIT_V
#undef PG8_WAIT_L
#undef PG8_BAR
#undef PG8_SCHED
}
}
namespace pg8 {
constexpr float ATT_C2 = 0.125f * 1.4426950408889634f;
constexpr float GLA_QS = 0.08838834764831845f;
struct EpiProj {
    static constexpr bool PERM = true;
    bf16_t *Qb, *Kb, *Vb, *GQ, *GK, *GV, *SG, *GT; const float* bgates;
    __device__ __forceinline__ void operator()(const f32x4 (&acc)[2][2][4][2], const Unit& u, int wr, int wc, int fr, int fq) const {
        asm volatile("" : "+v"(fr), "+v"(fq));
        const int pn = u.pn; bf16_t* base; int ldc = 1024, ct; int act = 0; float sc = 1.f;
        if (pn < 4) { base = Qb; ct = pn; sc = ATT_C2; }
        else if (pn < 8) { base = Kb; ct = pn - 4; }
        else if (pn < 12) { base = Vb; ct = pn - 8; }
        else if (pn < 14) { base = GQ; ldc = 512; ct = pn - 12; sc = GLA_QS; }
        else if (pn < 16) { base = GK; ldc = 512; ct = pn - 14; }
        else if (pn < 20) { base = GV; ct = pn - 16; }
        else if (pn < 24) { base = SG; ct = pn - 20; act = 1; }
        else { base = GT; ldc = 2048; ct = pn - 24; act = 2; }
        const int row0 = u.pm * BM + wr * 64 + fr, col0 = ct * BM + wc * 32 + 8 * fq;
        f32x4 bv[2][2];
#pragma unroll
        for (int bj = 0; bj < 2; ++bj)
#pragma unroll
            for (int n = 0; n < 2; ++n) bv[bj][n] = (act == 2) ? *(const f32x4*)(bgates + col0 + bj * HALF + 4 * n) : (f32x4){0.f, 0.f, 0.f, 0.f};
#pragma unroll
        for (int ai = 0; ai < 2; ++ai)
#pragma unroll
            for (int m = 0; m < 4; ++m) { bf16_t* rowp = base + (size_t)(row0 + ai * HALF + m * 16) * ldc + col0;
#pragma unroll
                for (int bj = 0; bj < 2; ++bj) { f32x4 v0 = acc[ai][bj][m][0] * sc + bv[bj][0], v1 = acc[ai][bj][m][1] * sc + bv[bj][1];
                    if (act != 0) {
#pragma unroll
                        for (int e = 0; e < 4; ++e) { const float s0 = sigmoidf_(v0[e]), s1 = sigmoidf_(v1[e]); v0[e] = (act == 1) ? v0[e] * s0 : s0; v1[e] = (act == 1) ? v1[e] * s1 : s1; } }
                    u32x4 w; w.x = cvt_pk_bf16(v0[0], v0[1]); w.y = cvt_pk_bf16(v0[2], v0[3]); w.z = cvt_pk_bf16(v1[0], v1[1]); w.w = cvt_pk_bf16(v1[2], v1[3]);
                    *(u32x4*)(rowp + bj * HALF) = w; } }
    }
};
template <int MODE> struct EpiGate {
    static constexpr bool PERM = true;
    bf16_t* O; int ldo; const bf16_t* T; const bf16_t* gate; int ldg, gcol0;
    __device__ __forceinline__ void operator()(const f32x4 (&acc)[2][2][4][2], const Unit& u, int wr, int wc, int fr, int fq) const {
        asm volatile("" : "+v"(fr), "+v"(fq));
        const int row0 = u.pm * BM + wr * 64 + fr, col0 = u.pn * BM + wc * 32 + 8 * fq;
#pragma unroll
        for (int ai = 0; ai < 2; ++ai)
#pragma unroll
            for (int m = 0; m < 4; ++m) { const size_t row = (size_t)(row0 + ai * HALF + m * 16);
#pragma unroll
                for (int bj = 0; bj < 2; ++bj) { f32x4 v0 = acc[ai][bj][m][0], v1 = acc[ai][bj][m][1]; const int col = col0 + bj * HALF;
                    if (MODE != 2) { const u32x4 gw = *(const u32x4*)(gate + row * ldg + gcol0 + col);
                        v0 = v0 * (f32x4){bf_lo(gw.x), bf_hi(gw.x), bf_lo(gw.y), bf_hi(gw.y)}; v1 = v1 * (f32x4){bf_lo(gw.z), bf_hi(gw.z), bf_lo(gw.w), bf_hi(gw.w)}; }
                    if (MODE == 1) { const u32x4 tw = *(const u32x4*)(T + row * ldo + col);
                        v0 = v0 + (f32x4){bf_lo(tw.x), bf_hi(tw.x), bf_lo(tw.y), bf_hi(tw.y)}; v1 = v1 + (f32x4){bf_lo(tw.z), bf_hi(tw.z), bf_lo(tw.w), bf_hi(tw.w)}; }
                    u32x4 w; w.x = cvt_pk_bf16(v0[0], v0[1]); w.y = cvt_pk_bf16(v0[2], v0[3]); w.z = cvt_pk_bf16(v1[0], v1[1]); w.w = cvt_pk_bf16(v1[2], v1[3]);
                    *(u32x4*)(O + row * ldo + col) = w; }
                asm volatile("" ::: "memory"); }
    }
};
struct EpiGatePair {
    static constexpr bool PERM = true;
    bf16_t* TMP; long mix_delta; const bf16_t* gate;
    __device__ __forceinline__ void operator()(const f32x4 (&acc)[2][2][4][2], const Unit& u, int wr, int wc, int fr, int fq) const {
        asm volatile("" : "+v"(fr), "+v"(fq));
        const int kind = u.pm >= 128 ? 1 : 0; const int row0 = (u.pm - 128 * kind) * BM + wr * 64 + fr, col0 = u.pn * BM + wc * 32 + 8 * fq;
#pragma unroll
        for (int ai = 0; ai < 2; ++ai)
#pragma unroll
            for (int m = 0; m < 4; ++m) { const size_t row = (size_t)(row0 + ai * HALF + m * 16);
#pragma unroll
                for (int bj = 0; bj < 2; ++bj) { f32x4 v0 = acc[ai][bj][m][0], v1 = acc[ai][bj][m][1]; const int col = col0 + bj * HALF;
                    { const u32x4 gw = *(const u32x4*)(gate + row * 2048 + kind * 1024 + col);
                      v0 = v0 * (f32x4){bf_lo(gw.x), bf_hi(gw.x), bf_lo(gw.y), bf_hi(gw.y)}; v1 = v1 * (f32x4){bf_lo(gw.z), bf_hi(gw.z), bf_lo(gw.w), bf_hi(gw.w)}; }
                    if (kind) { const u32x4 tw = *(const u32x4*)(TMP + row * 1024 + col);
                        v0 = v0 + (f32x4){bf_lo(tw.x), bf_hi(tw.x), bf_lo(tw.y), bf_hi(tw.y)}; v1 = v1 + (f32x4){bf_lo(tw.z), bf_hi(tw.z), bf_lo(tw.w), bf_hi(tw.w)}; }
                    u32x4 w; w.x = cvt_pk_bf16(v0[0], v0[1]); w.y = cvt_pk_bf16(v0[2], v0[3]); w.z = cvt_pk_bf16(v1[0], v1[1]); w.w = cvt_pk_bf16(v1[2], v1[3]);
                    *(u32x4*)(TMP + (long)kind * mix_delta + row * 1024 + col) = w; }
                asm volatile("" ::: "memory"); }
    }
};
struct PairOrder {
    StaticOrder S;
    __device__ __forceinline__ bool next(int i, Unit& u) const { if (!S.next(i >> 1, u)) return false; const int kind = i & 1; u.pm += 128 * kind; u.pb = u.pn + 16 * kind; return true; }
};
struct EpiResid {
    static constexpr bool PERM = false;
    const float* X; float* Xo; const float* gvec; int gstride; float alpha;
    __device__ __forceinline__ void operator()(const f32x4 (&acc)[2][2][4][2], const Unit& u, int wr, int wc, int fr, int fq) const {
        asm volatile("" : "+v"(fr), "+v"(fq));
        const int row0 = u.pm * BM + wr * 64 + fr, col0 = u.pn * BM + wc * 32 + 4 * fq; const float* gv = gvec + (size_t)(u.pm >> 4) * gstride;
        f32x4 g4[2][2];
#pragma unroll
        for (int bj = 0; bj < 2; ++bj)
#pragma unroll
            for (int n = 0; n < 2; ++n) g4[bj][n] = *(const f32x4*)(gv + col0 + bj * HALF + n * 16);
#pragma unroll
        for (int ai = 0; ai < 2; ++ai)
#pragma unroll
            for (int m = 0; m < 4; ++m) { const size_t ro = (size_t)(row0 + ai * HALF + m * 16) * 1024 + col0;
#pragma unroll
                for (int bj = 0; bj < 2; ++bj)
#pragma unroll
                    for (int n = 0; n < 2; ++n) { const size_t o = ro + bj * HALF + n * 16; const f32x4 xv = *(const f32x4*)(X + o); *(f32x4*)(Xo + o) = xv * alpha + g4[bj][n] * acc[ai][bj][m][n]; }
                asm volatile("" ::: "memory"); }
    }
};
struct EpiSwiGLU {
    static constexpr bool PERM = true;
    bf16_t* H;
    __device__ __forceinline__ void operator()(const f32x4 (&acc)[2][2][4][2], const Unit& u, int wr, int wc, int fr, int fq) const {
        asm volatile("" : "+v"(fr), "+v"(fq));
        const int row0 = u.pm * BM + wr * 64 + fr, col0 = u.pn * HALF + wc * 32 + 8 * fq;
#pragma unroll
        for (int ai = 0; ai < 2; ++ai)
#pragma unroll
            for (int m = 0; m < 4; ++m) { f32x4 h0, h1;
#pragma unroll
                for (int e = 0; e < 4; ++e) { const float g0 = acc[ai][0][m][0][e], g1 = acc[ai][0][m][1][e]; h0[e] = g0 * sigmoidf_(g0) * acc[ai][1][m][0][e]; h1[e] = g1 * sigmoidf_(g1) * acc[ai][1][m][1][e]; }
                u32x4 w; w.x = cvt_pk_bf16(h0[0], h0[1]); w.y = cvt_pk_bf16(h0[2], h0[3]); w.z = cvt_pk_bf16(h1[0], h1[1]); w.w = cvt_pk_bf16(h1[2], h1[3]);
                *(u32x4*)(H + (size_t)(row0 + ai * HALF + m * 16) * 512 + col0) = w; }
    }
};
}
#include <hip/hip_bf16.h>
#include <cmath>
namespace attn_body {
using bf16=__hip_bfloat16;
using bf16x8=__attribute__((ext_vector_type(8)))short;
using s16x4=__attribute__((ext_vector_type(4)))short;
using f32x16=__attribute__((ext_vector_type(16)))float;
using u32x4=__attribute__((ext_vector_type(4)))unsigned;
constexpr int BATCH=8,NHEAD=16,SEQ=4096,D=64,DM=NHEAD*D,OPITCH=2048;
constexpr int NW=8,QBLK=32,QB=QBLK*NW,KVBLK=64,NQB=SEQ/QB;
constexpr int ATTN_PITCH=DM, ATTN_UNIT_ROWS=QB;
__device__ __forceinline__ int crow(int r,int hi){return (r&3)+8*(r>>2)+4*hi;}
#define SBAR() __builtin_amdgcn_sched_barrier(0)
__device__ __forceinline__ void cmask(f32x16&p0,f32x16&p1,int jb,int qrel,int hi){
  const float NEG=-INFINITY; int kb=64*jb+4*hi;
  #pragma unroll
  for(int r=0;r<16;++r){int kv=kb+(r&3)+8*(r>>2); if(kv>qrel)p0[r]=NEG; if(kv+32>qrel)p1[r]=NEG;}
}

constexpr int NSLOT=3, SLOTB=8192;
constexpr int LDS_K=0, LDS_V=NSLOT*SLOTB, LDS_WS=3*NSLOT*SLOTB, LDS_OST=LDS_WS+NW*64*4, LDS_BYTES=LDS_OST+NW*4096;
constexpr float C2=0.125f*1.4426950408889634f;
__device__ __forceinline__ void glds16s(const void*sbase,unsigned voff,unsigned lds_dst){unsigned keep;
  asm volatile("s_mov_b32 %0, m0\n\ts_mov_b32 m0, %2\n\ts_nop 0\n\tglobal_load_lds_dwordx4 %1, %3\n\ts_mov_b32 m0, %0":"=&s"(keep):"v"(voff),"s"(lds_dst),"s"(sbase):"memory");}
__device__ __forceinline__ void glds16(const void*gsrc,unsigned lds_dst){unsigned keep;
  asm volatile("s_mov_b32 %0, m0\n\ts_mov_b32 m0, %2\n\ts_nop 0\n\tglobal_load_lds_dwordx4 %1, off\n\ts_mov_b32 m0, %0":"=&s"(keep):"v"(gsrc),"s"(lds_dst):"memory");}
__device__ __forceinline__ float max3f(float a,float b,float c){float r;asm("v_max3_f32 %0, %1, %2, %3":"=v"(r):"v"(a),"v"(b),"v"(c));return r;}
__device__ __forceinline__ float max2f(float a,float b){float r;asm("v_max_f32_e32 %0, %1, %2":"=v"(r):"v"(a),"v"(b));return r;}
__device__ __forceinline__ float fadd_s(float a,float b){float r;asm("v_add_f32_e32 %0, %1, %2":"=v"(r):"v"(a),"v"(b));return r;}
__device__ __forceinline__ float fsub_s(float a,float b){float r;asm("v_sub_f32_e32 %0, %1, %2":"=v"(r):"v"(a),"v"(b));return r;}
typedef float f32x2_t __attribute__((ext_vector_type(2))); typedef __bf16 bf16x2_t __attribute__((ext_vector_type(2)));
__device__ __forceinline__ unsigned cvtpk_s(float lo,float hi){f32x2_t v={lo,hi};bf16x2_t b=__builtin_convertvector(v,bf16x2_t);return __builtin_bit_cast(unsigned,b);}
#define WAIT_BAR(N) asm volatile("s_waitcnt vmcnt(" #N ") lgkmcnt(0)\n\ts_barrier":::"memory")

__device__ __forceinline__ void qkt(f32x16&p0,f32x16&p1,const char*Kslot,const bf16x8*qr,const f32x16&c0,const f32x16&c1,int r32,int hi){
  const char*kb=Kslot+hi*1024+r32*16;
  #pragma unroll
  for(int d0=0;d0<4;++d0){
    const bf16x8 b0=*reinterpret_cast<const bf16x8*>(kb+d0*2048);
    const bf16x8 b1=*reinterpret_cast<const bf16x8*>(kb+d0*2048+512);
    if(d0==0){p0=__builtin_amdgcn_mfma_f32_32x32x16_bf16(b0,qr[0],c0,0,0,0);p1=__builtin_amdgcn_mfma_f32_32x32x16_bf16(b1,qr[0],c1,0,0,0);}
    else{p0=__builtin_amdgcn_mfma_f32_32x32x16_bf16(b0,qr[d0],p0,0,0,0);p1=__builtin_amdgcn_mfma_f32_32x32x16_bf16(b1,qr[d0],p1,0,0,0);}}
}
typedef __attribute__((address_space(3))) const char* lds_cptr;
typedef short v4i16_t __attribute__((ext_vector_type(4)));
__device__ __forceinline__ void kload8(bf16x8*kf,lds_cptr kp){
  kf[0]=*(const __attribute__((address_space(3))) bf16x8*)(kp);      kf[1]=*(const __attribute__((address_space(3))) bf16x8*)(kp+512);
  kf[2]=*(const __attribute__((address_space(3))) bf16x8*)(kp+2048); kf[3]=*(const __attribute__((address_space(3))) bf16x8*)(kp+2560);
  kf[4]=*(const __attribute__((address_space(3))) bf16x8*)(kp+4096); kf[5]=*(const __attribute__((address_space(3))) bf16x8*)(kp+4608);
  kf[6]=*(const __attribute__((address_space(3))) bf16x8*)(kp+6144); kf[7]=*(const __attribute__((address_space(3))) bf16x8*)(kp+6656);
}
__device__ __forceinline__ void kload2(bf16x8*kf,lds_cptr kp,int j){ kf[2*j]=*(const __attribute__((address_space(3))) bf16x8*)(kp+j*2048); kf[2*j+1]=*(const __attribute__((address_space(3))) bf16x8*)(kp+j*2048+512); }
__device__ __forceinline__ s16x4 vtr(lds_cptr p){ return __builtin_bit_cast(s16x4,__builtin_amdgcn_ds_read_tr16_b64_v4i16((__attribute__((address_space(3))) v4i16_t*)p)); }
__device__ __forceinline__ float rowmax(const f32x16&p0,const f32x16&p1){
  float a=max3f(p0[0],p0[1],p1[0]),b=max3f(p0[2],p0[3],p1[1]);a=max3f(a,p1[2],p1[3]);
  #pragma unroll
  for(int r=4;r<16;r+=4){a=max3f(a,p0[r],p0[r+1]);b=max3f(b,p0[r+2],p0[r+3]);a=max3f(a,p1[r],p1[r+1]);b=max3f(b,p1[r+2],p1[r+3]);}
  const float m=max2f(a,b);
  auto rr=__builtin_amdgcn_permlane32_swap(__float_as_uint(m),__float_as_uint(m),false,false);
  return max2f(__uint_as_float(rr[0]),__uint_as_float(rr[1]));
}
__device__ __forceinline__ void pv(f32x16*o,int vb,bf16x8 pa0,bf16x8 pa1,bf16x8 pa2,bf16x8 pa3){
  #pragma unroll
  for(int d0=0;d0<4;++d0){s16x4 lo[4],hi[4];
    #pragma unroll
    for(int ks=0;ks<4;++ks){
      asm volatile("ds_read_b64_tr_b16 %0,%1 offset:%c2":"=&v"(lo[ks]):"v"(vb),"i"(d0*4096+ks*1024):"memory");
      asm volatile("ds_read_b64_tr_b16 %0,%1 offset:%c2":"=&v"(hi[ks]):"v"(vb),"i"(d0*4096+ks*1024+512):"memory");}
    asm volatile("s_waitcnt lgkmcnt(0)":::"memory");SBAR();
    #define PK(k) (bf16x8){lo[k][0],lo[k][1],lo[k][2],lo[k][3],hi[k][0],hi[k][1],hi[k][2],hi[k][3]}
    o[d0]=__builtin_amdgcn_mfma_f32_32x32x16_bf16(pa0,PK(0),o[d0],0,0,0);
    o[d0]=__builtin_amdgcn_mfma_f32_32x32x16_bf16(pa1,PK(1),o[d0],0,0,0);
    o[d0]=__builtin_amdgcn_mfma_f32_32x32x16_bf16(pa2,PK(2),o[d0],0,0,0);
    o[d0]=__builtin_amdgcn_mfma_f32_32x32x16_bf16(pa3,PK(3),o[d0],0,0,0);
    #undef PK
  }
}

#ifndef ATTN_STORE16
#define ATTN_STORE16(p,v) (*(u32x4*)(p)=(v))
#endif
template<int THRL> __device__ __forceinline__ void attn_unit(int b,int hq,int hv,int ocol,int qb,int nfar,float sl2,const bf16*Q,const bf16*__restrict__ K,const bf16*__restrict__ V,bf16*O,char*shm){
  int tid_=threadIdx.x; asm volatile("":"+v"(tid_));
  const int tid=tid_,lane=tid&63,r32=lane&31,hi=lane>>5; const int wid=__builtin_amdgcn_readfirstlane(tid>>6);
  const long rowbase=(long)b*SEQ; const int q0=qb*QB;
  const bf16*Qw=Q+(rowbase+q0+wid*QBLK)*DM+hq*D;
  const int NTf=(q0+QB)/KVBLK, NT=(NTf<4+nfar)?NTf:4+nfar, t0=NTf-NT, q0c=q0-64*t0;
  const bf16*Kh=K+(rowbase+64*t0)*DM+hq*D,*Vh=V+(rowbase+64*t0)*DM+hv*D;
  const unsigned lds0=(unsigned)(uintptr_t)shm;
  float*wsf=(float*)(shm+LDS_WS)+wid*64;
  const unsigned kvoff=(unsigned)(lane*DM+wid*8)*2u;
  const unsigned vvoff=(unsigned)((16*(wid&3)+(lane>>2))*DM+(wid>>2)*32+(lane&3)*8)*2u;
  const unsigned kdst=lds0+LDS_K+wid*1024, vdst=lds0+LDS_V+wid*1024;
  #define DMA_K(t,slot) glds16s(Kh+(long)(t)*KVBLK*DM,kvoff,(unsigned)__builtin_amdgcn_readfirstlane(kdst+(slot)))
  #define DMA_V(t,slot) do{ glds16s(Vh+(long)(t)*KVBLK*DM,vvoff,(unsigned)__builtin_amdgcn_readfirstlane(vdst+2*(slot))); glds16s(Vh+(long)(t)*KVBLK*DM+64,vvoff,(unsigned)__builtin_amdgcn_readfirstlane(vdst+2*(slot)+8192)); }while(0)
  const int vb0=(int)(lds0+LDS_V)+((lane>>4)&1)*32+(lane&3)*8+(4*hi+((lane&15)>>2))*64;
  const char*Kbase=shm+LDS_K; bf16x8 kf[8];
  const lds_cptr shm3=(lds_cptr)shm; const lds_cptr kp0=shm3+LDS_K+hi*1024+r32*16; const lds_cptr vp0=shm3+LDS_V+((lane>>4)&1)*32+(lane&3)*8+(4*hi+((lane&15)>>2))*64;
  DMA_K(0,0);DMA_V(0,0);DMA_K(1,SLOTB);
  bf16x8 qr[4];
  #pragma unroll
  for(int d0=0;d0<4;++d0)qr[d0]=*reinterpret_cast<const bf16x8*>(&Qw[(long)r32*DM+d0*16+hi*8]);
  float mhat=0.f,l_reg=0.f;f32x16 o[4];o[0]=f32x16{};o[1]=f32x16{};o[2]=f32x16{};o[3]=f32x16{};
  #define CINIT0(C0_,t_) do{ const float bt_=sl2*(float)(64*(t_)-q0c+4*hi)-mhat; _Pragma("unroll") for(int r=0;r<16;++r){C0_[r]=__builtin_fmaf(sl2,(float)((r&3)+8*(r>>2)),bt_);} }while(0)
  #define CINIT1(C1_,t_) do{ const float bt_=sl2*(float)(64*(t_)-q0c+4*hi)-mhat; _Pragma("unroll") for(int r=0;r<16;++r){C1_[r]=__builtin_fmaf(sl2,(float)((r&3)+8*(r>>2)+32),bt_);} }while(0)
  #define CINIT(C0_,C1_,t_) do{ CINIT0(C0_,t_); CINIT1(C1_,t_); }while(0)
  const int qrel=wid*QBLK+r32;
  #define CMASK(P0,P1,t) do{int jb_=(t)-(NT-4); if(jb_>=0)cmask(P0,P1,jb_,qrel,hi);}while(0)
  bool resc=false;
  #define START(P0,P1) do{ const float rm=rowmax(P0,P1); resc=false; \
    { const float dl=rm; mhat=fadd_s(mhat,dl); \
      _Pragma("unroll") for(int r=0;r<16;++r){P0[r]=fsub_s(P0[r],dl);P1[r]=fsub_s(P1[r],dl);} } \
    _Pragma("unroll") for(int r=0;r<16;++r)P0[r]=__builtin_amdgcn_exp2f(P0[r]); }while(0)
  #define RESC() do{ if(resc){ asm volatile("s_waitcnt lgkmcnt(0)":::"memory"); \
      _Pragma("unroll") for(int d_=0;d_<4;++d_) _Pragma("unroll") for(int r=0;r<16;++r)o[d_][r]*=wsf[crow(r,hi)]; } }while(0)
  f32x16 pA0,pA1,pB0,pB1;
  int sl_prev=0,sl_cur=0,sl_next=SLOTB;
  #define ROT() do{sl_prev=sl_cur;sl_cur=sl_next;sl_next=(sl_next==(NSLOT-1)*SLOTB)?0:sl_next+SLOTB;}while(0)
  DMA_K(2,2*SLOTB);
  WAIT_BAR(4);
  { f32x16 c0_,c1_; CINIT(c0_,c1_,0); qkt(pA0,pA1,Kbase,qr,c0_,c1_,r32,hi); } asm volatile("s_nop 15\n\ts_nop 7":"+v"(pA0),"+v"(pA1));CMASK(pA0,pA1,0);
  START(pA0,pA1);
  _Pragma("unroll") for(int r=0;r<16;++r)pA1[r]=__builtin_amdgcn_exp2f(pA1[r]);
  WAIT_BAR(0);
  DMA_K(3,0);DMA_V(1,SLOTB);
  ROT();
  kload8(kf,kp0+sl_cur);
  WAIT_BAR(3);
  s16x4 vlo[8],vhi[8]; u32x4 pw0,pw1,pw2,pw3;
  #define PKW(P,B) cvtpk_s(P[B],P[B+1])
  #define PAF(k) __builtin_bit_cast(bf16x8,pw##k)
  #define VFR(i) (bf16x8){vlo[i][0],vlo[i][1],vlo[i][2],vlo[i][3],vhi[i][0],vhi[i][1],vhi[i][2],vhi[i][3]}
  #define PIN(x) asm volatile("":"+v"(x))
  #define MX3(a,b,c) __builtin_fmaxf(__builtin_fmaxf((a),(b)),(c))
  #define GAPA(MF,A0,A1,A2,A3,W0,W1,PW) do{ MF; sacc+=A0; sacc+=A1; sacc+=A2; sacc+=A3; PIN(sacc); W0; W1; PIN(PW); SBAR(); }while(0)
  #define EX(v) __builtin_amdgcn_exp2f(v)
  #define GAPB(MF,X,B) do{ MF; X[B]=EX(X[B]); X[B+1]=EX(X[B+1]); PIN(X); SBAR(); }while(0)
  #define VRD2(sl,fr) do{ vlo[sl]=vtr(vp_+(((fr)>>2)*4096+((fr)&3)*1024)); vhi[sl]=vtr(vp_+(((fr)>>2)*4096+((fr)&3)*1024+512)); SBAR(); }while(0)
  #define VRD(i) do{ vlo[i]=vtr(vp_+(((i)>>2)*4096+((i)&3)*1024)); vhi[i]=vtr(vp_+(((i)>>2)*4096+((i)&3)*1024+512)); }while(0)
  #define KRD(G,j) do{ if(G){ kload2(kf,kp0+sl_next,j); SBAR(); } }while(0)
  #define STEP(C0,C1,P0,P1,t,GK,GV,GL) do{ CINIT0(C0,t); SBAR(); \
    const lds_cptr vp_=vp0+2*sl_prev; \
    VRD(0); SBAR(); float sacc=(P0[0]+P0[1]); \
    GAPA(C0=__builtin_amdgcn_mfma_f32_32x32x16_bf16(kf[0],qr[0],C0,0,0,0), P0[2],P0[3],P0[4],P0[5],     pw0[0]=PKW(P0,0), pw0[1]=PKW(P0,2), pw0); \
    CINIT1(C1,t); VRD(4); SBAR(); GAPA(C1=__builtin_amdgcn_mfma_f32_32x32x16_bf16(kf[1],qr[0],C1,0,0,0), P0[6],P0[7],P0[8],P0[9],     pw0[2]=PKW(P0,4), pw0[3]=PKW(P0,6), pw0); \
    VRD(1); SBAR(); GAPA(C0=__builtin_amdgcn_mfma_f32_32x32x16_bf16(kf[2],qr[1],C0,0,0,0),   P0[10],P0[11],P0[12],P0[13], pw1[0]=PKW(P0,8), pw1[1]=PKW(P0,10), pw1); \
    VRD(5); SBAR(); GAPA(C1=__builtin_amdgcn_mfma_f32_32x32x16_bf16(kf[3],qr[1],C1,0,0,0),   P0[14],P0[15],P1[0],P1[1],   pw1[2]=PKW(P0,12),pw1[3]=PKW(P0,14), pw1); \
    VRD(2); SBAR(); GAPA(C0=__builtin_amdgcn_mfma_f32_32x32x16_bf16(kf[4],qr[2],C0,0,0,0),   P1[2],P1[3],P1[4],P1[5],     pw2[0]=PKW(P1,0), pw2[1]=PKW(P1,2), pw2); \
    VRD(6); SBAR(); GAPA(C1=__builtin_amdgcn_mfma_f32_32x32x16_bf16(kf[5],qr[2],C1,0,0,0),   P1[6],P1[7],P1[8],P1[9],     pw2[2]=PKW(P1,4), pw2[3]=PKW(P1,6), pw2); \
    VRD(3); SBAR(); GAPA(C0=__builtin_amdgcn_mfma_f32_32x32x16_bf16(kf[6],qr[3],C0,0,0,0),   P1[10],P1[11],P1[12],P1[13], pw3[0]=PKW(P1,8), pw3[1]=PKW(P1,10), pw3); \
    VRD(7); SBAR(); GAPA(C1=__builtin_amdgcn_mfma_f32_32x32x16_bf16(kf[7],qr[3],C1,0,0,0),   P1[14],P1[15],0.f,0.f,       pw3[2]=PKW(P1,12),pw3[3]=PKW(P1,14), pw3); \
    l_reg+=sacc; \
    if(GK){DMA_K((t)+3,sl_cur);} if(GV){DMA_V((t)+1,sl_next);} \
    CMASK(C0,C1,t); \
    { float a=MX3(C0[0],C0[1],C1[0]),b=MX3(C0[2],C0[3],C1[1]); a=MX3(a,C1[2],C1[3]); \
      _Pragma("unroll") for(int r=4;r<16;r+=4){a=MX3(a,C0[r],C0[r+1]);b=MX3(b,C0[r+2],C0[r+3]);a=MX3(a,C1[r],C1[r+1]);b=MX3(b,C1[r+2],C1[r+3]);} \
      float rm=__builtin_fmaxf(a,b); { auto rr=__builtin_amdgcn_permlane32_swap(__float_as_uint(rm),__float_as_uint(rm),false,false); rm=__builtin_fmaxf(__uint_as_float(rr[0]),__uint_as_float(rr[1])); } \
      resc=false; \
      if(__builtin_expect(__any(rm>(float)THRL),0)){ const float dl=__builtin_fmaxf(rm,0.f); mhat+=dl; \
        _Pragma("unroll") for(int r=0;r<16;++r){C0[r]-=dl;C1[r]-=dl;} \
        const float f=__builtin_amdgcn_exp2f(-dl); l_reg*=f; if(hi==0)wsf[r32]=f; resc=true; } } \
    SBAR(); \
    GAPB(o[0]=__builtin_amdgcn_mfma_f32_32x32x16_bf16(PAF(0),VFR(0),o[0],0,0,0), C0,0);  VRD2(0,8); \
    GAPB(o[1]=__builtin_amdgcn_mfma_f32_32x32x16_bf16(PAF(0),VFR(4),o[1],0,0,0), C0,2);  VRD2(4,12); \
    KRD(GL,0); GAPB(o[0]=__builtin_amdgcn_mfma_f32_32x32x16_bf16(PAF(1),VFR(1),o[0],0,0,0), C0,4);  VRD2(1,9); \
    KRD(GL,1); GAPB(o[1]=__builtin_amdgcn_mfma_f32_32x32x16_bf16(PAF(1),VFR(5),o[1],0,0,0), C0,6);  VRD2(5,13); \
    KRD(GL,2); GAPB(o[0]=__builtin_amdgcn_mfma_f32_32x32x16_bf16(PAF(2),VFR(2),o[0],0,0,0), C0,8);  VRD2(2,10); \
    KRD(GL,3); GAPB(o[1]=__builtin_amdgcn_mfma_f32_32x32x16_bf16(PAF(2),VFR(6),o[1],0,0,0), C0,10); VRD2(6,14); \
    GAPB(o[0]=__builtin_amdgcn_mfma_f32_32x32x16_bf16(PAF(3),VFR(3),o[0],0,0,0), C0,12); VRD2(3,11); \
    GAPB(o[1]=__builtin_amdgcn_mfma_f32_32x32x16_bf16(PAF(3),VFR(7),o[1],0,0,0), C0,14); VRD2(7,15); \
    GAPB(o[2]=__builtin_amdgcn_mfma_f32_32x32x16_bf16(PAF(0),VFR(0),o[2],0,0,0), C1,0); \
    GAPB(o[3]=__builtin_amdgcn_mfma_f32_32x32x16_bf16(PAF(0),VFR(4),o[3],0,0,0), C1,2); \
    GAPB(o[2]=__builtin_amdgcn_mfma_f32_32x32x16_bf16(PAF(1),VFR(1),o[2],0,0,0), C1,4); \
    GAPB(o[3]=__builtin_amdgcn_mfma_f32_32x32x16_bf16(PAF(1),VFR(5),o[3],0,0,0), C1,6); \
    GAPB(o[2]=__builtin_amdgcn_mfma_f32_32x32x16_bf16(PAF(2),VFR(2),o[2],0,0,0), C1,8); \
    GAPB(o[3]=__builtin_amdgcn_mfma_f32_32x32x16_bf16(PAF(2),VFR(6),o[3],0,0,0), C1,10); \
    GAPB(o[2]=__builtin_amdgcn_mfma_f32_32x32x16_bf16(PAF(3),VFR(3),o[2],0,0,0), C1,12); \
    GAPB(o[3]=__builtin_amdgcn_mfma_f32_32x32x16_bf16(PAF(3),VFR(7),o[3],0,0,0), C1,14); \
    }while(0)
  int t=1;
  #undef CMASK
  #define CMASK(P0,P1,t) do{}while(0)
  for(;t+5<NT;t+=2){
    STEP(pB0,pB1,pA0,pA1,t,true,true,true);     WAIT_BAR(3); RESC(); ROT();
    STEP(pA0,pA1,pB0,pB1,t+1,true,true,true);   WAIT_BAR(3); RESC(); ROT();
  }
  #undef CMASK
  #define CMASK(P0,P1,t) do{int jb_=(t)-(NT-4); if(jb_>=0)cmask(P0,P1,jb_,qrel,hi);}while(0)
  #define ENDW(tt) do{ if((tt)+3<NT){WAIT_BAR(3);} else if((tt)+2<NT){WAIT_BAR(2);} else {WAIT_BAR(0);} }while(0)
  for(;t+1<NT;t+=2){
    STEP(pB0,pB1,pA0,pA1,t,(t+3<NT),(t+1<NT),(t+1<NT));       ENDW(t);   RESC(); ROT();
    STEP(pA0,pA1,pB0,pB1,t+1,(t+4<NT),(t+2<NT),(t+2<NT));     ENDW(t+1); RESC(); ROT();
  }
  STEP(pB0,pB1,pA0,pA1,NT-1,false,false,false); RESC();
  { float sacc=pB0[0]+pB0[1]; _Pragma("unroll") for(int r=2;r<16;++r)sacc+=pB0[r]; _Pragma("unroll") for(int r=0;r<16;++r)sacc+=pB1[r]; l_reg+=sacc;
    pw0=(u32x4){PKW(pB0,0),PKW(pB0,2),PKW(pB0,4),PKW(pB0,6)};pw1=(u32x4){PKW(pB0,8),PKW(pB0,10),PKW(pB0,12),PKW(pB0,14)};pw2=(u32x4){PKW(pB1,0),PKW(pB1,2),PKW(pB1,4),PKW(pB1,6)};pw3=(u32x4){PKW(pB1,8),PKW(pB1,10),PKW(pB1,12),PKW(pB1,14)};
    SBAR(); pv(o,vb0+2*sl_cur,PAF(0),PAF(1),PAF(2),PAF(3)); }
  #undef PKW
  #undef PAF
  #undef VFR
  #undef PIN
  #undef MX3
  #undef GAPA
  #undef GAPB
  #undef EX
  #undef VRD
  #undef VRD2
  #undef KRD
  #undef STEP
  #undef ENDW
  {auto rr=__builtin_amdgcn_permlane32_swap(__float_as_uint(l_reg),__float_as_uint(l_reg),false,false);l_reg=__uint_as_float(rr[0])+__uint_as_float(rr[1]);}
  if(hi==0)wsf[32+r32]=l_reg;asm volatile("s_waitcnt lgkmcnt(0)":::"memory");
  float rli[16];
  #pragma unroll
  for(int r=0;r<16;++r)rli[r]=__builtin_amdgcn_rcpf(wsf[32+crow(r,hi)]);
  bf16*Ow=O+(rowbase+q0+wid*QBLK)*OPITCH+ocol;
  { bf16*stg=(bf16*)(shm+LDS_OST)+wid*2048;
    int ln2_=lane; asm volatile("":"+v"(ln2_));
    #pragma unroll
    for(int hf=0;hf<2;++hf){
      #pragma unroll
      for(int r=0;r<16;++r){const int orow=crow(r,hi);
        #pragma unroll
        for(int d0=0;d0<2;++d0)stg[orow*64+d0*32+r32]=__float2bfloat16(o[2*hf+d0][r]*rli[r]);}
      asm volatile("s_waitcnt lgkmcnt(0)":::"memory");
      #pragma unroll
      for(int i=0;i<4;++i){const int row=i*8+(ln2_>>3),ch=ln2_&7; const u32x4 v=*(const u32x4*)(stg+row*64+ch*8); ATTN_STORE16(Ow+(long)row*OPITCH+hf*64+ch*8,v);}
      asm volatile("s_waitcnt lgkmcnt(0)":::"memory"); } }
  asm volatile("s_waitcnt lgkmcnt(0)\n\ts_barrier":::"memory");
  #undef DMA_K
  #undef DMA_V
  #undef CMASK
  #undef CINIT
  #undef CINIT0
  #undef CINIT1
  #undef START
  #undef RESC
  #undef ROT
}
constexpr int ATTN_LDS_BYTES=LDS_BYTES;
struct AttnTensors { const bf16* Q; const bf16* K; const bf16* V; bf16* O; };
template<int THRL=8> __device__ __forceinline__ void attn_phase(char*lds,const AttnTensors&T,unsigned*qw,volatile __attribute__((address_space(3))) unsigned*qs){
  for(;;){
    if(threadIdx.x==0) qs[0]=__hip_atomic_fetch_add(qw,2u,__ATOMIC_RELAXED,__HIP_MEMORY_SCOPE_AGENT);
    __syncthreads();
    const int idx0=__builtin_amdgcn_readfirstlane((int)qs[0]);
    __syncthreads();
    if(idx0>=2048)break;
    for(int idx=idx0;idx<idx0+2;++idx){
      const int c=idx&1,b=(idx>>1)&7,h=7-((idx>>4)&7),qb=15-(idx>>7);
      const float sl2=__uint_as_float(__builtin_amdgcn_readfirstlane(__float_as_uint(__builtin_amdgcn_exp2f(-(float)(h+1))*1.4426950408889634f)));
      const int nfar=(h==0)?6:(h==1)?10:(h==2)?20:(h==3)?38:64;
      attn_unit<THRL>(b,2*h+c,2*h,c*1024+h*128,qb,nfar,sl2,T.Q,T.K,T.V,T.O,lds);
    }
  }
}
#undef SBAR
#undef WAIT_BAR
}
#define GAS __attribute__((address_space(1)))
#define LAS __attribute__((address_space(3)))
typedef unsigned short bf16;
typedef unsigned v4u __attribute__((ext_vector_type(4)));
typedef float f32x4 __attribute__((ext_vector_type(4)));
typedef short bf16x8 __attribute__((ext_vector_type(8)));
typedef GAS unsigned gu32;
typedef GAS unsigned long long gu64;
#define RLX_AGENT __ATOMIC_RELAXED, __HIP_MEMORY_SCOPE_AGENT
#define LDS_WAIT() asm volatile("s_waitcnt lgkmcnt(0)" ::: "memory")
#define VM_WAIT() asm volatile("s_waitcnt vmcnt(0)" ::: "memory")
__device__ __forceinline__ unsigned long long rt() { return __builtin_amdgcn_s_memrealtime(); }
__device__ __forceinline__ unsigned f2bf(float f) { unsigned u = __builtin_bit_cast(unsigned, f); return (u + 0x7fffu + ((u >> 16) & 1u)) >> 16; }
__device__ __forceinline__ unsigned pk2(float lo, float hi) { return f2bf(lo) | (f2bf(hi) << 16); }

#define XB_TMO      128
#define XB_XCNT(j)  (256  + 64 * (j))
#define XB_XSUB(j)  (1280 + 64 * (j))
#define XB_XGEN(j)  (2304 + 64 * (j))
#define XB_TOP      3328
#define XB_TOPGEN   3392
#define XCD_BAR_WORDS 3456
#define XB_SPIN_CAP (1u << 18)

__device__ __forceinline__ unsigned xb_ld(unsigned* p)              { return __hip_atomic_load(p, __ATOMIC_RELAXED, __HIP_MEMORY_SCOPE_AGENT); }
__device__ __forceinline__ unsigned xb_add(unsigned* p, unsigned v) { return __hip_atomic_fetch_add(p, v, __ATOMIC_RELAXED, __HIP_MEMORY_SCOPE_AGENT); }
__device__ __forceinline__ unsigned xb_xcc_id() { return (unsigned)__builtin_amdgcn_s_getreg((3 << 11) | 20) & 0xFu; }
#define XB_SPIN(cond, bar) do { unsigned _sp = 0; while (cond) { __builtin_amdgcn_s_sleep(1); \
    if ((++_sp & 255u) == 0u) { if (xb_ld(&(bar)[XB_TMO])) break; if (_sp > XB_SPIN_CAP) { atomicAdd(&(bar)[XB_TMO], 1u); break; } } } } while (0)

struct XcdBarrier {
    unsigned* bar; unsigned x;
    volatile LAS unsigned* st;
};

__device__ __forceinline__ XcdBarrier xcd_barrier_post(unsigned* bar, volatile LAS unsigned* st) {
    XcdBarrier b; b.bar = bar; b.x = xb_xcc_id(); b.st = st;
    if (threadIdx.x == 0) (void)xb_add(&bar[XB_XCNT(b.x)], 1u);
    return b;
}
__device__ __forceinline__ void xcd_barrier_complete(unsigned* bar, unsigned x, unsigned& nloc, unsigned& nx) {
    const unsigned G = gridDim.x * gridDim.y * gridDim.z;
    unsigned sum, cnt, mine, sp = 0u;
    for (;;) {
        sum = 0u; cnt = 0u; mine = 0u;
#pragma unroll
        for (unsigned j = 0; j < 16; ++j) { const unsigned c = xb_ld(&bar[XB_XCNT(j)]); sum += c; cnt += (c > 0u) ? 1u : 0u; mine = (j == x) ? c : mine; }
        if (sum == G) break;
        __builtin_amdgcn_s_sleep(1);
        if ((++sp & 255u) == 0u) { if (xb_ld(&bar[XB_TMO])) break; if (sp > XB_SPIN_CAP) { atomicAdd(&bar[XB_TMO], 1u); break; } }
    }
    nloc = mine > 0u ? mine : 1u; nx = cnt > 0u ? cnt : 1u;
}

__device__ __forceinline__ void xcd_barrier(const XcdBarrier& b) {
    asm volatile("s_waitcnt vmcnt(0)" ::: "memory");
    __syncthreads();
    if (threadIdx.x == 0) {
        unsigned* bar = b.bar;
        __builtin_amdgcn_s_waitcnt(0);
        unsigned nloc = b.st[0], nx = b.st[1];
        if (nloc == 0u) { xcd_barrier_complete(bar, b.x, nloc, nx); b.st[0] = nloc; b.st[1] = nx; }
        const unsigned old = xb_add(&bar[XB_XSUB(b.x)], 1u);
        const unsigned gen = old / nloc;
        if (old + 1u == (gen + 1u) * nloc) {
            __builtin_amdgcn_fence(__ATOMIC_RELEASE, "agent");
            asm volatile("s_waitcnt vmcnt(0)" ::: "memory");
            const unsigned og = xb_add(&bar[XB_TOP], 1u);
            const unsigned tg = og / nx;
            if (og + 1u == (tg + 1u) * nx) xb_add(&bar[XB_TOPGEN], 1u);
            else XB_SPIN(xb_ld(&bar[XB_TOPGEN]) == tg, bar);
            __builtin_amdgcn_fence(__ATOMIC_ACQUIRE, "agent");
            xb_add(&bar[XB_XGEN(b.x)], 1u);
            asm volatile("s_waitcnt vmcnt(0)" ::: "memory");
        } else {
            XB_SPIN(xb_ld(&bar[XB_XGEN(b.x)]) == gen, bar);
            __builtin_amdgcn_fence(__ATOMIC_ACQUIRE, "agent");
            asm volatile("s_waitcnt vmcnt(0)" ::: "memory");
        }
    }
    __syncthreads();
}
constexpr int NWAVES = 8, NTHREADS = 512;
constexpr int BATCH = 8, SEQ = 4096, DM = 1024, NTOK = BATCH * SEQ, DEPTH = 4;
constexpr int DIN = 8208, NPROJ = 8192;
constexpr int NEXP = 32, DEXP = 512, LISTCAP = 32768, MOE_MAXT = 288;
constexpr float LN_EPS = 1e-5f, DN_ALPHA = 1.6817928305074292f;
constexpr size_t MiB = 1u << 20;
constexpr size_t WS_CTL = 0, CTL_ZERO_BYTES = 1 * MiB;
constexpr size_t WS_ADA = 1 * MiB;
constexpr size_t WS_ABWT = 2 * MiB;
constexpr size_t WS_RWT = 2 * MiB + 256 * 1024;
constexpr size_t WS_TOKINFO = 3 * MiB;
constexpr size_t WS_LIST = 4 * MiB;
constexpr size_t WS_SSQ = 8 * MiB;
constexpr size_t WS_PRM = 16 * MiB;
constexpr int PO_BGATES = 0, PO_WALPHA = 8192, PO_BALPHA = 40960, PO_LQ1 = 43008, PO_LK1 = 43264, PO_LQ2 = 43520, PO_LK2 = 43776, PO_DIFFG = 44032, PO_GLAG = 44544,
              PO_LN1G = 45568, PO_LN1B = 49664, PO_BRG = 53760, PO_BRE = 53776, PO_LN2G = 53904, PO_LN2B = 58000, PO_END = 62096;
constexpr size_t WS_GDEC = 18 * MiB;
constexpr size_t WS_WIN = 32 * MiB;
constexpr size_t WS_WBA = 96 * MiB, WS_WBB = 104 * MiB, WS_WOUT = 112 * MiB;
constexpr size_t WS_W1 = 120 * MiB;
constexpr size_t WS_WD = 376 * MiB;
constexpr size_t WS_U = 504 * MiB;
constexpr size_t WS_QB = 568 * MiB, WS_KB = 632 * MiB, WS_VB = 696 * MiB;
constexpr size_t WS_GQ = 760 * MiB, WS_GK = 792 * MiB;
constexpr size_t WS_GV = 824 * MiB, WS_SG = 888 * MiB;
constexpr size_t WS_GT = 952 * MiB;
constexpr size_t WS_LA = 1080 * MiB;
constexpr size_t WS_END = 1144 * MiB;
constexpr size_t WS_OB = WS_U;
constexpr size_t WS_OP = WS_GQ;
constexpr size_t WS_OA2 = WS_QB, WS_OB2 = WS_KB;
constexpr size_t WS_TMP = WS_VB, WS_MIX = WS_GQ;
constexpr size_t WS_H = WS_QB;
constexpr size_t WS_YB = WS_QB + 72 * MiB;
constexpr int CW_ATQ = 32768;
constexpr int CW_TMO = 0, CW_CODE = 1, CW_BAR = 4096, CW_CNT = 8192;
constexpr int RING_OFF = 0, RING_BYTES = 147456;
constexpr int LDSCTL_OFF = RING_BYTES, MISC_OFF = LDSCTL_OFF + 320;
constexpr int TAB_CNT = RING_BYTES + 512, TAB_BASE = RING_BYTES + 640, TAB_IDX = RING_BYTES + 1024, IDX_UNITS = 8;
constexpr int LDS_BYTES = 163840;
static_assert(TAB_IDX + IDX_UNITS * 256 * 4 <= LDS_BYTES, "LDS map");
struct Frame {
    LAS unsigned char* lds;
    gu32* ctl;
    int tid, lane, wave, vcu, G;
    float* out; unsigned char* ws; const float* prm;
    float* xst; bf16* Ubuf; float* LAbuf; int dry;
};
enum { I_X = 0, I_C, I_WADA, I_BADA, I_WIN, I_BGATES, I_WALPHA, I_BALPHA, I_LQ1, I_LK1, I_LQ2, I_LK2, I_DIFFG, I_GLAG, I_WBA, I_WBB, I_WOUT, I_LN1G, I_LN1B,
       I_WRG, I_BRG, I_WRE, I_BRE, I_WGE, I_WUE, I_WDE, I_LN2G, I_LN2B };
__device__ __forceinline__ float dpp_add(float v, const int ctrl_sel) {
    const int x = __float_as_int(v); int y;
    if (ctrl_sel == 0) y = __builtin_amdgcn_update_dpp(x, x, 0xB1, 0xF, 0xF, false);
    else if (ctrl_sel == 1) y = __builtin_amdgcn_update_dpp(x, x, 0x4E, 0xF, 0xF, false);
    else if (ctrl_sel == 2) y = __builtin_amdgcn_update_dpp(x, x, 0x141, 0xF, 0xF, false);
    else y = __builtin_amdgcn_update_dpp(x, x, 0x140, 0xF, 0xF, false);
    return v + __int_as_float(y);
}
__device__ __forceinline__ float wave_sum(float v) {
    v = dpp_add(v, 0); v = dpp_add(v, 1); v = dpp_add(v, 2); v = dpp_add(v, 3);
    { auto rr = __builtin_amdgcn_permlane16_swap(__float_as_uint(v), __float_as_uint(v), false, false); v = __uint_as_float(rr[0]) + __uint_as_float(rr[1]); }
    { auto rr = __builtin_amdgcn_permlane32_swap(__float_as_uint(v), __float_as_uint(v), false, false); v = __uint_as_float(rr[0]) + __uint_as_float(rr[1]); }
    return v;
}
__device__ __forceinline__ float siluf_(float x) { return x * __builtin_amdgcn_rcpf(1.0f + __expf(-x)); }
__device__ __forceinline__ float bflo(unsigned w) { return __uint_as_float(w << 16); }
__device__ __forceinline__ float bfhi(unsigned w) { return __uint_as_float(w & 0xffff0000u); }

__device__ __forceinline__ void p0_ada(Frame& F, const float* c, const float* wada, const float* bada) {
    LAS float* COND = (LAS float*)(F.lds);
    LAS float* PART = (LAS float*)(F.lds + 32768);
    float* ADA = (float*)(F.ws + WS_ADA);
    for (int i = F.tid; i < 8192; i += NTHREADS) COND[i] = siluf_(c[i]);
    __syncthreads();
    for (int cg = (int)blockIdx.x; cg < 256; cg += F.G) {
        const int l = cg >> 6, j0 = (cg & 63) * 96;
        const int col4 = F.lane % 24, ksub = F.lane / 24;
        f32x4 acc[8];
#pragma unroll
        for (int b = 0; b < 8; ++b) acc[b] = (f32x4){0.f, 0.f, 0.f, 0.f};
        if (ksub < 2) {
            const float* wp = wada + ((size_t)l * 1024 + (size_t)(F.wave * 128 + ksub)) * 6144 + j0 + 4 * col4;
#pragma unroll 8
            for (int kk = 0; kk < 64; ++kk) {
                const f32x4 wv = *(const GAS f32x4*)(wp + (size_t)kk * 2 * 6144); const int k = F.wave * 128 + 2 * kk + ksub;
#pragma unroll
                for (int b = 0; b < 8; ++b) acc[b] += wv * COND[b * 1024 + k];
            }
#pragma unroll
            for (int b = 0; b < 8; ++b) *(LAS f32x4*)(PART + ((F.wave * 2 + ksub) * 8 + b) * 96 + 4 * col4) = acc[b];
        }
        __syncthreads();
        for (int idx = F.tid; idx < 768; idx += NTHREADS) { const int b = idx / 96, col = idx % 96; float s = 0.f;
#pragma unroll
            for (int p = 0; p < 16; ++p) s += PART[(p * 8 + b) * 96 + col];
            ADA[((size_t)l * 8 + b) * 6144 + j0 + col] = s + bada[l * 6144 + j0 + col]; }
        __syncthreads();
    }
}
struct RmIdent { __device__ __forceinline__ int operator()(int n) const { return n; } };
struct RmWin { __device__ __forceinline__ int operator()(int n) const { return n < 6144 ? n : (n < 6160 ? -1 : n - 16); } };
struct RmGateUp { int up; __device__ __forceinline__ int operator()(int n) const { return (n >> 7) * 256 + up * 128 + (n & 127); } };
template <class RowMap>
__device__ __forceinline__ void p0_transpose_item(const float* W, int K, int N, bf16* WT, const RowMap rm, LAS float* scr, int kb, int nb, int lane) {
    const int k0 = 64 * kb, n0 = 32 * nb; const int n4 = (lane & 7) * 4; const bool nv = (n0 + n4 + 3 < N);
    f32x4 tv[8];
#pragma unroll
    for (int i = 0; i < 8; ++i) { const int kk = 8 * i + (lane >> 3); tv[i] = nv ? *(const GAS f32x4*)(W + (size_t)(k0 + kk) * N + n0 + n4) : (f32x4){0.f, 0.f, 0.f, 0.f}; }
#pragma unroll
    for (int i = 0; i < 8; ++i) { const int kk = 8 * i + (lane >> 3); LAS float* d = scr + kk * 33 + n4; d[0] = tv[i].x; d[1] = tv[i].y; d[2] = tv[i].z; d[3] = tv[i].w; }
    LDS_WAIT(); asm volatile("" ::: "memory");
    const int c = lane & 7;
#pragma unroll
    for (int j = 0; j < 4; ++j) { const int nn = (lane >> 3) + 8 * j, n = n0 + nn; const LAS float* s = scr + (8 * c) * 33 + nn;
        v4u o; o.x = pk2(s[0 * 33], s[1 * 33]); o.y = pk2(s[2 * 33], s[3 * 33]); o.z = pk2(s[4 * 33], s[5 * 33]); o.w = pk2(s[6 * 33], s[7 * 33]);
        const int r = (n < N) ? rm(n) : -1;
        if (r >= 0) *(GAS v4u*)(WT + (size_t)r * K + k0 + 8 * c) = o; }
    LDS_WAIT(); asm volatile("" ::: "memory");
}
struct SmallPrm { const float *bgates, *walpha, *balpha, *lq1, *lk1, *lq2, *lk2, *diffg, *glag, *ln1g, *ln1b, *brg, *bre, *ln2g, *ln2b; };
__device__ __forceinline__ void p0_copy(float* dst, const float* src, int n, int gt, int NGT) { for (int i = gt; i < n; i += NGT) dst[i] = src[i]; }
__device__ __forceinline__ void p0_weights(Frame& F, const float* win, const float* wba, const float* wbb, const float* wout, const float* wge, const float* wue, const float* wde, const float* wrg, const float* wre, const SmallPrm sp) {
    LAS float* scr = (LAS float*)(F.lds + RING_OFF + F.wave * 16384);
    const int gw = F.vcu * NWAVES + F.wave, NGW = F.G * NWAVES;
    constexpr int I_IN = 4 * 16 * 257, I_SQ = 12 * 16 * 32, I_E = 128 * 16 * 16, I_D = 128 * 8 * 32;
    constexpr int NITEMS = I_IN + I_SQ + 2 * I_E + I_D;
    for (int it = gw; it < NITEMS; it += NGW) {
        int r = it;
        if (r < I_IN) { const int l = r / 4112, q = r % 4112;
            p0_transpose_item(win + (size_t)l * 1024 * DIN, 1024, DIN, (bf16*)(F.ws + WS_WIN) + (size_t)l * NPROJ * 1024, RmWin{}, scr, q / 257, q % 257, F.lane); continue; }
        r -= I_IN;
        if (r < I_SQ) { const int mat = r / 512, q = r % 512, which = mat >> 2, l = mat & 3;
            const float* W = (which == 0 ? wba : (which == 1 ? wbb : wout)) + (size_t)l * 1024 * 1024;
            bf16* WT = (bf16*)(F.ws + (which == 0 ? WS_WBA : (which == 1 ? WS_WBB : WS_WOUT))) + (size_t)l * 1024 * 1024;
            p0_transpose_item(W, 1024, 1024, WT, RmIdent{}, scr, q / 32, q % 32, F.lane); continue; }
        r -= I_SQ;
        if (r < 2 * I_E) { const int up = r >= I_E ? 1 : 0; if (up) r -= I_E; const int me = r / 256, q = r % 256;
            p0_transpose_item((up ? wue : wge) + (size_t)me * 1024 * 512, 1024, 512, (bf16*)(F.ws + WS_W1) + (size_t)me * 1024 * 1024, RmGateUp{up}, scr, q / 16, q % 16, F.lane); continue; }
        r -= 2 * I_E;
        { const int me = r / 256, q = r % 256;
          p0_transpose_item(wde + (size_t)me * 512 * 1024, 512, 1024, (bf16*)(F.ws + WS_WD) + (size_t)me * 1024 * 512, RmIdent{}, scr, q / 32, q % 32, F.lane); }
    }
    const int gt = F.vcu * NTHREADS + F.tid, NGT = F.G * NTHREADS;
    float* ABWT = (float*)(F.ws + WS_ABWT); float* RWT = (float*)(F.ws + WS_RWT);
    { float* P = (float*)(F.ws + WS_PRM);
      p0_copy(P + PO_BGATES, sp.bgates, 8192, gt, NGT); p0_copy(P + PO_WALPHA, sp.walpha, 32768, gt, NGT); p0_copy(P + PO_BALPHA, sp.balpha, 2048, gt, NGT);
      p0_copy(P + PO_LQ1, sp.lq1, 256, gt, NGT); p0_copy(P + PO_LK1, sp.lk1, 256, gt, NGT); p0_copy(P + PO_LQ2, sp.lq2, 256, gt, NGT); p0_copy(P + PO_LK2, sp.lk2, 256, gt, NGT);
      p0_copy(P + PO_DIFFG, sp.diffg, 512, gt, NGT); p0_copy(P + PO_GLAG, sp.glag, 1024, gt, NGT); p0_copy(P + PO_LN1G, sp.ln1g, 4096, gt, NGT); p0_copy(P + PO_LN1B, sp.ln1b, 4096, gt, NGT);
      p0_copy(P + PO_BRG, sp.brg, 16, gt, NGT); p0_copy(P + PO_BRE, sp.bre, 128, gt, NGT); p0_copy(P + PO_LN2G, sp.ln2g, 4096, gt, NGT); p0_copy(P + PO_LN2B, sp.ln2b, 4096, gt, NGT); }
    for (int i = gt; i < 4 * 16 * 1024; i += NGT) { const int l = i >> 14, r = (i >> 10) & 15, k = i & 1023; ABWT[i] = win[((size_t)l * 1024 + k) * DIN + 6144 + r]; }
    for (int i = gt; i < 4 * 36 * 1024; i += NGT) { const int l = i / 36864, c = (i / 1024) % 36, k = i & 1023;
        RWT[i] = (c < 4) ? wrg[((size_t)l * 1024 + k) * 4 + c] : wre[((size_t)l * 1024 + k) * 32 + (c - 4)]; }
}

typedef f32x4 Row4[4];
__device__ __forceinline__ void row_load(Row4& v, const float* p, int lane) { const GAS f32x4* q = (const GAS f32x4*)p + lane;
#pragma unroll
    for (int j = 0; j < 4; ++j) v[j] = q[64 * j]; }
__device__ __forceinline__ void row_store(const Row4& v, float* p, int lane) { GAS f32x4* q = (GAS f32x4*)p + lane;
#pragma unroll
    for (int j = 0; j < 4; ++j) q[64 * j] = v[j]; }
__device__ __forceinline__ void row_standardize(Row4& v) {
    float s = 0.f;
#pragma unroll
    for (int j = 0; j < 4; ++j) s += (v[j].x + v[j].y) + (v[j].z + v[j].w);
    const float mean = wave_sum(s) * (1.f / DM); float s2 = 0.f;
#pragma unroll
    for (int j = 0; j < 4; ++j) { v[j] = v[j] - mean; s2 += (v[j].x * v[j].x + v[j].y * v[j].y) + (v[j].z * v[j].z + v[j].w * v[j].w); }
    const float rstd = 1.f / sqrtf(wave_sum(s2) * (1.f / DM) + LN_EPS);
#pragma unroll
    for (int j = 0; j < 4; ++j) v[j] = v[j] * rstd;
}
__device__ __forceinline__ void row_affine(Row4& v, const float* g, const float* b, bool one_plus, int lane) {
    asm volatile("" : "+s"(g), "+s"(b));
#pragma unroll
    for (int j = 0; j < 4; ++j) { f32x4 gv = *((const GAS f32x4*)g + lane + 64 * j); const f32x4 bv = *((const GAS f32x4*)b + lane + 64 * j); if (one_plus) gv = gv + 1.0f; v[j] = v[j] * gv + bv; }
}
__device__ __forceinline__ void row_store_bf16(const Row4& v, bf16* p, int lane) { GAS unsigned long long* o8 = (GAS unsigned long long*)p + lane;
#pragma unroll
    for (int j = 0; j < 4; ++j) o8[64 * j] = (unsigned long long)pk2(v[j].x, v[j].y) | ((unsigned long long)pk2(v[j].z, v[j].w) << 32); }
__device__ __forceinline__ int idx16(int L) { return ((L >> 5) & 1) + 2 * ((L >> 4) & 1) + 4 * ((L >> 3) & 1) + 8 * ((L >> 2) & 1) + 16 * ((L >> 1) & 1) + 32 * (L & 1); }
__device__ __forceinline__ int idx4(int L) { return ((L >> 5) & 1) + 2 * ((L >> 4) & 1) + 4 * ((L >> 3) & 1) + 8 * ((L >> 2) & 1); }
template <int NC, class WP>
__device__ __forceinline__ float rows4_proj(const Row4 (&u)[4], WP wT, int lane) {
    float p[4 * NC]; f32x4 wa[4], wb[4];
    asm volatile("" : "+s"(wT));
    const WP wp = wT + lane;
#define R4_LDW(DD_, CC_) do { _Pragma("unroll") for (int j = 0; j < 4; ++j) DD_[j] = wp[(CC_) * 256 + 64 * j]; } while (0)
#define R4_DOT(WW_, CC_) do { _Pragma("unroll") for (int r = 0; r < 4; ++r) { pg8::f32x2 s_ = (pg8::f32x2){0.f, 0.f}; _Pragma("unroll") for (int j = 0; j < 4; ++j) { \
        s_ = __builtin_elementwise_fma((pg8::f32x2){u[r][j].x, u[r][j].y}, (pg8::f32x2){WW_[j].x, WW_[j].y}, s_); s_ = __builtin_elementwise_fma((pg8::f32x2){u[r][j].z, u[r][j].w}, (pg8::f32x2){WW_[j].z, WW_[j].w}, s_); } \
        p[r * NC + (CC_)] = s_.x + s_.y; } } while (0)
    R4_LDW(wa, 0);
#pragma unroll
    for (int c = 0; c < NC; c += 2) {
        R4_LDW(wb, c + 1); __builtin_amdgcn_sched_barrier(0);
        R4_DOT(wa, c);
        if (c + 2 < NC) R4_LDW(wa, c + 2);
        __builtin_amdgcn_sched_barrier(0);
        R4_DOT(wb, c + 1);
        __builtin_amdgcn_sched_barrier(0);
    }
#undef R4_LDW
#undef R4_DOT
    int V = 4 * NC;
#pragma unroll
    for (int M = 32; M >= 1; M >>= 1) {
        if (V > 1) { const bool bit = (lane & M) != 0;
#pragma unroll
            for (int i = 0; i < 32; ++i) if (i < V / 2) { const float a = p[2 * i], b = p[2 * i + 1]; const float send = bit ? a : b; const float recv = __shfl_xor(send, M); p[i] = (bit ? b : a) + recv; }
            V >>= 1; }
        else p[0] += __shfl_xor(p[0], M);
    }
    return p[0];
}
__device__ __forceinline__ int idx8(int L) { return ((L >> 5) & 1) + 2 * ((L >> 4) & 1) + 4 * ((L >> 3) & 1) + 8 * ((L >> 2) & 1) + 16 * ((L >> 1) & 1); }
__device__ __forceinline__ float rows4_proj8g(const Row4 (&u)[4], const LAS f32x4* wre, const int (&g)[4], int lane) {
    float p[32];
    asm volatile("" : "+s"(wre));
#pragma unroll
    for (int c = 0; c < 8; ++c) {
#pragma unroll
        for (int r = 0; r < 4; ++r) { const LAS f32x4* wp = wre + (g[r] * 8 + c) * 256 + lane; pg8::f32x2 s_ = (pg8::f32x2){0.f, 0.f};
#pragma unroll
            for (int j = 0; j < 4; ++j) { const f32x4 w_ = wp[64 * j];
                s_ = __builtin_elementwise_fma((pg8::f32x2){u[r][j].x, u[r][j].y}, (pg8::f32x2){w_.x, w_.y}, s_); s_ = __builtin_elementwise_fma((pg8::f32x2){u[r][j].z, u[r][j].w}, (pg8::f32x2){w_.z, w_.w}, s_); }
            p[r * 8 + c] = s_.x + s_.y; }
        __builtin_amdgcn_sched_barrier(0); }
    int V = 32;
#pragma unroll
    for (int M = 32; M >= 1; M >>= 1) {
        if (V > 1) { const bool bit = (lane & M) != 0;
#pragma unroll
            for (int i = 0; i < 16; ++i) if (i < V / 2) { const float a = p[2 * i], b = p[2 * i + 1]; const float send = bit ? a : b; const float recv = __shfl_xor(send, M); p[i] = (bit ? b : a) + recv; }
            V >>= 1; }
        else p[0] += __shfl_xor(p[0], M);
    }
    return p[0];
}
constexpr int WAL_OFF = 16384, BAL_OFF = 16384 + 32768, ABL_OFF = 16384 + 32768 + 2048;
__device__ __forceinline__ void load_walpha(Frame& F, int l) {
    const float* walpha_all = F.prm + PO_WALPHA; const float* balpha_all = F.prm + PO_BALPHA;
    LAS float* WAL = (LAS float*)(F.lds + RING_OFF + WAL_OFF); LAS float* BAL = (LAS float*)(F.lds + RING_OFF + BAL_OFF);
    for (int i = F.tid; i < 8192; i += NTHREADS) WAL[i] = walpha_all[(size_t)l * 8192 + i];
    if (F.tid < 512) BAL[F.tid] = balpha_all[l * 512 + F.tid];
    { const GAS f32x4* src = (const GAS f32x4*)((const float*)(F.ws + WS_ABWT) + (size_t)l * 16 * 1024); LAS f32x4* dst = (LAS f32x4*)(F.lds + RING_OFF + ABL_OFF);
      for (int i = F.tid; i < 4096; i += NTHREADS) dst[i] = src[i]; }
    __syncthreads();
}
__device__ __forceinline__ void rows4_mod1(Frame& F, Row4 (&x)[4], int m0, int l, LAS float* scr, const float* pf) {
    const int b = m0 >> 12; const float* ada = (const float*)(F.ws + WS_ADA) + ((size_t)l * 8 + b) * 6144;
#pragma unroll
    for (int r = 0; r < 4; ++r) { row_standardize(x[r]); row_affine(x[r], ada + 1024, ada, true, F.lane); row_store_bf16(x[r], F.Ubuf + (size_t)(m0 + r) * 1024, F.lane); __builtin_amdgcn_sched_barrier(0); }
    if (F.dry == 3) { if (pf) {
#pragma unroll
        for (int r = 0; r < 4; ++r) row_load(x[r], pf + (size_t)r * 1024, F.lane); } return; }
    const float abv = rows4_proj<16>(x, (const LAS f32x4*)(F.lds + RING_OFF + ABL_OFF), F.lane);
    __builtin_amdgcn_sched_barrier(0);
    if (pf) {
#pragma unroll
        for (int r = 0; r < 4; ++r) row_load(x[r], pf + (size_t)r * 1024, F.lane); }
    __builtin_amdgcn_sched_barrier(0);
    scr[idx16(F.lane)] = abv;
    if (F.dry == 2) return;
    LDS_WAIT(); asm volatile("" ::: "memory");
    const LAS float* WAL = (const LAS float*)(F.lds + RING_OFF + WAL_OFF); const LAS float* BAL = (const LAS float*)(F.lds + RING_OFF + BAL_OFF); float* LA = F.LAbuf;
    asm volatile("" : "+s"(WAL), "+s"(BAL));
    float z[4][8];
#pragma unroll
    for (int i = 0; i < 8; ++i) { const float bb = BAL[F.lane + 64 * i];
#pragma unroll
        for (int r = 0; r < 4; ++r) z[r][i] = bb; }
#pragma unroll
    for (int rr = 0; rr < 16; ++rr) { float a[4];
#pragma unroll
        for (int r = 0; r < 4; ++r) a[r] = scr[r * 16 + rr];
#pragma unroll
        for (int i = 0; i < 8; ++i) { const float w_ = WAL[rr * 512 + F.lane + 64 * i];
#pragma unroll
            for (int r = 0; r < 4; ++r) z[r][i] += a[r] * w_; }
        __builtin_amdgcn_sched_barrier(0); }
#pragma unroll
    for (int r = 0; r < 4; ++r) {
#pragma unroll
        for (int i = 0; i < 8; ++i) { const float zz = z[r][i]; const float ls = fminf(zz, 0.f) - __logf(1.0f + __expf(-fabsf(zz)));
            LA[(size_t)(m0 + r) * 512 + F.lane + 64 * i] = __expf(ls * (1.0f / 16.0f)); }
        __builtin_amdgcn_sched_barrier(0); }
    LDS_WAIT(); asm volatile("" ::: "memory");
}
__device__ __forceinline__ void phase_r0(Frame& F, const float* xin) {
    LAS float* scr = (LAS float*)(F.lds + RING_OFF) + F.wave * 256;
    load_walpha(F, 0);
    const int gstep = F.G * NWAVES; int gi = F.vcu * NWAVES + F.wave; Row4 x[4];
    if (gi < NTOK / 4) {
#pragma unroll
        for (int r = 0; r < 4; ++r) row_load(x[r], xin + (size_t)(4 * gi + r) * 1024, F.lane); }
    for (; gi < NTOK / 4; gi += gstep) { const int m0 = 4 * gi;
#pragma unroll
        for (int r = 0; r < 4; ++r) row_store(x[r], F.xst + (size_t)(m0 + r) * 1024, F.lane);
        __builtin_amdgcn_sched_barrier(0);
        rows4_mod1(F, x, m0, 0, scr, (gi + gstep < NTOK / 4) ? xin + (size_t)(4 * (gi + gstep)) * 1024 : nullptr); }
}
__device__ __forceinline__ void phase_r1(Frame& F, int l) {
    LAS float* scr = (LAS float*)(F.lds + RING_OFF) + F.wave * 256;
    const float* g1 = F.prm + PO_LN1G + l * 1024; const float* b1 = F.prm + PO_LN1B + l * 1024; const float* RWT = (const float*)(F.ws + WS_RWT) + (size_t)l * 36 * 1024;
    const float* brg = F.prm + PO_BRG + l * 4; const float* bre = F.prm + PO_BRE + l * 32;
    LAS unsigned* LCNT = (LAS unsigned*)(F.lds + TAB_CNT); LAS unsigned* BASEW = (LAS unsigned*)(F.lds + TAB_BASE); LAS unsigned* TOKBUF = (LAS unsigned*)(F.lds + TAB_IDX);
    { const GAS f32x4* src = (const GAS f32x4*)(RWT + 4 * 1024); LAS f32x4* dst = (LAS f32x4*)(F.lds + RING_OFF + 8192);
      for (int i = F.tid; i < 8192; i += NTHREADS) dst[i] = src[i]; }
    const LAS f32x4* WRE = (const LAS f32x4*)(F.lds + RING_OFF + 8192);
    if (F.tid < 32) LCNT[F.tid] = 0u; for (int i = F.tid; i < 256; i += NTHREADS) TOKBUF[i * 8] = 0xffffffffu;
    __syncthreads();
    int giter = 0;
    gu32* cnt = F.ctl + CW_CNT + l * 32 * 64 + (F.dry ? 16384 : 0); int* LIST = (int*)(F.ws + (F.dry ? WS_SSQ : WS_LIST)); unsigned* TI = (unsigned*)(F.ws + (F.dry ? WS_SSQ + 4 * MiB : WS_TOKINFO));
    const int gstep = F.G * NWAVES; int gi = F.vcu * NWAVES + F.wave; Row4 x[4];
    if (gi < NTOK / 4) {
#pragma unroll
        for (int r = 0; r < 4; ++r) row_load(x[r], F.out + (size_t)(4 * gi + r) * 1024, F.lane); }
    for (; gi < NTOK / 4; gi += gstep, ++giter) { const int m0 = 4 * gi, b = m0 >> 12;
        const float* ada = (const float*)(F.ws + WS_ADA) + ((size_t)l * 8 + b) * 6144;
#pragma unroll
        for (int r = 0; r < 4; ++r) { row_standardize(x[r]); row_affine(x[r], g1, b1, false, F.lane); if (F.dry < 3) row_store(x[r], F.xst + (size_t)(m0 + r) * 1024, F.lane);
            row_standardize(x[r]); row_affine(x[r], ada + 4 * 1024, ada + 3 * 1024, true, F.lane); if (F.dry < 3) row_store_bf16(x[r], F.Ubuf + (size_t)(m0 + r) * 1024, F.lane); __builtin_amdgcn_sched_barrier(0); }
        if (F.dry >= 2) { if (F.dry == 3) { float q_ = 0.f;
#pragma unroll
                for (int r = 0; r < 4; ++r) q_ += x[r][0].x; if (q_ == 123.456f) scr[0] = q_; }
            if (gi + gstep < NTOK / 4) {
#pragma unroll
                for (int r = 0; r < 4; ++r) row_load(x[r], F.out + (size_t)(4 * (gi + gstep) + r) * 1024, F.lane); }
            continue; }
        const float vg = rows4_proj<4>(x, (const GAS f32x4*)RWT, F.lane);
        __builtin_amdgcn_sched_barrier(0);
        { const int i4 = idx4(F.lane); scr[(i4 >> 2) * 40 + (i4 & 3)] = vg; }
        LDS_WAIT(); asm volatile("" ::: "memory");
        int gsel[4];
#pragma unroll
        for (int r = 0; r < 4; ++r) { int gi_ = 0; float gm = scr[r * 40] + brg[0];
#pragma unroll
            for (int j = 1; j < 4; ++j) { const float gv_ = scr[r * 40 + j] + brg[j]; if (gv_ > gm) { gm = gv_; gi_ = j; } }
            gsel[r] = __builtin_amdgcn_readfirstlane(gi_); }
        const float ve = rows4_proj8g(x, WRE, gsel, F.lane);
        __builtin_amdgcn_sched_barrier(0);
        if (gi + gstep < NTOK / 4) {
#pragma unroll
            for (int r = 0; r < 4; ++r) row_load(x[r], F.out + (size_t)(4 * (gi + gstep) + r) * 1024, F.lane); }
        __builtin_amdgcn_sched_barrier(0);
        { const int i8 = idx8(F.lane); scr[(i8 >> 3) * 40 + 4 + (i8 & 7)] = ve; }
        LDS_WAIT(); asm volatile("" ::: "memory");
        if (F.lane < 4) { const LAS float* s = scr + F.lane * 40; const int m = m0 + F.lane;
            float gl[4];
#pragma unroll
            for (int j = 0; j < 4; ++j) gl[j] = s[j] + brg[j];
            int gidx = 0; float gmax = gl[0];
#pragma unroll
            for (int j = 1; j < 4; ++j) if (gl[j] > gmax) { gmax = gl[j]; gidx = j; }
            float den = 0.f;
#pragma unroll
            for (int j = 0; j < 4; ++j) den += __expf(gl[j] - gmax);
            const float gw = 1.0f / den;
            float el[8];
#pragma unroll
            for (int j = 0; j < 8; ++j) el[j] = s[4 + j] + bre[gidx * 8 + j];
            int i0 = 0; float v0 = el[0];
#pragma unroll
            for (int j = 1; j < 8; ++j) if (el[j] > v0) { v0 = el[j]; i0 = j; }
            int i1 = -1; float v1 = -INFINITY;
#pragma unroll
            for (int j = 0; j < 8; ++j) if (j != i0 && el[j] > v1) { v1 = el[j]; i1 = j; }
            if (i1 < 0) i1 = (i0 + 1) & 7;
            const float ex = __expf(v1 - v0), inv = 1.0f / (1.0f + ex); const float w0 = inv * gw, w1 = ex * inv * gw;
            const int e0 = gidx * 8 + i0, e1 = gidx * 8 + i1;
            const unsigned lp0 = __hip_atomic_fetch_add(LCNT + e0, 1u, __ATOMIC_RELAXED, __HIP_MEMORY_SCOPE_WORKGROUP), lp1 = __hip_atomic_fetch_add(LCNT + e1, 1u, __ATOMIC_RELAXED, __HIP_MEMORY_SCOPE_WORKGROUP);
            const int slot = F.wave * 32 + (giter & 7) * 4 + F.lane;
            *(LAS v4u*)(TOKBUF + slot * 8) = (v4u){(unsigned)m, (unsigned)e0 | ((unsigned)e1 << 8), lp0, lp1}; TOKBUF[slot * 8 + 4] = __float_as_uint(w0); TOKBUF[slot * 8 + 5] = __float_as_uint(w1);
        }
        LDS_WAIT(); asm volatile("" ::: "memory");
    }
    __syncthreads();
    if (F.tid < 32) BASEW[F.tid] = __hip_atomic_fetch_add(cnt + F.tid * 64, LCNT[F.tid], RLX_AGENT);
    __syncthreads();
    if (F.tid < 256) { const v4u tk = *(const LAS v4u*)(TOKBUF + F.tid * 8);
        if (tk.x != 0xffffffffu) { const unsigned m = tk.x, e0 = tk.y & 255u, e1 = tk.y >> 8, p0 = BASEW[e0] + tk.z, p1 = BASEW[e1] + tk.w;
            LIST[(size_t)e0 * LISTCAP + p0] = (int)m; LIST[(size_t)e1 * LISTCAP + p1] = (int)m;
            *(GAS v4u*)(TI + (size_t)m * 8) = (v4u){e0, p0, e1, p1}; *(GAS v4u*)(TI + (size_t)m * 8 + 4) = (v4u){TOKBUF[F.tid * 8 + 4], TOKBUF[F.tid * 8 + 5], 0u, 0u}; } }
    __syncthreads();
}
__device__ __forceinline__ void moe_tables(Frame& F, int l) {
    LAS int* CNT = (LAS int*)(F.lds + TAB_CNT); LAS int* BASE = (LAS int*)(F.lds + TAB_BASE);
    if (F.tid < 32) CNT[F.tid] = (int)__hip_atomic_load(F.ctl + CW_CNT + (l * 32 + F.tid) * 64, RLX_AGENT);
    __syncthreads();
    if (F.tid == 0) { int a = 0; for (int e = 0; e < 32; ++e) { BASE[e] = a; a += (CNT[e] + 255) >> 8; } BASE[32] = a; }
    __syncthreads();
}
__device__ __forceinline__ void phase_r2(Frame& F, int l) {
    LAS float* scr = (LAS float*)(F.lds + RING_OFF) + F.wave * 256; const LAS int* BASE = (const LAS int*)(F.lds + TAB_BASE);
    if (l + 1 < DEPTH) load_walpha(F, l + 1);
    const float* g2 = F.prm + PO_LN2G + l * 1024; const float* b2 = F.prm + PO_LN2B + l * 1024; const unsigned* TI = (const unsigned*)(F.ws + WS_TOKINFO); const bf16* YB = (const bf16*)(F.ws + WS_YB);
    const int gstep = F.G * NWAVES;
    for (int gi = F.vcu * NWAVES + F.wave; gi < NTOK / 4; gi += gstep) { const int m0 = 4 * gi, b = m0 >> 12; Row4 x[4];
#pragma unroll
        for (int r = 0; r < 4; ++r) row_load(x[r], F.out + (size_t)(m0 + r) * 1024, F.lane);
        const float* gate = (const float*)(F.ws + WS_ADA) + ((size_t)l * 8 + b) * 6144 + 5 * 1024;
        v4u ta[4]; float w0[4], w1[4];
#pragma unroll
        for (int r = 0; r < 4; ++r) { ta[r] = *(const GAS v4u*)(TI + (size_t)(m0 + r) * 8); const v4u tb = *(const GAS v4u*)(TI + (size_t)(m0 + r) * 8 + 4); w0[r] = __uint_as_float(tb.x); w1[r] = __uint_as_float(tb.y); }
        unsigned long long ya_[4][4], yc_[4][4];
#pragma unroll
        for (int r = 0; r < 4; ++r) { const size_t r0 = (size_t)BASE[ta[r].x & 31] * 256 + ta[r].y, r1 = (size_t)BASE[ta[r].z & 31] * 256 + ta[r].w;
            const GAS unsigned long long* y0 = (const GAS unsigned long long*)(YB + r0 * 1024) + F.lane; const GAS unsigned long long* y1 = (const GAS unsigned long long*)(YB + r1 * 1024) + F.lane;
#pragma unroll
            for (int j = 0; j < 4; ++j) { ya_[r][j] = y0[64 * j]; yc_[r][j] = y1[64 * j]; } }
        __builtin_amdgcn_sched_barrier(0);
#pragma unroll
        for (int r = 0; r < 4; ++r) { const int m = m0 + r;
#pragma unroll
            for (int j = 0; j < 4; ++j) { const unsigned long long a = ya_[r][j], c = yc_[r][j]; const f32x4 gv = *((const GAS f32x4*)gate + F.lane + 64 * j);
                const f32x4 ya = (f32x4){bflo((unsigned)a), bfhi((unsigned)a), bflo((unsigned)(a >> 32)), bfhi((unsigned)(a >> 32))};
                const f32x4 yc = (f32x4){bflo((unsigned)c), bfhi((unsigned)c), bflo((unsigned)(c >> 32)), bfhi((unsigned)(c >> 32))};
                x[r][j] = x[r][j] * DN_ALPHA + gv * (ya * w0[r] + yc * w1[r]); }
            row_standardize(x[r]); row_affine(x[r], g2, b2, false, F.lane); row_store(x[r], F.xst + (size_t)m * 1024, F.lane); __builtin_amdgcn_sched_barrier(0); }
        if (l + 1 < DEPTH) rows4_mod1(F, x, m0, l + 1, scr, nullptr);
    }
}
typedef short s16x8 __attribute__((ext_vector_type(8)));
#define MFMA16(a, b, c) __builtin_amdgcn_mfma_f32_16x16x32_bf16((a), (b), (c), 0, 0, 0)
struct GlaRegs { v4u rq[2], rk[2]; float rl[16]; unsigned long long vr; };
__device__ __forceinline__ void phase_gla(Frame& F, const int glav) {
    constexpr int QK0_OFF = 0, QK1_OFF = 16384, LAR_OFF = 32768, KLT_OFF = 65536, VT_OFF = 83968  , SBT_OFF = 93184, ATT_OFF = 101888, TOT_OFF = 111104, DEC_OFF = 113152;
    constexpr int QS = 272, TS = 144;
    LAS unsigned char* L = F.lds + RING_OFF;
    LAS float* TOT = (LAS float*)(L + TOT_OFF); LAS float* DEC = (LAS float*)(L + DEC_OFF);
    const int tid = F.tid, lane = F.lane, w = F.wave, k = tid & 127, tg = tid >> 7, fr = lane & 15, fq = lane >> 4;
    const bf16* GQ = (const bf16*)(F.ws + WS_GQ); const bf16* GK = (const bf16*)(F.ws + WS_GK); const bf16* GV = (const bf16*)(F.ws + WS_GV);
    const float* LA = (const float*)(F.ws + WS_LA); bf16* OB = (bf16*)(F.ws + WS_OB); float* SSQ = (float*)(F.ws + WS_SSQ);
    const int cr = tid >> 4, cc = tid & 15;
    const int qk_dst = cr * 256 + ((cc ^ (cr & 15)) << 4);
    const int kc = k >> 3, kb2 = (k & 7) * 2;
    for (int item = F.vcu; item < 256; item += F.G) {
        const int s = item & 7, hg = (item >> 3) & 3, b = item >> 5; const size_t row0 = (size_t)b * SEQ;
        const bf16* gq = GQ + (row0 + cr) * 512 + hg * 128 + cc * 8; const bf16* gk = GK + (row0 + cr) * 512 + hg * 128 + cc * 8; const float* la = LA + (row0 + tg * 16) * 512 + hg * 128 + k;
        const bf16* gv = GV + (row0 + (tid >> 3)) * 1024 + hg * 256 + s * 32 + (tid & 7) * 4;
        bf16* ob = OB + row0 * 1024 + hg * 256 + s * 32; float* ssq = SSQ + row0 * 64 + hg * 16 + s * 2;
        for (int i = tid; i < 8704 / 4; i += NTHREADS) ((LAS unsigned*)(L + SBT_OFF))[i] = 0u;
        f32x4 accS[2]; accS[0] = (f32x4){0.f, 0.f, 0.f, 0.f}; accS[1] = accS[0];
        GlaRegs RA, RB;
#define GLA_BAR() asm volatile("s_waitcnt lgkmcnt(0)\n\ts_barrier" ::: "memory")
#define GLA_LOAD(R_, c_) do { const size_t o_ = (size_t)(c_) * 64; R_.rq[0] = *(const GAS v4u*)(gq + o_ * 512); R_.rq[1] = *(const GAS v4u*)(gq + (o_ + 32) * 512); R_.rk[0] = *(const GAS v4u*)(gk + o_ * 512); R_.rk[1] = *(const GAS v4u*)(gk + (o_ + 32) * 512); \
        _Pragma("unroll") for (int i_ = 0; i_ < 16; ++i_) R_.rl[i_] = *(const GAS float*)(la + (o_ + i_) * 512); R_.vr = *(const GAS unsigned long long*)(gv + o_ * 1024); } while (0)
        GLA_LOAD(RA, 0); GLA_LOAD(RB, 1);
        __syncthreads();
        auto chunk = [&](const int c, GlaRegs& R) {
            *(LAS v4u*)(L + QK0_OFF + qk_dst) = R.rq[0]; *(LAS v4u*)(L + QK0_OFF + qk_dst + 8192) = R.rq[1]; *(LAS v4u*)(L + QK1_OFF + qk_dst) = R.rk[0]; *(LAS v4u*)(L + QK1_OFF + qk_dst + 8192) = R.rk[1];
            const int vto = VT_OFF + (c & 1) * 4608;
            { const int t = tid >> 3, w0 = (tid & 7) * 4;
#pragma unroll
              for (int i = 0; i < 4; ++i) *(LAS bf16*)(L + vto + (w0 + i) * TS + t * 2) = (bf16)((R.vr >> (16 * i)) & 0xffffu); }
            float cs[16]; { float run = 1.f;
#pragma unroll
                for (int i = 0; i < 16; ++i) { run *= R.rl[i]; cs[i] = run; }
                TOT[tg * 128 + k] = run; }
            if (c + 2 < 64 && !(glav & 8)) GLA_LOAD(R, c + 2);
            GLA_BAR();
            if (!(glav & 1)) { float off = 1.f, last = 1.f;
#pragma unroll
              for (int g = 0; g < 4; ++g) { const float tv = TOT[g * 128 + k]; if (g < tg) off *= tv; last *= tv; }
              unsigned klw[8]; float klp = 0.f;
#pragma unroll
              for (int i = 0; i < 16; ++i) { const float e1 = cs[i] * off, e2 = __builtin_amdgcn_rcpf(e1), e3 = last * e2;
                  const int eo = (tg * 16 + i) * 256 + ((kc ^ i) << 4) + kb2;
                  const float qf = __uint_as_float((unsigned)(*(const LAS bf16*)(L + QK0_OFF + eo)) << 16), kf = __uint_as_float((unsigned)(*(const LAS bf16*)(L + QK1_OFF + eo)) << 16);
                  const unsigned qk = pg8::cvt_pk_bf16_c(qf * e1, kf * e2);
                  *(LAS bf16*)(L + QK0_OFF + eo) = (bf16)(qk & 0xffffu); *(LAS bf16*)(L + QK1_OFF + eo) = (bf16)(qk >> 16);
                  if (i & 1) klw[i >> 1] = pg8::cvt_pk_bf16_c(klp, kf * e3); else klp = kf * e3; }
              *(LAS v4u*)(L + KLT_OFF + k * TS + tg * 32) = (v4u){klw[0], klw[1], klw[2], klw[3]}; *(LAS v4u*)(L + KLT_OFF + k * TS + tg * 32 + 16) = (v4u){klw[4], klw[5], klw[6], klw[7]};
              if (tg == 0) DEC[k] = last;
            }
            GLA_BAR();
            const int ti = w >> 1, wi = w & 1; f32x4 acco = (f32x4){0.f, 0.f, 0.f, 0.f};
            if (!(glav & 2)) { s16x8 aq[4];
#pragma unroll
              for (int kk = 0; kk < 4; ++kk) aq[kk] = *(const LAS s16x8*)(L + QK0_OFF + (ti * 16 + fr) * 256 + (((kk * 4 + fq) ^ fr) << 4));
#pragma unroll
              for (int s2 = 0; s2 < 2; ++s2) { const int si = wi * 2 + s2; f32x4 a4 = (f32x4){0.f, 0.f, 0.f, 0.f};
                  if (si <= ti) {
#pragma unroll
                      for (int kk = 0; kk < 4; ++kk) { const s16x8 bb = *(const LAS s16x8*)(L + QK1_OFF + (si * 16 + fr) * 256 + (((kk * 4 + fq) ^ fr) << 4)); a4 = MFMA16(aq[kk], bb, a4); } }
#pragma unroll
                  for (int r = 0; r < 4; ++r) { const int t = ti * 16 + fq * 4 + r, sc = si * 16 + fr; const float v = (sc <= t) ? a4[r] : 0.f; *(LAS bf16*)(L + ATT_OFF + t * TS + sc * 2) = (bf16)f2bf(v); } }
#pragma unroll
              for (int kk = 0; kk < 4; ++kk) { const s16x8 bb = *(const LAS s16x8*)(L + SBT_OFF + (wi * 16 + fr) * QS + (kk * 32 + 8 * fq) * 2); acco = MFMA16(aq[kk], bb, acco); }
            }
            GLA_BAR();
            if (!(glav & 4)) {
              s16x8 aat[2], bvo[2], akl[2], bv0[2], bv1[2];
#pragma unroll
              for (int kk = 0; kk < 2; ++kk) { aat[kk] = *(const LAS s16x8*)(L + ATT_OFF + (ti * 16 + fr) * TS + (kk * 32 + 8 * fq) * 2); bvo[kk] = *(const LAS s16x8*)(L + vto + (wi * 16 + fr) * TS + (kk * 32 + 8 * fq) * 2);
                  akl[kk] = *(const LAS s16x8*)(L + KLT_OFF + (w * 16 + fr) * TS + (kk * 32 + 8 * fq) * 2); bv0[kk] = *(const LAS s16x8*)(L + vto + fr * TS + (kk * 32 + 8 * fq) * 2); bv1[kk] = *(const LAS s16x8*)(L + vto + (16 + fr) * TS + (kk * 32 + 8 * fq) * 2); }
              const f32x4 dv = *(const LAS f32x4*)(DEC + w * 16 + fq * 4);
              acco = MFMA16(aat[0], bvo[0], acco); accS[0] = accS[0] * dv; accS[1] = accS[1] * dv;
              accS[0] = MFMA16(akl[0], bv0[0], accS[0]); accS[1] = MFMA16(akl[0], bv1[0], accS[1]);
              acco = MFMA16(aat[1], bvo[1], acco);
              accS[0] = MFMA16(akl[1], bv0[1], accS[0]); accS[1] = MFMA16(akl[1], bv1[1], accS[1]);
              { const unsigned o01 = pg8::cvt_pk_bf16_c(acco[0], acco[1]), o23 = pg8::cvt_pk_bf16_c(acco[2], acco[3]); bf16* obp = ob + (size_t)(c * 64 + ti * 16 + fq * 4) * 1024 + wi * 16 + fr;
                if (!(glav & 16)) { obp[0] = (bf16)(o01 & 0xffffu); obp[1024] = (bf16)(o01 >> 16); obp[2048] = (bf16)(o23 & 0xffffu); obp[3072] = (bf16)(o23 >> 16); } }
#pragma unroll
              for (int w2 = 0; w2 < 2; ++w2)
                  *(LAS unsigned long long*)(L + SBT_OFF + (w2 * 16 + fr) * QS + (w * 16 + fq * 4) * 2) = (unsigned long long)pg8::cvt_pk_bf16_c(accS[w2][0], accS[w2][1]) | ((unsigned long long)pg8::cvt_pk_bf16_c(accS[w2][2], accS[w2][3]) << 32);
#pragma unroll
              for (int r = 0; r < 4; ++r) { const int t = c * 64 + ti * 16 + fq * 4 + r;
                  float q = acco[r] * acco[r]; q = dpp_add(q, 0); q = dpp_add(q, 1); q = dpp_add(q, 2); q = dpp_add(q, 3);
                  if (fr == 0 && !(glav & 32)) ssq[(size_t)t * 64 + wi] = q; }
            }
        };
        for (int c = 0; c < 64; c += 2) { chunk(c, RA); chunk(c + 1, RB); }
#undef GLA_LOAD
#undef GLA_BAR
        __syncthreads();
    }
}
__device__ __forceinline__ size_t gla_fp16k(size_t rowg0, int hg, int p) { return ((rowg0 + (size_t)(p >> 4)) * 512 + hg * 128) * 2 + (size_t)(p & 15) * 16; }
__device__ __forceinline__ size_t gla_fp32k(size_t rowg0, int hg, int p) { return ((rowg0 + (size_t)(p >> 5)) * 1024 + hg * 256) * 2 + (size_t)(p & 31) * 16; }
__device__ __forceinline__ void phase_gla_a(Frame& F) {
    constexpr int QK0_OFF = 0, QK1_OFF = 16384, KLT_OFF = 32768, VT_OFF = 51200, ATT_OFF = 88064, TOT_OFF = 97280, DEC_OFF = 99328, TS = 144;
    LAS unsigned char* L = F.lds + RING_OFF;
    LAS float* TOT = (LAS float*)(L + TOT_OFF); LAS float* DEC = (LAS float*)(L + DEC_OFF);
    const int tid = F.tid, lane = F.lane, w = F.wave, k = tid & 127, tg = tid >> 7, fr = lane & 15, fq = lane >> 4;
    unsigned char* GQb = F.ws + WS_GQ; unsigned char* GKb = F.ws + WS_GK; unsigned char* GVb = F.ws + WS_GV; unsigned char* LAb = F.ws + WS_LA; float* DECG = (float*)(F.ws + WS_GDEC);
    const int cr = tid >> 4, cc = tid & 15, qk_dst = cr * 256 + ((cc ^ (cr & 15)) << 4), kc = k >> 3, kb2 = (k & 7) * 2;
    v4u rq[2], rk[2], rv[4]; float rl[16];
#define GLA_A_LOAD(u_) do { const int c_ = (u_) & 63, hg_ = ((u_) >> 6) & 3, b_ = (u_) >> 8; const size_t rg_ = (size_t)b_ * SEQ + (size_t)c_ * 64; \
        const GAS unsigned char* gq = (const GAS unsigned char*)GQb + ((rg_ + cr) * 512 + hg_ * 128 + cc * 8) * 2; const GAS unsigned char* gk = (const GAS unsigned char*)GKb + ((rg_ + cr) * 512 + hg_ * 128 + cc * 8) * 2; \
        rq[0] = *(const GAS v4u*)gq; rq[1] = *(const GAS v4u*)(gq + 32 * 1024); rk[0] = *(const GAS v4u*)gk; rk[1] = *(const GAS v4u*)(gk + 32 * 1024); \
        const GAS float* la = (const GAS float*)LAb + (rg_ + tg * 16) * 512 + hg_ * 128 + k; \
        _Pragma("unroll") for (int i = 0; i < 16; ++i) rl[i] = la[(size_t)i * 512]; \
        _Pragma("unroll") for (int i = 0; i < 4; ++i) { const int p = tid + 512 * i; rv[i] = *(const GAS v4u*)((const GAS unsigned char*)GVb + gla_fp32k(rg_, hg_, p)); } } while (0)
    __syncthreads();
    if (F.vcu < 2048) GLA_A_LOAD(F.vcu);
    for (int unit = F.vcu; unit < 2048; unit += F.G) {
        const int c = unit & 63, hg = (unit >> 6) & 3, b = unit >> 8; const size_t rowg0 = (size_t)b * SEQ + (size_t)c * 64;
        *(LAS v4u*)(L + QK0_OFF + qk_dst) = rq[0]; *(LAS v4u*)(L + QK0_OFF + qk_dst + 8192) = rq[1]; *(LAS v4u*)(L + QK1_OFF + qk_dst) = rk[0]; *(LAS v4u*)(L + QK1_OFF + qk_dst + 8192) = rk[1];
#pragma unroll
        for (int i = 0; i < 4; ++i) { const int p = tid + 512 * i, t = p >> 5, cp = p & 31; const int tsw = t ^ (8 * (cp & 7));
            const unsigned wd[4] = {rv[i].x, rv[i].y, rv[i].z, rv[i].w};
#pragma unroll
            for (int e = 0; e < 8; ++e) *(LAS bf16*)(L + VT_OFF + (8 * cp + e) * TS + tsw * 2) = (bf16)((wd[e >> 1] >> (16 * (e & 1))) & 0xffffu); }
        float cs[16]; { float run = 1.f;
#pragma unroll
            for (int i = 0; i < 16; ++i) { run *= rl[i]; cs[i] = run; }
            TOT[tg * 128 + k] = run; }
        if (unit + F.G < 2048) GLA_A_LOAD(unit + F.G);
        asm volatile("s_waitcnt lgkmcnt(0)\n\ts_barrier" ::: "memory");
        { float off = 1.f, last = 1.f;
#pragma unroll
          for (int g = 0; g < 4; ++g) { const float tv = TOT[g * 128 + k]; if (g < tg) off *= tv; last *= tv; }
          unsigned klw[8]; float klp = 0.f;
#pragma unroll
          for (int i = 0; i < 16; ++i) { const float e1 = cs[i] * off, e2 = __builtin_amdgcn_rcpf(e1), e3 = last * e2;
              const int eo = (tg * 16 + i) * 256 + ((kc ^ i) << 4) + kb2;
              const float qf = __uint_as_float((unsigned)(*(const LAS bf16*)(L + QK0_OFF + eo)) << 16), kf = __uint_as_float((unsigned)(*(const LAS bf16*)(L + QK1_OFF + eo)) << 16);
              const unsigned qk = pg8::cvt_pk_bf16_c(qf * e1, kf * e2);
              *(LAS bf16*)(L + QK0_OFF + eo) = (bf16)(qk & 0xffffu); *(LAS bf16*)(L + QK1_OFF + eo) = (bf16)(qk >> 16);
              if (i & 1) klw[i >> 1] = pg8::cvt_pk_bf16_c(klp, kf * e3); else klp = kf * e3; }
          *(LAS v4u*)(L + KLT_OFF + k * TS + tg * 32) = (v4u){klw[0], klw[1], klw[2], klw[3]}; *(LAS v4u*)(L + KLT_OFF + k * TS + tg * 32 + 16) = (v4u){klw[4], klw[5], klw[6], klw[7]};
          if (tg == 0) DEC[k] = last; }
        asm volatile("s_waitcnt lgkmcnt(0)\n\ts_barrier" ::: "memory");
        { const int ti = w >> 1, wi = w & 1; s16x8 aq[4];
#pragma unroll
          for (int kk = 0; kk < 4; ++kk) aq[kk] = *(const LAS s16x8*)(L + QK0_OFF + (ti * 16 + fr) * 256 + (((kk * 4 + fq) ^ fr) << 4));
#pragma unroll
          for (int s2 = 0; s2 < 2; ++s2) { const int si = wi * 2 + s2; f32x4 a4 = (f32x4){0.f, 0.f, 0.f, 0.f};
              if (si <= ti) {
#pragma unroll
                  for (int kk = 0; kk < 4; ++kk) { const s16x8 bb = *(const LAS s16x8*)(L + QK1_OFF + (si * 16 + fr) * 256 + (((kk * 4 + fq) ^ fr) << 4)); a4 = MFMA16(aq[kk], bb, a4); } }
#pragma unroll
              for (int r = 0; r < 4; ++r) { const int t = ti * 16 + fq * 4 + r, sc = si * 16 + fr; const float v = (sc <= t) ? a4[r] : 0.f; *(LAS bf16*)(L + ATT_OFF + t * TS + sc * 2) = (bf16)f2bf(v); } } }
#pragma unroll
        for (int i = 0; i < 2; ++i) { const int p = tid + 512 * i;
            const int l_ = p & 63, t = (p >> 8) * 16 + (l_ & 15), k0 = ((p >> 6) & 3) * 32 + 4 * (l_ >> 4);
            const unsigned long long lo = *(const LAS unsigned long long*)(L + QK0_OFF + t * 256 + (((k0 >> 3) ^ (t & 15)) << 4) + (k0 & 7) * 2);
            const unsigned long long hi = *(const LAS unsigned long long*)(L + QK0_OFF + t * 256 + ((((k0 + 16) >> 3) ^ (t & 15)) << 4) + (k0 & 7) * 2);
            *(GAS v4u*)((GAS unsigned char*)GQb + gla_fp16k(rowg0, hg, p)) = (v4u){(unsigned)lo, (unsigned)(lo >> 32), (unsigned)hi, (unsigned)(hi >> 32)}; }
#pragma unroll
        for (int i = 0; i < 2; ++i) { const int p = tid + 512 * i;
            const int l_ = p & 63, kk = (p >> 7) * 16 + (l_ & 15), t0 = ((p >> 6) & 1) * 32 + 8 * (l_ >> 4);
            *(GAS v4u*)((GAS unsigned char*)GKb + gla_fp16k(rowg0, hg, p)) = *(const LAS v4u*)(L + KLT_OFF + kk * TS + t0 * 2); }
#pragma unroll
        for (int i = 0; i < 4; ++i) { const int p = tid + 512 * i;
            const int l_ = p & 63, wv = (p >> 7) * 16 + (l_ & 15), t0 = (((p >> 6) & 1) * 32 + 8 * (l_ >> 4)) ^ (8 * ((wv >> 3) & 7));
            *(GAS v4u*)((GAS unsigned char*)GVb + gla_fp32k(rowg0, hg, p)) = *(const LAS v4u*)(L + VT_OFF + wv * TS + t0 * 2); }
        if (tid < 128) DECG[(size_t)unit * 128 + tid] = DEC[tid];
        asm volatile("s_waitcnt lgkmcnt(0)\n\ts_barrier" ::: "memory");
        { const int ti = w >> 1; s16x8 aat[2];
#pragma unroll
          for (int kk = 0; kk < 2; ++kk) aat[kk] = *(const LAS s16x8*)(L + ATT_OFF + (ti * 16 + fr) * TS + (kk * 32 + 8 * fq) * 2);
#pragma unroll
          for (int j = 0; j < 8; ++j) { const int wt = (w & 1) * 8 + j, wv = wt * 16 + fr; f32x4 a4 = (f32x4){0.f, 0.f, 0.f, 0.f};
#pragma unroll
              for (int kk = 0; kk < 2; ++kk) { const s16x8 bb = *(const LAS s16x8*)(L + VT_OFF + wv * TS + (((kk * 32 + 8 * fq) ^ (8 * ((wv >> 3) & 7))) * 2)); a4 = MFMA16(aat[kk], bb, a4); }
              const unsigned long long pk = (unsigned long long)pg8::cvt_pk_bf16_c(a4[0], a4[1]) | ((unsigned long long)pg8::cvt_pk_bf16_c(a4[2], a4[3]) << 32);
              *(GAS unsigned long long*)((GAS unsigned char*)LAb + ((rowg0 + (size_t)(ti * 16 + wt)) * 512 + hg * 128) * 4 + (size_t)lane * 8) = pk; } }
        asm volatile("s_waitcnt lgkmcnt(0)\n\ts_barrier" ::: "memory");
    }
#undef GLA_A_LOAD
    __syncthreads();
}
__device__ __forceinline__ void phase_gla_b(Frame& F, const int gbv) {
    constexpr int SLOT = 37888, O_QEF = 0, O_KLF = 16384, O_VTF = 32768, O_DEC = 36864, PART_OFF = 3 * SLOT;
    static_assert(PART_OFF + 32768 <= RING_BYTES, "GB LDS map");
    LAS unsigned char* L = F.lds + RING_OFF;
    const int lane = F.lane, w = F.wave, fr = lane & 15, fq = lane >> 4, kq = w >> 1, wi = w & 1;
    const GAS unsigned char* GQb = (const GAS unsigned char*)(F.ws + WS_GQ); const GAS unsigned char* GKb = (const GAS unsigned char*)(F.ws + WS_GK); const GAS unsigned char* GVb = (const GAS unsigned char*)(F.ws + WS_GV);
    const GAS unsigned char* LAb = (const GAS unsigned char*)(F.ws + WS_LA); const GAS unsigned char* DECb = (const GAS unsigned char*)(F.ws + WS_GDEC); bf16* OB = (bf16*)(F.ws + WS_OB); float* SSQ = (float*)(F.ws + WS_SSQ);
    for (int item = F.vcu; item < 256; item += F.G) {
        const int s = item & 7, hg = (item >> 3) & 3, b = item >> 5, wt = 2 * s + wi; const size_t row0 = (size_t)b * SEQ;
        bf16* ob = OB + row0 * 1024 + hg * 256 + s * 32; float* ssq = SSQ + row0 * 64 + hg * 16 + s * 2;
        f32x4 accS[2]; accS[0] = (f32x4){0.f, 0.f, 0.f, 0.f}; accS[1] = accS[0];
        const GAS unsigned char* pbase[5]; unsigned pstride[5];
#pragma unroll
        for (int i = 0; i < 5; ++i) { const int j = (w + 8 * i < 37) ? w + 8 * i : 36;
            if (j < 16) { pbase[i] = GQb + gla_fp16k(row0, hg, j * 64 + lane); pstride[i] = 64u * 1024u; }
            else if (j < 32) { pbase[i] = GKb + gla_fp16k(row0, hg, (j - 16) * 64 + lane); pstride[i] = 64u * 1024u; }
            else if (j < 36) { pbase[i] = GVb + gla_fp32k(row0, hg, ((2 * s + ((j - 32) >> 1)) * 2 + ((j - 32) & 1)) * 64 + lane); pstride[i] = 64u * 2048u; }
            else { pbase[i] = DECb + ((size_t)((b * 4 + hg) * 64) * 128) * 4 + (size_t)(lane & 31) * 16; pstride[i] = 512u; } }
#define GLB_DMA(c_, slot_) do { _Pragma("unroll") for (int i_ = 0; i_ < 5; ++i_) \
            __builtin_amdgcn_global_load_lds((const GAS unsigned*)(pbase[i_] + (size_t)(c_) * pstride[i_]), (LAS unsigned*)(L + (slot_) * SLOT + ((w + 8 * i_ < 37) ? w + 8 * i_ : 36) * 1024), 16, 0, 0); } while (0)
        const GAS unsigned char* oib = LAb + ((row0 + (size_t)(kq * 16 + wt)) * 512 + hg * 128) * 4 + (size_t)lane * 8;
        __syncthreads();
        GLB_DMA(0, 0); GLB_DMA(1, 1);
        int slot = 0;
        for (int c = 0; c < 64; ++c) {
            if (c == 0) asm volatile("s_waitcnt vmcnt(5) lgkmcnt(0)\n\ts_barrier" ::: "memory"); else asm volatile("s_waitcnt vmcnt(13) lgkmcnt(0)\n\ts_barrier" ::: "memory");
            unsigned long long oic; { const GAS unsigned char* oip = oib + (size_t)c * (64 * 2048); asm volatile("global_load_dwordx2 %0, %1, off" : "=v"(oic) : "v"(oip) : "memory"); }
            if (!(gbv & 1)) { const int cn = (c + 2 < 64) ? c + 2 : 63; const int sn = (slot == 0) ? 2 : slot - 1; GLB_DMA(cn, sn); }
            if (gbv & 2) { slot = (slot == 2) ? 0 : slot + 1; asm volatile("s_barrier" ::: "memory"); continue; }
            const LAS unsigned char* S_ = L + slot * SLOT;
            s16x8 aqs[4], akl[2][2], bv[2]; f32x4 dv[2];
#pragma unroll
            for (int ti = 0; ti < 4; ++ti) aqs[ti] = *(const LAS s16x8*)(S_ + O_QEF + ((ti * 4 + kq) * 64 + lane) * 16);
#pragma unroll
            for (int e = 0; e < 2; ++e) { akl[e][0] = *(const LAS s16x8*)(S_ + O_KLF + (((2 * kq + e) * 2 + 0) * 64 + lane) * 16); akl[e][1] = *(const LAS s16x8*)(S_ + O_KLF + (((2 * kq + e) * 2 + 1) * 64 + lane) * 16);
                dv[e] = *(const LAS f32x4*)(S_ + O_DEC + ((2 * kq + e) * 16 + 4 * fq) * 4); bv[e] = *(const LAS s16x8*)(S_ + O_VTF + ((wi * 2 + e) * 64 + lane) * 16); }
            { const v4u bsw = (v4u){pg8::cvt_pk_bf16_c(accS[0][0], accS[0][1]), pg8::cvt_pk_bf16_c(accS[0][2], accS[0][3]), pg8::cvt_pk_bf16_c(accS[1][0], accS[1][1]), pg8::cvt_pk_bf16_c(accS[1][2], accS[1][3])};
              const s16x8 bs = __builtin_bit_cast(s16x8, bsw);
#pragma unroll
              for (int ti = 0; ti < 4; ++ti) { const f32x4 pt = MFMA16(aqs[ti], bs, ((f32x4){0.f, 0.f, 0.f, 0.f})); *(LAS f32x4*)(L + PART_OFF + (((ti * 2 + wi) * 4 + kq) * 64 + lane) * 16) = pt; } }
#pragma unroll
            for (int e = 0; e < 2; ++e) { accS[e] = accS[e] * dv[e]; accS[e] = MFMA16(akl[e][0], bv[0], accS[e]); accS[e] = MFMA16(akl[e][1], bv[1], accS[e]); }
            asm volatile("s_waitcnt lgkmcnt(0)\n\ts_barrier" ::: "memory");
            asm volatile("s_waitcnt vmcnt(5)" : "+v"(oic) :: "memory");
            f32x4 acco = (f32x4){bflo((unsigned)oic), bfhi((unsigned)oic), bflo((unsigned)(oic >> 32)), bfhi((unsigned)(oic >> 32))};
#pragma unroll
            for (int q2 = 0; q2 < 4; ++q2) acco = acco + *(const LAS f32x4*)(L + PART_OFF + (((kq * 2 + wi) * 4 + q2) * 64 + lane) * 16);
            { const unsigned o01 = pg8::cvt_pk_bf16_c(acco[0], acco[1]), o23 = pg8::cvt_pk_bf16_c(acco[2], acco[3]); bf16* obp = ob + (size_t)(c * 64 + kq * 16 + fq * 4) * 1024 + wi * 16 + fr;
              obp[0] = (bf16)(o01 & 0xffffu); obp[1024] = (bf16)(o01 >> 16); obp[2048] = (bf16)(o23 & 0xffffu); obp[3072] = (bf16)(o23 >> 16); }
#pragma unroll
            for (int r = 0; r < 4; ++r) { const int t = c * 64 + kq * 16 + fq * 4 + r;
                float q = acco[r] * acco[r]; q = dpp_add(q, 0); q = dpp_add(q, 1); q = dpp_add(q, 2); q = dpp_add(q, 3);
                if (fr == 0) ssq[(size_t)t * 64 + wi] = q; }
            slot = (slot == 2) ? 0 : slot + 1;
        }
#undef GLB_DMA
        asm volatile("s_waitcnt vmcnt(0) lgkmcnt(0)\n\ts_barrier" ::: "memory");
    }
}
__device__ __forceinline__ void unpack8(const v4u w, float* d) { d[0] = bflo(w.x); d[1] = bfhi(w.x); d[2] = bflo(w.y); d[3] = bfhi(w.y); d[4] = bflo(w.z); d[5] = bfhi(w.z); d[6] = bflo(w.w); d[7] = bfhi(w.w); }
__device__ __forceinline__ v4u pack8(const float* d) { v4u o; o.x = pk2(d[0], d[1]); o.y = pk2(d[2], d[3]); o.z = pk2(d[4], d[5]); o.w = pk2(d[6], d[7]); return o; }
__device__ __forceinline__ void phase_post(Frame& F, int l) {
    const float* lq1 = F.prm + PO_LQ1; const float* lk1 = F.prm + PO_LK1; const float* lq2 = F.prm + PO_LQ2; const float* lk2 = F.prm + PO_LK2; const float* diffg = F.prm + PO_DIFFG; const float* glag = F.prm + PO_GLAG;
    const int lane = F.lane;
    const float lam_init = 0.8f - 0.6f * expf(-0.3f * (float)l);
    const float d1 = lq1[l * 64 + lane] * lk1[l * 64 + lane], d2 = lq2[l * 64 + lane] * lk2[l * 64 + lane];
    const float lam = expf(wave_sum(d1)) - expf(wave_sum(d2)) + lam_init, osc = 1.0f - lam_init;
    float dgr[16], ggr[16];
#pragma unroll
    for (int i = 0; i < 16; ++i) { dgr[i] = diffg[l * 128 + 16 * (lane & 7) + i] * osc; ggr[i] = glag[l * 256 + 16 * (lane & 15) + i]; }
    const bf16* OP = (const bf16*)(F.ws + WS_OP); const bf16* OB = (const bf16*)(F.ws + WS_OB); const bf16* SG = (const bf16*)(F.ws + WS_SG); const float* SSQ = (const float*)(F.ws + WS_SSQ);
    bf16* OA2 = (bf16*)(F.ws + WS_OA2); bf16* OB2 = (bf16*)(F.ws + WS_OB2);
    const int mstep = F.G * NWAVES;
    for (int m = F.vcu * NWAVES + F.wave; m < NTOK; m += 2 * mstep) {
        v4u rp0[2][2], rp1[2][2], rb[2][2], rs[2][2]; f32x4 rq[2][4];
#pragma unroll
        for (int u = 0; u < 2; ++u) { const int mm = (m + u * mstep < NTOK) ? m + u * mstep : m;
            const GAS v4u* p0 = (const GAS v4u*)(OP + (size_t)mm * 2048 + 16 * lane); const GAS v4u* p1 = (const GAS v4u*)(OP + (size_t)mm * 2048 + 1024 + 16 * lane);
            const GAS v4u* pb = (const GAS v4u*)(OB + (size_t)mm * 1024 + 16 * lane); const GAS v4u* ps = (const GAS v4u*)(SG + (size_t)mm * 1024 + 16 * lane);
            const GAS f32x4* sp = (const GAS f32x4*)(SSQ + (size_t)mm * 64 + (lane >> 4) * 16);
            rp0[u][0] = p0[0]; rp0[u][1] = p0[1]; rp1[u][0] = p1[0]; rp1[u][1] = p1[1]; rb[u][0] = pb[0]; rb[u][1] = pb[1]; rs[u][0] = ps[0]; rs[u][1] = ps[1];
#pragma unroll
            for (int j = 0; j < 4; ++j) rq[u][j] = sp[j]; }
#pragma unroll
        for (int u = 0; u < 2; ++u) { const int mm = m + u * mstep; if (mm >= NTOK) break;
            float o0[16], o1[16], d[16];
            unpack8(rp0[u][0], o0); unpack8(rp0[u][1], o0 + 8); unpack8(rp1[u][0], o1); unpack8(rp1[u][1], o1 + 8);
            float ss = 0.f;
#pragma unroll
            for (int i = 0; i < 16; ++i) { d[i] = o0[i] - lam * o1[i]; ss += d[i] * d[i]; }
            ss = dpp_add(ss, 0); ss = dpp_add(ss, 1); ss = dpp_add(ss, 2);
            { const float r = 1.0f / sqrtf(ss * (1.0f / 128.0f) + LN_EPS);
#pragma unroll
              for (int i = 0; i < 16; ++i) d[i] = d[i] * r * dgr[i];
              GAS v4u* q = (GAS v4u*)(OA2 + (size_t)mm * 1024 + 16 * lane); q[0] = pack8(d); q[1] = pack8(d + 8); }
            unpack8(rb[u][0], o0); unpack8(rb[u][1], o0 + 8); unpack8(rs[u][0], o1); unpack8(rs[u][1], o1 + 8);
            { float sq = 0.f;
#pragma unroll
              for (int j = 0; j < 4; ++j) { const f32x4 v = rq[u][j]; sq += v.x; sq += v.y; sq += v.z; sq += v.w; }
              const float r = 1.0f / sqrtf(sq * (1.0f / 256.0f) + LN_EPS);
#pragma unroll
              for (int i = 0; i < 16; ++i) d[i] = o0[i] * r * ggr[i] * o1[i];
              GAS v4u* q = (GAS v4u*)(OB2 + (size_t)mm * 1024 + 16 * lane); q[0] = pack8(d); q[1] = pack8(d + 8); } }
    }
}
struct MoeOrder {
    const LAS int* BASE; int total4, G, c;
    __device__ __forceinline__ bool next(int i, pg8::Unit& u) const {
        const int Lx = i * G + c; if (Lx >= total4) return false;
        const int rt = Lx >> 2, pn = Lx & 3; int e = 0;
        for (int j = 1; j < 32; ++j) if (BASE[j] <= rt) e = j;
        e = __builtin_amdgcn_readfirstlane(e);
        u.pm = rt; u.pn = pn; u.pb = e * 4 + pn; return true;
    }
};

#ifndef PHMASK
#define PHMASK 0xFFFF
#endif
#ifndef REPMASK
#define REPMASK 0
#endif
#define REP(bit) for (int rep_ = 0; rep_ < ((REPMASK & (bit)) ? 2 : 1); ++rep_)
struct Args { const float* in[28]; float* out; unsigned char* ws; };
__global__ void __launch_bounds__(NTHREADS, 2) mk_fwd(Args args) {
    extern __shared__ __attribute__((aligned(16))) unsigned char lds[];
    Frame F;
    F.lds = (LAS unsigned char*)lds;
    F.tid = threadIdx.x; F.lane = F.tid & 63; F.wave = __builtin_amdgcn_readfirstlane(F.tid >> 6);
    F.G = gridDim.x; { const int bx = blockIdx.x; F.vcu = (F.G % 8 == 0) ? (bx % 8) * (F.G / 8) + bx / 8 : bx; }
    F.out = args.out; F.ws = args.ws; F.ctl = (gu32*)(args.ws + WS_CTL); F.prm = (const float*)(args.ws + WS_PRM);
    unsigned char* ws = args.ws;
    for (int u = F.tid; u < (LDS_BYTES - LDSCTL_OFF) / 4; u += NTHREADS) ((LAS unsigned*)(F.lds + LDSCTL_OFF))[u] = 0u;
    __syncthreads();
    volatile LAS unsigned* MISC = (volatile LAS unsigned*)(F.lds + MISC_OFF);
    XcdBarrier bar = xcd_barrier_post((unsigned*)(F.ctl + CW_BAR), MISC + 8);
    if ((REPMASK & 16384) && threadIdx.x == 0) MISC[21] = (unsigned)rt();
#ifndef BARSEL
#define BARSEL 0xFFF
#endif
#ifndef PSEL
#define PSEL 0
#endif
#ifndef DRYLVL
#define DRYLVL 1
#endif
#ifndef GLAV
#define GLAV 0
#endif
#ifndef G5_PAIR
#define G5_PAIR 1
#endif
#ifndef GLA_TWO_PHASE
#define GLA_TWO_PHASE 1
#endif
#define GRID_BAR(id_) do { const unsigned long long tb0_ = (REPMASK & (8192 | 16384)) ? rt() : 0ull; \
        if ((REPMASK & 16384) && ((PSEL >> (id_)) & 1) && threadIdx.x == 0) MISC[20] += (unsigned)tb0_ - MISC[21];     \
        GAS unsigned char* bw_ = (GAS unsigned char*)args.ws; asm volatile("" : "+s"(bw_)); unsigned bx_ = bar.x; asm volatile("" : "+s"(bx_)); XcdBarrier b_ = bar; b_.x = bx_; b_.bar = (unsigned*)(bw_ + WS_CTL) + CW_BAR; xcd_barrier(b_); if (REPMASK & 4096) xcd_barrier(b_); \
        if ((REPMASK & 8192) && ((BARSEL >> (id_)) & 1) && threadIdx.x == 0) MISC[20] += (unsigned)(rt() - tb0_); if ((REPMASK & 16384) && threadIdx.x == 0) MISC[21] = (unsigned)rt(); } while (0)
#define PHASE_ENTER() do { int t_ = threadIdx.x; asm volatile("" : "+v"(t_)); F.tid = t_; F.lane = t_ & 63; F.wave = __builtin_amdgcn_readfirstlane(t_ >> 6); \
        GAS unsigned char* w_ = (GAS unsigned char*)args.ws; GAS float* o_ = (GAS float*)args.out; asm volatile("" : "+s"(w_), "+s"(o_));   \
        F.ws = (unsigned char*)w_; F.out = (float*)o_; ws = (unsigned char*)w_; F.ctl = (gu32*)(w_ + WS_CTL); F.prm = (const float*)(w_ + WS_PRM); F.xst = (float*)o_; F.Ubuf = (bf16*)(w_ + WS_U); F.LAbuf = (float*)(w_ + WS_LA); F.dry = 0; } while (0)
    typedef pg8::bf16_t pb;
    REP(1) if (PHMASK & 1) { PHASE_ENTER(); p0_ada(F, args.in[I_C], args.in[I_WADA], args.in[I_BADA]);
        __syncthreads();
        p0_weights(F, args.in[I_WIN], args.in[I_WBA], args.in[I_WBB], args.in[I_WOUT], args.in[I_WGE], args.in[I_WUE], args.in[I_WDE], args.in[I_WRG], args.in[I_WRE],
                   SmallPrm{args.in[I_BGATES], args.in[I_WALPHA], args.in[I_BALPHA], args.in[I_LQ1], args.in[I_LK1], args.in[I_LQ2], args.in[I_LK2], args.in[I_DIFFG], args.in[I_GLAG], args.in[I_LN1G], args.in[I_LN1B], args.in[I_BRG], args.in[I_BRE], args.in[I_LN2G], args.in[I_LN2B]}); __syncthreads(); }
    GRID_BAR(0);
    REP(2) if (PHMASK & 2) { PHASE_ENTER(); phase_r0(F, args.in[I_X]); }
    GRID_BAR(1);
    for (int l = 0; l < DEPTH; ++l) {
        REP(4) if (PHMASK & 4) { PHASE_ENTER(); pg8::Gemm g{(const pb*)(ws + WS_U), (const pb*)(ws + WS_WIN) + (size_t)l * NPROJ * 1024, NTOK, NPROJ, 1024}; pg8::StaticOrder S; S.init(NTOK, NPROJ, F.G, (int)blockIdx.x);
          pg8::EpiProj E{(pb*)(ws + WS_QB), (pb*)(ws + WS_KB), (pb*)(ws + WS_VB), (pb*)(ws + WS_GQ), (pb*)(ws + WS_GK), (pb*)(ws + WS_GV), (pb*)(ws + WS_SG), (pb*)(ws + WS_GT), F.prm + PO_BGATES + l * 2048};
          pg8::gemm_phase<pg8::EpiProj, pg8::StaticOrder, true, false>(F.lds + RING_OFF, g, S, E, nullptr); }
        GRID_BAR(2);
#if GLA_TWO_PHASE
        if (PHMASK & 8) { PHASE_ENTER(); phase_gla_a(F); }
        GRID_BAR(12);
        REP(8) if (PHMASK & 8) { PHASE_ENTER(); phase_gla_b(F, ((REPMASK & 8) && rep_ == 0) ? GLAV : 0); }
#else
        REP(8) if (PHMASK & 8) { PHASE_ENTER(); phase_gla(F, ((REPMASK & 8) && rep_ == 0) ? GLAV : 0); }
#endif
        GRID_BAR(3);
        REP(16) if (PHMASK & 16) { PHASE_ENTER(); const attn_body::AttnTensors AT{(const attn_body::bf16*)(ws + WS_QB), (const attn_body::bf16*)(ws + WS_KB), (const attn_body::bf16*)(ws + WS_VB), (attn_body::bf16*)(ws + WS_OP)};
          attn_body::attn_phase<20>((char*)lds + RING_OFF, AT, (unsigned*)(F.ctl + CW_ATQ + (l * 2 + ((REPMASK & 16) ? rep_ : 0)) * 64), MISC + 16); }
        GRID_BAR(4);
        REP(32) if (PHMASK & 32) { PHASE_ENTER(); phase_post(F, l); }
        GRID_BAR(5);
#if G5_PAIR
        REP(64) if (PHMASK & 64) { PHASE_ENTER(); pg8::PairOrder S; S.S.init(NTOK, 1024, F.G, (int)blockIdx.x);
          static_assert(WS_OB2 == WS_OA2 + (size_t)NTOK * 1024 * 2 && WS_WBB == WS_WBA + 16 * 256 * 1024 * 2, "stacked A / B views of the two branch GEMMs");
          pg8::Gemm g{(const pb*)(ws + WS_OA2), (const pb*)(ws + WS_WBA) + (size_t)l * 1024 * 1024, 2 * NTOK, 1024, 1024};
          pg8::EpiGatePair E{(pb*)(ws + WS_TMP), (long)((WS_MIX - WS_TMP) / 2), (const pb*)(ws + WS_GT)};
          pg8::gemm_phase<pg8::EpiGatePair, pg8::PairOrder, true, false>(F.lds + RING_OFF, g, S, E, nullptr); }
#else
        REP(64) if (PHMASK & 64) { PHASE_ENTER(); pg8::StaticOrder S; S.init(NTOK, 1024, F.G, (int)blockIdx.x);
          { pg8::Gemm g{(const pb*)(ws + WS_OA2), (const pb*)(ws + WS_WBA) + (size_t)l * 1024 * 1024, NTOK, 1024, 1024};
            pg8::EpiGate<0> E{(pb*)(ws + WS_TMP), 1024, nullptr, (const pb*)(ws + WS_GT), 2048, 0};
            pg8::gemm_phase<pg8::EpiGate<0>, pg8::StaticOrder, true, false>(F.lds + RING_OFF, g, S, E, nullptr); }
          { pg8::Gemm g{(const pb*)(ws + WS_OB2), (const pb*)(ws + WS_WBB) + (size_t)l * 1024 * 1024, NTOK, 1024, 1024};
            pg8::EpiGate<1> E{(pb*)(ws + WS_MIX), 1024, (const pb*)(ws + WS_TMP), (const pb*)(ws + WS_GT), 2048, 1024};
            pg8::gemm_phase<pg8::EpiGate<1>, pg8::StaticOrder, true, false>(F.lds + RING_OFF, g, S, E, nullptr); } }
#endif
        GRID_BAR(6);
        if (PHMASK & 128) { PHASE_ENTER(); pg8::Gemm g{(const pb*)(ws + WS_MIX), (const pb*)(ws + WS_WOUT) + (size_t)l * 1024 * 1024, NTOK, 1024, 1024}; pg8::StaticOrder S; S.init(NTOK, 1024, F.G, (int)blockIdx.x);
          REP(128) { pg8::EpiResid E{F.out, ((REPMASK & 128) && rep_ == 0) ? (float*)(ws + WS_QB) : F.out, (const float*)(ws + WS_ADA) + (size_t)l * 8 * 6144 + 2 * 1024, 6144, DN_ALPHA};
          pg8::gemm_phase<pg8::EpiResid, pg8::StaticOrder, true, false>(F.lds + RING_OFF, g, S, E, nullptr); } }
        GRID_BAR(7);
        REP(256) if (PHMASK & 256) { PHASE_ENTER(); if ((REPMASK & 256) && rep_ == 0) { F.dry = DRYLVL; F.xst = (float*)(ws + WS_QB); F.Ubuf = (bf16*)(ws + WS_VB); } phase_r1(F, l); }
        GRID_BAR(8);
        if (PHMASK & 512) { PHASE_ENTER(); moe_tables(F, l); }
        if (PHMASK & 512) { const LAS int* BASE = (const LAS int*)(F.lds + TAB_BASE); const LAS int* CNT = (const LAS int*)(F.lds + TAB_CNT); LAS int* IDX = (LAS int*)(F.lds + TAB_IDX);
          const int total4 = __builtin_amdgcn_readfirstlane(BASE[32]) * 4; const int* LIST = (const int*)(ws + WS_LIST);
          MoeOrder S{BASE, total4, F.G, (int)blockIdx.x};
          for (int ui = 0; ui < IDX_UNITS; ++ui) { pg8::Unit u; if (!S.next(ui, u)) break; const int e = u.pb >> 2;
              if (F.tid < 256) { const int pos = (u.pm - BASE[e]) * 256 + F.tid; IDX[ui * 256 + F.tid] = (pos < CNT[e]) ? LIST[(size_t)e * LISTCAP + pos] : 0; } }
          __syncthreads();
          REP(512) { pg8::Gemm g{(const pb*)(ws + WS_U), (const pb*)(ws + WS_W1) + (size_t)l * 32 * 1024 * 1024, MOE_MAXT * 256, 1024, 1024};
            pg8::EpiSwiGLU E{(pb*)(ws + WS_H)};
            pg8::gemm_phase<pg8::EpiSwiGLU, MoeOrder, true, true>(F.lds + RING_OFF, g, S, E, IDX); }
          GRID_BAR(9);
          PHASE_ENTER();
          REP(2048) { pg8::Gemm g{(const pb*)(ws + WS_H), (const pb*)(ws + WS_WD) + (size_t)l * 32 * 1024 * 512, MOE_MAXT * 256, 1024, 512};
            pg8::EpiGate<2> E{(pb*)(ws + WS_YB), 1024, nullptr, nullptr, 0, 0};
            pg8::gemm_phase<pg8::EpiGate<2>, MoeOrder, true, false>(F.lds + RING_OFF, g, S, E, nullptr); }
        }
        GRID_BAR(10);
        REP(1024) if (PHMASK & 1024) { PHASE_ENTER(); if ((REPMASK & 1024) && rep_ == 0) { F.dry = DRYLVL; F.xst = (float*)(ws + WS_GT); F.Ubuf = (bf16*)(ws + WS_SG); F.LAbuf = (float*)(ws + WS_GV); } phase_r2(F, l); }
        if (l + 1 < DEPTH) GRID_BAR(11);
    }
    if ((REPMASK & 16384) && ((PSEL >> 11) & 1) && threadIdx.x == 0) MISC[20] += (unsigned)rt() - MISC[21];
    if ((REPMASK & (8192 | 16384)) && blockIdx.x == 0 && threadIdx.x == 0) { const unsigned tw_ = MISC[20]; const unsigned long long ts_ = rt(); while ((unsigned)(rt() - ts_) < tw_) __builtin_amdgcn_s_sleep(8); }
}

extern "C" void kernel_launch(void* const* d_in, const int* in_sizes, int n_in, void* d_out, int out_size, void* d_ws, size_t ws_size, hipStream_t stream) {
    static int grid = 0;
    if (grid == 0) {
        if (n_in != 28 || in_sizes[0] != NTOK * DM || out_size != NTOK * DM || ws_size < WS_END) { fprintf(stderr, "kernel_launch: unexpected shapes (n_in %d, in0 %d, out %d, ws %zu < %zu); nothing launched\n", n_in, n_in > 0 ? in_sizes[0] : -1, out_size, ws_size, (size_t)WS_END); grid = -1; return; }
        int dev = 0, cus = 0, per_cu = 0;
        if (hipGetDevice(&dev) != hipSuccess || hipDeviceGetAttribute(&cus, hipDeviceAttributeMultiprocessorCount, dev) != hipSuccess) { fprintf(stderr, "kernel_launch: device query failed\n"); grid = -1; return; }
        if (hipFuncSetAttribute((const void*)mk_fwd, hipFuncAttributeMaxDynamicSharedMemorySize, LDS_BYTES) != hipSuccess) { fprintf(stderr, "kernel_launch: hipFuncSetAttribute failed\n"); grid = -1; return; }
        if (hipOccupancyMaxActiveBlocksPerMultiprocessor(&per_cu, (const void*)mk_fwd, NTHREADS, LDS_BYTES) != hipSuccess || per_cu < 1) { fprintf(stderr, "kernel_launch: occupancy query says %d\n", per_cu); }
        (void)hipGetLastError();
        grid = cus;
    }
    if (grid < 0) return;
    if (hipMemsetAsync((char*)d_ws + WS_CTL, 0, CTL_ZERO_BYTES, stream) != hipSuccess) { fprintf(stderr, "kernel_launch: memset failed\n"); return; }
    Args a{};
    for (int i = 0; i < 28; ++i) a.in[i] = (const float*)d_in[i];
    a.out = (float*)d_out; a.ws = (unsigned char*)d_ws;
    hipLaunchKernelGGL(mk_fwd, dim3(grid), dim3(NTHREADS), LDS_BYTES, stream, a);
    const hipError_t le = hipPeekAtLastError();
    if (le != hipSuccess) fprintf(stderr, "kernel_launch: launch failed: %s\n", hipGetErrorName(le));
}
```
